# Optimizing an MI355X kernel written in HIP

```python
import math
import jax
import jax.numpy as jnp
from jax import lax
import numpy as np

D_MODEL = 1024
BATCH = 8
SEQ = 4096
DEPTH = 4

GRID_W = 64
N_MEM = 256
HEAD_DIM = 64
MIX_WIDTH = D_MODEL
POOL_WIDTH = MIX_WIDTH // 4
POOL_WINDOWS = (2, 4, 8, 16)
POOL_GROUP = POOL_WIDTH // len(POOL_WINDOWS)
MLSTM_WIDTH = MIX_WIDTH // 4
MLSTM_HEADS = MLSTM_WIDTH // HEAD_DIM
MLSTM_CHUNK = 128
MLSTM_CONV = 5
ATTN_Q_WIDTH = MIX_WIDTH // 2
ATTN_Q_HEADS = ATTN_Q_WIDTH // HEAD_DIM
ATTN_KV_HEADS = ATTN_Q_HEADS // 4
ATTN_KV_WIDTH = ATTN_KV_HEADS * HEAD_DIM
Q_BLOCK = 128
ROPE_THETA = 10000.0
IN_SPLITS = (POOL_WIDTH, MLSTM_WIDTH, MLSTM_WIDTH, MLSTM_WIDTH, MLSTM_WIDTH,
             2 * MLSTM_HEADS, 2 * MLSTM_HEADS, ATTN_Q_WIDTH, ATTN_KV_WIDTH, ATTN_KV_WIDTH)
IN_COLS = sum(IN_SPLITS)
CA_HEADS = 4
CA_WIDTH = D_MODEL // 2
CA_HEAD_DIM = CA_WIDTH // CA_HEADS
N_EXPERTS = 16
EC_CAPACITY_FACTOR = 2
D_FF_EXPERT = 2 * D_MODEL
EPS = 1e-6

kernel_name = 'hybrid_pool_mlstm_gqa_ec_encoder'

F32 = jnp.float32


def rmsnorm(x, g):
    xf = x.astype(F32)
    y = xf * lax.rsqrt(jnp.mean(xf * xf, axis=-1, keepdims=True) + EPS)
    return (y * g.astype(F32)).astype(x.dtype)


def head_rmsnorm(a, g):
    af = a.astype(F32)
    return af * lax.rsqrt(jnp.mean(af * af, axis=-1, keepdims=True) + EPS) * g.astype(F32)


def axial_rope_tables(s):
    rows = s // GRID_W
    row_ids = jnp.repeat(jnp.arange(rows), GRID_W).astype(F32)
    col_ids = jnp.tile(jnp.arange(GRID_W), rows).astype(F32)
    n_freq = HEAD_DIM // 4
    inv_freq = ROPE_THETA ** (-jnp.arange(n_freq, dtype=F32) / n_freq)
    ang = jnp.concatenate([row_ids[:, None] * inv_freq, col_ids[:, None] * inv_freq], axis=-1)
    return jnp.cos(ang), jnp.sin(ang)


def apply_rope(a, cos, sin):
    a2 = a.reshape(*a.shape[:-1], HEAD_DIM // 2, 2)
    x0, x1 = a2[..., 0], a2[..., 1]
    c = cos[None, :, None, :]
    sn = sin[None, :, None, :]
    return jnp.stack([x0 * c - x1 * sn, x0 * sn + x1 * c], axis=-1).reshape(a.shape)


def pool_mixer(u, w, scale):
    b, s, _ = u.shape
    uf = u.astype(F32)
    cs = jnp.concatenate([jnp.zeros((b, 1, POOL_WIDTH), F32), jnp.cumsum(uf, axis=1)], axis=1)
    t = jnp.arange(s)
    diffs = []
    for g, win in enumerate(POOL_WINDOWS):
        lo = jnp.clip(t - win // 2, 0, s)
        hi = jnp.clip(t + win // 2, 0, s)
        c0 = g * POOL_GROUP
        csg = cs[:, :, c0:c0 + POOL_GROUP]
        mean = (csg[:, hi] - csg[:, lo]) / (hi - lo).astype(F32)[None, :, None]
        diffs.append(mean - uf[:, :, c0:c0 + POOL_GROUP])
    d = jnp.stack(diffs, axis=2)
    y = jnp.einsum('bsgc,gce->bsge', d, w.astype(F32)).reshape(b, s, POOL_WIDTH)
    return (y * scale.astype(F32)).astype(u.dtype)


def mlstm_scan(q, k, v, log_i, log_f):
    b, h, s, dh = q.shape
    nc = s // MLSTM_CHUNK

    def chunks(a):
        a = a.reshape(b, h, nc, MLSTM_CHUNK, *a.shape[3:])
        return jnp.moveaxis(a, 2, 0)

    lower = jnp.tril(jnp.ones((MLSTM_CHUNK, MLSTM_CHUNK), dtype=bool))

    def step(carry, inp):
        c_st, n_st, m_st = carry
        qc, kc, vc, li, lf = inp
        bcum = jnp.cumsum(lf, axis=-1)
        dmat = jnp.where(lower, bcum[..., :, None] - bcum[..., None, :] + li[..., None, :], -jnp.inf)
        inter = bcum + m_st[..., None]
        m_j = jnp.maximum(inter, jnp.max(dmat, axis=-1))
        a_mat = jnp.exp(dmat - m_j[..., None]) * jnp.einsum('bhjd,bhsd->bhjs', qc, kc)
        a_int = jnp.exp(inter - m_j)
        num = (jnp.einsum('bhjs,bhse->bhje', a_mat, vc)
               + a_int[..., None] * jnp.einsum('bhed,bhjd->bhje', c_st, qc))
        den = jnp.sum(a_mat, axis=-1) + a_int * jnp.einsum('bhd,bhjd->bhj', n_st, qc)
        h_out = num / jnp.maximum(jnp.abs(den), jnp.exp(-m_j))[..., None]
        b_last = bcum[..., -1]
        g = b_last[..., None] - bcum + li
        m_new = jnp.maximum(b_last + m_st, jnp.max(g, axis=-1))
        w_s = jnp.exp(g - m_new[..., None])
        decay = jnp.exp(b_last + m_st - m_new)
        c_new = decay[..., None, None] * c_st + jnp.einsum('bhs,bhse,bhsd->bhed', w_s, vc, kc)
        n_new = decay[..., None] * n_st + jnp.einsum('bhs,bhsd->bhd', w_s, kc)
        return (c_new, n_new, m_new), h_out

    init = (jnp.zeros((b, h, dh, dh), F32), jnp.zeros((b, h, dh), F32), jnp.zeros((b, h), F32))
    _, hs = lax.scan(step, init, (chunks(q), chunks(k), chunks(v), chunks(log_i), chunks(log_f)))
    return jnp.moveaxis(hs, 0, 2).reshape(b, h, s, dh)


def mlstm_mixer(q, k, v, o, i_pre, f_pre, conv_w, norm_g):
    b, s, _ = q.shape
    qk = jnp.concatenate([q, k], axis=-1)
    qk = lax.conv_general_dilated(qk, conv_w[:, None, :].astype(qk.dtype), window_strides=(1,),
                                  padding=[(MLSTM_CONV // 2, MLSTM_CONV // 2)],
                                  dimension_numbers=('NWC', 'WIO', 'NWC'),
                                  feature_group_count=2 * MLSTM_WIDTH)
    qk = jax.nn.silu(qk)
    q, k = jnp.split(qk, 2, axis=-1)

    def heads(a):
        return a.astype(F32).reshape(b, s, MLSTM_HEADS, HEAD_DIM).transpose(0, 2, 1, 3)

    qh, kh, vh = heads(q), heads(k) / math.sqrt(HEAD_DIM), heads(v)
    log_i = i_pre.astype(F32).reshape(b, s, 2, MLSTM_HEADS).transpose(2, 0, 3, 1)
    log_f = jax.nn.log_sigmoid(f_pre.astype(F32)).reshape(b, s, 2, MLSTM_HEADS).transpose(2, 0, 3, 1)
    flip = lambda a: jnp.flip(a, axis=2)
    h_fwd = mlstm_scan(qh, kh, vh, log_i[0], log_f[0])
    h_bwd = flip(mlstm_scan(flip(qh), flip(kh), flip(vh), flip(log_i[1]), flip(log_f[1])))
    hsum = h_fwd + h_bwd
    hsum = hsum * lax.rsqrt(jnp.mean(hsum * hsum, axis=-1, keepdims=True) + EPS)
    hsum = hsum.transpose(0, 2, 1, 3).reshape(b, s, MLSTM_WIDTH) * norm_g.astype(F32)
    return (hsum * jax.nn.sigmoid(o.astype(F32))).astype(q.dtype)


def attn_mixer(q, k, v, qn_g, kn_g, cos, sin):
    b, s, _ = q.shape
    group = ATTN_Q_HEADS // ATTN_KV_HEADS
    qh = apply_rope(head_rmsnorm(q.reshape(b, s, ATTN_Q_HEADS, HEAD_DIM), qn_g), cos, sin)
    kh = apply_rope(head_rmsnorm(k.reshape(b, s, ATTN_KV_HEADS, HEAD_DIM), kn_g), cos, sin)
    qh = (qh * HEAD_DIM ** -0.5).astype(q.dtype)
    kh = kh.astype(k.dtype).transpose(0, 2, 1, 3)
    vh = v.reshape(b, s, ATTN_KV_HEADS, HEAD_DIM).transpose(0, 2, 1, 3)
    nb = s // Q_BLOCK
    qb = qh.reshape(b, nb, Q_BLOCK, ATTN_KV_HEADS, group, HEAD_DIM).transpose(1, 0, 3, 4, 2, 5)

    def block(qi):
        sc = jnp.einsum('bhgqd,bhkd->bhgqk', qi, kh, preferred_element_type=F32)
        p = jax.nn.softmax(sc, axis=-1).astype(vh.dtype)
        return jnp.einsum('bhgqk,bhkd->bhgqd', p, vh)

    ob = lax.map(block, qb)
    return ob.transpose(1, 0, 4, 2, 3, 5).reshape(b, s, ATTN_Q_WIDTH)


def mem_cross_attn(hn, mem, wq, wkv, wo):
    b, s, _ = hn.shape
    q = (hn @ wq).reshape(b, s, CA_HEADS, CA_HEAD_DIM)
    kv = (mem @ wkv).reshape(b, mem.shape[1], 2, CA_HEADS, CA_HEAD_DIM)
    sc = jnp.einsum('bshd,bmhd->bhsm', q, kv[:, :, 0], preferred_element_type=F32) * CA_HEAD_DIM ** -0.5
    p = jax.nn.softmax(sc, axis=-1).astype(hn.dtype)
    o = jnp.einsum('bhsm,bmhd->bshd', p, kv[:, :, 1]).reshape(b, s, CA_WIDTH)
    return o @ wo


def ec_moe(h, router_w, w_gu, w_down):
    b, n, d = h.shape
    cap = EC_CAPACITY_FACTOR * n // N_EXPERTS
    logits = jnp.einsum('bnd,de->bne', h, router_w, preferred_element_type=F32)
    aff = jax.nn.softmax(logits, axis=-1)
    gates, idx = lax.top_k(jnp.swapaxes(aff, 1, 2), cap)
    xs = jax.vmap(lambda hb, ib: hb[ib])(h, idx)

    def expert(args):
        xe, wgu, wd = args
        gu = jnp.einsum('bcd,df->bcf', xe, wgu)
        ga, up = jnp.split(gu, 2, axis=-1)
        return jnp.einsum('bcf,fd->bcd', jax.nn.silu(ga) * up, wd)

    ys = lax.map(expert, (jnp.swapaxes(xs, 0, 1), w_gu, w_down))
    ys = jnp.swapaxes(ys, 0, 1) * gates[..., None].astype(ys.dtype)
    return jax.vmap(lambda ib, yb: jnp.zeros((n, d), yb.dtype).at[ib.reshape(-1)].add(yb.reshape(-1, d)))(idx, ys)


def setup_inputs(seed: int = 0) -> dict:
    key = jax.random.key(seed)
    ks = jax.random.split(key, 24)
    nrm = lambda k, shape, scale: jax.random.normal(k, shape, F32) * scale
    gain = lambda k, shape: 1.0 + 0.05 * jax.random.normal(k, shape, F32)
    gate_b = jnp.concatenate([nrm(ks[7], (DEPTH, 2 * MLSTM_HEADS), 0.1),
                              3.0 + nrm(ks[8], (DEPTH, 2 * MLSTM_HEADS), 0.5)], axis=-1)
    return {
        'x': nrm(ks[0], (BATCH, SEQ, D_MODEL), 1.0),
        'mem': nrm(ks[1], (BATCH, N_MEM, D_MODEL), 1.0),
        'norm_mix_g': gain(ks[2], (DEPTH, D_MODEL)),
        'w_in': nrm(ks[3], (DEPTH, D_MODEL, IN_COLS), D_MODEL ** -0.5),
        'pool_w': nrm(ks[4], (DEPTH, len(POOL_WINDOWS), POOL_GROUP, POOL_GROUP), POOL_GROUP ** -0.5),
        'pool_scale': gain(ks[5], (DEPTH, POOL_WIDTH)),
        'mlstm_conv_w': nrm(ks[6], (DEPTH, MLSTM_CONV, 2 * MLSTM_WIDTH), MLSTM_CONV ** -0.5),
        'mlstm_gate_b': gate_b,
        'mlstm_norm_g': gain(ks[9], (DEPTH, MLSTM_WIDTH)),
        'q_norm_g': gain(ks[10], (DEPTH, HEAD_DIM)),
        'k_norm_g': gain(ks[11], (DEPTH, HEAD_DIM)),
        'w_out': nrm(ks[12], (DEPTH, MIX_WIDTH, D_MODEL), MIX_WIDTH ** -0.5),
        'norm_mem_g': gain(ks[13], (DEPTH, D_MODEL)),
        'ca_wq': nrm(ks[14], (DEPTH, D_MODEL, CA_WIDTH), D_MODEL ** -0.5),
        'ca_wkv': nrm(ks[15], (DEPTH, D_MODEL, 2 * CA_WIDTH), D_MODEL ** -0.5),
        'ca_wo': nrm(ks[16], (DEPTH, CA_WIDTH, D_MODEL), CA_WIDTH ** -0.5),
        'norm_ffn_g': gain(ks[17], (DEPTH, D_MODEL)),
        'router_w': nrm(ks[18], (DEPTH, D_MODEL, N_EXPERTS), D_MODEL ** -0.5),
        'expert_w_gu': nrm(ks[19], (DEPTH, N_EXPERTS, D_MODEL, 2 * D_FF_EXPERT), D_MODEL ** -0.5),
        'expert_w_down': nrm(ks[20], (DEPTH, N_EXPERTS, D_FF_EXPERT, D_MODEL), D_FF_EXPERT ** -0.5),
        'final_norm_g': gain(ks[21], (D_MODEL,)),
    }


def reference(x, mem, norm_mix_g, w_in, pool_w, pool_scale, mlstm_conv_w, mlstm_gate_b,
              mlstm_norm_g, q_norm_g, k_norm_g, w_out, norm_mem_g, ca_wq, ca_wkv, ca_wo,
              norm_ffn_g, router_w, expert_w_gu, expert_w_down, final_norm_g):
    s = x.shape[1]
    cos, sin = axial_rope_tables(s)
    offsets = np.cumsum(IN_SPLITS)[:-1].tolist()
    n_gate = 2 * MLSTM_HEADS
    for layer in range(DEPTH):
        hn = rmsnorm(x, norm_mix_g[layer])
        proj = hn @ w_in[layer]
        u_pool, m_q, m_k, m_v, m_o, m_i, m_f, a_q, a_k, a_v = jnp.split(proj, offsets, axis=-1)
        gb = mlstm_gate_b[layer]
        y_pool = pool_mixer(u_pool, pool_w[layer], pool_scale[layer])
        y_mlstm = mlstm_mixer(m_q, m_k, m_v, m_o, m_i + gb[:n_gate], m_f + gb[n_gate:],
                              mlstm_conv_w[layer], mlstm_norm_g[layer])
        y_attn = attn_mixer(a_q, a_k, a_v, q_norm_g[layer], k_norm_g[layer], cos, sin)
        x = x + jnp.concatenate([y_pool, y_mlstm, y_attn], axis=-1) @ w_out[layer]
        x = x + mem_cross_attn(rmsnorm(x, norm_mem_g[layer]), mem, ca_wq[layer], ca_wkv[layer], ca_wo[layer])
        x = x + ec_moe(rmsnorm(x, norm_ffn_g[layer]), router_w[layer], expert_w_gu[layer], expert_w_down[layer])
    return rmsnorm(x, final_norm_g)
```

```cpp
#include <hip/hip_runtime.h>
#include <hip/hip_bf16.h>
#include <cstdio>
#include <cstdint>
#include <cmath>
__device__ __forceinline__ int opaque_tid() { int t = (int)threadIdx.x; asm volatile("" : "+v"(t)); return t; }
namespace pg8 {
#define PG8_LAS __attribute__((address_space(3)))
typedef unsigned short bf16_t;
typedef short bf16x8 __attribute__((ext_vector_type(8)));
typedef float f32x4 __attribute__((ext_vector_type(4)));
typedef unsigned u32x4 __attribute__((ext_vector_type(4)));
constexpr int BM = 256, BK = 64, HALF = 128, HTB = HALF * BK * 2  , STAGE_BYTES = 8 * HTB, NXCD = 8, WGM = 8;

__host__ __device__ __forceinline__ int lds_byte(int r, int c) { const int st = (r >> 4) * 2 + (c >> 5), rr = r & 15, cc = c & 31, ob = rr * 64 + cc * 2; return st * 1024 + (ob ^ (((ob >> 9) & 1) << 5)); }
__host__ __device__ __forceinline__ void stage_rc(int b, int& R, int& C) { const int st = b / 1024, sb = b % 1024, swz = sb ^ (((sb >> 9) & 1) << 5); R = (st >> 1) * 16 + swz / 64; C = (st & 1) * 32 + (swz % 64) / 2; }
__host__ __device__ __forceinline__ int perm32(int rho) { const int n = rho >> 4, i = rho & 15; return 8 * (i >> 2) + 4 * n + (i & 3); }

struct Unit { int pm, pn, e; };
struct Gemm { const bf16_t* A; const bf16_t* Bt; int K; long sAe, sBe; const int* gidx; int rowsPerE; };

struct Sched {
    int nM, nN, P, total, G, c;
    __device__ __forceinline__ void init(int nM_, int nN_, int nE_, int G_, int c_) { nM = nM_; nN = nN_; P = nM_ * nN_; total = P * nE_; G = G_; c = c_; }
    __device__ __forceinline__ bool next(int i, Unit& u) const {
        const long L = (long)i * G + c; if (L >= total) return false;
        const int e = (int)(L / P); int wgid = (int)(L % P);
        { const int q = P / NXCD, r = P % NXCD, xcd = wgid % NXCD, off = wgid / NXCD; wgid = (xcd < r ? xcd * (q + 1) : r * (q + 1) + (xcd - r) * q) + off; }
        const int nig = WGM * nN, gid = wgid / nig, fm = gid * WGM, gsz = (nM - fm) < WGM ? (nM - fm) : WGM;
        u.pm = fm + ((wgid % nig) % gsz); u.pn = (wgid % nig) / gsz; u.e = e; return true;
    }
};

__device__ __forceinline__ unsigned cvt_pk_bf16(float lo, float hi) { unsigned r; asm volatile("v_cvt_pk_bf16_f32 %0, %1, %2" : "=v"(r) : "v"(lo), "v"(hi)); return r; }

struct EpiBf16 {
    bf16_t* O; int ldc; long strideE; float scale;
    __device__ __forceinline__ void operator()(const f32x4 (&acc)[2][2][4][2], const Unit& u, int wr, int wc, int fr, int fq) const {
        const int row0 = u.pm * BM + wr * 64 + fr; const int col0 = u.pn * BM + wc * 32 + 8 * fq; bf16_t* base = O + (long)u.e * strideE;
#pragma unroll
        for (int ai = 0; ai < 2; ++ai)
#pragma unroll
            for (int m = 0; m < 4; ++m) { bf16_t* rowp = base + (size_t)(row0 + ai * HALF + m * 16) * ldc + col0;
#pragma unroll
                for (int bj = 0; bj < 2; ++bj) { const f32x4 v0 = acc[ai][bj][m][0] * scale, v1 = acc[ai][bj][m][1] * scale;
                    u32x4 w; w.x = cvt_pk_bf16(v0[0], v0[1]); w.y = cvt_pk_bf16(v0[2], v0[3]); w.z = cvt_pk_bf16(v1[0], v1[1]); w.w = cvt_pk_bf16(v1[2], v1[3]);
                    *(u32x4*)(rowp + bj * HALF) = w; } }
    }
};
struct EpiResid {
    const float* xin; float* xout; int ldc;
    __device__ __forceinline__ void operator()(const f32x4 (&acc)[2][2][4][2], const Unit& u, int wr, int wc, int fr, int fq) const {
        const int row0 = u.pm * BM + wr * 64 + fr; const int col0 = u.pn * BM + wc * 32 + 8 * fq;
#pragma unroll
        for (int ai = 0; ai < 2; ++ai)
#pragma unroll
            for (int m = 0; m < 4; ++m) { const size_t ro = (size_t)(row0 + ai * HALF + m * 16) * ldc + col0;
#pragma unroll
                for (int bj = 0; bj < 2; ++bj) { const f32x4 a0 = *(const f32x4*)(xin + ro + bj * HALF), a1 = *(const f32x4*)(xin + ro + bj * HALF + 4);
                    *(f32x4*)(xout + ro + bj * HALF) = a0 + acc[ai][bj][m][0]; *(f32x4*)(xout + ro + bj * HALF + 4) = a1 + acc[ai][bj][m][1]; } }
    }
};
__device__ __forceinline__ float silu_f(float x) { return x * __builtin_amdgcn_rcpf(1.0f + __builtin_amdgcn_exp2f(-1.4426950408889634f * x)); }
struct EpiSwiGLU {
    bf16_t* O; int ldc; int rowsPerE;
    __device__ __forceinline__ void operator()(const f32x4 (&acc)[2][2][4][2], const Unit& u, int wr, int wc, int fr, int fq) const {
        const int row0 = u.e * rowsPerE + u.pm * BM + wr * 64 + fr; const int col0 = u.pn * HALF + wc * 32 + 8 * fq;
#pragma unroll
        for (int ai = 0; ai < 2; ++ai)
#pragma unroll
            for (int m = 0; m < 4; ++m) { bf16_t* rowp = O + (size_t)(row0 + ai * HALF + m * 16) * ldc + col0;
                const f32x4 g0 = acc[ai][0][m][0], g1 = acc[ai][0][m][1], u0 = acc[ai][1][m][0], u1 = acc[ai][1][m][1];
                u32x4 w; w.x = cvt_pk_bf16(silu_f(g0[0]) * u0[0], silu_f(g0[1]) * u0[1]); w.y = cvt_pk_bf16(silu_f(g0[2]) * u0[2], silu_f(g0[3]) * u0[3]);
                w.z = cvt_pk_bf16(silu_f(g1[0]) * u1[0], silu_f(g1[1]) * u1[1]); w.w = cvt_pk_bf16(silu_f(g1[2]) * u1[2], silu_f(g1[3]) * u1[3]);
                *(u32x4*)rowp = w; }
    }
};
struct EpiDown {
    bf16_t* O; int ldc; int rowsPerE; const float* gate;
    __device__ __forceinline__ void operator()(const f32x4 (&acc)[2][2][4][2], const Unit& u, int wr, int wc, int fr, int fq) const {
        const int row0 = u.e * rowsPerE + u.pm * BM + wr * 64 + fr; const int col0 = u.pn * BM + wc * 32 + 8 * fq;
#pragma unroll
        for (int ai = 0; ai < 2; ++ai)
#pragma unroll
            for (int m = 0; m < 4; ++m) { const int row = row0 + ai * HALF + m * 16; const float gt = gate[row]; bf16_t* rowp = O + (size_t)row * ldc + col0;
#pragma unroll
                for (int bj = 0; bj < 2; ++bj) { const f32x4 v0 = acc[ai][bj][m][0] * gt, v1 = acc[ai][bj][m][1] * gt;
                    u32x4 w; w.x = cvt_pk_bf16(v0[0], v0[1]); w.y = cvt_pk_bf16(v0[2], v0[3]); w.z = cvt_pk_bf16(v1[0], v1[1]); w.w = cvt_pk_bf16(v1[2], v1[3]);
                    *(u32x4*)(rowp + bj * HALF) = w; } }
    }
};

template <class Epi, bool ALIGN_EPI, bool GATHER>
__device__ __forceinline__ void gemm_phase(PG8_LAS unsigned char* lds, const Gemm g, const Sched& S, const Epi& E) {
    const int tid = opaque_tid(), wid = __builtin_amdgcn_readfirstlane(tid >> 6), lane = tid & 63, wr = wid >> 2, wc = wid & 3, fr = lane & 15, fq = lane >> 4;
    const int K = g.K, nt = K / BK;
    int Rr[2], Cc[2]; unsigned voffB[2];
#pragma unroll
    for (int i = 0; i < 2; ++i) { stage_rc(tid * 16 + i * 8192, Rr[i], Cc[i]); const int Rb = (Rr[i] & ~31) + perm32(Rr[i] & 31); voffB[i] = (unsigned)(Rb * K + Cc[i]) * 2u; }
    const size_t kstep = (size_t)(BK * 2);
    const size_t hstep = (size_t)HALF * K * 2;
    const size_t tstep = 2 * hstep;
    const unsigned ldsw = (unsigned)wid * 1024u;
    const int aoff = lds_byte(wr * 64 + fr, fq * 8), boff = lds_byte(wc * 32 + fr, fq * 8);
#define PG8_SA(b, h) (((b) * 2 + (h)) * HTB)
#define PG8_SB(b, h) ((4 + (b) * 2 + (h)) * HTB)
#define PG8_STAGE(bufoff, gbase, voff) do { _Pragma("unroll") for (int _i = 0; _i < 2; ++_i) \
        __builtin_amdgcn_global_load_lds((const unsigned*)((const char*)(gbase) + (voff)[_i]), (PG8_LAS unsigned*)(lds + (bufoff) + ldsw + _i * 8192), 16, 0, 0); } while (0)
#define PG8_LDA(dst, b, h) do { _Pragma("unroll") for (int m = 0; m < 4; ++m) _Pragma("unroll") for (int k = 0; k < 2; ++k) dst[m][k] = *(const PG8_LAS bf16x8*)(lds + PG8_SA(b, h) + aoff + m * 2048 + k * 1024); } while (0)
#define PG8_LDB(dst, b, h) do { _Pragma("unroll") for (int n = 0; n < 2; ++n) _Pragma("unroll") for (int k = 0; k < 2; ++k) dst[n][k] = *(const PG8_LAS bf16x8*)(lds + PG8_SB(b, h) + boff + n * 2048 + k * 1024); } while (0)
#define PG8_MMA(ai, bj, At, Bt) do { __builtin_amdgcn_s_setprio(1); _Pragma("unroll") for (int m = 0; m < 4; ++m) _Pragma("unroll") for (int n = 0; n < 2; ++n) _Pragma("unroll") for (int k = 0; k < 2; ++k) \
        acc[ai][bj][m][n] = __builtin_amdgcn_mfma_f32_16x16x32_bf16(Bt[n][k], At[m][k], acc[ai][bj][m][n], 0, 0, 0); __builtin_amdgcn_s_setprio(0); } while (0)
#define PG8_WAIT_V(n) asm volatile("s_waitcnt vmcnt(" #n ")" ::: "memory")
#define PG8_WAIT_L(n) asm volatile("s_waitcnt lgkmcnt(" #n ")" ::: "memory")
#define PG8_BAR __builtin_amdgcn_s_barrier()
#define PG8_SCHED __builtin_amdgcn_sched_barrier(0)
#define PG8_AOFF(dst, un) do { _Pragma("unroll") for (int _h = 0; _h < 2; ++_h) _Pragma("unroll") for (int _i = 0; _i < 2; ++_i) { \
        if constexpr (GATHER) { const int _row = g.gidx[(size_t)(un).e * g.rowsPerE + (un).pm * BM + _h * HALF + Rr[_i]]; dst[_h][_i] = (unsigned)(_row * K + Cc[_i]) * 2u; } \
        else dst[_h][_i] = (unsigned)((Rr[_i] + _h * HALF) * K + Cc[_i]) * 2u; } } while (0)
#define PG8_ABASE(un) (GATHER ? (const char*)g.A : (const char*)g.A + ((size_t)(un).e * g.sAe) * 2 + (size_t)(un).pm * tstep)
#define PG8_BBASE(un) ((const char*)g.Bt + ((size_t)(un).e * g.sBe) * 2 + (size_t)(un).pn * tstep)
    Unit cur, nxt; int ui = 0;
    if (!S.next(0, cur)) return;
    f32x4 acc[2][2][4][2];
#pragma unroll
    for (int a = 0; a < 2; ++a)
#pragma unroll
        for (int b = 0; b < 2; ++b)
#pragma unroll
            for (int m = 0; m < 4; ++m)
#pragma unroll
                for (int n = 0; n < 2; ++n) acc[a][b][m][n] = (f32x4){0.f, 0.f, 0.f, 0.f};
    bf16x8 At[4][2], B0[2][2], B1[2][2];
    unsigned vC[2][2], vN[2][2];
    PG8_AOFF(vC, cur);
#pragma unroll
    for (int _h = 0; _h < 2; ++_h) { vN[_h][0] = vC[_h][0]; vN[_h][1] = vC[_h][1]; }
    const char* cA = PG8_ABASE(cur); const char* cB = PG8_BBASE(cur);
    PG8_STAGE(PG8_SB(0, 0), cB, voffB); PG8_STAGE(PG8_SB(0, 1), cB + hstep, voffB); PG8_STAGE(PG8_SA(0, 0), cA, vC[0]); PG8_STAGE(PG8_SA(0, 1), cA, vC[1]);
    if (wr == 1) PG8_BAR;
    PG8_WAIT_V(2); PG8_BAR;
    PG8_STAGE(PG8_SB(1, 0), cB + kstep, voffB); PG8_STAGE(PG8_SA(1, 0), cA + kstep, vC[0]); PG8_STAGE(PG8_SB(1, 1), cB + hstep + kstep, voffB);
    PG8_WAIT_V(6); PG8_BAR;
    for (;;) {
        const bool has_next = S.next(ui + 1, nxt);
        const char* nA = has_next ? PG8_ABASE(nxt) : cA; const char* nB = has_next ? PG8_BBASE(nxt) : cB;
        if constexpr (GATHER) { if (has_next) { PG8_AOFF(vN, nxt); } else {
#pragma unroll
            for (int _h = 0; _h < 2; ++_h) { vN[_h][0] = vC[_h][0]; vN[_h][1] = vC[_h][1]; } } }
        for (int t = 0; t < nt; t += 2) {
            const bool last = (t == nt - 2);
            const char* a1 = cA + (size_t)(t + 1) * kstep;
            const char* a2 = last ? nA : cA + (size_t)(t + 2) * kstep; const char* b2 = last ? nB : cB + (size_t)(t + 2) * kstep;
            const char* a3 = a2 + kstep; const char* b3 = b2 + kstep;
            unsigned v2[2][2];
#pragma unroll
            for (int _h = 0; _h < 2; ++_h)
#pragma unroll
                for (int _i = 0; _i < 2; ++_i) { if constexpr (GATHER) v2[_h][_i] = last ? vN[_h][_i] : vC[_h][_i]; else v2[_h][_i] = vC[_h][_i]; }
            PG8_LDB(B0, 0, 0); PG8_LDB(B1, 0, 1); PG8_SCHED; PG8_LDA(At, 0, 0); PG8_STAGE(PG8_SA(1, 1), a1, vC[1]);
            PG8_WAIT_V(8); PG8_WAIT_L(0); PG8_BAR; PG8_MMA(0, 0, At, B0); PG8_MMA(0, 1, At, B1); PG8_BAR; PG8_SCHED;
            PG8_LDA(At, 0, 1); PG8_STAGE(PG8_SB(0, 0), b2, voffB); PG8_STAGE(PG8_SB(0, 1), b2 + hstep, voffB); PG8_STAGE(PG8_SA(0, 0), a2, v2[0]);
            PG8_WAIT_V(8); PG8_WAIT_L(0); PG8_BAR; PG8_MMA(1, 0, At, B0); PG8_MMA(1, 1, At, B1); PG8_BAR; PG8_SCHED;
            PG8_LDB(B0, 1, 0); PG8_LDB(B1, 1, 1); PG8_SCHED; PG8_LDA(At, 1, 0); PG8_STAGE(PG8_SA(0, 1), a2, v2[1]);
            PG8_WAIT_V(8); PG8_WAIT_L(0); PG8_BAR; PG8_MMA(0, 0, At, B0); PG8_MMA(0, 1, At, B1); PG8_BAR; PG8_SCHED;
            PG8_LDA(At, 1, 1); PG8_STAGE(PG8_SB(1, 0), b3, voffB); PG8_STAGE(PG8_SB(1, 1), b3 + hstep, voffB); PG8_STAGE(PG8_SA(1, 0), a3, v2[0]);
            PG8_WAIT_V(8); PG8_WAIT_L(0); PG8_BAR; PG8_MMA(1, 0, At, B0); PG8_MMA(1, 1, At, B1); PG8_BAR; PG8_SCHED;
        }
        if constexpr (ALIGN_EPI) { if (wr == 0) PG8_BAR; }
        E(acc, cur, wr, wc, fr, fq);
        if (!has_next) break;
#pragma unroll
        for (int a = 0; a < 2; ++a)
#pragma unroll
            for (int b = 0; b < 2; ++b)
#pragma unroll
                for (int m = 0; m < 4; ++m)
#pragma unroll
                    for (int n = 0; n < 2; ++n) acc[a][b][m][n] = (f32x4){0.f, 0.f, 0.f, 0.f};
        cur = nxt; cA = nA; cB = nB; ++ui;
#pragma unroll
        for (int _h = 0; _h < 2; ++_h) { vC[_h][0] = vN[_h][0]; vC[_h][1] = vN[_h][1]; }
        if constexpr (ALIGN_EPI) { if (wr == 1) PG8_BAR; }
    }
    PG8_WAIT_V(0);
    if constexpr (!ALIGN_EPI) { if (wr == 0) PG8_BAR; }
    PG8_BAR;
#undef PG8_SA
#undef PG8_SB
#undef PG8_STAGE
#undef PG8_LDA
#undef PG8_LDB
#undef PG8_MMA
#undef PG8_WAIT_V
#undef PG8_WAIT_L
#undef PG8_BAR
#undef PG8_SCHED
#undef PG8_AOFF
#undef PG8_ABASE
#undef PG8_BBASE
}
}
namespace attn_body {
using bf16=__hip_bfloat16;
using bf16x8=__attribute__((ext_vector_type(8)))short;
using s16x4=__attribute__((ext_vector_type(4)))short;
using f32x16=__attribute__((ext_vector_type(16)))float;
using u32x4=__attribute__((ext_vector_type(4)))unsigned;
constexpr int SEQ=4096,D=64,QP=2048,KP=2048,VP=2048,OP=1024;
constexpr int NW=8,QBLK=32,QB=QBLK*NW,KVBLK=64;
constexpr int ATTN_UNIT_ROWS=QB;
__device__ __forceinline__ int crow(int r,int hi){return (r&3)+8*(r>>2)+4*hi;}
#define SBAR() __builtin_amdgcn_sched_barrier(0)
__device__ __forceinline__ void cmask(f32x16&p0,f32x16&p1,int jb,int qrel,int hi){
  const float NEG=-INFINITY; int kb=64*jb+4*hi;
  #pragma unroll
  for(int r=0;r<16;++r){int kv=kb+(r&3)+8*(r>>2); if(kv>qrel)p0[r]=NEG; if(kv+32>qrel)p1[r]=NEG;}
}

constexpr int NSLOT=3, SLOTB=8192;
constexpr int LDS_K=0, LDS_V=NSLOT*SLOTB, LDS_WS=2*NSLOT*SLOTB, LDS_OST=LDS_WS+NW*64*4, LDS_BYTES=LDS_OST+NW*4096;
constexpr float C2=0.125f*1.4426950408889634f;
__device__ __forceinline__ void glds16(const void*gsrc,unsigned lds_dst){unsigned keep;
  asm volatile("s_mov_b32 %0, m0\n\ts_mov_b32 m0, %2\n\ts_nop 0\n\tglobal_load_lds_dwordx4 %1, off\n\ts_mov_b32 m0, %0":"=&s"(keep):"v"(gsrc),"s"(lds_dst):"memory");}
__device__ __forceinline__ float max3f(float a,float b,float c){float r;asm("v_max3_f32 %0, %1, %2, %3":"=v"(r):"v"(a),"v"(b),"v"(c));return r;}
__device__ __forceinline__ float max2f(float a,float b){float r;asm("v_max_f32_e32 %0, %1, %2":"=v"(r):"v"(a),"v"(b));return r;}
__device__ __forceinline__ float fadd_s(float a,float b){float r;asm("v_add_f32_e32 %0, %1, %2":"=v"(r):"v"(a),"v"(b));return r;}
__device__ __forceinline__ float fsub_s(float a,float b){float r;asm("v_sub_f32_e32 %0, %1, %2":"=v"(r):"v"(a),"v"(b));return r;}
typedef float f32x2_t __attribute__((ext_vector_type(2))); typedef __bf16 bf16x2_t __attribute__((ext_vector_type(2)));
__device__ __forceinline__ unsigned cvtpk_s(float lo,float hi){f32x2_t v={lo,hi};bf16x2_t b=__builtin_convertvector(v,bf16x2_t);return __builtin_bit_cast(unsigned,b);}
#define WAIT_BAR(N) asm volatile("s_waitcnt vmcnt(" #N ") lgkmcnt(0)\n\ts_barrier":::"memory")

__device__ __forceinline__ void qkt(f32x16&p0,f32x16&p1,const char*Kslot,const bf16x8*qr,const f32x16&negm,int r32,int hi){
  const char*kb=Kslot+hi*1024+r32*16;
  #pragma unroll
  for(int d0=0;d0<4;++d0){
    const bf16x8 b0=*reinterpret_cast<const bf16x8*>(kb+d0*2048);
    const bf16x8 b1=*reinterpret_cast<const bf16x8*>(kb+d0*2048+512);
    if(d0==0){p0=__builtin_amdgcn_mfma_f32_32x32x16_bf16(b0,qr[0],negm,0,0,0);p1=__builtin_amdgcn_mfma_f32_32x32x16_bf16(b1,qr[0],negm,0,0,0);}
    else{p0=__builtin_amdgcn_mfma_f32_32x32x16_bf16(b0,qr[d0],p0,0,0,0);p1=__builtin_amdgcn_mfma_f32_32x32x16_bf16(b1,qr[d0],p1,0,0,0);}}
}
typedef __attribute__((address_space(3))) const char* lds_cptr;
typedef short v4i16_t __attribute__((ext_vector_type(4)));
__device__ __forceinline__ void kload8(bf16x8*kf,lds_cptr kp){
  kf[0]=*(const __attribute__((address_space(3))) bf16x8*)(kp);      kf[1]=*(const __attribute__((address_space(3))) bf16x8*)(kp+512);
  kf[2]=*(const __attribute__((address_space(3))) bf16x8*)(kp+2048); kf[3]=*(const __attribute__((address_space(3))) bf16x8*)(kp+2560);
  kf[4]=*(const __attribute__((address_space(3))) bf16x8*)(kp+4096); kf[5]=*(const __attribute__((address_space(3))) bf16x8*)(kp+4608);
  kf[6]=*(const __attribute__((address_space(3))) bf16x8*)(kp+6144); kf[7]=*(const __attribute__((address_space(3))) bf16x8*)(kp+6656);
}
__device__ __forceinline__ void kload2(bf16x8*kf,lds_cptr kp,int j){ kf[2*j]=*(const __attribute__((address_space(3))) bf16x8*)(kp+j*2048); kf[2*j+1]=*(const __attribute__((address_space(3))) bf16x8*)(kp+j*2048+512); }
__device__ __forceinline__ s16x4 vtr(lds_cptr p){ return __builtin_bit_cast(s16x4,__builtin_amdgcn_ds_read_tr16_b64_v4i16((__attribute__((address_space(3))) v4i16_t*)p)); }
__device__ __forceinline__ float rowmax(const f32x16&p0,const f32x16&p1){
  float a=max3f(p0[0],p0[1],p1[0]),b=max3f(p0[2],p0[3],p1[1]);a=max3f(a,p1[2],p1[3]);
  #pragma unroll
  for(int r=4;r<16;r+=4){a=max3f(a,p0[r],p0[r+1]);b=max3f(b,p0[r+2],p0[r+3]);a=max3f(a,p1[r],p1[r+1]);b=max3f(b,p1[r+2],p1[r+3]);}
  const float m=max2f(a,b);
  auto rr=__builtin_amdgcn_permlane32_swap(__float_as_uint(m),__float_as_uint(m),false,false);
  return max2f(__uint_as_float(rr[0]),__uint_as_float(rr[1]));
}
__device__ __forceinline__ void pv(f32x16*o,int vb,bf16x8 pa0,bf16x8 pa1,bf16x8 pa2,bf16x8 pa3){
  #pragma unroll
  for(int d0=0;d0<2;++d0){s16x4 lo[4],hi[4];
    #pragma unroll
    for(int ks=0;ks<4;++ks){
      asm volatile("ds_read_b64_tr_b16 %0,%1 offset:%c2":"=&v"(lo[ks]):"v"(vb),"i"(d0*4096+ks*1024):"memory");
      asm volatile("ds_read_b64_tr_b16 %0,%1 offset:%c2":"=&v"(hi[ks]):"v"(vb),"i"(d0*4096+ks*1024+512):"memory");}
    asm volatile("s_waitcnt lgkmcnt(0)":::"memory");SBAR();
    #define PK(k) (bf16x8){lo[k][0],lo[k][1],lo[k][2],lo[k][3],hi[k][0],hi[k][1],hi[k][2],hi[k][3]}
    o[d0]=__builtin_amdgcn_mfma_f32_32x32x16_bf16(pa0,PK(0),o[d0],0,0,0);
    o[d0]=__builtin_amdgcn_mfma_f32_32x32x16_bf16(pa1,PK(1),o[d0],0,0,0);
    o[d0]=__builtin_amdgcn_mfma_f32_32x32x16_bf16(pa2,PK(2),o[d0],0,0,0);
    o[d0]=__builtin_amdgcn_mfma_f32_32x32x16_bf16(pa3,PK(3),o[d0],0,0,0);
    #undef PK
  }
}

#ifndef ATTN_STORE16
#define ATTN_STORE16(p,v) (*(u32x4*)(p)=(v))
#endif
template<int THRL> __device__ __forceinline__ void attn_unit(long rowbase,int q0,const bf16*Qh,const bf16*__restrict__ Kh,const bf16*__restrict__ Vh,bf16*Oh,char*shm){
  const int tid=opaque_tid(),lane=tid&63,r32=lane&31,hi=lane>>5; const int wid=__builtin_amdgcn_readfirstlane(tid>>6);
  const bf16*Qw=Qh+(rowbase+q0+wid*QBLK)*QP;
  const bf16*Kb=Kh+rowbase*KP,*Vb=Vh+rowbase*VP;
  const unsigned lds0=(unsigned)(uintptr_t)shm;
  float*wsf=(float*)(shm+LDS_WS)+wid*64;
  const bf16*ksrc=Kb+(long)lane*KP+wid*8;
  const bf16*vsrc=Vb+(long)(16*(wid&3)+(lane>>2))*VP+(wid>>2)*32+(lane&3)*8;
  const unsigned kdst=lds0+LDS_K+wid*1024, vdst=lds0+LDS_V+wid*1024;
  #define DMA_K(t,slot) glds16(ksrc+(long)(t)*KVBLK*KP,(unsigned)__builtin_amdgcn_readfirstlane(kdst+(slot)))
  #define DMA_V(t,slot) glds16(vsrc+(long)(t)*KVBLK*VP,(unsigned)__builtin_amdgcn_readfirstlane(vdst+(slot)))
  const int vb0=(int)(lds0+LDS_V)+((lane>>4)&1)*32+(lane&3)*8+(4*hi+((lane&15)>>2))*64;
  const char*Kbase=shm+LDS_K; bf16x8 kf[8];
  const lds_cptr shm3=(lds_cptr)shm; const lds_cptr kp0=shm3+LDS_K+hi*1024+r32*16; const lds_cptr vp0=shm3+LDS_V+((lane>>4)&1)*32+(lane&3)*8+(4*hi+((lane&15)>>2))*64;
  constexpr int NT=SEQ/KVBLK;
  DMA_K(0,0);DMA_V(0,0);DMA_K(1,SLOTB);
  bf16x8 qr[4];
  #pragma unroll
  for(int d0=0;d0<4;++d0)qr[d0]=*reinterpret_cast<const bf16x8*>(&Qw[(long)r32*QP+d0*16+hi*8]);
  float mhat=0.f,l_reg=0.f;f32x16 o[2];o[0]=f32x16{};o[1]=f32x16{};f32x16 negm=f32x16{};asm volatile("":"+v"(negm));
  const int qrel=wid*QBLK+r32;
  #define CMASK(P0,P1,t) do{}while(0)
  bool resc=false;
  #define START(P0,P1) do{ const float rm=rowmax(P0,P1); resc=false; \
    { const float dl=rm; mhat=fadd_s(mhat,dl); \
      _Pragma("unroll") for(int r=0;r<16;++r){P0[r]=fsub_s(P0[r],dl);P1[r]=fsub_s(P1[r],dl);} \
      _Pragma("unroll") for(int r=0;r<16;++r)negm[r]=-mhat; asm volatile("":"+v"(negm)); } \
    _Pragma("unroll") for(int r=0;r<16;++r)P0[r]=__builtin_amdgcn_exp2f(P0[r]); }while(0)
  #define RESC() do{ if(resc){ asm volatile("s_waitcnt lgkmcnt(0)":::"memory"); \
      _Pragma("unroll") for(int d_=0;d_<2;++d_) _Pragma("unroll") for(int r=0;r<16;++r)o[d_][r]*=wsf[crow(r,hi)]; } }while(0)
  f32x16 pA0,pA1,pB0,pB1;
  int sl_prev=0,sl_cur=0,sl_next=SLOTB;
  #define ROT() do{sl_prev=sl_cur;sl_cur=sl_next;sl_next=(sl_next==(NSLOT-1)*SLOTB)?0:sl_next+SLOTB;}while(0)
  DMA_K(2,2*SLOTB);
  WAIT_BAR(3);
  qkt(pA0,pA1,Kbase,qr,negm,r32,hi);asm volatile("s_nop 15\n\ts_nop 7":"+v"(pA0),"+v"(pA1));CMASK(pA0,pA1,0);
  START(pA0,pA1);
  _Pragma("unroll") for(int r=0;r<16;++r)pA1[r]=__builtin_amdgcn_exp2f(pA1[r]);
  WAIT_BAR(0);
  DMA_K(3,0);DMA_V(1,SLOTB);
  ROT();
  kload8(kf,kp0+sl_cur);
  WAIT_BAR(2);
  s16x4 vlo[8],vhi[8]; u32x4 pw0,pw1,pw2,pw3;
  #define PKW(P,B) cvtpk_s(P[B],P[B+1])
  #define PAF(k) __builtin_bit_cast(bf16x8,pw##k)
  #define VFR(i) (bf16x8){vlo[i][0],vlo[i][1],vlo[i][2],vlo[i][3],vhi[i][0],vhi[i][1],vhi[i][2],vhi[i][3]}
  #define PIN(x) asm volatile("":"+v"(x))
  #define MX3(a,b,c) __builtin_fmaxf(__builtin_fmaxf((a),(b)),(c))
  #define GAPA(MF,A0,A1,A2,A3,W0,W1,PW) do{ MF; sacc+=A0; sacc+=A1; sacc+=A2; sacc+=A3; PIN(sacc); W0; W1; PIN(PW); SBAR(); }while(0)
  #define EX(v) __builtin_amdgcn_exp2f(v)
  #define GAPB(MF,X,B) do{ MF; X[B]=EX(X[B]); X[B+1]=EX(X[B+1]); X[B+2]=EX(X[B+2]); X[B+3]=EX(X[B+3]); PIN(X); SBAR(); }while(0)
  #define VRD(i) do{ vlo[i]=vtr(vp_+(((i)>>2)*4096+((i)&3)*1024)); vhi[i]=vtr(vp_+(((i)>>2)*4096+((i)&3)*1024+512)); }while(0)
  #define KRD(G,j) do{ if(G){ kload2(kf,kp0+sl_next,j); SBAR(); } }while(0)
  #define STEP(C0,C1,P0,P1,t,GK,GV,GL) do{ SBAR(); \
    const lds_cptr vp_=vp0+sl_prev; \
    VRD(0); SBAR(); float sacc=(P0[0]+P0[1]); \
    GAPA(C0=__builtin_amdgcn_mfma_f32_32x32x16_bf16(kf[0],qr[0],negm,0,0,0), P0[2],P0[3],P0[4],P0[5],     pw0[0]=PKW(P0,0), pw0[1]=PKW(P0,2), pw0); \
    VRD(4); SBAR(); GAPA(C1=__builtin_amdgcn_mfma_f32_32x32x16_bf16(kf[1],qr[0],negm,0,0,0), P0[6],P0[7],P0[8],P0[9],     pw0[2]=PKW(P0,4), pw0[3]=PKW(P0,6), pw0); \
    VRD(1); SBAR(); GAPA(C0=__builtin_amdgcn_mfma_f32_32x32x16_bf16(kf[2],qr[1],C0,0,0,0),   P0[10],P0[11],P0[12],P0[13], pw1[0]=PKW(P0,8), pw1[1]=PKW(P0,10), pw1); \
    VRD(5); SBAR(); GAPA(C1=__builtin_amdgcn_mfma_f32_32x32x16_bf16(kf[3],qr[1],C1,0,0,0),   P0[14],P0[15],P1[0],P1[1],   pw1[2]=PKW(P0,12),pw1[3]=PKW(P0,14), pw1); \
    VRD(2); SBAR(); GAPA(C0=__builtin_amdgcn_mfma_f32_32x32x16_bf16(kf[4],qr[2],C0,0,0,0),   P1[2],P1[3],P1[4],P1[5],     pw2[0]=PKW(P1,0), pw2[1]=PKW(P1,2), pw2); \
    VRD(6); SBAR(); GAPA(C1=__builtin_amdgcn_mfma_f32_32x32x16_bf16(kf[5],qr[2],C1,0,0,0),   P1[6],P1[7],P1[8],P1[9],     pw2[2]=PKW(P1,4), pw2[3]=PKW(P1,6), pw2); \
    VRD(3); SBAR(); GAPA(C0=__builtin_amdgcn_mfma_f32_32x32x16_bf16(kf[6],qr[3],C0,0,0,0),   P1[10],P1[11],P1[12],P1[13], pw3[0]=PKW(P1,8), pw3[1]=PKW(P1,10), pw3); \
    VRD(7); SBAR(); GAPA(C1=__builtin_amdgcn_mfma_f32_32x32x16_bf16(kf[7],qr[3],C1,0,0,0),   P1[14],P1[15],0.f,0.f,       pw3[2]=PKW(P1,12),pw3[3]=PKW(P1,14), pw3); \
    l_reg+=sacc; \
    if(GK){DMA_K((t)+3,sl_cur);} if(GV){DMA_V((t)+1,sl_next);} \
    CMASK(C0,C1,t); \
    { float a=MX3(C0[0],C0[1],C1[0]),b=MX3(C0[2],C0[3],C1[1]); a=MX3(a,C1[2],C1[3]); \
      _Pragma("unroll") for(int r=4;r<16;r+=4){a=MX3(a,C0[r],C0[r+1]);b=MX3(b,C0[r+2],C0[r+3]);a=MX3(a,C1[r],C1[r+1]);b=MX3(b,C1[r+2],C1[r+3]);} \
      float rm=__builtin_fmaxf(a,b); { auto rr=__builtin_amdgcn_permlane32_swap(__float_as_uint(rm),__float_as_uint(rm),false,false); rm=__builtin_fmaxf(__uint_as_float(rr[0]),__uint_as_float(rr[1])); } \
      resc=false; \
      if(__builtin_expect(__any(rm>(float)THRL),0)){ const float dl=__builtin_fmaxf(rm,0.f); mhat+=dl; \
        _Pragma("unroll") for(int r=0;r<16;++r){C0[r]-=dl;C1[r]-=dl;} \
        _Pragma("unroll") for(int r=0;r<16;++r)negm[r]=-mhat; asm volatile("":"+v"(negm)); \
        const float f=__builtin_amdgcn_exp2f(-dl); l_reg*=f; if(hi==0)wsf[r32]=f; resc=true; } } \
    SBAR(); \
    GAPB(o[0]=__builtin_amdgcn_mfma_f32_32x32x16_bf16(PAF(0),VFR(0),o[0],0,0,0), C0,0); \
    GAPB(o[1]=__builtin_amdgcn_mfma_f32_32x32x16_bf16(PAF(0),VFR(4),o[1],0,0,0), C0,4); \
    KRD(GL,0); GAPB(o[0]=__builtin_amdgcn_mfma_f32_32x32x16_bf16(PAF(1),VFR(1),o[0],0,0,0), C0,8); \
    KRD(GL,1); GAPB(o[1]=__builtin_amdgcn_mfma_f32_32x32x16_bf16(PAF(1),VFR(5),o[1],0,0,0), C0,12); \
    KRD(GL,2); GAPB(o[0]=__builtin_amdgcn_mfma_f32_32x32x16_bf16(PAF(2),VFR(2),o[0],0,0,0), C1,0); \
    KRD(GL,3); GAPB(o[1]=__builtin_amdgcn_mfma_f32_32x32x16_bf16(PAF(2),VFR(6),o[1],0,0,0), C1,4); \
    GAPB(o[0]=__builtin_amdgcn_mfma_f32_32x32x16_bf16(PAF(3),VFR(3),o[0],0,0,0), C1,8); \
    GAPB(o[1]=__builtin_amdgcn_mfma_f32_32x32x16_bf16(PAF(3),VFR(7),o[1],0,0,0), C1,12); \
    }while(0)
  int t=1;
  #undef CMASK
  #define CMASK(P0,P1,t) do{}while(0)
  for(;t+5<NT;t+=2){
    STEP(pB0,pB1,pA0,pA1,t,true,true,true);     WAIT_BAR(2); RESC(); ROT();
    STEP(pA0,pA1,pB0,pB1,t+1,true,true,true);   WAIT_BAR(2); RESC(); ROT();
  }
  #undef CMASK
  #define CMASK(P0,P1,t) do{}while(0)
  #define ENDW(tt) do{ if((tt)+3<NT){WAIT_BAR(2);} else if((tt)+2<NT){WAIT_BAR(1);} else {WAIT_BAR(0);} }while(0)
  for(;t+1<NT;t+=2){
    STEP(pB0,pB1,pA0,pA1,t,(t+3<NT),(t+1<NT),(t+1<NT));       ENDW(t);   RESC(); ROT();
    STEP(pA0,pA1,pB0,pB1,t+1,(t+4<NT),(t+2<NT),(t+2<NT));     ENDW(t+1); RESC(); ROT();
  }
  STEP(pB0,pB1,pA0,pA1,NT-1,false,false,false); RESC();
  { float sacc=pB0[0]+pB0[1]; _Pragma("unroll") for(int r=2;r<16;++r)sacc+=pB0[r]; _Pragma("unroll") for(int r=0;r<16;++r)sacc+=pB1[r]; l_reg+=sacc;
    pw0=(u32x4){PKW(pB0,0),PKW(pB0,2),PKW(pB0,4),PKW(pB0,6)};pw1=(u32x4){PKW(pB0,8),PKW(pB0,10),PKW(pB0,12),PKW(pB0,14)};pw2=(u32x4){PKW(pB1,0),PKW(pB1,2),PKW(pB1,4),PKW(pB1,6)};pw3=(u32x4){PKW(pB1,8),PKW(pB1,10),PKW(pB1,12),PKW(pB1,14)};
    SBAR(); pv(o,vb0+sl_cur,PAF(0),PAF(1),PAF(2),PAF(3)); }
  #undef PKW
  #undef PAF
  #undef VFR
  #undef PIN
  #undef MX3
  #undef GAPA
  #undef GAPB
  #undef EX
  #undef VRD
  #undef KRD
  #undef STEP
  #undef ENDW
  {auto rr=__builtin_amdgcn_permlane32_swap(__float_as_uint(l_reg),__float_as_uint(l_reg),false,false);l_reg=__uint_as_float(rr[0])+__uint_as_float(rr[1]);}
  if(hi==0)wsf[32+r32]=l_reg;asm volatile("s_waitcnt lgkmcnt(0)":::"memory");
  float rli[16];
  #pragma unroll
  for(int r=0;r<16;++r)rli[r]=__builtin_amdgcn_rcpf(wsf[32+crow(r,hi)]);
  bf16*Ow=Oh+(rowbase+q0+wid*QBLK)*OP;
  { bf16*stg=(bf16*)(shm+LDS_OST)+wid*2048;
    #pragma unroll
    for(int r=0;r<16;++r){const int orow=crow(r,hi);
      #pragma unroll
      for(int d0=0;d0<2;++d0)stg[orow*64+d0*32+r32]=__float2bfloat16(o[d0][r]*rli[r]);}
    asm volatile("s_waitcnt lgkmcnt(0)":::"memory");
    #pragma unroll
    for(int i=0;i<4;++i){const int row=i*8+(lane>>3),ch=lane&7; const u32x4 v=*(const u32x4*)(stg+row*64+ch*8); ATTN_STORE16(Ow+(long)row*OP+ch*8,v);} }
  asm volatile("s_waitcnt lgkmcnt(0)\n\ts_barrier":::"memory");
  #undef DMA_K
  #undef DMA_V
  #undef CMASK
  #undef START
  #undef RESC
  #undef ROT
}
constexpr int CA_K=0, CA_V=65536, CA_BYTES=131072;
constexpr int CQP=512, CKP=1024;
constexpr float CA_C2=0.08838834764831845f*1.4426950408889634f;
__device__ __forceinline__ void ca_qkt(f32x16&p0,f32x16&p1,const char*Kslot,const bf16x8*qr,const f32x16&init,int r32,int hi){
  #pragma unroll
  for(int dh=0;dh<2;++dh){ const char*kb=Kslot+dh*8192+hi*1024+r32*16;
    #pragma unroll
    for(int d0=0;d0<4;++d0){
      const bf16x8 b0=*reinterpret_cast<const bf16x8*>(kb+d0*2048);
      const bf16x8 b1=*reinterpret_cast<const bf16x8*>(kb+d0*2048+512);
      if(dh==0&&d0==0){p0=__builtin_amdgcn_mfma_f32_32x32x16_bf16(b0,qr[0],init,0,0,0);p1=__builtin_amdgcn_mfma_f32_32x32x16_bf16(b1,qr[0],init,0,0,0);}
      else{p0=__builtin_amdgcn_mfma_f32_32x32x16_bf16(b0,qr[dh*4+d0],p0,0,0,0);p1=__builtin_amdgcn_mfma_f32_32x32x16_bf16(b1,qr[dh*4+d0],p1,0,0,0);}}}
}
__device__ __forceinline__ void ca_pair(int b,int hd,int qt0,const bf16*Q,const bf16*__restrict__ KV,bf16*O,char*shm,float*wsf_all){
  const int tid=opaque_tid(),lane=tid&63,r32=lane&31,hi=lane>>5; const int wid=__builtin_amdgcn_readfirstlane(tid>>6);
  const unsigned lds0=(unsigned)(uintptr_t)shm;
  float*wsf=wsf_all+wid*64;
  const bf16*Kg=KV+(long)(b*256)*CKP+hd*128; const bf16*Vg=Kg+512;
  #pragma unroll
  for(int kt=0;kt<4;++kt){
    #pragma unroll
    for(int dh=0;dh<2;++dh){
      glds16(Kg+(long)(kt*64+lane)*CKP+dh*64+wid*8,(unsigned)__builtin_amdgcn_readfirstlane(lds0+CA_K+(kt*2+dh)*8192+wid*1024));
      glds16(Vg+(long)(kt*64+16*(wid&3)+(lane>>2))*CKP+dh*64+(wid>>2)*32+(lane&3)*8,(unsigned)__builtin_amdgcn_readfirstlane(lds0+CA_V+(kt*2+dh)*8192+wid*1024));
    }}
  WAIT_BAR(0);
  const int vb0=(int)(lds0+CA_V)+((lane>>4)&1)*32+(lane&3)*8+(4*hi+((lane&15)>>2))*64;
  for(int qi=0;qi<2;++qi){
    const long rowq=(long)b*4096+(qt0+qi)*256+wid*32;
    const bf16*Qw=Q+rowq*CQP+hd*128;
    bf16x8 qr[8];
    #pragma unroll
    for(int d0=0;d0<8;++d0)qr[d0]=*reinterpret_cast<const bf16x8*>(&Qw[(long)r32*CQP+d0*16+hi*8]);
    f32x16 zero=f32x16{};
    float mx=-INFINITY;
    #pragma unroll 1
    for(int kt=0;kt<4;++kt){ f32x16 p0,p1; ca_qkt(p0,p1,shm+CA_K+kt*2*8192,qr,zero,r32,hi);
      #pragma unroll
      for(int r=0;r<16;++r)mx=__builtin_fmaxf(mx,__builtin_fmaxf(p0[r],p1[r])); }
    { auto rr=__builtin_amdgcn_permlane32_swap(__float_as_uint(mx),__float_as_uint(mx),false,false); mx=__builtin_fmaxf(__uint_as_float(rr[0]),__uint_as_float(rr[1])); }
    f32x16 negm;
    #pragma unroll
    for(int r=0;r<16;++r)negm[r]=-mx;
    float l=0.f; f32x16 o[4]; o[0]=f32x16{};o[1]=f32x16{};o[2]=f32x16{};o[3]=f32x16{};
    #pragma unroll 1
    for(int kt=0;kt<4;++kt){ f32x16 p0,p1; ca_qkt(p0,p1,shm+CA_K+kt*2*8192,qr,negm,r32,hi);
      #pragma unroll
      for(int r=0;r<16;++r){p0[r]=__builtin_amdgcn_exp2f(p0[r]);p1[r]=__builtin_amdgcn_exp2f(p1[r]);}
      float sacc=0.f;
      #pragma unroll
      for(int r=0;r<16;++r)sacc+=p0[r]+p1[r];
      l+=sacc;
      u32x4 pw0,pw1,pw2,pw3;
      pw0=(u32x4){cvtpk_s(p0[0],p0[1]),cvtpk_s(p0[2],p0[3]),cvtpk_s(p0[4],p0[5]),cvtpk_s(p0[6],p0[7])};
      pw1=(u32x4){cvtpk_s(p0[8],p0[9]),cvtpk_s(p0[10],p0[11]),cvtpk_s(p0[12],p0[13]),cvtpk_s(p0[14],p0[15])};
      pw2=(u32x4){cvtpk_s(p1[0],p1[1]),cvtpk_s(p1[2],p1[3]),cvtpk_s(p1[4],p1[5]),cvtpk_s(p1[6],p1[7])};
      pw3=(u32x4){cvtpk_s(p1[8],p1[9]),cvtpk_s(p1[10],p1[11]),cvtpk_s(p1[12],p1[13]),cvtpk_s(p1[14],p1[15])};
      SBAR();
      pv(o,vb0+(kt*2)*8192,__builtin_bit_cast(bf16x8,pw0),__builtin_bit_cast(bf16x8,pw1),__builtin_bit_cast(bf16x8,pw2),__builtin_bit_cast(bf16x8,pw3));
      pv(o+2,vb0+(kt*2+1)*8192,__builtin_bit_cast(bf16x8,pw0),__builtin_bit_cast(bf16x8,pw1),__builtin_bit_cast(bf16x8,pw2),__builtin_bit_cast(bf16x8,pw3));
    }
    { auto rr=__builtin_amdgcn_permlane32_swap(__float_as_uint(l),__float_as_uint(l),false,false); l=__uint_as_float(rr[0])+__uint_as_float(rr[1]); }
    if(hi==0)wsf[r32]=l;
    asm volatile("s_waitcnt lgkmcnt(0)":::"memory");
    bf16*Ow=O+rowq*CQP+hd*128;
    #pragma unroll
    for(int r=0;r<16;++r){ const int orow=crow(r,hi); const float rl=__builtin_amdgcn_rcpf(wsf[orow]);
      #pragma unroll
      for(int d0=0;d0<4;++d0)Ow[(long)orow*CQP+d0*32+r32]=__float2bfloat16(o[d0][r]*rl); }
    asm volatile("s_waitcnt lgkmcnt(0)":::"memory");
  }
  asm volatile("s_waitcnt lgkmcnt(0)\n\ts_barrier":::"memory");
}
#undef SBAR
#undef WAIT_BAR
}
#define GAS __attribute__((address_space(1)))
#define LAS __attribute__((address_space(3)))
typedef unsigned short bf16;
typedef unsigned v4u __attribute__((ext_vector_type(4)));
typedef float f32x4 __attribute__((ext_vector_type(4)));
typedef short bf16x8 __attribute__((ext_vector_type(8)));
typedef GAS unsigned gu32;
typedef GAS unsigned long long gu64;
#define RLX_AGENT __ATOMIC_RELAXED, __HIP_MEMORY_SCOPE_AGENT
#define LDS_WAIT() asm volatile("s_waitcnt lgkmcnt(0)" ::: "memory")
#define VM_WAIT() asm volatile("s_waitcnt vmcnt(0)" ::: "memory")
__device__ __forceinline__ unsigned long long rt() { return __builtin_amdgcn_s_memrealtime(); }
__device__ __forceinline__ unsigned f2bf(float f) { unsigned u = __builtin_bit_cast(unsigned, f); return (u + 0x7fffu + ((u >> 16) & 1u)) >> 16; }
__device__ __forceinline__ unsigned pk2(float lo, float hi) { return f2bf(lo) | (f2bf(hi) << 16); }

#define XB_TMO      128
#define XB_XCNT(j)  (256  + 64 * (j))
#define XB_XSUB(j)  (1280 + 64 * (j))
#define XB_XGEN(j)  (2304 + 64 * (j))
#define XB_TOP      3328
#define XB_TOPGEN   3392
#define XCD_BAR_WORDS 3456
#define XB_SPIN_CAP (1u << 18)

__device__ __forceinline__ unsigned xb_ld(unsigned* p)              { return __hip_atomic_load(p, __ATOMIC_RELAXED, __HIP_MEMORY_SCOPE_AGENT); }
__device__ __forceinline__ unsigned xb_add(unsigned* p, unsigned v) { return __hip_atomic_fetch_add(p, v, __ATOMIC_RELAXED, __HIP_MEMORY_SCOPE_AGENT); }
__device__ __forceinline__ unsigned xb_xcc_id() { return (unsigned)__builtin_amdgcn_s_getreg((3 << 11) | 20) & 0xFu; }
#define XB_SPIN(cond, bar) do { unsigned _sp = 0; while (cond) { __builtin_amdgcn_s_sleep(1); \
    if ((++_sp & 255u) == 0u) { if (xb_ld(&(bar)[XB_TMO])) break; if (_sp > XB_SPIN_CAP) { atomicAdd(&(bar)[XB_TMO], 1u); break; } } } } while (0)

struct XcdBarrier {
    unsigned* bar; unsigned x;
    volatile LAS unsigned* st;
};

__device__ __forceinline__ XcdBarrier xcd_barrier_post(unsigned* bar, volatile LAS unsigned* st) {
    XcdBarrier b; b.bar = bar; b.x = xb_xcc_id(); b.st = st;
    if (threadIdx.x == 0) (void)xb_add(&bar[XB_XCNT(b.x)], 1u);
    return b;
}
__device__ __forceinline__ void xcd_barrier_complete(unsigned* bar, unsigned x, unsigned& nloc, unsigned& nx) {
    const unsigned G = gridDim.x * gridDim.y * gridDim.z;
    unsigned sum, cnt, mine, sp = 0u;
    for (;;) {
        sum = 0u; cnt = 0u; mine = 0u;
#pragma unroll
        for (unsigned j = 0; j < 16; ++j) { const unsigned c = xb_ld(&bar[XB_XCNT(j)]); sum += c; cnt += (c > 0u) ? 1u : 0u; mine = (j == x) ? c : mine; }
        if (sum == G) break;
        __builtin_amdgcn_s_sleep(1);
        if ((++sp & 255u) == 0u) { if (xb_ld(&bar[XB_TMO])) break; if (sp > XB_SPIN_CAP) { atomicAdd(&bar[XB_TMO], 1u); break; } }
    }
    nloc = mine > 0u ? mine : 1u; nx = cnt > 0u ? cnt : 1u;
}

__device__ __forceinline__ void xcd_barrier(const XcdBarrier& b) {
    asm volatile("s_waitcnt vmcnt(0)" ::: "memory");
    __syncthreads();
    if (threadIdx.x == 0) {
        unsigned* bar = b.bar;
        __builtin_amdgcn_s_waitcnt(0);
        unsigned nloc = b.st[0], nx = b.st[1];
        if (nloc == 0u) { xcd_barrier_complete(bar, b.x, nloc, nx); b.st[0] = nloc; b.st[1] = nx; }
        const unsigned old = xb_add(&bar[XB_XSUB(b.x)], 1u);
        const unsigned gen = old / nloc;
        if (old + 1u == (gen + 1u) * nloc) {
            __builtin_amdgcn_fence(__ATOMIC_RELEASE, "agent");
            asm volatile("s_waitcnt vmcnt(0)" ::: "memory");
            const unsigned og = xb_add(&bar[XB_TOP], 1u);
            const unsigned tg = og / nx;
            if (og + 1u == (tg + 1u) * nx) xb_add(&bar[XB_TOPGEN], 1u);
            else XB_SPIN(xb_ld(&bar[XB_TOPGEN]) == tg, bar);
            __builtin_amdgcn_fence(__ATOMIC_ACQUIRE, "agent");
            xb_add(&bar[XB_XGEN(b.x)], 1u);
            asm volatile("s_waitcnt vmcnt(0)" ::: "memory");
        } else {
            XB_SPIN(xb_ld(&bar[XB_XGEN(b.x)]) == gen, bar);
            __builtin_amdgcn_fence(__ATOMIC_ACQUIRE, "agent");
            asm volatile("s_waitcnt vmcnt(0)" ::: "memory");
        }
    }
    __syncthreads();
}
constexpr int DMODEL = 1024, NBATCH = 8, SEQL = 4096, DEPTH = 4, NTOK = NBATCH * SEQL;
constexpr int NPROJ = 2048;
constexpr int C_POOL = 0, C_MQ = 256, C_MK = 512, C_MV = 768, C_MO = 1024, C_AQ = 1280, C_AK = 1792, C_AV = 1920;
constexpr int NEXP = 16, CAP = 512, FFE = 2048, ROWS_E = NBATCH * CAP  , NSLOTS = NEXP * ROWS_E;
constexpr float EPS = 1e-6f;
enum { I_X = 0, I_MEM, I_NMIXG, I_WIN, I_POOLW, I_POOLS, I_CONVW, I_GATEB, I_MNORMG, I_QNG, I_KNG, I_WOUT, I_NMEMG, I_CAWQ, I_CAWKV, I_CAWO, I_NFFNG, I_ROUTER, I_WGU, I_WDN, I_FNG, N_IN };

constexpr size_t MiB = 1u << 20;
constexpr size_t WS_CTL = 0, CTL_ZERO_BYTES = 1 * MiB;
constexpr size_t WS_ROPE = 1 * MiB;
constexpr size_t WS_POOLW = 2 * MiB;
constexpr size_t WS_MEMB = 3 * MiB;
constexpr size_t WS_WIN = 8 * MiB;
constexpr size_t WS_WOUT = 24 * MiB;
constexpr size_t WS_WCAQ = 32 * MiB;
constexpr size_t WS_WCAKV = 36 * MiB;
constexpr size_t WS_WCAO = 44 * MiB;
constexpr size_t WS_KVCA = 48 * MiB;
constexpr size_t WS_WGU = 64 * MiB;
constexpr size_t WS_WDN = 576 * MiB;
constexpr size_t WS_X = 832 * MiB;
constexpr size_t WS_HN = 960 * MiB;
constexpr size_t WS_PROJ = 1024 * MiB;
constexpr size_t WS_MQK = 1152 * MiB;
constexpr size_t WS_YCAT = 1184 * MiB;
constexpr size_t WS_QCA = 1248 * MiB;
constexpr size_t WS_GATES = 1280 * MiB;
constexpr size_t WS_AFF = 1282 * MiB;
constexpr size_t WS_TOKI = 1284 * MiB;
constexpr size_t WS_SLOTMAP = 1285 * MiB;
constexpr size_t WS_MSC = 1287 * MiB;
constexpr size_t WS_CST = 1288 * MiB;
constexpr size_t WS_ACT = 1322 * MiB;
constexpr size_t WS_YS = 1578 * MiB;
constexpr size_t WS_DBG = 1706 * MiB;
constexpr size_t WS_END = 1708 * MiB;
constexpr int CST_SZ = 65 * 64;
constexpr int CW_BAR = 4096;

constexpr int RING_OFF = 0, RING_BYTES = 131072;
constexpr int LDSCTL_OFF = RING_BYTES, MISC_OFF = LDSCTL_OFF + 320;
constexpr int XTRA_OFF = MISC_OFF + 128;
constexpr int LDS_BYTES = 147456;

__device__ __forceinline__ float wave_sum(float v) {
#pragma unroll
    for (int o = 1; o < 64; o <<= 1) v += __shfl_xor(v, o);
    return v;
}
__device__ __forceinline__ float bf_lo(unsigned w) { return __uint_as_float(w << 16); }
__device__ __forceinline__ float bf_hi(unsigned w) { return __uint_as_float(w & 0xffff0000u); }
__device__ __forceinline__ float bf2f(bf16 h) { return __uint_as_float(((unsigned)h) << 16); }
__device__ __forceinline__ float wscan_add(float v, int lane) {
#pragma unroll
    for (int o = 1; o < 64; o <<= 1) { const float t = __shfl_up(v, o); if (lane >= o) v += t; }
    return v;
}
__device__ __forceinline__ float wscan_add_rev(float v, int lane) {
#pragma unroll
    for (int o = 1; o < 64; o <<= 1) { const float t = __shfl_down(v, o); if (lane + o < 64) v += t; }
    return v;
}
__device__ __forceinline__ float wscan_max(float v, int lane) {
#pragma unroll
    for (int o = 1; o < 64; o <<= 1) { const float t = __shfl_up(v, o); if (lane >= o) v = fmaxf(v, t); }
    return v;
}
__device__ __forceinline__ float wscan_max_rev(float v, int lane) {
#pragma unroll
    for (int o = 1; o < 64; o <<= 1) { const float t = __shfl_down(v, o); if (lane + o < 64) v = fmaxf(v, t); }
    return v;
}
__device__ __forceinline__ float fexp(float x) { return __builtin_amdgcn_exp2f(x * 1.4426950408889634f); }
__device__ __forceinline__ float flog(float x) { return __builtin_amdgcn_logf(x) * 0.6931471805599453f; }
__device__ __forceinline__ float fsigmoid(float x) { return __builtin_amdgcn_rcpf(1.0f + fexp(-x)); }
#define MFMA16(a, b, c) __builtin_amdgcn_mfma_f32_16x16x32_bf16((a), (b), (c), 0, 0, 0)

struct Ctx { int tid, lane, wave, G, vcu, gw, NGW; unsigned char* lds; unsigned char* ws; };
__device__ __forceinline__ Ctx phase_ctx(const Ctx& C0) { Ctx C = C0; C.tid = opaque_tid(); C.lane = C.tid & 63; return C; }

__device__ __forceinline__ void transpose_item(const float* W, int ldw, bf16* WT, int K, int n0dst, int srccol0, int k0, float* scr, int lane) {
#pragma unroll 8
    for (int i = 0; i < 32; ++i) { const int kk = 2 * i + (lane >> 5); scr[kk * 33 + (lane & 31)] = W[(size_t)(k0 + kk) * ldw + srccol0 + (lane & 31)]; }
    LDS_WAIT(); asm volatile("" ::: "memory");
    const int c = lane & 7;
#pragma unroll
    for (int j = 0; j < 4; ++j) { const int n = (lane >> 3) + 8 * j; const float* s = scr + (8 * c) * 33 + n;
        v4u o; o.x = pk2(s[0 * 33], s[1 * 33]); o.y = pk2(s[2 * 33], s[3 * 33]); o.z = pk2(s[4 * 33], s[5 * 33]); o.w = pk2(s[6 * 33], s[7 * 33]);
        *(v4u*)(WT + (size_t)(n0dst + n) * K + k0 + 8 * c) = o; }
    LDS_WAIT(); asm volatile("" ::: "memory");
}
__device__ __forceinline__ void prologue_convert(const Ctx& C0, const float* const* in) {
    const Ctx C = phase_ctx(C0);
    float* scr = (float*)(C.lds + RING_OFF + C.wave * 16384);
    unsigned char* ws = C.ws;
    constexpr int N0 = 4 * 1024, N1 = N0 + 4 * 512, N2 = N1 + 4 * 256, N3 = N2 + 4 * 512, N4 = N3 + 4 * 256, N5 = N4 + 64 * 2048, N6 = N5 + 64 * 1024;
    for (int it = C.gw; it < N6; it += C.NGW) {
        if (it < N0) { const int l = it >> 10, r = it & 1023, kb = r >> 6, nb = r & 63, n0 = nb * 32;
            transpose_item(in[I_WIN] + (size_t)l * 1024 * 2064, 2064, (bf16*)(ws + WS_WIN) + (size_t)l * 2048 * 1024, 1024, n0, n0 < 1280 ? n0 : n0 + 16, kb * 64, scr, C.lane); }
        else if (it < N1) { const int q = it - N0, l = q >> 9, r = q & 511, kb = r >> 5, nb = r & 31;
            transpose_item(in[I_WOUT] + (size_t)l * 1024 * 1024, 1024, (bf16*)(ws + WS_WOUT) + (size_t)l * 1024 * 1024, 1024, nb * 32, nb * 32, kb * 64, scr, C.lane); }
        else if (it < N2) { const int q = it - N1, l = q >> 8, r = q & 255, kb = r >> 4, nb = r & 15;
            transpose_item(in[I_CAWQ] + (size_t)l * 1024 * 512, 512, (bf16*)(ws + WS_WCAQ) + (size_t)l * 512 * 1024, 1024, nb * 32, nb * 32, kb * 64, scr, C.lane); }
        else if (it < N3) { const int q = it - N2, l = q >> 9, r = q & 511, kb = r >> 5, nb = r & 31;
            transpose_item(in[I_CAWKV] + (size_t)l * 1024 * 1024, 1024, (bf16*)(ws + WS_WCAKV) + (size_t)l * 1024 * 1024, 1024, nb * 32, nb * 32, kb * 64, scr, C.lane); }
        else if (it < N4) { const int q = it - N3, l = q >> 8, r = q & 255, kb = r >> 5, nb = r & 31;
            transpose_item(in[I_CAWO] + (size_t)l * 512 * 1024, 1024, (bf16*)(ws + WS_WCAO) + (size_t)l * 1024 * 512, 512, nb * 32, nb * 32, kb * 64, scr, C.lane); }
        else if (it < N5) { const int q = it - N4, le = q >> 11, r = q & 2047, kb = r >> 7, nb = r & 127, n0 = nb * 32, pn = n0 >> 8, j = n0 & 255;
            transpose_item(in[I_WGU] + (size_t)le * 1024 * 4096, 4096, (bf16*)(ws + WS_WGU) + (size_t)le * 4096 * 1024, 1024, n0, j < 128 ? pn * 128 + j : 2048 + pn * 128 + (j - 128), kb * 64, scr, C.lane); }
        else { const int q = it - N5, le = q >> 10, r = q & 1023, kb = r >> 5, nb = r & 31;
            transpose_item(in[I_WDN] + (size_t)le * 2048 * 1024, 1024, (bf16*)(ws + WS_WDN) + (size_t)le * 1024 * 2048, 2048, nb * 32, nb * 32, kb * 64, scr, C.lane); }
    }
    const int gt = C.gw * 64 + C.lane, NGT = C.NGW * 64;
    for (int i = gt; i < 2048 * 1024 / 8; i += NGT) { const f32x4* s = (const f32x4*)(in[I_MEM]) + 2 * (size_t)i; const f32x4 a = s[0], b = s[1];
        v4u o; o.x = pk2(a.x, a.y); o.y = pk2(a.z, a.w); o.z = pk2(b.x, b.y); o.w = pk2(b.z, b.w); ((v4u*)(ws + WS_MEMB))[i] = o; }
    for (int i = gt; i < 4096 * 32; i += NGT) { const int t = i >> 5, f = i & 31; const int pos = (f < 16) ? (t >> 6) : (t & 63);
        double invd = 1.0; for (int k = 0; k < (f & 15); ++k) invd *= 0.5623413251903491;
        const float inv = (float)invd; const float ang = (float)pos * inv; const double ad = (double)ang;
        const double nq = rint(ad * 0.6366197723675814); const double r = ad - nq * 1.5707963267948966, r2 = r * r;
        const double sr = r * (1.0 + r2 * (-1.0 / 6 + r2 * (1.0 / 120 + r2 * (-1.0 / 5040 + r2 * (1.0 / 362880 + r2 * (-1.0 / 39916800 + r2 * (1.0 / 6227020800.0)))))));
        const double cr = 1.0 + r2 * (-0.5 + r2 * (1.0 / 24 + r2 * (-1.0 / 720 + r2 * (1.0 / 40320 + r2 * (-1.0 / 3628800 + r2 * (1.0 / 479001600.0))))));
        const int qd = ((int)nq) & 3; const double sn = (qd == 0) ? sr : (qd == 1) ? cr : (qd == 2) ? -sr : -cr; const double cs = (qd == 0) ? cr : (qd == 1) ? -sr : (qd == 2) ? -cr : sr;
        ((float*)(ws + WS_ROPE))[i] = (float)cs; ((float*)(ws + WS_ROPE))[4096 * 32 + i] = (float)sn; }
    for (int i = gt; i < 4 * 4 * 64 * 64; i += NGT) { const int c = i & 63, e = (i >> 6) & 63, g = (i >> 12) & 3, l = i >> 14;
        const float v = in[I_POOLW][((size_t)(l * 4 + g) * 64 + c) * 64 + e] * in[I_POOLS][l * 256 + g * 64 + e]; ((bf16*)(ws + WS_POOLW))[i] = (bf16)f2bf(v); }
}

template <int MODE, bool COMBINE>
__device__ __forceinline__ void row_phase(const Ctx& C0, const float* xsrc, float* xdst, const float* gain, bf16* hn, const float* w16, int w16s, const float* bias16, float* out16, float* outf,
                                          const int* slotmap, const bf16* ys) {
    const Ctx C = phase_ctx(C0);
    float* W = (float*)(C.lds + RING_OFF);
    if (MODE == 1 || MODE == 2) {
        for (int idx = C.tid; idx < 16384; idx += 512) { const int e = idx >> 10, k = idx & 1023; W[idx] = w16[(size_t)k * w16s + e] * gain[k]; }
        __syncthreads();
    }
    const int lane = C.lane;
    f32x4 gv[4];
#pragma unroll
    for (int j = 0; j < 4; ++j) gv[j] = *(const f32x4*)(gain + 4 * lane + 256 * j);
    for (int pr = C.gw; pr < NTOK / 2; pr += C.NGW) {
        const int row0 = 2 * pr;
        f32x4 v[2][4];
#pragma unroll
        for (int r = 0; r < 2; ++r)
#pragma unroll
            for (int j = 0; j < 4; ++j) v[r][j] = *(const f32x4*)(xsrc + (size_t)(row0 + r) * 1024 + 4 * lane + 256 * j);
        if (COMBINE) {
#pragma unroll
            for (int r = 0; r < 2; ++r) { const int row = row0 + r, b = row >> 12;
                const int sm = slotmap[(size_t)row * 16 + (lane & 15)];
#pragma unroll
                for (int e = 0; e < 16; ++e) { const int s = __builtin_amdgcn_readlane(sm, e);
                    if (s >= 0) { const bf16* yr = ys + ((size_t)(e * ROWS_E + b * CAP + s)) * 1024 + 4 * lane;
#pragma unroll
                        for (int j = 0; j < 4; ++j) { const uint2 w = *(const uint2*)(yr + 256 * j); v[r][j] += (f32x4){bf_lo(w.x), bf_hi(w.x), bf_lo(w.y), bf_hi(w.y)}; } } }
#pragma unroll
                for (int j = 0; j < 4; ++j) *(f32x4*)(xdst + (size_t)row * 1024 + 4 * lane + 256 * j) = v[r][j]; }
        }
        float rstd[2];
#pragma unroll
        for (int r = 0; r < 2; ++r) { float ss = 0.f;
#pragma unroll
            for (int j = 0; j < 4; ++j) ss += (v[r][j].x * v[r][j].x + v[r][j].y * v[r][j].y) + (v[r][j].z * v[r][j].z + v[r][j].w * v[r][j].w);
            rstd[r] = 1.0f / sqrtf(wave_sum(ss) * (1.0f / 1024.0f) + EPS); }
#pragma unroll
        for (int r = 0; r < 2; ++r)
#pragma unroll
            for (int j = 0; j < 4; ++j) { const f32x4 h = v[r][j] * rstd[r] * gv[j];
                if (MODE == 3) *(f32x4*)(outf + (size_t)(row0 + r) * 1024 + 4 * lane + 256 * j) = h;
                else { uint2 o; o.x = pk2(h.x, h.y); o.y = pk2(h.z, h.w); *(uint2*)(hn + (size_t)(row0 + r) * 1024 + 4 * lane + 256 * j) = o; } }
        if (MODE == 1 || MODE == 2) {
            float a[32];
#pragma unroll
            for (int e = 0; e < 16; ++e) { float a0 = 0.f, a1 = 0.f;
#pragma unroll
                for (int j = 0; j < 4; ++j) { const f32x4 w = *(const f32x4*)(W + e * 1024 + 4 * lane + 256 * j);
                    a0 += (v[0][j].x * w.x + v[0][j].y * w.y) + (v[0][j].z * w.z + v[0][j].w * w.w); a1 += (v[1][j].x * w.x + v[1][j].y * w.y) + (v[1][j].z * w.z + v[1][j].w * w.w); }
                a[e] = a0; a[16 + e] = a1; if (e & 1) asm volatile("" ::: "memory"); }
            float b16[16], b8[8], b4[4], b2[2], b1;
#pragma unroll
            for (int i = 0; i < 16; ++i) { const bool up = (lane & 32) != 0; const float send = up ? a[i] : a[16 + i], keep = up ? a[16 + i] : a[i]; b16[i] = keep + __shfl_xor(send, 32); }
#pragma unroll
            for (int i = 0; i < 8; ++i) { const bool up = (lane & 16) != 0; const float send = up ? b16[i] : b16[8 + i], keep = up ? b16[8 + i] : b16[i]; b8[i] = keep + __shfl_xor(send, 16); }
#pragma unroll
            for (int i = 0; i < 4; ++i) { const bool up = (lane & 8) != 0; const float send = up ? b8[i] : b8[4 + i], keep = up ? b8[4 + i] : b8[i]; b4[i] = keep + __shfl_xor(send, 8); }
#pragma unroll
            for (int i = 0; i < 2; ++i) { const bool up = (lane & 4) != 0; const float send = up ? b4[i] : b4[2 + i], keep = up ? b4[2 + i] : b4[i]; b2[i] = keep + __shfl_xor(send, 4); }
            { const bool up = (lane & 2) != 0; const float send = up ? b2[0] : b2[1], keep = up ? b2[1] : b2[0]; b1 = keep + __shfl_xor(send, 2); }
            b1 += __shfl_xor(b1, 1);
            const int rr = lane >> 5, e = (lane >> 1) & 15, row = row0 + rr;
            float val = b1 * (rr ? rstd[1] : rstd[0]);
            if (MODE == 1) { val += bias16[e];
                if (e >= 8) val = fminf(val, 0.f) - flog(1.0f + fexp(-fabsf(val)));
                if ((lane & 1) == 0) out16[(size_t)row * 16 + e] = val; }
            else { float mx = val;
#pragma unroll
                for (int o = 2; o < 32; o <<= 1) mx = fmaxf(mx, __shfl_xor(mx, o));
                const float ex = fexp(val - mx); float sm = ex;
#pragma unroll
                for (int o = 2; o < 32; o <<= 1) sm += __shfl_xor(sm, o);
                if ((lane & 1) == 0) out16[((size_t)((row >> 12) * 16 + e)) * 4096 + (row & 4095)] = ex / sm; }
        }
    }
    if (MODE == 1 || MODE == 2) __syncthreads();
}

__device__ __forceinline__ void prep_phase(const Ctx& C0, int layer, const float* const* in) {
    const Ctx C = phase_ctx(C0);
    bf16* PROJ = (bf16*)(C.ws + WS_PROJ); bf16* YCAT = (bf16*)(C.ws + WS_YCAT); bf16* MQK = (bf16*)(C.ws + WS_MQK);
    const bf16* PW = (const bf16*)(C.ws + WS_POOLW) + (size_t)layer * 4 * 64 * 64;
    const float* ROPEC = (const float*)(C.ws + WS_ROPE); const float* ROPES = ROPEC + 4096 * 32;
    const float* qg = in[I_QNG] + layer * 64; const float* kg = in[I_KNG] + layer * 64;
    const float* cw = in[I_CONVW] + (size_t)layer * 5 * 512;
    const int lane = C.lane, rr = lane & 15, q = lane >> 4;
    float cwv[5][8];
#pragma unroll
    for (int j = 0; j < 5; ++j)
#pragma unroll
        for (int i = 0; i < 8; ++i) cwv[j][i] = cw[j * 512 + lane * 8 + i];
    for (int grp = C.gw; grp < NTOK / 16; grp += C.NGW) {
        const int r0 = grp * 16, brow = r0 & ~4095, t0 = r0 & 4095;
        { const int t = t0 + rr;
#pragma unroll
          for (int g = 0; g < 4; ++g) { const int half = 1 << g, w = 2 << g; const int lo = max(t - half, 0), hi = min(t + half, 4096); const float inv = 1.0f / (float)(hi - lo);
            bf16x8 bfr[2];
#pragma unroll
            for (int ks = 0; ks < 2; ++ks) { const int c0 = C_POOL + g * 64 + ks * 32 + q * 8; float sum[8];
#pragma unroll
                for (int i = 0; i < 8; ++i) sum[i] = 0.f;
                for (int u = 0; u < w; ++u) { const int tu = t - half + u; if (tu >= 0 && tu < 4096) { const v4u x = *(const v4u*)(PROJ + (size_t)(brow + tu) * NPROJ + c0);
                    sum[0] += bf_lo(x.x); sum[1] += bf_hi(x.x); sum[2] += bf_lo(x.y); sum[3] += bf_hi(x.y); sum[4] += bf_lo(x.z); sum[5] += bf_hi(x.z); sum[6] += bf_lo(x.w); sum[7] += bf_hi(x.w); } }
                const v4u s = *(const v4u*)(PROJ + (size_t)(brow + t) * NPROJ + c0);
                const float d0 = sum[0] * inv - bf_lo(s.x), d1 = sum[1] * inv - bf_hi(s.x), d2 = sum[2] * inv - bf_lo(s.y), d3 = sum[3] * inv - bf_hi(s.y);
                const float d4 = sum[4] * inv - bf_lo(s.z), d5 = sum[5] * inv - bf_hi(s.z), d6 = sum[6] * inv - bf_lo(s.w), d7 = sum[7] * inv - bf_hi(s.w);
                v4u pk; pk.x = pk2(d0, d1); pk.y = pk2(d2, d3); pk.z = pk2(d4, d5); pk.w = pk2(d6, d7); bfr[ks] = __builtin_bit_cast(bf16x8, pk); }
#pragma unroll
            for (int et = 0; et < 4; ++et) { f32x4 acc = (f32x4){0.f, 0.f, 0.f, 0.f};
#pragma unroll
                for (int ks = 0; ks < 2; ++ks) { const bf16x8 afr = *(const bf16x8*)(PW + ((size_t)(g * 64 + et * 16 + rr)) * 64 + ks * 32 + q * 8); acc = MFMA16(afr, bfr[ks], acc); }
                uint2 o; o.x = pk2(acc.x, acc.y); o.y = pk2(acc.z, acc.w);
                *(uint2*)(YCAT + (size_t)(r0 + rr) * 1024 + g * 64 + et * 16 + 4 * q) = o; } } }
        for (int r = 0; r < 16; ++r) { const int row = r0 + r, t = t0 + r;
            bf16* prow = PROJ + (size_t)row * NPROJ;
#pragma unroll
            for (int ps = 0; ps < 5; ++ps) { const int p = ps * 64 + lane; const int col = (ps < 4) ? C_AQ + 2 * p : C_AK + 2 * (p - 256); const int i = lane & 31;
                const unsigned w = *(const unsigned*)(prow + col); const float x0 = bf_lo(w), x1 = bf_hi(w);
                float ss = x0 * x0 + x1 * x1;
#pragma unroll
                for (int o = 1; o < 32; o <<= 1) ss += __shfl_xor(ss, o);
                const float rs = 1.0f / sqrtf(ss * (1.0f / 64.0f) + EPS);
                const float* gg = (ps < 4) ? qg : kg; const float y0 = x0 * rs * gg[2 * i], y1 = x1 * rs * gg[2 * i + 1];
                const float cs = ROPEC[t * 32 + i], sn = ROPES[t * 32 + i]; const float sc = (ps < 4) ? attn_body::C2 : 1.0f;
                *(unsigned*)(prow + col) = pk2((y0 * cs - y1 * sn) * sc, (y0 * sn + y1 * cs) * sc); }
            { float acc[8];
#pragma unroll
              for (int i = 0; i < 8; ++i) acc[i] = 0.f;
#pragma unroll
              for (int j = 0; j < 5; ++j) { const int tu = t + j - 2; if (tu >= 0 && tu < 4096) { const v4u x = *(const v4u*)(PROJ + (size_t)(brow + tu) * NPROJ + C_MQ + lane * 8);
                  acc[0] += cwv[j][0] * bf_lo(x.x); acc[1] += cwv[j][1] * bf_hi(x.x); acc[2] += cwv[j][2] * bf_lo(x.y); acc[3] += cwv[j][3] * bf_hi(x.y);
                  acc[4] += cwv[j][4] * bf_lo(x.z); acc[5] += cwv[j][5] * bf_hi(x.z); acc[6] += cwv[j][6] * bf_lo(x.w); acc[7] += cwv[j][7] * bf_hi(x.w); } }
              const float ks = (lane >= 32) ? 0.125f : 1.0f;
#pragma unroll
              for (int i = 0; i < 8; ++i) acc[i] = acc[i] * fsigmoid(acc[i]) * ks;
              v4u o; o.x = pk2(acc[0], acc[1]); o.y = pk2(acc[2], acc[3]); o.z = pk2(acc[4], acc[5]); o.w = pk2(acc[6], acc[7]);
              *(v4u*)(MQK + (size_t)row * 512 + lane * 8) = o; }
        }
    }
}

constexpr int ML_KT = 0, ML_VF = 17408, ML_VB = ML_VF + 21760, ML_SC = ML_VB + 21760;
__device__ __forceinline__ void mlstm_local_phase(const Ctx& C0) {
    const Ctx C = phase_ctx(C0);
    const bf16* PROJ = (const bf16*)(C.ws + WS_PROJ); const bf16* MQK = (const bf16*)(C.ws + WS_MQK); const float* GATES = (const float*)(C.ws + WS_GATES);
    float* CST = (float*)(C.ws + WS_CST); float* MLOC = (float*)(C.ws + WS_MSC); float* BLAST = MLOC + 2048;
    bf16* Kt = (bf16*)(C.lds + ML_KT); bf16* VtF = (bf16*)(C.lds + ML_VF); bf16* VtB = (bf16*)(C.lds + ML_VB);
    float* sc = (float*)(C.lds + ML_SC);
    const int tid = C.tid, lane = C.lane, wave = C.wave;
    for (int unit = C.vcu; unit < NBATCH * 4 * 32; unit += C.G) {
        const int c = unit & 31, h = (unit >> 5) & 3, b = unit >> 7; const size_t row0 = (size_t)b * 4096 + c * 128;
        if (tid < 128) { const float* gr = GATES + (row0 + tid) * 16; sc[tid] = gr[h]; sc[128 + tid] = gr[8 + h]; sc[256 + tid] = gr[4 + h]; sc[384 + tid] = gr[12 + h]; }
        __syncthreads();
        if (wave < 2) { const int dir = wave; const float* li = sc + dir * 256; const float* lf = li + 128; float* wv = sc + 512 + dir * 128;
            const int s0 = 2 * lane, s1 = s0 + 1; const float f0 = lf[s0], f1 = lf[s1]; float bc0, bc1, tot;
            if (dir == 0) { const float inc = wscan_add(f0 + f1, lane); bc1 = inc; bc0 = inc - f1; tot = __shfl(inc, 63); }
            else { const float suf = wscan_add_rev(f0 + f1, lane); bc0 = suf; bc1 = suf - f0; tot = __shfl(suf, 0); }
            const float g0 = tot - bc0 + li[s0], g1 = tot - bc1 + li[s1]; float mx = fmaxf(g0, g1);
#pragma unroll
            for (int o = 1; o < 64; o <<= 1) mx = fmaxf(mx, __shfl_xor(mx, o));
            wv[s0] = fexp(g0 - mx); wv[s1] = fexp(g1 - mx);
            if (lane == 0) { const int sidx = ((b * 4 + h) * 2 + dir) * 32 + c; MLOC[sidx] = mx; BLAST[sidx] = tot; } }
        __syncthreads();
#pragma unroll
        for (int it = 0; it < 2; ++it) { const int id = tid + it * 512, s = id >> 3, sl = id & 7; const float wf = sc[512 + s], wb = sc[640 + s];
            const v4u kx = *(const v4u*)(MQK + (row0 + s) * 512 + 256 + h * 64 + sl * 8); const v4u vx = *(const v4u*)(PROJ + (row0 + s) * NPROJ + C_MV + h * 64 + sl * 8);
            const unsigned kk[4] = {kx.x, kx.y, kx.z, kx.w}, vv[4] = {vx.x, vx.y, vx.z, vx.w};
#pragma unroll
            for (int i = 0; i < 4; ++i) { Kt[(sl * 8 + 2 * i) * 136 + s] = (bf16)(kk[i] & 0xffffu); Kt[(sl * 8 + 2 * i + 1) * 136 + s] = (bf16)(kk[i] >> 16);
                const float v0 = bf_lo(vv[i]), v1 = bf_hi(vv[i]);
                VtF[(sl * 8 + 2 * i) * 136 + s] = (bf16)f2bf(v0 * wf); VtF[(sl * 8 + 2 * i + 1) * 136 + s] = (bf16)f2bf(v1 * wf);
                VtB[(sl * 8 + 2 * i) * 136 + s] = (bf16)f2bf(v0 * wb); VtB[(sl * 8 + 2 * i + 1) * 136 + s] = (bf16)f2bf(v1 * wb); } }
        if (tid < 128) { VtF[64 * 136 + tid] = (bf16)f2bf(sc[512 + tid]); VtB[64 * 136 + tid] = (bf16)f2bf(sc[640 + tid]);
#pragma unroll
            for (int e = 65; e < 80; ++e) { VtF[e * 136 + tid] = 0; VtB[e * 136 + tid] = 0; } }
        __syncthreads();
        { const int dir = wave >> 2, nt = wave & 3, rr = lane & 15, q = lane >> 4; const bf16* Vt = dir ? VtB : VtF;
          f32x4 acc[5];
#pragma unroll
          for (int m = 0; m < 5; ++m) acc[m] = (f32x4){0.f, 0.f, 0.f, 0.f};
#pragma unroll
          for (int ks = 0; ks < 4; ++ks) { const bf16x8 bfr = *(const bf16x8*)(Kt + (nt * 16 + rr) * 136 + ks * 32 + q * 8);
#pragma unroll
              for (int m = 0; m < 5; ++m) { const bf16x8 afr = *(const bf16x8*)(Vt + (m * 16 + rr) * 136 + ks * 32 + q * 8); acc[m] = MFMA16(afr, bfr, acc[m]); } }
          float* out = CST + (size_t)(((b * 4 + h) * 2 + dir) * 32 + c) * CST_SZ;
#pragma unroll
          for (int m = 0; m < 5; ++m)
#pragma unroll
              for (int j = 0; j < 4; ++j) { const int row = m * 16 + 4 * q + j; if (row < 65) out[row * 64 + nt * 16 + rr] = acc[m][j]; } }
        __syncthreads();
    }
}

__device__ __forceinline__ void mlstm_scan_phase(const Ctx& C0) {
    const Ctx C = phase_ctx(C0);
    float* CST = (float*)(C.ws + WS_CST); const float* MLOC = (const float*)(C.ws + WS_MSC); const float* BLAST = MLOC + 2048; float* MST = (float*)(C.ws + WS_MSC) + 4096;
    const int gt = C.gw * 64 + C.lane, NGT = C.NGW * 64;
    for (int item = gt; item < 64 * CST_SZ; item += NGT) {
        const int seq = item / CST_SZ, el = item - seq * CST_SZ, dir = seq & 1;
        float loc[32], ml[32], bl[32];
#pragma unroll
        for (int s = 0; s < 32; ++s) { const int c = dir ? 31 - s : s; const int idx = seq * 32 + c; loc[s] = CST[(size_t)idx * CST_SZ + el]; ml[s] = MLOC[idx]; bl[s] = BLAST[idx]; }
        float m = 0.f, st = 0.f;
#pragma unroll
        for (int s = 0; s < 32; ++s) { const int c = dir ? 31 - s : s; const int idx = seq * 32 + c;
            CST[(size_t)idx * CST_SZ + el] = st; if (el == 0) MST[idx] = m;
            const float mn = fmaxf(bl[s] + m, ml[s]); st = fexp(bl[s] + m - mn) * st + fexp(ml[s] - mn) * loc[s]; m = mn; }
    }
}

constexpr int MO_Q = 0, MO_K = 18432, MO_VT = 36864, MO_P = MO_VT + 21760, MO_C = MO_P + 34816, MO_SC = MO_C + 11520;
__device__ __forceinline__ void mlstm_out_phase(const Ctx& C0, int layer, const float* const* in) {
    const Ctx C = phase_ctx(C0);
    const bf16* PROJ = (const bf16*)(C.ws + WS_PROJ); const bf16* MQK = (const bf16*)(C.ws + WS_MQK); const float* GATES = (const float*)(C.ws + WS_GATES);
    const float* CST = (const float*)(C.ws + WS_CST); const float* MST = (const float*)(C.ws + WS_MSC) + 4096; bf16* YCAT = (bf16*)(C.ws + WS_YCAT);
    const float* ng = in[I_MNORMG] + layer * 256;
    bf16* Qs = (bf16*)(C.lds + MO_Q); bf16* Ks = (bf16*)(C.lds + MO_K); bf16* Vt = (bf16*)(C.lds + MO_VT); bf16* Ps = (bf16*)(C.lds + MO_P); bf16* Cs = (bf16*)(C.lds + MO_C);
    float* sc = (float*)(C.lds + MO_SC);
    const int tid = C.tid, lane = C.lane, wave = C.wave, rr = lane & 15, q = lane >> 4, j0 = wave * 16;
    for (int unit = C.vcu; unit < NBATCH * 4 * 32; unit += C.G) {
        const int c = unit & 31, h = (unit >> 5) & 3, b = unit >> 7; const size_t row0 = (size_t)b * 4096 + c * 128;
#pragma unroll
        for (int it = 0; it < 2; ++it) { const int id = tid + it * 512, s = id >> 3, sl = id & 7;
            *(v4u*)(Qs + s * 72 + sl * 8) = *(const v4u*)(MQK + (row0 + s) * 512 + h * 64 + sl * 8);
            *(v4u*)(Ks + s * 72 + sl * 8) = *(const v4u*)(MQK + (row0 + s) * 512 + 256 + h * 64 + sl * 8);
            const v4u vx = *(const v4u*)(PROJ + (row0 + s) * NPROJ + C_MV + h * 64 + sl * 8); const unsigned vv[4] = {vx.x, vx.y, vx.z, vx.w};
#pragma unroll
            for (int i = 0; i < 4; ++i) { Vt[(sl * 8 + 2 * i) * 136 + s] = (bf16)(vv[i] & 0xffffu); Vt[(sl * 8 + 2 * i + 1) * 136 + s] = (bf16)(vv[i] >> 16); } }
        if (tid < 128) { Vt[64 * 136 + tid] = (bf16)0x3f80;
#pragma unroll
            for (int e = 65; e < 80; ++e) Vt[e * 136 + tid] = 0; }
        f32x4 hsum[4];
#pragma unroll
        for (int et = 0; et < 4; ++et) hsum[et] = (f32x4){0.f, 0.f, 0.f, 0.f};
#pragma unroll 1
        for (int dir = 0; dir < 2; ++dir) {
            const int sidx = ((b * 4 + h) * 2 + dir) * 32 + c;
            __syncthreads();
            if (tid < 128) { const float* gr = GATES + (row0 + tid) * 16; sc[tid] = gr[dir * 4 + h]; sc[128 + tid] = gr[8 + dir * 4 + h]; }
            { const float* cs = CST + (size_t)sidx * CST_SZ;
              for (int id = tid; id < 80 * 64; id += 512) { const int e = id >> 6, d = id & 63; Cs[e * 72 + d] = (e < 65) ? (bf16)f2bf(cs[id]) : (bf16)0; } }
            __syncthreads();
            if (wave == 0) { const float mst = MST[sidx]; const int s0 = 2 * lane, s1 = s0 + 1; const float f0 = sc[128 + s0], f1 = sc[128 + s1]; float bc0, bc1;
                if (dir == 0) { const float inc = wscan_add(f0 + f1, lane); bc1 = inc; bc0 = inc - f1; }
                else { const float suf = wscan_add_rev(f0 + f1, lane); bc0 = suf; bc1 = suf - f0; }
                const float cb0 = sc[s0] - bc0, cb1 = sc[s1] - bc1; float mx0, mx1;
                if (dir == 0) { const float inc = wscan_max(fmaxf(cb0, cb1), lane); float prev = __shfl_up(inc, 1); if (lane == 0) prev = -INFINITY; mx1 = inc; mx0 = fmaxf(prev, cb0); }
                else { const float suf = wscan_max_rev(fmaxf(cb0, cb1), lane); float nxt = __shfl_down(suf, 1); if (lane == 63) nxt = -INFINITY; mx0 = suf; mx1 = fmaxf(nxt, cb1); }
                const float m0 = bc0 + fmaxf(mst, mx0), m1 = bc1 + fmaxf(mst, mx1);
                sc[256 + s0] = bc0 - m0; sc[256 + s1] = bc1 - m1; sc[384 + s0] = cb0; sc[384 + s1] = cb1;
                sc[512 + s0] = fexp(bc0 + mst - m0); sc[512 + s1] = fexp(bc1 + mst - m1); sc[640 + s0] = fexp(-m0); sc[640 + s1] = fexp(-m1); }
            __syncthreads();
            bf16x8 qa[2];
#pragma unroll
            for (int ks = 0; ks < 2; ++ks) qa[ks] = *(const bf16x8*)(Qs + (j0 + rr) * 72 + ks * 32 + q * 8);
            float ra[4];
#pragma unroll
            for (int i = 0; i < 4; ++i) ra[i] = sc[256 + j0 + 4 * q + i];
#pragma unroll
            for (int nt = 0; nt < 8; ++nt) { f32x4 acc = (f32x4){0.f, 0.f, 0.f, 0.f};
#pragma unroll
                for (int ks = 0; ks < 2; ++ks) { const bf16x8 bfr = *(const bf16x8*)(Ks + (nt * 16 + rr) * 72 + ks * 32 + q * 8); acc = MFMA16(qa[ks], bfr, acc); }
                const int s = nt * 16 + rr; const float cb = sc[384 + s];
#pragma unroll
                for (int i = 0; i < 4; ++i) { const int j = j0 + 4 * q + i; const bool ok = dir ? (s >= j) : (s <= j); const float p = ok ? acc[i] * fexp(ra[i] + cb) : 0.f; Ps[j * 136 + s] = (bf16)f2bf(p); } }
            LDS_WAIT(); asm volatile("" ::: "memory");
            f32x4 o[5];
#pragma unroll
            for (int et = 0; et < 5; ++et) { o[et] = (f32x4){0.f, 0.f, 0.f, 0.f};
#pragma unroll
                for (int ks = 0; ks < 2; ++ks) { const bf16x8 bfr = *(const bf16x8*)(Cs + (et * 16 + rr) * 72 + ks * 32 + q * 8); o[et] = MFMA16(qa[ks], bfr, o[et]); } }
            float ai[4], em[4];
#pragma unroll
            for (int i = 0; i < 4; ++i) { ai[i] = sc[512 + j0 + 4 * q + i]; em[i] = sc[640 + j0 + 4 * q + i]; }
#pragma unroll
            for (int et = 0; et < 5; ++et)
#pragma unroll
                for (int i = 0; i < 4; ++i) o[et][i] *= ai[i];
#pragma unroll
            for (int ks = 0; ks < 4; ++ks) { const bf16x8 afr = *(const bf16x8*)(Ps + (j0 + rr) * 136 + ks * 32 + q * 8);
#pragma unroll
                for (int et = 0; et < 5; ++et) { const bf16x8 bfr = *(const bf16x8*)(Vt + (et * 16 + rr) * 136 + ks * 32 + q * 8); o[et] = MFMA16(afr, bfr, o[et]); } }
#pragma unroll
            for (int i = 0; i < 4; ++i) { const float den = __shfl(o[4][i], lane & 48); const float dn = fmaxf(fabsf(den), em[i]); const float rinv = 1.0f / dn;
#pragma unroll
                for (int et = 0; et < 4; ++et) hsum[et][i] += o[et][i] * rinv; }
        }
#pragma unroll
        for (int i = 0; i < 4; ++i) { float ss = 0.f;
#pragma unroll
            for (int et = 0; et < 4; ++et) ss += hsum[et][i] * hsum[et][i];
#pragma unroll
            for (int o = 1; o < 16; o <<= 1) ss += __shfl_xor(ss, o);
            const float rs = 1.0f / sqrtf(ss * (1.0f / 64.0f) + EPS); const size_t row = row0 + j0 + 4 * q + i;
#pragma unroll
            for (int et = 0; et < 4; ++et) { const int e = et * 16 + rr; const float og = bf2f(PROJ[row * NPROJ + C_MO + h * 64 + e]);
                const float y = hsum[et][i] * rs * ng[h * 64 + e] * fsigmoid(og); YCAT[row * 1024 + 256 + h * 64 + e] = (bf16)f2bf(y); } }
        __syncthreads();
    }
}

__device__ __forceinline__ void topk_phase(const Ctx& C0) {
    const Ctx C = phase_ctx(C0);
    const float* AFF = (const float*)(C.ws + WS_AFF); int* TOKI = (int*)(C.ws + WS_TOKI); float* GATEV = (float*)(C.ws + WS_TOKI + 262144); int* SLOTMAP = (int*)(C.ws + WS_SLOTMAP);
    unsigned* hist = (unsigned*)(C.lds + RING_OFF); unsigned* sel = hist + 256; unsigned* wtot = hist + 264;
    const int tid = C.tid, lane = C.lane, wave = C.wave;
    for (int unit = C.vcu; unit < NBATCH * NEXP; unit += C.G) {
        const int b = unit >> 4, e = unit & 15; const float* a = AFF + (size_t)unit * 4096;
        unsigned key[8];
#pragma unroll
        for (int i = 0; i < 8; ++i) key[i] = __float_as_uint(a[tid + 512 * i]);
        unsigned prefix = 0u, mask = 0u; int krem = CAP;
#pragma unroll 1
        for (int pass = 3; pass >= 0; --pass) { const int shift = pass * 8;
            if (tid < 256) hist[tid] = 0u;
            __syncthreads();
#pragma unroll
            for (int i = 0; i < 8; ++i) if ((key[i] & mask) == prefix) atomicAdd(&hist[(key[i] >> shift) & 255u], 1u);
            __syncthreads();
            if (tid < 256) { unsigned s = 0u; for (int bb = tid + 1; bb < 256; ++bb) s += hist[bb]; const unsigned hh = hist[tid];
                if ((int)s < krem && (int)(s + hh) >= krem) { sel[0] = (unsigned)tid; sel[1] = s; } }
            __syncthreads();
            prefix |= sel[0] << shift; mask |= 255u << shift; krem -= (int)sel[1];
            __syncthreads();
        }
        const int cnt_gt = CAP - krem; int base_gt = 0, base_eq = 0;
#pragma unroll 1
        for (int i = 0; i < 8; ++i) { const bool gt = key[i] > prefix, eq = key[i] == prefix; const unsigned pk = (gt ? 1u : 0u) | (eq ? 65536u : 0u);
            unsigned inc = pk;
#pragma unroll
            for (int o = 1; o < 64; o <<= 1) { const unsigned t2 = __shfl_up(inc, o); if (lane >= o) inc += t2; }
            if (lane == 63) wtot[wave] = inc;
            __syncthreads();
            unsigned woff = 0u, tot = 0u;
#pragma unroll
            for (int w = 0; w < 8; ++w) { const unsigned x = wtot[w]; if (w < wave) woff += x; tot += x; }
            const unsigned ex = woff + inc - pk; const int pos_gt = base_gt + (int)(ex & 0xffffu), pos_eq = base_eq + (int)(ex >> 16);
            const bool selected = gt || (eq && pos_eq < krem); const int slot = gt ? pos_gt : cnt_gt + pos_eq; const int t = tid + 512 * i;
            if (selected) { TOKI[e * ROWS_E + b * CAP + slot] = b * 4096 + t; GATEV[e * ROWS_E + b * CAP + slot] = __uint_as_float(key[i]); }
            SLOTMAP[((size_t)(b * 4096 + t)) * 16 + e] = selected ? slot : -1;
            base_gt += (int)(tot & 0xffffu); base_eq += (int)(tot >> 16);
            __syncthreads();
        }
    }
}
#ifndef MK_ONE_LAUNCH
#define MK_ONE_LAUNCH 1
#endif
#ifndef PHM
#define PHM 0xFFFF
#endif
constexpr int NWAVES = 8;
constexpr int PH_PER_LAYER = 15, N_PHASES = 1 + DEPTH * PH_PER_LAYER;
struct Args { const float* in[N_IN]; float* out; unsigned char* ws; int ph_lo, ph_hi; };
static_assert(sizeof(Args) == (N_IN + 2) * 8 + 8, "no padding in Args");

__global__ void __launch_bounds__(NWAVES * 64, 2) mk_fwd(Args args) {
    extern __shared__ __attribute__((aligned(16))) unsigned char lds[];
    Ctx C;
    C.tid = threadIdx.x; C.lane = C.tid & 63; C.wave = __builtin_amdgcn_readfirstlane(C.tid >> 6);
    C.G = gridDim.x; { const int bx = blockIdx.x; C.vcu = (C.G % 8 == 0) ? (bx % 8) * (C.G / 8) + bx / 8 : bx; }
    C.gw = C.vcu * NWAVES + C.wave; C.NGW = C.G * NWAVES; C.lds = lds; C.ws = args.ws;
    unsigned char* ws = args.ws;
    LAS unsigned char* ldsl = (LAS unsigned char*)lds;
    volatile LAS unsigned* MISC = (volatile LAS unsigned*)(ldsl + MISC_OFF);
    for (int u = C.tid; u < (LDS_BYTES - LDSCTL_OFF) / 4; u += NWAVES * 64) ((LAS unsigned*)(ldsl + LDSCTL_OFF))[u] = 0u;
    __syncthreads();
    XcdBarrier bar; bar.bar = (unsigned*)(ws + WS_CTL) + CW_BAR; bar.x = 0; bar.st = nullptr;
    if (MK_ONE_LAUNCH) bar = xcd_barrier_post((unsigned*)(ws + WS_CTL) + CW_BAR, MISC + 8);
    const int lo = args.ph_lo, hi = args.ph_hi;
#define IN(k) (lo <= (k) && (k) < hi)
#define SEAM(k) do { if (IN(k) && IN((k) + 1)) xcd_barrier(bar); } while (0)
    const float* const* in = args.in;
#define HN ((bf16*)(ws + WS_HN))
#define PROJ ((bf16*)(ws + WS_PROJ))
#define YCAT ((bf16*)(ws + WS_YCAT))
#define QCA ((bf16*)(ws + WS_QCA))
#define X ((float*)(ws + WS_X))
#define GATES ((float*)(ws + WS_GATES))
#define AFF ((float*)(ws + WS_AFF))
#define TOKI ((int*)(ws + WS_TOKI))
#define GATEV ((float*)(ws + WS_TOKI + 262144))
#define SLOTMAP ((int*)(ws + WS_SLOTMAP))
#define ACT ((bf16*)(ws + WS_ACT))
#define YS ((bf16*)(ws + WS_YS))

    if ((PHM & 1) && IN(0)) {
        prologue_convert(C, in);
        __syncthreads();
        row_phase<1, false>(C, in[I_X], nullptr, in[I_NMIXG], HN, in[I_WIN] + 1280, 2064, in[I_GATEB], GATES, nullptr, nullptr, nullptr);
        SEAM(0);
    }
#pragma unroll 1
    for (int l = 0; l < DEPTH; ++l) {
        const int pb = 1 + l * PH_PER_LAYER;
        if ((PHM & (1 << 1)) && IN(pb + 0)) {
            if (l == 0) { pg8::Gemm g{(const pg8::bf16_t*)(ws + WS_MEMB), (const pg8::bf16_t*)(ws + WS_WCAKV), 1024, 0, 1024L * 1024, nullptr, 0}; pg8::Sched S; S.init(8, 4, 4, C.G, (int)blockIdx.x);
                pg8::EpiBf16 E{(pg8::bf16_t*)(ws + WS_KVCA), 1024, 2048L * 1024, 1.0f};
                pg8::gemm_phase<pg8::EpiBf16, true, false>(ldsl + RING_OFF, g, S, E); }
            { pg8::Gemm g{(const pg8::bf16_t*)HN, (const pg8::bf16_t*)(ws + WS_WIN) + (size_t)l * 2048 * 1024, 1024, 0, 0, nullptr, 0}; pg8::Sched S; S.init(NTOK / 256, NPROJ / 256, 1, C.G, (int)blockIdx.x);
              pg8::EpiBf16 E{(pg8::bf16_t*)PROJ, NPROJ, 0, 1.0f};
              pg8::gemm_phase<pg8::EpiBf16, true, false>(ldsl + RING_OFF, g, S, E); }
            SEAM(pb + 0);
        }
        if ((PHM & (1 << 2)) && IN(pb + 1)) { prep_phase(C, l, in); SEAM(pb + 1); }
        if ((PHM & (1 << 3)) && IN(pb + 2)) { mlstm_local_phase(C); SEAM(pb + 2); }
        if ((PHM & (1 << 4)) && IN(pb + 3)) { mlstm_scan_phase(C); SEAM(pb + 3); }
        if ((PHM & (1 << 5)) && IN(pb + 4)) {
#ifndef NO_MOUT
            mlstm_out_phase(C, l, in);
            __syncthreads();
#endif
#ifndef NO_ATTN
            for (int i = 0; i < 4; ++i) { const int u = C.vcu * 4 + i; if (u >= NBATCH * 8 * 16) break; const int qb = u & 15, h = (u >> 4) & 7, b = u >> 7;
                attn_body::attn_unit<8>((long)b * 4096, qb * 256, (const attn_body::bf16*)PROJ + C_AQ + h * 64, (const attn_body::bf16*)PROJ + C_AK + (h >> 2) * 64, (const attn_body::bf16*)PROJ + C_AV + (h >> 2) * 64,
                                        (attn_body::bf16*)YCAT + 512 + h * 64, (char*)lds + RING_OFF); }
#endif
            SEAM(pb + 4);
        }
        if ((PHM & (1 << 6)) && IN(pb + 5)) {
            pg8::Gemm g{(const pg8::bf16_t*)YCAT, (const pg8::bf16_t*)(ws + WS_WOUT) + (size_t)l * 1024 * 1024, 1024, 0, 0, nullptr, 0}; pg8::Sched S; S.init(NTOK / 256, 4, 1, C.G, (int)blockIdx.x);
            pg8::EpiResid E{(l == 0) ? in[I_X] : X, X, 1024};
            pg8::gemm_phase<pg8::EpiResid, true, false>(ldsl + RING_OFF, g, S, E);
            SEAM(pb + 5);
        }
        if ((PHM & (1 << 7)) && IN(pb + 6)) { row_phase<0, false>(C, X, nullptr, in[I_NMEMG] + l * 1024, HN, nullptr, 0, nullptr, nullptr, nullptr, nullptr, nullptr); SEAM(pb + 6); }
        if ((PHM & (1 << 8)) && IN(pb + 7)) {
            pg8::Gemm g{(const pg8::bf16_t*)HN, (const pg8::bf16_t*)(ws + WS_WCAQ) + (size_t)l * 512 * 1024, 1024, 0, 0, nullptr, 0}; pg8::Sched S; S.init(NTOK / 256, 2, 1, C.G, (int)blockIdx.x);
            pg8::EpiBf16 E{(pg8::bf16_t*)QCA, 512, 0, attn_body::CA_C2};
            pg8::gemm_phase<pg8::EpiBf16, true, false>(ldsl + RING_OFF, g, S, E);
            SEAM(pb + 7);
        }
        if ((PHM & (1 << 9)) && IN(pb + 8)) {
            for (int up = C.vcu; up < 256; up += C.G) { const int bh = up >> 3, b = bh >> 2, hd = bh & 3, qt0 = (up & 7) * 2;
                attn_body::ca_pair(b, hd, qt0, (const attn_body::bf16*)QCA, (const attn_body::bf16*)(ws + WS_KVCA) + (size_t)l * 2048 * 1024, (attn_body::bf16*)QCA, (char*)lds + RING_OFF, (float*)(lds + XTRA_OFF)); }
            SEAM(pb + 8);
        }
        if ((PHM & (1 << 10)) && IN(pb + 9)) {
            pg8::Gemm g{(const pg8::bf16_t*)QCA, (const pg8::bf16_t*)(ws + WS_WCAO) + (size_t)l * 1024 * 512, 512, 0, 0, nullptr, 0}; pg8::Sched S; S.init(NTOK / 256, 4, 1, C.G, (int)blockIdx.x);
            pg8::EpiResid E{X, X, 1024};
            pg8::gemm_phase<pg8::EpiResid, true, false>(ldsl + RING_OFF, g, S, E);
            SEAM(pb + 9);
        }
        if ((PHM & (1 << 11)) && IN(pb + 10)) { row_phase<2, false>(C, X, nullptr, in[I_NFFNG] + l * 1024, HN, in[I_ROUTER] + (size_t)l * 1024 * 16, 16, nullptr, AFF, nullptr, nullptr, nullptr); SEAM(pb + 10); }
        if ((PHM & (1 << 12)) && IN(pb + 11)) { topk_phase(C); SEAM(pb + 11); }
        if ((PHM & (1 << 13)) && IN(pb + 12)) {
            pg8::Gemm g{(const pg8::bf16_t*)HN, (const pg8::bf16_t*)(ws + WS_WGU) + (size_t)l * 16 * 4096 * 1024, 1024, 0, 4096L * 1024, TOKI, ROWS_E}; pg8::Sched S; S.init(ROWS_E / 256, 16, NEXP, C.G, (int)blockIdx.x);
            pg8::EpiSwiGLU E{(pg8::bf16_t*)ACT, FFE, ROWS_E};
            pg8::gemm_phase<pg8::EpiSwiGLU, true, true>(ldsl + RING_OFF, g, S, E);
            SEAM(pb + 12);
        }
        if ((PHM & (1 << 14)) && IN(pb + 13)) {
            pg8::Gemm g{(const pg8::bf16_t*)ACT, (const pg8::bf16_t*)(ws + WS_WDN) + (size_t)l * 16 * 1024 * 2048, 2048, (long)ROWS_E * FFE, 1024L * 2048, nullptr, 0}; pg8::Sched S; S.init(ROWS_E / 256, 4, NEXP, C.G, (int)blockIdx.x);
            pg8::EpiDown E{(pg8::bf16_t*)YS, 1024, ROWS_E, GATEV};
            pg8::gemm_phase<pg8::EpiDown, true, false>(ldsl + RING_OFF, g, S, E);
            SEAM(pb + 13);
        }
        if ((PHM & (1 << 15)) && IN(pb + 14)) {
            if (l + 1 < DEPTH) { row_phase<1, true>(C, X, X, in[I_NMIXG] + (l + 1) * 1024, HN, in[I_WIN] + (size_t)(l + 1) * 1024 * 2064 + 1280, 2064, in[I_GATEB] + (l + 1) * 16, GATES, nullptr, SLOTMAP, YS); SEAM(pb + 14); }
            else row_phase<3, true>(C, X, X, in[I_FNG], nullptr, nullptr, 0, nullptr, nullptr, args.out, SLOTMAP, YS);
        }
    }
#undef IN
#undef SEAM
#undef HN
#undef PROJ
#undef YCAT
#undef QCA
#undef X
#undef GATES
#undef AFF
#undef TOKI
#undef GATEV
#undef SLOTMAP
#undef ACT
#undef YS
}

extern "C" void kernel_launch(void* const* d_in, const int* in_sizes, int n_in, void* d_out, int out_size, void* d_ws, size_t ws_size, hipStream_t stream) {
    static int grid = 0;
    if (grid == 0) {
        if (n_in != N_IN || in_sizes[0] != NTOK * DMODEL || out_size != NTOK * DMODEL || ws_size < WS_END) { fprintf(stderr, "kernel_launch: unexpected shapes (n_in %d, in0 %d, out %d, ws %zu); nothing launched\n", n_in, n_in > 0 ? in_sizes[0] : -1, out_size, ws_size); grid = -1; return; }
        int dev = 0, cus = 0, per_cu = 0;
        if (hipGetDevice(&dev) != hipSuccess || hipDeviceGetAttribute(&cus, hipDeviceAttributeMultiprocessorCount, dev) != hipSuccess) { grid = -1; return; }
        if (hipFuncSetAttribute((const void*)mk_fwd, hipFuncAttributeMaxDynamicSharedMemorySize, LDS_BYTES) != hipSuccess) { fprintf(stderr, "kernel_launch: hipFuncSetAttribute failed\n"); grid = -1; return; }
        if (hipOccupancyMaxActiveBlocksPerMultiprocessor(&per_cu, (const void*)mk_fwd, NWAVES * 64, LDS_BYTES) != hipSuccess || per_cu < 1) fprintf(stderr, "kernel_launch: occupancy query reports %d workgroups per CU\n", per_cu);
        (void)hipGetLastError();
        grid = cus;
    }
    if (grid < 0) return;
    if (hipMemsetAsync((char*)d_ws + WS_CTL, 0, CTL_ZERO_BYTES, stream) != hipSuccess) { fprintf(stderr, "kernel_launch: memset failed\n"); return; }
    Args a{};
    for (int i = 0; i < N_IN; ++i) a.in[i] = (const float*)d_in[i];
    a.out = (float*)d_out; a.ws = (unsigned char*)d_ws;
#if MK_ONE_LAUNCH
    a.ph_lo = 0; a.ph_hi = N_PHASES;
    hipLaunchKernelGGL(mk_fwd, dim3(grid), dim3(NWAVES * 64), LDS_BYTES, stream, a);
#else
    for (int p = 0; p < N_PHASES; ++p) { a.ph_lo = p; a.ph_hi = p + 1; hipLaunchKernelGGL(mk_fwd, dim3(grid), dim3(NWAVES * 64), LDS_BYTES, stream, a); }
#endif
    const hipError_t le = hipPeekAtLastError();
    if (le != hipSuccess) fprintf(stderr, "kernel_launch: launch failed: %s\n", hipGetErrorName(le));
}
```

```cpp
#include <hip/hip_runtime.h>
#include <hip/hip_bf16.h>
#include <cstdio>
#include <cstdint>
#include <cmath>
__device__ __forceinline__ int opaque_tid() { int t = (int)threadIdx.x; asm volatile("" : "+v"(t)); return t; }
#ifndef WGM_SET
#define WGM_SET 8
#endif
namespace pg8 {
#define PG8_LAS __attribute__((address_space(3)))
typedef unsigned short bf16_t;
typedef short bf16x8 __attribute__((ext_vector_type(8)));
typedef float f32x4 __attribute__((ext_vector_type(4)));
typedef unsigned u32x4 __attribute__((ext_vector_type(4)));
constexpr int BM = 256, BK = 64, HALF = 128, HTB = HALF * BK * 2  , STAGE_BYTES = 8 * HTB, NXCD = 8, WGM = WGM_SET;

__host__ __device__ __forceinline__ int lds_byte(int r, int c) { const int st = (r >> 4) * 2 + (c >> 5), rr = r & 15, cc = c & 31, ob = rr * 64 + cc * 2; return st * 1024 + (ob ^ (((ob >> 9) & 1) << 5)); }
__host__ __device__ __forceinline__ void stage_rc(int b, int& R, int& C) { const int st = b / 1024, sb = b % 1024, swz = sb ^ (((sb >> 9) & 1) << 5); R = (st >> 1) * 16 + swz / 64; C = (st & 1) * 32 + (swz % 64) / 2; }
__host__ __device__ __forceinline__ int perm32(int rho) { const int n = rho >> 4, i = rho & 15; return 8 * (i >> 2) + 4 * n + (i & 3); }

struct Unit { int pm, pn, e, i; };
struct Gemm { const bf16_t* A; const bf16_t* Bt; int K; long sAe, sBe; const int* gidx; int rowsPerE; const PG8_LAS unsigned short* ltab; };

struct Sched {
    int nM, nN, P, total, G, c, pm0;
    __device__ __forceinline__ void init(int nM_, int nN_, int nE_, int G_, int c_, int pm0_ = 0) { nM = nM_; nN = nN_; P = nM_ * nN_; total = P * nE_; G = G_; c = c_; pm0 = pm0_; }
    __device__ __forceinline__ bool next(int i, Unit& u) const {
        const long L = (long)i * G + c; if (L >= total) return false;
        const int e = (int)(L / P); int wgid = (int)(L % P);
        { const int q = P / NXCD, r = P % NXCD, xcd = wgid % NXCD, off = wgid / NXCD; wgid = (xcd < r ? xcd * (q + 1) : r * (q + 1) + (xcd - r) * q) + off; }
        const int nig = WGM * nN, gid = wgid / nig, fm = gid * WGM, gsz = (nM - fm) < WGM ? (nM - fm) : WGM;
        u.pm = pm0 + fm + ((wgid % nig) % gsz); u.pn = (wgid % nig) / gsz; u.e = e; u.i = i; return true;
    }
};

__device__ __forceinline__ unsigned cvt_pk_bf16(float lo, float hi) { unsigned r; asm volatile("v_cvt_pk_bf16_f32 %0, %1, %2" : "=v"(r) : "v"(lo), "v"(hi)); return r; }


#ifndef EPI_WT
#define EPI_WT 0
#endif
__device__ __forceinline__ void st16_u(void* p, u32x4 v) {
#if EPI_WT
    asm volatile("global_store_dwordx4 %0, %1, off sc1\n\ts_nop 2" :: "v"(p), "v"(v) : "memory");
#else
    *(u32x4*)p = v;
#endif
}
__device__ __forceinline__ void st16_f(void* p, f32x4 v) {
#if EPI_WT
    asm volatile("global_store_dwordx4 %0, %1, off sc1\n\ts_nop 2" :: "v"(p), "v"(v) : "memory");
#else
    *(f32x4*)p = v;
#endif
}
struct EpiBf16 {
    static constexpr int NST = 16;
    bf16_t* O; int ldc; long strideE; float scale;
    __device__ __forceinline__ void operator()(const f32x4 (&acc)[2][2][4][2], const Unit& u, int wr, int wc, int fr, int fq) const {
        const int row0 = u.pm * BM + wr * 64 + fr; const int col0 = u.pn * BM + wc * 32 + 8 * fq; bf16_t* base = O + (long)u.e * strideE;
#pragma unroll
        for (int ai = 0; ai < 2; ++ai)
#pragma unroll
            for (int m = 0; m < 4; ++m) { bf16_t* rowp = base + (size_t)(row0 + ai * HALF + m * 16) * ldc + col0;
#pragma unroll
                for (int bj = 0; bj < 2; ++bj) { const f32x4 v0 = acc[ai][bj][m][0] * scale, v1 = acc[ai][bj][m][1] * scale;
                    u32x4 w; w.x = cvt_pk_bf16(v0[0], v0[1]); w.y = cvt_pk_bf16(v0[2], v0[3]); w.z = cvt_pk_bf16(v1[0], v1[1]); w.w = cvt_pk_bf16(v1[2], v1[3]);
                    st16_u(rowp + bj * HALF, w); } }
    }
};
struct EpiResid {
    const float* xin; float* xout; int ldc; static constexpr int NST = 32;
    __device__ __forceinline__ void operator()(const f32x4 (&acc)[2][2][4][2], const Unit& u, int wr, int wc, int fr, int fq) const {
        const int row0 = u.pm * BM + wr * 64 + fr; const int col0 = u.pn * BM + wc * 32 + 8 * fq;
#pragma unroll
        for (int ai = 0; ai < 2; ++ai) { f32x4 r[4][2][2];
#pragma unroll
            for (int m = 0; m < 4; ++m) { const size_t ro = (size_t)(row0 + ai * HALF + m * 16) * ldc + col0;
#pragma unroll
                for (int bj = 0; bj < 2; ++bj) { r[m][bj][0] = *(const f32x4*)(xin + ro + bj * HALF); r[m][bj][1] = *(const f32x4*)(xin + ro + bj * HALF + 4); } }
#pragma unroll
            for (int m = 0; m < 4; ++m) { const size_t ro = (size_t)(row0 + ai * HALF + m * 16) * ldc + col0;
#pragma unroll
                for (int bj = 0; bj < 2; ++bj) { st16_f(xout + ro + bj * HALF, r[m][bj][0] + acc[ai][bj][m][0]); st16_f(xout + ro + bj * HALF + 4, r[m][bj][1] + acc[ai][bj][m][1]); } } }
    }
};
struct EpiResidX {
    const float* xin; float* xout; bf16_t* xb; float* part; int ldc; static constexpr int NST = 55;
    __device__ __forceinline__ void operator()(const f32x4 (&acc)[2][2][4][2], const Unit& u, int wr, int wc, int fr, int fq) const {
        const int row0 = u.pm * BM + wr * 64 + fr; const int col0 = u.pn * BM + wc * 32 + 8 * fq;
#pragma unroll
        for (int ai = 0; ai < 2; ++ai) { f32x4 r[4][2][2];
#pragma unroll
            for (int m = 0; m < 4; ++m) { const size_t ro = (size_t)(row0 + ai * HALF + m * 16) * ldc + col0;
#pragma unroll
                for (int bj = 0; bj < 2; ++bj) { r[m][bj][0] = *(const f32x4*)(xin + ro + bj * HALF); r[m][bj][1] = *(const f32x4*)(xin + ro + bj * HALF + 4); } }
#pragma unroll
            for (int m = 0; m < 4; ++m) { const int row = row0 + ai * HALF + m * 16; const size_t ro = (size_t)row * ldc + col0; float ss = 0.f;
#pragma unroll
                for (int bj = 0; bj < 2; ++bj) { const f32x4 n0 = r[m][bj][0] + acc[ai][bj][m][0], n1 = r[m][bj][1] + acc[ai][bj][m][1];
                    st16_f(xout + ro + bj * HALF, n0); st16_f(xout + ro + bj * HALF + 4, n1);
                    u32x4 w; w.x = cvt_pk_bf16(n0[0], n0[1]); w.y = cvt_pk_bf16(n0[2], n0[3]); w.z = cvt_pk_bf16(n1[0], n1[1]); w.w = cvt_pk_bf16(n1[2], n1[3]);
                    st16_u(xb + ro + bj * HALF, w);
                    ss += ((n0[0] * n0[0] + n0[1] * n0[1]) + (n0[2] * n0[2] + n0[3] * n0[3])) + ((n1[0] * n1[0] + n1[1] * n1[1]) + (n1[2] * n1[2] + n1[3] * n1[3])); }
                ss += __shfl_xor(ss, 16); ss += __shfl_xor(ss, 32);
                if (fq == 0) part[(size_t)row * 16 + u.pn * 4 + wc] = ss; } }
    }
};
struct EpiBf16S {
    bf16_t* O; int ldc; const PG8_LAS float* rs; static constexpr int NST = 16;
    __device__ __forceinline__ void operator()(const f32x4 (&acc)[2][2][4][2], const Unit& u, int wr, int wc, int fr, int fq) const {
        const int row0 = u.pm * BM + wr * 64 + fr; const int col0 = u.pn * BM + wc * 32 + 8 * fq;
        float rq[2][4];
#pragma unroll
        for (int ai = 0; ai < 2; ++ai)
#pragma unroll
            for (int m = 0; m < 4; ++m) rq[ai][m] = rs[u.i * BM + wr * 64 + fr + ai * HALF + m * 16];
#pragma unroll
        for (int ai = 0; ai < 2; ++ai)
#pragma unroll
            for (int m = 0; m < 4; ++m) { bf16_t* rowp = O + (size_t)(row0 + ai * HALF + m * 16) * ldc + col0;
#pragma unroll
                for (int bj = 0; bj < 2; ++bj) { const f32x4 v0 = acc[ai][bj][m][0] * rq[ai][m], v1 = acc[ai][bj][m][1] * rq[ai][m];
                    u32x4 w; w.x = cvt_pk_bf16(v0[0], v0[1]); w.y = cvt_pk_bf16(v0[2], v0[3]); w.z = cvt_pk_bf16(v1[0], v1[1]); w.w = cvt_pk_bf16(v1[2], v1[3]);
                    st16_u(rowp + bj * HALF, w); } }
    }
};
struct EpiResidB {
    const bf16_t* xin; bf16_t* xout; int ldc; static constexpr int NST = 16;
    __device__ __forceinline__ void operator()(const f32x4 (&acc)[2][2][4][2], const Unit& u, int wr, int wc, int fr, int fq) const {
        const int row0 = u.pm * BM + wr * 64 + fr; const int col0 = u.pn * BM + wc * 32 + 8 * fq;
#pragma unroll
        for (int ai = 0; ai < 2; ++ai) { u32x4 r[4][2];
#pragma unroll
            for (int m = 0; m < 4; ++m) { const size_t ro = (size_t)(row0 + ai * HALF + m * 16) * ldc + col0;
#pragma unroll
                for (int bj = 0; bj < 2; ++bj) r[m][bj] = *(const u32x4*)(xin + ro + bj * HALF); }
#pragma unroll
            for (int m = 0; m < 4; ++m) { const size_t ro = (size_t)(row0 + ai * HALF + m * 16) * ldc + col0;
#pragma unroll
                for (int bj = 0; bj < 2; ++bj) { const u32x4 q = r[m][bj];
                    const f32x4 n0 = (f32x4){__uint_as_float(q.x << 16), __uint_as_float(q.x & 0xffff0000u), __uint_as_float(q.y << 16), __uint_as_float(q.y & 0xffff0000u)} + acc[ai][bj][m][0];
                    const f32x4 n1 = (f32x4){__uint_as_float(q.z << 16), __uint_as_float(q.z & 0xffff0000u), __uint_as_float(q.w << 16), __uint_as_float(q.w & 0xffff0000u)} + acc[ai][bj][m][1];
                    u32x4 w; w.x = cvt_pk_bf16(n0[0], n0[1]); w.y = cvt_pk_bf16(n0[2], n0[3]); w.z = cvt_pk_bf16(n1[0], n1[1]); w.w = cvt_pk_bf16(n1[2], n1[3]);
                    st16_u(xout + ro + bj * HALF, w); } } }
    }
};
struct EpiResidXB {
    const bf16_t* xin; bf16_t* xout; float* part; int ldc; static constexpr int NST = 24;
    __device__ __forceinline__ void operator()(const f32x4 (&acc)[2][2][4][2], const Unit& u, int wr, int wc, int fr, int fq) const {
        const int row0 = u.pm * BM + wr * 64 + fr; const int col0 = u.pn * BM + wc * 32 + 8 * fq;
#pragma unroll
        for (int ai = 0; ai < 2; ++ai) { u32x4 r[4][2];
#pragma unroll
            for (int m = 0; m < 4; ++m) { const size_t ro = (size_t)(row0 + ai * HALF + m * 16) * ldc + col0;
#pragma unroll
                for (int bj = 0; bj < 2; ++bj) r[m][bj] = *(const u32x4*)(xin + ro + bj * HALF); }
#pragma unroll
            for (int m = 0; m < 4; ++m) { const int row = row0 + ai * HALF + m * 16; const size_t ro = (size_t)row * ldc + col0; float ss = 0.f;
#pragma unroll
                for (int bj = 0; bj < 2; ++bj) { const u32x4 q = r[m][bj];
                    const f32x4 n0 = (f32x4){__uint_as_float(q.x << 16), __uint_as_float(q.x & 0xffff0000u), __uint_as_float(q.y << 16), __uint_as_float(q.y & 0xffff0000u)} + acc[ai][bj][m][0];
                    const f32x4 n1 = (f32x4){__uint_as_float(q.z << 16), __uint_as_float(q.z & 0xffff0000u), __uint_as_float(q.w << 16), __uint_as_float(q.w & 0xffff0000u)} + acc[ai][bj][m][1];
                    u32x4 w; w.x = cvt_pk_bf16(n0[0], n0[1]); w.y = cvt_pk_bf16(n0[2], n0[3]); w.z = cvt_pk_bf16(n1[0], n1[1]); w.w = cvt_pk_bf16(n1[2], n1[3]);
                    st16_u(xout + ro + bj * HALF, w);
                    ss += ((n0[0] * n0[0] + n0[1] * n0[1]) + (n0[2] * n0[2] + n0[3] * n0[3])) + ((n1[0] * n1[0] + n1[1] * n1[1]) + (n1[2] * n1[2] + n1[3] * n1[3])); }
                ss += __shfl_xor(ss, 16); ss += __shfl_xor(ss, 32);
                if (fq == 0) part[(size_t)row * 16 + u.pn * 4 + wc] = ss; } }
    }
};
struct EpiBf16R {
    bf16_t* O; int ldc; float scale; const float* part; float eps; static constexpr int NST = 16;
    __device__ __forceinline__ void operator()(const f32x4 (&acc)[2][2][4][2], const Unit& u, int wr, int wc, int fr, int fq) const {
        const int row0 = u.pm * BM + wr * 64 + fr; const int col0 = u.pn * BM + wc * 32 + 8 * fq;
        f32x4 pq[2][4];
#pragma unroll
        for (int ai = 0; ai < 2; ++ai)
#pragma unroll
            for (int m = 0; m < 4; ++m) pq[ai][m] = *(const f32x4*)(part + (size_t)(row0 + ai * HALF + m * 16) * 16 + 4 * fq);
#pragma unroll
        for (int ai = 0; ai < 2; ++ai)
#pragma unroll
            for (int m = 0; m < 4; ++m) { const int row = row0 + ai * HALF + m * 16; const f32x4 p = pq[ai][m];
                float sq = (p[0] + p[1]) + (p[2] + p[3]); sq += __shfl_xor(sq, 16); sq += __shfl_xor(sq, 32);
                const float rs = scale * __builtin_amdgcn_rsqf(sq * (1.0f / 1024.0f) + eps);
                bf16_t* rowp = O + (size_t)row * ldc + col0;
#pragma unroll
                for (int bj = 0; bj < 2; ++bj) { const f32x4 v0 = acc[ai][bj][m][0] * rs, v1 = acc[ai][bj][m][1] * rs;
                    u32x4 w; w.x = cvt_pk_bf16(v0[0], v0[1]); w.y = cvt_pk_bf16(v0[2], v0[3]); w.z = cvt_pk_bf16(v1[0], v1[1]); w.w = cvt_pk_bf16(v1[2], v1[3]);
                    st16_u(rowp + bj * HALF, w); } }
    }
};
__device__ __forceinline__ float silu_f(float x) { return x * __builtin_amdgcn_rcpf(1.0f + __builtin_amdgcn_exp2f(-1.4426950408889634f * x)); }
struct EpiSwiGLU {
    bf16_t* O; int ldc; int rowsPerE; const PG8_LAS float* rs; static constexpr int NST = 8;
    __device__ __forceinline__ void operator()(const f32x4 (&acc)[2][2][4][2], const Unit& u, int wr, int wc, int fr, int fq) const {
        const int row0 = u.e * rowsPerE + u.pm * BM + wr * 64 + fr; const int col0 = u.pn * HALF + wc * 32 + 8 * fq;
        float rq[2][4];
#pragma unroll
        for (int ai = 0; ai < 2; ++ai)
#pragma unroll
            for (int m = 0; m < 4; ++m) rq[ai][m] = rs[u.i * BM + wr * 64 + fr + ai * HALF + m * 16];
#pragma unroll
        for (int ai = 0; ai < 2; ++ai)
#pragma unroll
            for (int m = 0; m < 4; ++m) { bf16_t* rowp = O + (size_t)(row0 + ai * HALF + m * 16) * ldc + col0; const float r = rq[ai][m];
                const f32x4 g0 = acc[ai][0][m][0] * r, g1 = acc[ai][0][m][1] * r, u0 = acc[ai][1][m][0] * r, u1 = acc[ai][1][m][1] * r;
                u32x4 w; w.x = cvt_pk_bf16(silu_f(g0[0]) * u0[0], silu_f(g0[1]) * u0[1]); w.y = cvt_pk_bf16(silu_f(g0[2]) * u0[2], silu_f(g0[3]) * u0[3]);
                w.z = cvt_pk_bf16(silu_f(g1[0]) * u1[0], silu_f(g1[1]) * u1[1]); w.w = cvt_pk_bf16(silu_f(g1[2]) * u1[2], silu_f(g1[3]) * u1[3]);
                st16_u(rowp, w); }
    }
};
struct EpiDown {
    bf16_t* O; int ldc; int rowsPerE; const PG8_LAS float* gate; static constexpr int NST = 16;
    __device__ __forceinline__ void operator()(const f32x4 (&acc)[2][2][4][2], const Unit& u, int wr, int wc, int fr, int fq) const {
        const int row0 = u.e * rowsPerE + u.pm * BM + wr * 64 + fr; const int col0 = u.pn * BM + wc * 32 + 8 * fq;
        float gt[2][4];
#pragma unroll
        for (int ai = 0; ai < 2; ++ai)
#pragma unroll
            for (int m = 0; m < 4; ++m) gt[ai][m] = gate[u.i * BM + wr * 64 + fr + ai * HALF + m * 16];
#pragma unroll
        for (int ai = 0; ai < 2; ++ai)
#pragma unroll
            for (int m = 0; m < 4; ++m) { const int row = row0 + ai * HALF + m * 16; bf16_t* rowp = O + (size_t)row * ldc + col0;
#pragma unroll
                for (int bj = 0; bj < 2; ++bj) { const f32x4 v0 = acc[ai][bj][m][0] * gt[ai][m], v1 = acc[ai][bj][m][1] * gt[ai][m];
                    u32x4 w; w.x = cvt_pk_bf16(v0[0], v0[1]); w.y = cvt_pk_bf16(v0[2], v0[3]); w.z = cvt_pk_bf16(v1[0], v1[1]); w.w = cvt_pk_bf16(v1[2], v1[3]);
                    st16_u(rowp + bj * HALF, w); } }
    }
};

typedef int i32x4 __attribute__((ext_vector_type(4)));
constexpr int TAB_MAXU = 16;
__device__ __forceinline__ void gather_table(PG8_LAS unsigned short* ltab, const int* gidx, int rowsPerE, const Sched& S, int maxu, PG8_LAS float* rtab, const float* rsrc) {
    const int tid = opaque_tid(), i = tid >> 5, r = (tid & 31) * 8; Unit u;
    if (i < maxu && S.next(i, u)) { const size_t o = (size_t)u.e * rowsPerE + u.pm * BM + r;
        const i32x4 g0 = *(const i32x4*)(gidx + o), g1 = *(const i32x4*)(gidx + o + 4); const f32x4 r0 = *(const f32x4*)(rsrc + o), r1 = *(const f32x4*)(rsrc + o + 4);
        u32x4 pk; pk.x = (unsigned)g0.x | ((unsigned)g0.y << 16); pk.y = (unsigned)g0.z | ((unsigned)g0.w << 16); pk.z = (unsigned)g1.x | ((unsigned)g1.y << 16); pk.w = (unsigned)g1.z | ((unsigned)g1.w << 16);
        *(PG8_LAS u32x4*)(ltab + i * BM + r) = pk; *(PG8_LAS f32x4*)(rtab + i * BM + r) = r0; *(PG8_LAS f32x4*)(rtab + i * BM + r + 4) = r1; }
    __syncthreads();
}
__device__ __forceinline__ void row_table(PG8_LAS float* tab, const float* src, int rowsPerE, const Sched& S, int maxu) {
    const int tid = opaque_tid(), i = tid >> 5, r = (tid & 31) * 8; Unit u;
    if (i < maxu && S.next(i, u)) { const size_t o = (size_t)u.e * rowsPerE + u.pm * BM + r; const f32x4 r0 = *(const f32x4*)(src + o), r1 = *(const f32x4*)(src + o + 4);
        *(PG8_LAS f32x4*)(tab + i * BM + r) = r0; *(PG8_LAS f32x4*)(tab + i * BM + r + 4) = r1; }
    __syncthreads();
}
template <class Epi, bool ALIGN_EPI, bool GATHER>
__device__ __forceinline__ void gemm_phase(PG8_LAS unsigned char* lds, const Gemm g, const Sched& S, const Epi& E) {
    const int tid = opaque_tid(), wid = __builtin_amdgcn_readfirstlane(tid >> 6), lane = tid & 63, wr = wid >> 2, wc = wid & 3, fr = lane & 15, fq = lane >> 4;
    const int K = g.K, nt = K / BK;
    int Rr[2], Cc[2]; unsigned voffB[2];
#pragma unroll
    for (int i = 0; i < 2; ++i) { stage_rc(tid * 16 + i * 8192, Rr[i], Cc[i]); const int Rb = (Rr[i] & ~31) + perm32(Rr[i] & 31); voffB[i] = (unsigned)(Rb * K + Cc[i]) * 2u; }
    const size_t kstep = (size_t)(BK * 2);
    const size_t hstep = (size_t)HALF * K * 2;
    const size_t tstep = 2 * hstep;
    const unsigned ldsw = (unsigned)wid * 1024u;
    const int aoff = lds_byte(wr * 64 + fr, fq * 8), boff = lds_byte(wc * 32 + fr, fq * 8);
#define PG8_SA(b, h) (((b) * 2 + (h)) * HTB)
#define PG8_SB(b, h) ((4 + (b) * 2 + (h)) * HTB)
#define PG8_STAGE(bufoff, gbase, voff) do { _Pragma("unroll") for (int _i = 0; _i < 2; ++_i) \
        __builtin_amdgcn_global_load_lds((const unsigned*)((const char*)(gbase) + (voff)[_i]), (PG8_LAS unsigned*)(lds + (bufoff) + ldsw + _i * 8192), 16, 0, 0); } while (0)
#define PG8_LDA(dst, b, h) do { _Pragma("unroll") for (int m = 0; m < 4; ++m) _Pragma("unroll") for (int k = 0; k < 2; ++k) dst[m][k] = *(const PG8_LAS bf16x8*)(lds + PG8_SA(b, h) + aoff + m * 2048 + k * 1024); } while (0)
#define PG8_LDB(dst, b, h) do { _Pragma("unroll") for (int n = 0; n < 2; ++n) _Pragma("unroll") for (int k = 0; k < 2; ++k) dst[n][k] = *(const PG8_LAS bf16x8*)(lds + PG8_SB(b, h) + boff + n * 2048 + k * 1024); } while (0)
#define PG8_MMA(ai, bj, At, Bt) do { __builtin_amdgcn_s_setprio(1); _Pragma("unroll") for (int m = 0; m < 4; ++m) _Pragma("unroll") for (int n = 0; n < 2; ++n) _Pragma("unroll") for (int k = 0; k < 2; ++k) \
        acc[ai][bj][m][n] = __builtin_amdgcn_mfma_f32_16x16x32_bf16(Bt[n][k], At[m][k], acc[ai][bj][m][n], 0, 0, 0); __builtin_amdgcn_s_setprio(0); } while (0)
#define PG8_WAIT_V(n) asm volatile("s_waitcnt vmcnt(" #n ")" ::: "memory")
#define PG8_WAIT_L(n) asm volatile("s_waitcnt lgkmcnt(" #n ")" ::: "memory")
#define PG8_WAIT_VR(flag, n) asm volatile("s_cmp_lg_u32 %0, 0\n\ts_cbranch_scc1 .Lrlx%=\n\ts_waitcnt vmcnt(8)\n.Lrlx%=:\n\ts_waitcnt vmcnt(%1)" :: "s"(flag), "n"(n) : "memory", "scc")
#define PG8_BAR __builtin_amdgcn_s_barrier()
#define PG8_SCHED __builtin_amdgcn_sched_barrier(0)
#define PG8_AOFF(dst, un, uidx) do { _Pragma("unroll") for (int _h = 0; _h < 2; ++_h) _Pragma("unroll") for (int _i = 0; _i < 2; ++_i) { \
        if constexpr (GATHER) { const int _row = g.ltab[(uidx) * BM + _h * HALF + Rr[_i]]; dst[_h][_i] = (unsigned)(_row * K + Cc[_i]) * 2u; } \
        else dst[_h][_i] = (unsigned)((Rr[_i] + _h * HALF) * K + Cc[_i]) * 2u; } } while (0)
#define PG8_ABASE(un) (GATHER ? (const char*)g.A : (const char*)g.A + ((size_t)(un).e * g.sAe) * 2 + (size_t)(un).pm * tstep)
#define PG8_BBASE(un) ((const char*)g.Bt + ((size_t)(un).e * g.sBe) * 2 + (size_t)(un).pn * tstep)
    Unit cur, nxt; int ui = 0;
    if (!S.next(0, cur)) return;
    f32x4 acc[2][2][4][2];
#pragma unroll
    for (int a = 0; a < 2; ++a)
#pragma unroll
        for (int b = 0; b < 2; ++b)
#pragma unroll
            for (int m = 0; m < 4; ++m)
#pragma unroll
                for (int n = 0; n < 2; ++n) acc[a][b][m][n] = (f32x4){0.f, 0.f, 0.f, 0.f};
    bf16x8 At[4][2], B0[2][2], B1[2][2];
    unsigned vC[2][2], vN[2][2];
    PG8_AOFF(vC, cur, 0);
#pragma unroll
    for (int _h = 0; _h < 2; ++_h) { vN[_h][0] = vC[_h][0]; vN[_h][1] = vC[_h][1]; }
    const char* cA = PG8_ABASE(cur); const char* cB = PG8_BBASE(cur);
    PG8_STAGE(PG8_SB(0, 0), cB, voffB); PG8_STAGE(PG8_SB(0, 1), cB + hstep, voffB); PG8_STAGE(PG8_SA(0, 0), cA, vC[0]); PG8_STAGE(PG8_SA(0, 1), cA, vC[1]);
    if (wr == 1) PG8_BAR;
    PG8_WAIT_V(2); PG8_BAR;
    PG8_STAGE(PG8_SB(1, 0), cB + kstep, voffB); PG8_STAGE(PG8_SA(1, 0), cA + kstep, vC[0]); PG8_STAGE(PG8_SB(1, 1), cB + hstep + kstep, voffB);
    PG8_WAIT_V(6); PG8_BAR;
    for (;;) {
        const bool has_next = S.next(ui + 1, nxt);
        const char* nA = has_next ? PG8_ABASE(nxt) : cA; const char* nB = has_next ? PG8_BBASE(nxt) : cB;
        if constexpr (GATHER) { if (has_next) { PG8_AOFF(vN, nxt, ui + 1); } else {
#pragma unroll
            for (int _h = 0; _h < 2; ++_h) { vN[_h][0] = vC[_h][0]; vN[_h][1] = vC[_h][1]; } } }
        for (int t = 0; t < nt; t += 2) {
            const bool last = (t == nt - 2);
            const char* a1 = cA + (size_t)(t + 1) * kstep;
            const char* a2 = last ? nA : cA + (size_t)(t + 2) * kstep; const char* b2 = last ? nB : cB + (size_t)(t + 2) * kstep;
            const char* a3 = a2 + kstep; const char* b3 = b2 + kstep;
            unsigned v2[2][2];
#pragma unroll
            for (int _h = 0; _h < 2; ++_h)
#pragma unroll
                for (int _i = 0; _i < 2; ++_i) { if constexpr (GATHER) v2[_h][_i] = last ? vN[_h][_i] : vC[_h][_i]; else v2[_h][_i] = vC[_h][_i]; }
            const int relax = __builtin_amdgcn_readfirstlane(((t == 0) && (ui > 0)) ? 1 : 0);
            PG8_LDB(B0, 0, 0); PG8_LDB(B1, 0, 1); PG8_SCHED; PG8_LDA(At, 0, 0); PG8_STAGE(PG8_SA(1, 1), a1, vC[1]);
            PG8_WAIT_VR(relax, 8 + Epi::NST);
            PG8_WAIT_L(0); PG8_BAR; PG8_MMA(0, 0, At, B0); PG8_MMA(0, 1, At, B1); PG8_BAR; PG8_SCHED;
            PG8_LDA(At, 0, 1); PG8_STAGE(PG8_SB(0, 0), b2, voffB); PG8_STAGE(PG8_SB(0, 1), b2 + hstep, voffB); PG8_STAGE(PG8_SA(0, 0), a2, v2[0]);
            PG8_WAIT_VR(relax, 8 + Epi::NST);
            PG8_WAIT_L(0); PG8_BAR; PG8_MMA(1, 0, At, B0); PG8_MMA(1, 1, At, B1); PG8_BAR; PG8_SCHED;
            PG8_LDB(B0, 1, 0); PG8_LDB(B1, 1, 1); PG8_SCHED; PG8_LDA(At, 1, 0); PG8_STAGE(PG8_SA(0, 1), a2, v2[1]);
            PG8_WAIT_V(8); PG8_WAIT_L(0); PG8_BAR; PG8_MMA(0, 0, At, B0); PG8_MMA(0, 1, At, B1); PG8_BAR; PG8_SCHED;
            PG8_LDA(At, 1, 1); PG8_STAGE(PG8_SB(1, 0), b3, voffB); PG8_STAGE(PG8_SB(1, 1), b3 + hstep, voffB); PG8_STAGE(PG8_SA(1, 0), a3, v2[0]);
            PG8_WAIT_V(8); PG8_WAIT_L(0); PG8_BAR; PG8_MMA(1, 0, At, B0); PG8_MMA(1, 1, At, B1); PG8_BAR; PG8_SCHED;
        }
        if constexpr (ALIGN_EPI) { if (wr == 0) PG8_BAR; }
        E(acc, cur, wr, wc, fr, fq);
        if (!has_next) break;
#pragma unroll
        for (int a = 0; a < 2; ++a)
#pragma unroll
            for (int b = 0; b < 2; ++b)
#pragma unroll
                for (int m = 0; m < 4; ++m)
#pragma unroll
                    for (int n = 0; n < 2; ++n) acc[a][b][m][n] = (f32x4){0.f, 0.f, 0.f, 0.f};
        cur = nxt; cA = nA; cB = nB; ++ui;
#pragma unroll
        for (int _h = 0; _h < 2; ++_h) { vC[_h][0] = vN[_h][0]; vC[_h][1] = vN[_h][1]; }
        if constexpr (ALIGN_EPI) { if (wr == 1) PG8_BAR; }
    }
    PG8_WAIT_V(0);
    if constexpr (!ALIGN_EPI) { if (wr == 0) PG8_BAR; }
    PG8_BAR;
#undef PG8_SA
#undef PG8_SB
#undef PG8_STAGE
#undef PG8_LDA
#undef PG8_LDB
#undef PG8_MMA
#undef PG8_WAIT_V
#undef PG8_WAIT_L
#undef PG8_WAIT_VR
#undef PG8_BAR
#undef PG8_SCHED
#undef PG8_AOFF
#undef PG8_ABASE
#undef PG8_BBASE
}
}
namespace attn_body {
using bf16=__hip_bfloat16;
using bf16x8=__attribute__((ext_vector_type(8)))short;
using s16x4=__attribute__((ext_vector_type(4)))short;
using f32x16=__attribute__((ext_vector_type(16)))float;
using u32x4=__attribute__((ext_vector_type(4)))unsigned;
constexpr int SEQ=4096,D=64,QP=2048,KP=2048,VP=2048,OP=1024;
constexpr int NW=8,QBLK=32,QB=QBLK*NW,KVBLK=64;
constexpr int ATTN_UNIT_ROWS=QB;
__device__ __forceinline__ int crow(int r,int hi){return (r&3)+8*(r>>2)+4*hi;}
#define SBAR() __builtin_amdgcn_sched_barrier(0)
__device__ __forceinline__ void cmask(f32x16&p0,f32x16&p1,int jb,int qrel,int hi){
  const float NEG=-INFINITY; int kb=64*jb+4*hi;
  #pragma unroll
  for(int r=0;r<16;++r){int kv=kb+(r&3)+8*(r>>2); if(kv>qrel)p0[r]=NEG; if(kv+32>qrel)p1[r]=NEG;}
}

#ifndef MAXCHK
#define MAXCHK 8
#endif
constexpr int NSLOT=3, SLOTB=8192;
constexpr int LDS_K=0, LDS_V=NSLOT*SLOTB, LDS_WS=2*NSLOT*SLOTB, LDS_OST=LDS_WS+NW*64*4, LDS_BYTES=LDS_OST+NW*4096;
constexpr float C2=0.125f*1.4426950408889634f;
__device__ __forceinline__ void glds16(const void*gsrc,unsigned lds_dst){unsigned keep;
  asm volatile("s_mov_b32 %0, m0\n\ts_mov_b32 m0, %2\n\ts_nop 0\n\tglobal_load_lds_dwordx4 %1, off\n\ts_mov_b32 m0, %0":"=&s"(keep):"v"(gsrc),"s"(lds_dst):"memory");}
__device__ __forceinline__ float max3f(float a,float b,float c){float r;asm("v_max3_f32 %0, %1, %2, %3":"=v"(r):"v"(a),"v"(b),"v"(c));return r;}
__device__ __forceinline__ float max2f(float a,float b){float r;asm("v_max_f32_e32 %0, %1, %2":"=v"(r):"v"(a),"v"(b));return r;}
__device__ __forceinline__ float fadd_s(float a,float b){float r;asm("v_add_f32_e32 %0, %1, %2":"=v"(r):"v"(a),"v"(b));return r;}
__device__ __forceinline__ float fsub_s(float a,float b){float r;asm("v_sub_f32_e32 %0, %1, %2":"=v"(r):"v"(a),"v"(b));return r;}
typedef float f32x2_t __attribute__((ext_vector_type(2))); typedef __bf16 bf16x2_t __attribute__((ext_vector_type(2)));
__device__ __forceinline__ unsigned cvtpk_s(float lo,float hi){f32x2_t v={lo,hi};bf16x2_t b=__builtin_convertvector(v,bf16x2_t);return __builtin_bit_cast(unsigned,b);}
#define WAIT_BAR(N) asm volatile("s_waitcnt vmcnt(" #N ") lgkmcnt(0)\n\ts_barrier":::"memory")

__device__ __forceinline__ void qkt(f32x16&p0,f32x16&p1,const char*Kslot,const bf16x8*qr,const f32x16&negm,int r32,int hi){
  const char*kb=Kslot+hi*1024+r32*16;
  #pragma unroll
  for(int d0=0;d0<4;++d0){
    const bf16x8 b0=*reinterpret_cast<const bf16x8*>(kb+d0*2048);
    const bf16x8 b1=*reinterpret_cast<const bf16x8*>(kb+d0*2048+512);
    if(d0==0){p0=__builtin_amdgcn_mfma_f32_32x32x16_bf16(b0,qr[0],negm,0,0,0);p1=__builtin_amdgcn_mfma_f32_32x32x16_bf16(b1,qr[0],negm,0,0,0);}
    else{p0=__builtin_amdgcn_mfma_f32_32x32x16_bf16(b0,qr[d0],p0,0,0,0);p1=__builtin_amdgcn_mfma_f32_32x32x16_bf16(b1,qr[d0],p1,0,0,0);}}
}
typedef __attribute__((address_space(3))) const char* lds_cptr;
typedef short v4i16_t __attribute__((ext_vector_type(4)));
__device__ __forceinline__ void kload8(bf16x8*kf,lds_cptr kp){
  kf[0]=*(const __attribute__((address_space(3))) bf16x8*)(kp);      kf[1]=*(const __attribute__((address_space(3))) bf16x8*)(kp+512);
  kf[2]=*(const __attribute__((address_space(3))) bf16x8*)(kp+2048); kf[3]=*(const __attribute__((address_space(3))) bf16x8*)(kp+2560);
  kf[4]=*(const __attribute__((address_space(3))) bf16x8*)(kp+4096); kf[5]=*(const __attribute__((address_space(3))) bf16x8*)(kp+4608);
  kf[6]=*(const __attribute__((address_space(3))) bf16x8*)(kp+6144); kf[7]=*(const __attribute__((address_space(3))) bf16x8*)(kp+6656);
}
__device__ __forceinline__ void kload2(bf16x8*kf,lds_cptr kp,int j){ kf[2*j]=*(const __attribute__((address_space(3))) bf16x8*)(kp+j*2048); kf[2*j+1]=*(const __attribute__((address_space(3))) bf16x8*)(kp+j*2048+512); }
__device__ __forceinline__ s16x4 vtr(lds_cptr p){ return __builtin_bit_cast(s16x4,__builtin_amdgcn_ds_read_tr16_b64_v4i16((__attribute__((address_space(3))) v4i16_t*)p)); }
__device__ __forceinline__ float rowmax(const f32x16&p0,const f32x16&p1){
  float a=max3f(p0[0],p0[1],p1[0]),b=max3f(p0[2],p0[3],p1[1]);a=max3f(a,p1[2],p1[3]);
  #pragma unroll
  for(int r=4;r<16;r+=4){a=max3f(a,p0[r],p0[r+1]);b=max3f(b,p0[r+2],p0[r+3]);a=max3f(a,p1[r],p1[r+1]);b=max3f(b,p1[r+2],p1[r+3]);}
  const float m=max2f(a,b);
  auto rr=__builtin_amdgcn_permlane32_swap(__float_as_uint(m),__float_as_uint(m),false,false);
  return max2f(__uint_as_float(rr[0]),__uint_as_float(rr[1]));
}
__device__ __forceinline__ void pv(f32x16*o,int vb,bf16x8 pa0,bf16x8 pa1,bf16x8 pa2,bf16x8 pa3){
  #pragma unroll
  for(int d0=0;d0<2;++d0){s16x4 lo[4],hi[4];
    #pragma unroll
    for(int ks=0;ks<4;++ks){
      asm volatile("ds_read_b64_tr_b16 %0,%1 offset:%c2":"=&v"(lo[ks]):"v"(vb),"i"(d0*4096+ks*1024):"memory");
      asm volatile("ds_read_b64_tr_b16 %0,%1 offset:%c2":"=&v"(hi[ks]):"v"(vb),"i"(d0*4096+ks*1024+512):"memory");}
    asm volatile("s_waitcnt lgkmcnt(0)":::"memory");SBAR();
    #define PK(k) (bf16x8){lo[k][0],lo[k][1],lo[k][2],lo[k][3],hi[k][0],hi[k][1],hi[k][2],hi[k][3]}
    o[d0]=__builtin_amdgcn_mfma_f32_32x32x16_bf16(pa0,PK(0),o[d0],0,0,0);
    o[d0]=__builtin_amdgcn_mfma_f32_32x32x16_bf16(pa1,PK(1),o[d0],0,0,0);
    o[d0]=__builtin_amdgcn_mfma_f32_32x32x16_bf16(pa2,PK(2),o[d0],0,0,0);
    o[d0]=__builtin_amdgcn_mfma_f32_32x32x16_bf16(pa3,PK(3),o[d0],0,0,0);
    #undef PK
  }
}

#ifndef ATTN_STORE16
#define ATTN_STORE16(p,v) (*(u32x4*)(p)=(v))
#endif
template<int THRL> __device__ __forceinline__ void attn_unit(long rowbase,int q0,const bf16*Qh,const bf16*__restrict__ Kh,const bf16*__restrict__ Vh,bf16*Oh,char*shm){
  const int tid=opaque_tid(),lane=tid&63,r32=lane&31,hi=lane>>5; const int wid=__builtin_amdgcn_readfirstlane(tid>>6);
  const bf16*Qw=Qh+(rowbase+q0+wid*QBLK)*QP;
  const bf16*Kb=Kh+rowbase*KP,*Vb=Vh+rowbase*VP;
  const unsigned lds0=(unsigned)(uintptr_t)shm;
  float*wsf=(float*)(shm+LDS_WS)+wid*64;
  const bf16*ksrc=Kb+(long)lane*KP+wid*8;
  const bf16*vsrc=Vb+(long)(16*(wid&3)+(lane>>2))*VP+(wid>>2)*32+(lane&3)*8;
  const unsigned kdst=lds0+LDS_K+wid*1024, vdst=lds0+LDS_V+wid*1024;
  #define DMA_K(t,slot) glds16(ksrc+(long)(t)*KVBLK*KP,(unsigned)__builtin_amdgcn_readfirstlane(kdst+(slot)))
  #define DMA_V(t,slot) glds16(vsrc+(long)(t)*KVBLK*VP,(unsigned)__builtin_amdgcn_readfirstlane(vdst+(slot)))
  const int vb0=(int)(lds0+LDS_V)+((lane>>4)&1)*32+(lane&3)*8+(4*hi+((lane&15)>>2))*64;
  const char*Kbase=shm+LDS_K; bf16x8 kf[8];
  const lds_cptr shm3=(lds_cptr)shm; const lds_cptr kp0=shm3+LDS_K+hi*1024+r32*16; const lds_cptr vp0=shm3+LDS_V+((lane>>4)&1)*32+(lane&3)*8+(4*hi+((lane&15)>>2))*64;
  constexpr int NT=SEQ/KVBLK;
  DMA_K(0,0);DMA_V(0,0);DMA_K(1,SLOTB);
  bf16x8 qr[4];
  #pragma unroll
  for(int d0=0;d0<4;++d0)qr[d0]=*reinterpret_cast<const bf16x8*>(&Qw[(long)r32*QP+d0*16+hi*8]);
  float mhat=0.f,l_reg=0.f;f32x16 o[2];o[0]=f32x16{};o[1]=f32x16{};f32x16 negm=f32x16{};asm volatile("":"+v"(negm));
  const int qrel=wid*QBLK+r32;
  #define CMASK(P0,P1,t) do{}while(0)
  bool resc=false;
  #define START(P0,P1) do{ const float rm=rowmax(P0,P1); resc=false; \
    { const float dl=rm; mhat=fadd_s(mhat,dl); \
      _Pragma("unroll") for(int r=0;r<16;++r){P0[r]=fsub_s(P0[r],dl);P1[r]=fsub_s(P1[r],dl);} \
      _Pragma("unroll") for(int r=0;r<16;++r)negm[r]=-mhat; asm volatile("":"+v"(negm)); } \
    _Pragma("unroll") for(int r=0;r<16;++r)P0[r]=__builtin_amdgcn_exp2f(P0[r]); }while(0)
  #define RESC() do{ if(resc){ asm volatile("s_waitcnt lgkmcnt(0)":::"memory"); \
      _Pragma("unroll") for(int d_=0;d_<2;++d_) _Pragma("unroll") for(int r=0;r<16;++r)o[d_][r]*=wsf[crow(r,hi)]; } }while(0)
  f32x16 pA0,pA1,pB0,pB1;
  int sl_prev=0,sl_cur=0,sl_next=SLOTB;
  #define ROT() do{sl_prev=sl_cur;sl_cur=sl_next;sl_next=(sl_next==(NSLOT-1)*SLOTB)?0:sl_next+SLOTB;}while(0)
  DMA_K(2,2*SLOTB);
  WAIT_BAR(3);
  qkt(pA0,pA1,Kbase,qr,negm,r32,hi);asm volatile("s_nop 15\n\ts_nop 7":"+v"(pA0),"+v"(pA1));CMASK(pA0,pA1,0);
  START(pA0,pA1);
  _Pragma("unroll") for(int r=0;r<16;++r)pA1[r]=__builtin_amdgcn_exp2f(pA1[r]);
  WAIT_BAR(0);
  DMA_K(3,0);DMA_V(1,SLOTB);
  ROT();
  kload8(kf,kp0+sl_cur);
  WAIT_BAR(2);
  s16x4 vlo[8],vhi[8]; u32x4 pw0,pw1,pw2,pw3;
  #define PKW(P,B) cvtpk_s(P[B],P[B+1])
  #define PAF(k) __builtin_bit_cast(bf16x8,pw##k)
  #define VFR(i) (bf16x8){vlo[i][0],vlo[i][1],vlo[i][2],vlo[i][3],vhi[i][0],vhi[i][1],vhi[i][2],vhi[i][3]}
  #define PIN(x) asm volatile("":"+v"(x))
  #define MX3(a,b,c) __builtin_fmaxf(__builtin_fmaxf((a),(b)),(c))
  #define GAPA(MF,A0,A1,A2,A3,W0,W1,PW) do{ MF; sacc+=A0; sacc+=A1; sacc+=A2; sacc+=A3; PIN(sacc); W0; W1; PIN(PW); SBAR(); }while(0)
  #define EX(v) __builtin_amdgcn_exp2f(v)
  #define GAPB(MF,X,B) do{ MF; X[B]=EX(X[B]); X[B+1]=EX(X[B+1]); X[B+2]=EX(X[B+2]); X[B+3]=EX(X[B+3]); PIN(X); SBAR(); }while(0)
  #define VRD(i) do{ vlo[i]=vtr(vp_+(((i)>>2)*4096+((i)&3)*1024)); vhi[i]=vtr(vp_+(((i)>>2)*4096+((i)&3)*1024+512)); }while(0)
  #define KRD(G,j) do{ if(G){ kload2(kf,kp0+sl_next,j); SBAR(); } }while(0)
  #define STEP(C0,C1,P0,P1,t,GK,GV,GL) do{ SBAR(); \
    const lds_cptr vp_=vp0+sl_prev; \
    VRD(0); SBAR(); float sacc=(P0[0]+P0[1]); \
    GAPA(C0=__builtin_amdgcn_mfma_f32_32x32x16_bf16(kf[0],qr[0],negm,0,0,0), P0[2],P0[3],P0[4],P0[5],     pw0[0]=PKW(P0,0), pw0[1]=PKW(P0,2), pw0); \
    VRD(4); SBAR(); GAPA(C1=__builtin_amdgcn_mfma_f32_32x32x16_bf16(kf[1],qr[0],negm,0,0,0), P0[6],P0[7],P0[8],P0[9],     pw0[2]=PKW(P0,4), pw0[3]=PKW(P0,6), pw0); \
    VRD(1); SBAR(); GAPA(C0=__builtin_amdgcn_mfma_f32_32x32x16_bf16(kf[2],qr[1],C0,0,0,0),   P0[10],P0[11],P0[12],P0[13], pw1[0]=PKW(P0,8), pw1[1]=PKW(P0,10), pw1); \
    VRD(5); SBAR(); GAPA(C1=__builtin_amdgcn_mfma_f32_32x32x16_bf16(kf[3],qr[1],C1,0,0,0),   P0[14],P0[15],P1[0],P1[1],   pw1[2]=PKW(P0,12),pw1[3]=PKW(P0,14), pw1); \
    VRD(2); SBAR(); GAPA(C0=__builtin_amdgcn_mfma_f32_32x32x16_bf16(kf[4],qr[2],C0,0,0,0),   P1[2],P1[3],P1[4],P1[5],     pw2[0]=PKW(P1,0), pw2[1]=PKW(P1,2), pw2); \
    VRD(6); SBAR(); GAPA(C1=__builtin_amdgcn_mfma_f32_32x32x16_bf16(kf[5],qr[2],C1,0,0,0),   P1[6],P1[7],P1[8],P1[9],     pw2[2]=PKW(P1,4), pw2[3]=PKW(P1,6), pw2); \
    VRD(3); SBAR(); GAPA(C0=__builtin_amdgcn_mfma_f32_32x32x16_bf16(kf[6],qr[3],C0,0,0,0),   P1[10],P1[11],P1[12],P1[13], pw3[0]=PKW(P1,8), pw3[1]=PKW(P1,10), pw3); \
    VRD(7); SBAR(); GAPA(C1=__builtin_amdgcn_mfma_f32_32x32x16_bf16(kf[7],qr[3],C1,0,0,0),   P1[14],P1[15],0.f,0.f,       pw3[2]=PKW(P1,12),pw3[3]=PKW(P1,14), pw3); \
    l_reg+=sacc; \
    if(GK){DMA_K((t)+3,sl_cur);} if(GV){DMA_V((t)+1,sl_next);} \
    CMASK(C0,C1,t); \
    resc=false; \
    if((((t)&(MAXCHK-1))==0)){ float a=MX3(C0[0],C0[1],C1[0]),b=MX3(C0[2],C0[3],C1[1]); a=MX3(a,C1[2],C1[3]); \
      _Pragma("unroll") for(int r=4;r<16;r+=4){a=MX3(a,C0[r],C0[r+1]);b=MX3(b,C0[r+2],C0[r+3]);a=MX3(a,C1[r],C1[r+1]);b=MX3(b,C1[r+2],C1[r+3]);} \
      float rm=__builtin_fmaxf(a,b); { auto rr=__builtin_amdgcn_permlane32_swap(__float_as_uint(rm),__float_as_uint(rm),false,false); rm=__builtin_fmaxf(__uint_as_float(rr[0]),__uint_as_float(rr[1])); } \
      if(__builtin_expect(__any(rm>(float)THRL),0)){ const float dl=__builtin_fmaxf(rm,0.f); mhat+=dl; \
        _Pragma("unroll") for(int r=0;r<16;++r){C0[r]-=dl;C1[r]-=dl;} \
        _Pragma("unroll") for(int r=0;r<16;++r)negm[r]=-mhat; asm volatile("":"+v"(negm)); \
        const float f=__builtin_amdgcn_exp2f(-dl); l_reg*=f; if(hi==0)wsf[r32]=f; resc=true; } } \
    SBAR(); \
    GAPB(o[0]=__builtin_amdgcn_mfma_f32_32x32x16_bf16(PAF(0),VFR(0),o[0],0,0,0), C0,0); \
    GAPB(o[1]=__builtin_amdgcn_mfma_f32_32x32x16_bf16(PAF(0),VFR(4),o[1],0,0,0), C0,4); \
    KRD(GL,0); GAPB(o[0]=__builtin_amdgcn_mfma_f32_32x32x16_bf16(PAF(1),VFR(1),o[0],0,0,0), C0,8); \
    KRD(GL,1); GAPB(o[1]=__builtin_amdgcn_mfma_f32_32x32x16_bf16(PAF(1),VFR(5),o[1],0,0,0), C0,12); \
    KRD(GL,2); GAPB(o[0]=__builtin_amdgcn_mfma_f32_32x32x16_bf16(PAF(2),VFR(2),o[0],0,0,0), C1,0); \
    KRD(GL,3); GAPB(o[1]=__builtin_amdgcn_mfma_f32_32x32x16_bf16(PAF(2),VFR(6),o[1],0,0,0), C1,4); \
    GAPB(o[0]=__builtin_amdgcn_mfma_f32_32x32x16_bf16(PAF(3),VFR(3),o[0],0,0,0), C1,8); \
    GAPB(o[1]=__builtin_amdgcn_mfma_f32_32x32x16_bf16(PAF(3),VFR(7),o[1],0,0,0), C1,12); \
    }while(0)
  int t=1;
  #undef CMASK
  #define CMASK(P0,P1,t) do{}while(0)
  for(;t+5<NT;t+=2){
    STEP(pB0,pB1,pA0,pA1,t,true,true,true);     WAIT_BAR(2); RESC(); ROT();
    STEP(pA0,pA1,pB0,pB1,t+1,true,true,true);   WAIT_BAR(2); RESC(); ROT();
  }
  #undef CMASK
  #define CMASK(P0,P1,t) do{}while(0)
  #define ENDW(tt) do{ if((tt)+3<NT){WAIT_BAR(2);} else if((tt)+2<NT){WAIT_BAR(1);} else {WAIT_BAR(0);} }while(0)
  for(;t+1<NT;t+=2){
    STEP(pB0,pB1,pA0,pA1,t,(t+3<NT),(t+1<NT),(t+1<NT));       ENDW(t);   RESC(); ROT();
    STEP(pA0,pA1,pB0,pB1,t+1,(t+4<NT),(t+2<NT),(t+2<NT));     ENDW(t+1); RESC(); ROT();
  }
  STEP(pB0,pB1,pA0,pA1,NT-1,false,false,false); RESC();
  { float sacc=pB0[0]+pB0[1]; _Pragma("unroll") for(int r=2;r<16;++r)sacc+=pB0[r]; _Pragma("unroll") for(int r=0;r<16;++r)sacc+=pB1[r]; l_reg+=sacc;
    pw0=(u32x4){PKW(pB0,0),PKW(pB0,2),PKW(pB0,4),PKW(pB0,6)};pw1=(u32x4){PKW(pB0,8),PKW(pB0,10),PKW(pB0,12),PKW(pB0,14)};pw2=(u32x4){PKW(pB1,0),PKW(pB1,2),PKW(pB1,4),PKW(pB1,6)};pw3=(u32x4){PKW(pB1,8),PKW(pB1,10),PKW(pB1,12),PKW(pB1,14)};
    SBAR(); pv(o,vb0+sl_cur,PAF(0),PAF(1),PAF(2),PAF(3)); }
  #undef PKW
  #undef PAF
  #undef VFR
  #undef PIN
  #undef MX3
  #undef GAPA
  #undef GAPB
  #undef EX
  #undef VRD
  #undef KRD
  #undef STEP
  #undef ENDW
  {auto rr=__builtin_amdgcn_permlane32_swap(__float_as_uint(l_reg),__float_as_uint(l_reg),false,false);l_reg=__uint_as_float(rr[0])+__uint_as_float(rr[1]);}
  if(hi==0)wsf[32+r32]=l_reg;asm volatile("s_waitcnt lgkmcnt(0)":::"memory");
  float rli[16];
  #pragma unroll
  for(int r=0;r<16;++r)rli[r]=__builtin_amdgcn_rcpf(wsf[32+crow(r,hi)]);
  bf16*Ow=Oh+(rowbase+q0+wid*QBLK)*OP;
  { bf16*stg=(bf16*)(shm+LDS_OST)+wid*2048;
    #pragma unroll
    for(int r=0;r<16;++r){const int orow=crow(r,hi);
      #pragma unroll
      for(int d0=0;d0<2;++d0)stg[orow*64+d0*32+r32]=__float2bfloat16(o[d0][r]*rli[r]);}
    asm volatile("s_waitcnt lgkmcnt(0)":::"memory");
    #pragma unroll
    for(int i=0;i<4;++i){const int row=i*8+(lane>>3),ch=lane&7; const u32x4 v=*(const u32x4*)(stg+row*64+ch*8); ATTN_STORE16(Ow+(long)row*OP+ch*8,v);} }
  asm volatile("s_waitcnt lgkmcnt(0)\n\ts_barrier":::"memory");
  #undef DMA_K
  #undef DMA_V
  #undef CMASK
  #undef START
  #undef RESC
  #undef ROT
}
constexpr int CA_K=0, CA_V=65536, CA_BYTES=131072;
constexpr int CQP=512, CKP=1024;
constexpr float CA_C2=0.08838834764831845f*1.4426950408889634f;
__device__ __forceinline__ void ca_qkt(f32x16&p0,f32x16&p1,const char*Kslot,const bf16x8*qr,const f32x16&init,int r32,int hi){
  #pragma unroll
  for(int dh=0;dh<2;++dh){ const char*kb=Kslot+dh*8192+hi*1024+r32*16;
    #pragma unroll
    for(int d0=0;d0<4;++d0){
      const bf16x8 b0=*reinterpret_cast<const bf16x8*>(kb+d0*2048);
      const bf16x8 b1=*reinterpret_cast<const bf16x8*>(kb+d0*2048+512);
      if(dh==0&&d0==0){p0=__builtin_amdgcn_mfma_f32_32x32x16_bf16(b0,qr[0],init,0,0,0);p1=__builtin_amdgcn_mfma_f32_32x32x16_bf16(b1,qr[0],init,0,0,0);}
      else{p0=__builtin_amdgcn_mfma_f32_32x32x16_bf16(b0,qr[dh*4+d0],p0,0,0,0);p1=__builtin_amdgcn_mfma_f32_32x32x16_bf16(b1,qr[dh*4+d0],p1,0,0,0);}}}
}
template<int NQ> __device__ __forceinline__ void ca_tiles(int b,int hd,int qt0,const bf16*Q,const bf16*__restrict__ KV,bf16*O,char*shm,float*wsf_all){
  const int tid=opaque_tid(),lane=tid&63,r32=lane&31,hi=lane>>5; const int wid=__builtin_amdgcn_readfirstlane(tid>>6);
  const unsigned lds0=(unsigned)(uintptr_t)shm;
  float*wsf=wsf_all+wid*64;
  const bf16*Kg=KV+(long)(b*256)*CKP+hd*128; const bf16*Vg=Kg+512;
  #pragma unroll
  for(int kt=0;kt<4;++kt){
    #pragma unroll
    for(int dh=0;dh<2;++dh) glds16(Kg+(long)(kt*64+lane)*CKP+dh*64+wid*8,(unsigned)__builtin_amdgcn_readfirstlane(lds0+CA_K+(kt*2+dh)*8192+wid*1024)); }

  const int vb0=(int)(lds0+CA_V)+((lane>>4)&1)*32+(lane&3)*8+(4*hi+((lane&15)>>2))*64;
  for(int qi=0;qi<NQ;++qi){
    const long rowq=(long)b*4096+(qt0+qi)*256+wid*32;
    const bf16*Qw=Q+rowq*CQP+hd*128;
    bf16x8 qr[8];
    #pragma unroll
    for(int d0=0;d0<8;++d0)qr[d0]=*reinterpret_cast<const bf16x8*>(&Qw[(long)r32*CQP+d0*16+hi*8]);
    if(qi==0){
      #pragma unroll
      for(int kt=0;kt<4;++kt){
        #pragma unroll
        for(int dh=0;dh<2;++dh) glds16(Vg+(long)(kt*64+16*(wid&3)+(lane>>2))*CKP+dh*64+(wid>>2)*32+(lane&3)*8,(unsigned)__builtin_amdgcn_readfirstlane(lds0+CA_V+(kt*2+dh)*8192+wid*1024)); }
      WAIT_BAR(8); }
    f32x16 zero=f32x16{};
    f32x16 sc[4][2];
    #pragma unroll
    for(int kt=0;kt<4;++kt) ca_qkt(sc[kt][0],sc[kt][1],shm+CA_K+kt*2*8192,qr,zero,r32,hi);
    float mx=-INFINITY;
    #pragma unroll
    for(int kt=0;kt<4;++kt){
      #pragma unroll
      for(int r=0;r<16;++r)mx=__builtin_fmaxf(mx,__builtin_fmaxf(sc[kt][0][r],sc[kt][1][r])); }
    { auto rr=__builtin_amdgcn_permlane32_swap(__float_as_uint(mx),__float_as_uint(mx),false,false); mx=__builtin_fmaxf(__uint_as_float(rr[0]),__uint_as_float(rr[1])); }
    float l=0.f; u32x4 pw[4][4];
    #pragma unroll
    for(int kt=0;kt<4;++kt){ f32x16&p0=sc[kt][0]; f32x16&p1=sc[kt][1];
      #pragma unroll
      for(int r=0;r<16;++r){p0[r]=__builtin_amdgcn_exp2f(p0[r]-mx);p1[r]=__builtin_amdgcn_exp2f(p1[r]-mx);}
      float sacc=0.f;
      #pragma unroll
      for(int r=0;r<16;++r)sacc+=p0[r]+p1[r];
      l+=sacc;
      pw[kt][0]=(u32x4){cvtpk_s(p0[0],p0[1]),cvtpk_s(p0[2],p0[3]),cvtpk_s(p0[4],p0[5]),cvtpk_s(p0[6],p0[7])};
      pw[kt][1]=(u32x4){cvtpk_s(p0[8],p0[9]),cvtpk_s(p0[10],p0[11]),cvtpk_s(p0[12],p0[13]),cvtpk_s(p0[14],p0[15])};
      pw[kt][2]=(u32x4){cvtpk_s(p1[0],p1[1]),cvtpk_s(p1[2],p1[3]),cvtpk_s(p1[4],p1[5]),cvtpk_s(p1[6],p1[7])};
      pw[kt][3]=(u32x4){cvtpk_s(p1[8],p1[9]),cvtpk_s(p1[10],p1[11]),cvtpk_s(p1[12],p1[13]),cvtpk_s(p1[14],p1[15])}; }
    f32x16 o[4]; o[0]=f32x16{};o[1]=f32x16{};o[2]=f32x16{};o[3]=f32x16{};
    if(qi==0){ WAIT_BAR(0); }
    SBAR();
    #pragma unroll
    for(int kt=0;kt<4;++kt){
      pv(o,vb0+(kt*2)*8192,__builtin_bit_cast(bf16x8,pw[kt][0]),__builtin_bit_cast(bf16x8,pw[kt][1]),__builtin_bit_cast(bf16x8,pw[kt][2]),__builtin_bit_cast(bf16x8,pw[kt][3]));
      pv(o+2,vb0+(kt*2+1)*8192,__builtin_bit_cast(bf16x8,pw[kt][0]),__builtin_bit_cast(bf16x8,pw[kt][1]),__builtin_bit_cast(bf16x8,pw[kt][2]),__builtin_bit_cast(bf16x8,pw[kt][3]));
    }
    { auto rr=__builtin_amdgcn_permlane32_swap(__float_as_uint(l),__float_as_uint(l),false,false); l=__uint_as_float(rr[0])+__uint_as_float(rr[1]); }
    if(hi==0)wsf[r32]=l;
    asm volatile("s_waitcnt lgkmcnt(0)":::"memory");
    bf16*Ow=O+rowq*CQP+hd*128;
    float rli[16];
    #pragma unroll
    for(int r=0;r<16;++r)rli[r]=__builtin_amdgcn_rcpf(wsf[crow(r,hi)]);
    bf16*stg=(bf16*)(wsf_all+8*64)+wid*1024;
    #pragma unroll
    for(int d0=0;d0<4;++d0){
      #pragma unroll
      for(int r=0;r<16;++r)stg[crow(r,hi)*32+r32]=__float2bfloat16(o[d0][r]*rli[r]);
      asm volatile("s_waitcnt lgkmcnt(0)":::"memory");
      #pragma unroll
      for(int i=0;i<2;++i){const int idx=i*64+lane,row=idx>>2,ch=idx&3; const u32x4 v=*(const u32x4*)(stg+row*32+ch*8); *(u32x4*)(Ow+(long)row*CQP+d0*32+ch*8)=v;}
      asm volatile("s_waitcnt lgkmcnt(0)":::"memory");
    }
  }
  asm volatile("s_waitcnt lgkmcnt(0)\n\ts_barrier":::"memory");
}
#undef SBAR
#undef WAIT_BAR
}
#define GAS __attribute__((address_space(1)))
#define LAS __attribute__((address_space(3)))
typedef unsigned short bf16;
typedef unsigned v4u __attribute__((ext_vector_type(4)));
typedef float f32x4 __attribute__((ext_vector_type(4)));
typedef short bf16x8 __attribute__((ext_vector_type(8)));
typedef GAS unsigned gu32;
typedef GAS unsigned long long gu64;
#define RLX_AGENT __ATOMIC_RELAXED, __HIP_MEMORY_SCOPE_AGENT
#define LDS_WAIT() asm volatile("s_waitcnt lgkmcnt(0)" ::: "memory")
#define VM_WAIT() asm volatile("s_waitcnt vmcnt(0)" ::: "memory")
__device__ __forceinline__ unsigned long long rt() { return __builtin_amdgcn_s_memrealtime(); }
typedef float f32x2h __attribute__((ext_vector_type(2))); typedef __bf16 bf16x2h __attribute__((ext_vector_type(2)));
__device__ __forceinline__ unsigned pk2(float lo, float hi) { f32x2h v = {lo, hi}; bf16x2h b = __builtin_convertvector(v, bf16x2h); return __builtin_bit_cast(unsigned, b); }
__device__ __forceinline__ unsigned f2bf(float f) { return pk2(f, 0.f) & 0xffffu; }

#define XB_TMO      128
#define XB_XCNT(j)  (256  + 64 * (j))
#define XB_XSUB(j)  (1280 + 64 * (j))
#define XB_XGEN(j)  (2304 + 64 * (j))
#define XB_TOP      3328
#define XB_TOPGEN   3392
#define XCD_BAR_WORDS 3456
#define XB_SPIN_CAP (1u << 18)

__device__ __forceinline__ unsigned xb_ld(unsigned* p)              { return __hip_atomic_load(p, __ATOMIC_RELAXED, __HIP_MEMORY_SCOPE_AGENT); }
__device__ __forceinline__ unsigned xb_add(unsigned* p, unsigned v) { return __hip_atomic_fetch_add(p, v, __ATOMIC_RELAXED, __HIP_MEMORY_SCOPE_AGENT); }
__device__ __forceinline__ unsigned xb_xcc_id() { return (unsigned)__builtin_amdgcn_s_getreg((3 << 11) | 20) & 0xFu; }
__device__ __forceinline__ unsigned xb_poll(unsigned* p) { unsigned r; const unsigned z = 0u; asm volatile("global_atomic_add %0, %1, %2, off sc0\n\ts_waitcnt vmcnt(0)" : "=&v"(r) : "v"(p), "v"(z) : "memory"); return r; }
#define XB_SPIN(cond, bar) do { unsigned _sp = 0; while (cond) { __builtin_amdgcn_s_sleep(1); \
    if ((++_sp & 255u) == 0u) { if (xb_ld(&(bar)[XB_TMO])) break; if (_sp > XB_SPIN_CAP) { atomicAdd(&(bar)[XB_TMO], 1u); break; } } } } while (0)

struct XcdBarrier {
    unsigned* bar; unsigned x;
    volatile LAS unsigned* st;
};

__device__ __forceinline__ XcdBarrier xcd_barrier_post(unsigned* bar, volatile LAS unsigned* st) {
    XcdBarrier b; b.bar = bar; b.x = xb_xcc_id(); b.st = st;
    if (threadIdx.x == 0) (void)xb_add(&bar[XB_XCNT(b.x)], 1u);
    return b;
}
__device__ __forceinline__ void xcd_barrier_complete(unsigned* bar, unsigned x, unsigned& nloc, unsigned& nx) {
    const unsigned G = gridDim.x * gridDim.y * gridDim.z;
    unsigned sum, cnt, mine, sp = 0u;
    for (;;) {
        sum = 0u; cnt = 0u; mine = 0u;
        { unsigned cq[16]; unsigned* cb = &bar[XB_XCNT(0)];
#pragma unroll
          for (int j = 0; j < 16; ++j) asm volatile("global_load_dword %0, %1, off offset:%2 sc1" : "=v"(cq[j]) : "v"(cb), "n"(256 * j) : "memory");
          asm volatile("s_waitcnt vmcnt(0)" : "+v"(cq[0]), "+v"(cq[1]), "+v"(cq[2]), "+v"(cq[3]), "+v"(cq[4]), "+v"(cq[5]), "+v"(cq[6]), "+v"(cq[7]), "+v"(cq[8]), "+v"(cq[9]), "+v"(cq[10]), "+v"(cq[11]), "+v"(cq[12]), "+v"(cq[13]), "+v"(cq[14]), "+v"(cq[15]) :: "memory");
#pragma unroll
          for (unsigned j = 0; j < 16; ++j) { const unsigned c = cq[j]; sum += c; cnt += (c > 0u) ? 1u : 0u; mine = (j == x) ? c : mine; } }
        if (sum == G) break;
        __builtin_amdgcn_s_sleep(1);
        if ((++sp & 255u) == 0u) { if (xb_ld(&bar[XB_TMO])) break; if (sp > XB_SPIN_CAP) { atomicAdd(&bar[XB_TMO], 1u); break; } }
    }
    nloc = mine > 0u ? mine : 1u; nx = cnt > 0u ? cnt : 1u;
}

__device__ __forceinline__ void xcd_barrier(const XcdBarrier& b) {
    asm volatile("s_waitcnt vmcnt(0)" ::: "memory");
    __syncthreads();
    if (threadIdx.x == 0) {
        unsigned* bar = b.bar;
        __builtin_amdgcn_s_waitcnt(0);
        unsigned nloc = b.st[0], nx = b.st[1];
        if (nloc == 0u) { xcd_barrier_complete(bar, b.x, nloc, nx); b.st[0] = nloc; b.st[1] = nx; }
        const unsigned old = xb_add(&bar[XB_XSUB(b.x)], 1u);
        const unsigned gen = old / nloc;
        if (old + 1u == (gen + 1u) * nloc) {
            __builtin_amdgcn_fence(__ATOMIC_RELEASE, "agent");
            asm volatile("s_waitcnt vmcnt(0)" ::: "memory");
            const unsigned og = xb_add(&bar[XB_TOP], 1u);
            const unsigned tg = og / nx;
            if (og + 1u == (tg + 1u) * nx) xb_add(&bar[XB_TOPGEN], 1u);
            else XB_SPIN(xb_poll(&bar[XB_TOPGEN]) == tg, bar);
            __builtin_amdgcn_fence(__ATOMIC_ACQUIRE, "agent");
            xb_add(&bar[XB_XGEN(b.x)], 1u);
            asm volatile("s_waitcnt vmcnt(0)" ::: "memory");
        } else {
            XB_SPIN(xb_poll(&bar[XB_XGEN(b.x)]) == gen, bar);
            __builtin_amdgcn_fence(__ATOMIC_ACQUIRE, "agent");
            asm volatile("s_waitcnt vmcnt(0)" ::: "memory");
        }
    }
    __syncthreads();
}

template <class Work>
__device__ __forceinline__ void xcd_barrier_w(const XcdBarrier& b, const Work& work, volatile LAS unsigned* ctl) {
    asm volatile("s_waitcnt vmcnt(0)" ::: "memory");
    if (threadIdx.x == 0) { ctl[0] = 0u; work.reset(ctl); }
    __syncthreads();
    if (__builtin_amdgcn_readfirstlane(threadIdx.x >> 6) != 0) { work(ctl); }
    else if (threadIdx.x == 0) {
        unsigned* bar = b.bar;
        __builtin_amdgcn_s_waitcnt(0);
        unsigned nloc = b.st[0], nx = b.st[1];
        if (nloc == 0u) { xcd_barrier_complete(bar, b.x, nloc, nx); b.st[0] = nloc; b.st[1] = nx; }
        const unsigned old = xb_add(&bar[XB_XSUB(b.x)], 1u);
        const unsigned gen = old / nloc;
        if (old + 1u == (gen + 1u) * nloc) {
            __builtin_amdgcn_fence(__ATOMIC_RELEASE, "agent");
            asm volatile("s_waitcnt vmcnt(0)" ::: "memory");
            const unsigned og = xb_add(&bar[XB_TOP], 1u);
            const unsigned tg = og / nx;
            if (og + 1u == (tg + 1u) * nx) xb_add(&bar[XB_TOPGEN], 1u);
            else XB_SPIN(xb_ld(&bar[XB_TOPGEN]) == tg, bar);
            __builtin_amdgcn_fence(__ATOMIC_ACQUIRE, "agent");
            xb_add(&bar[XB_XGEN(b.x)], 1u);
            asm volatile("s_waitcnt vmcnt(0)" ::: "memory");
        } else {
            XB_SPIN(xb_ld(&bar[XB_XGEN(b.x)]) == gen, bar);
            __builtin_amdgcn_fence(__ATOMIC_ACQUIRE, "agent");
            asm volatile("s_waitcnt vmcnt(0)" ::: "memory");
        }
        ctl[0] = 1u;
    }
    __syncthreads();
}

__device__ __forceinline__ void local_barrier(unsigned* bar, unsigned* cnt, unsigned nblk, volatile LAS unsigned* genw) {
    asm volatile("s_waitcnt vmcnt(0)" ::: "memory");
    __syncthreads();
    if (threadIdx.x == 0) {
        __builtin_amdgcn_s_waitcnt(0);
        const unsigned gen = genw[0] + 1u; genw[0] = gen;
        (void)xb_add(cnt, 1u);
        XB_SPIN(xb_poll(cnt) < gen * nblk, bar);
        __builtin_amdgcn_fence(__ATOMIC_ACQUIRE, "agent");
        asm volatile("s_waitcnt vmcnt(0)" ::: "memory");
    }
    __syncthreads();
}

constexpr int DMODEL = 1024, NBATCH = 8, SEQL = 4096, DEPTH = 4, NTOK = NBATCH * SEQL;
constexpr int NPROJ = 2048;
constexpr int C_POOL = 0, C_MQ = 256, C_MK = 512, C_MV = 768, C_MO = 1024, C_AQ = 1280, C_AK = 1792, C_AV = 1920;
constexpr int NEXP = 16, CAP = 512, FFE = 2048, ROWS_E = NBATCH * CAP  , NSLOTS = NEXP * ROWS_E;
constexpr float EPS = 1e-6f;
enum { I_X = 0, I_MEM, I_NMIXG, I_WIN, I_POOLW, I_POOLS, I_CONVW, I_GATEB, I_MNORMG, I_QNG, I_KNG, I_WOUT, I_NMEMG, I_CAWQ, I_CAWKV, I_CAWO, I_NFFNG, I_ROUTER, I_WGU, I_WDN, I_FNG, N_IN };

constexpr size_t MiB = 1u << 20;
constexpr size_t WS_CTL = 0, CTL_ZERO_BYTES = 1 * MiB;
constexpr size_t WS_ROPE = 1 * MiB;
constexpr size_t WS_POOLW = 2 * MiB;
constexpr size_t WS_MEMB = 3 * MiB;
constexpr size_t WS_WIN = 8 * MiB;
constexpr size_t WS_WOUT = 24 * MiB;
constexpr size_t WS_WCAQ = 32 * MiB;
constexpr size_t WS_WCAKV = 36 * MiB;
constexpr size_t WS_WCAO = 44 * MiB;
constexpr size_t WS_KVCA = 48 * MiB;
constexpr size_t WS_WGU = 64 * MiB;
constexpr size_t WS_WDN = 576 * MiB;
constexpr size_t WS_X = 832 * MiB;
constexpr size_t WS_HN = 960 * MiB;
constexpr size_t WS_PROJ = 1024 * MiB;
constexpr size_t WS_MQK = 1152 * MiB;
constexpr size_t WS_YCAT = 1184 * MiB;
constexpr size_t WS_QCA = 1248 * MiB;
constexpr size_t WS_GATES = 1280 * MiB;
constexpr size_t WS_AFF = 1282 * MiB;
constexpr size_t WS_TOKI = 1284 * MiB;
constexpr size_t WS_SLOTMAP = 1285 * MiB;
constexpr size_t WS_MSC = 1287 * MiB;
constexpr size_t WS_CST = 1288 * MiB;
constexpr size_t WS_ACT = 1322 * MiB;
constexpr size_t WS_YS = 1578 * MiB;
constexpr size_t WS_KT = 1706 * MiB;
constexpr size_t WS_VT = 1722 * MiB;
constexpr size_t WS_CSB = 1738 * MiB;
constexpr size_t WS_PART = 1756 * MiB;
constexpr size_t WS_GV = 1758 * MiB;
constexpr size_t WS_END = 1762 * MiB;
constexpr int CST_SZ = 65 * 64;
constexpr int CW_BAR = 4096;
constexpr int CW_LOC = 8192;

constexpr int RING_OFF = 0, RING_BYTES = 131072;
constexpr int LDSCTL_OFF = RING_BYTES, MISC_OFF = LDSCTL_OFF + 320;
constexpr int XTRA_OFF = MISC_OFF + 128;
constexpr int LDS_BYTES = 156672;

__device__ __forceinline__ float wave_sum(float v) {
#pragma unroll
    for (int o = 1; o < 64; o <<= 1) v += __shfl_xor(v, o);
    return v;
}
__device__ __forceinline__ float bf_lo(unsigned w) { return __uint_as_float(w << 16); }
__device__ __forceinline__ float bf_hi(unsigned w) { return __uint_as_float(w & 0xffff0000u); }
__device__ __forceinline__ float bf2f(bf16 h) { return __uint_as_float(((unsigned)h) << 16); }
__device__ __forceinline__ float wscan_add(float v, int lane) {
#pragma unroll
    for (int o = 1; o < 64; o <<= 1) { const float t = __shfl_up(v, o); if (lane >= o) v += t; }
    return v;
}
__device__ __forceinline__ float wscan_add_rev(float v, int lane) {
#pragma unroll
    for (int o = 1; o < 64; o <<= 1) { const float t = __shfl_down(v, o); if (lane + o < 64) v += t; }
    return v;
}
__device__ __forceinline__ float wscan_max(float v, int lane) {
#pragma unroll
    for (int o = 1; o < 64; o <<= 1) { const float t = __shfl_up(v, o); if (lane >= o) v = fmaxf(v, t); }
    return v;
}
__device__ __forceinline__ float wscan_max_rev(float v, int lane) {
#pragma unroll
    for (int o = 1; o < 64; o <<= 1) { const float t = __shfl_down(v, o); if (lane + o < 64) v = fmaxf(v, t); }
    return v;
}
__device__ __forceinline__ float fexp(float x) { return __builtin_amdgcn_exp2f(x * 1.4426950408889634f); }
__device__ __forceinline__ float flog(float x) { return __builtin_amdgcn_logf(x) * 0.6931471805599453f; }
__device__ __forceinline__ float fsigmoid(float x) { return __builtin_amdgcn_rcpf(1.0f + fexp(-x)); }
typedef float f32x2v __attribute__((ext_vector_type(2)));
#define MFMA16(a, b, c) __builtin_amdgcn_mfma_f32_16x16x32_bf16((a), (b), (c), 0, 0, 0)

struct Ctx { int tid, lane, wave, G, vcu, gw, NGW; unsigned char* lds; unsigned char* ws; LAS unsigned char* ldsl; int ng, GB, grp, lb; };
__device__ __forceinline__ Ctx phase_ctx(const Ctx& C0) { Ctx C = C0; C.tid = opaque_tid(); C.lane = C.tid & 63; return C; }

__device__ __forceinline__ void transpose_item(const float* W, int ldw, bf16* WT, int K, int n0dst, int srccol0, int k0, LAS float* scr, int lane, const float* kscale = nullptr) {
    f32x4 v[8]; const int lr = lane >> 3, lc = (lane & 7) * 4;
#pragma unroll
    for (int i = 0; i < 8; ++i) v[i] = __builtin_nontemporal_load((const f32x4*)(W + (size_t)(k0 + 8 * i + lr) * ldw + srccol0 + lc));
    if (kscale) { float kq[8];
#pragma unroll
        for (int i = 0; i < 8; ++i) kq[i] = kscale[k0 + 8 * i + lr];
#pragma unroll
        for (int i = 0; i < 8; ++i) v[i] = v[i] * kq[i]; }
#pragma unroll
    for (int i = 0; i < 8; ++i) { LAS float* d = scr + (8 * i + lr) * 33 + lc; d[0] = v[i].x; d[1] = v[i].y; d[2] = v[i].z; d[3] = v[i].w; }
    LDS_WAIT(); asm volatile("" ::: "memory");
    const int c = lane & 7;
#pragma unroll
    for (int j = 0; j < 4; ++j) { const int n = (lane >> 3) + 8 * j; const LAS float* s = scr + (8 * c) * 33 + n;
        v4u o; o.x = pk2(s[0 * 33], s[1 * 33]); o.y = pk2(s[2 * 33], s[3 * 33]); o.z = pk2(s[4 * 33], s[5 * 33]); o.w = pk2(s[6 * 33], s[7 * 33]);
        *(v4u*)(WT + (size_t)(n0dst + n) * K + k0 + 8 * c) = o; }
    LDS_WAIT(); asm volatile("" ::: "memory");
}
#ifndef CV_NT
#define CV_NT 1
#endif
constexpr int EXP_ITEMS = 16 * 2048 + 16 * 1024;
struct ItemSrc { const float* W; int ldw; bf16* WT; int K, n0dst, srccol0, k0; const float* ks; };
__device__ __forceinline__ ItemSrc expert_item(unsigned char* ws, const float* const* in, int layer, int j) {
    ItemSrc I;
    if (j < 32768) { const int le = layer * 16 + (j >> 11), r = j & 2047, kb = r >> 7, nb = r & 127, n0 = nb * 32, pn = n0 >> 8, jj = n0 & 255;
        I.W = in[I_WGU] + (size_t)le * 1024 * 4096; I.ldw = 4096; I.WT = (bf16*)(ws + WS_WGU) + (size_t)le * 4096 * 1024; I.K = 1024; I.n0dst = n0; I.srccol0 = jj < 128 ? pn * 128 + jj : 2048 + pn * 128 + (jj - 128); I.k0 = kb * 64; I.ks = in[I_NFFNG] + layer * 1024; }
    else { const int q = j - 32768, le = layer * 16 + (q >> 10), r = q & 1023, kb = r >> 5, nb = r & 31;
        I.W = in[I_WDN] + (size_t)le * 2048 * 1024; I.ldw = 1024; I.WT = (bf16*)(ws + WS_WDN) + (size_t)le * 1024 * 2048; I.K = 2048; I.n0dst = nb * 32; I.srccol0 = nb * 32; I.k0 = kb * 64; I.ks = nullptr; }
    return I;
}
__device__ __forceinline__ void item_load(const ItemSrc& I, f32x4 (&v)[8], int lane) {
    const int lr = lane >> 3, lc = (lane & 7) * 4;
#pragma unroll
    for (int i = 0; i < 8; ++i) { const f32x4* p_ = (const f32x4*)(I.W + (size_t)(I.k0 + 8 * i + lr) * I.ldw + I.srccol0 + lc); v[i] = CV_NT ? __builtin_nontemporal_load(p_) : *p_; }
}
__device__ __forceinline__ void item_scale(const ItemSrc& I, f32x4 (&v)[8], int lane) {
    if (I.ks) { const int lr = lane >> 3; float kq[8];
#pragma unroll
        for (int i = 0; i < 8; ++i) kq[i] = I.ks[I.k0 + 8 * i + lr];
#pragma unroll
        for (int i = 0; i < 8; ++i) v[i] = v[i] * kq[i]; }
}
__device__ __forceinline__ void item_store(const ItemSrc& I, const f32x4 (&v)[8], LAS float* scr, int lane) {
    const int lr = lane >> 3, lc = (lane & 7) * 4;
#pragma unroll
    for (int i = 0; i < 8; ++i) { LAS float* d = scr + (8 * i + lr) * 33 + lc; d[0] = v[i].x; d[1] = v[i].y; d[2] = v[i].z; d[3] = v[i].w; }
    LDS_WAIT(); asm volatile("" ::: "memory");
    const int c = lane & 7;
#pragma unroll
    for (int j = 0; j < 4; ++j) { const int n = (lane >> 3) + 8 * j; const LAS float* s = scr + (8 * c) * 33 + n;
        v4u o; o.x = pk2(s[0 * 33], s[1 * 33]); o.y = pk2(s[2 * 33], s[3 * 33]); o.z = pk2(s[4 * 33], s[5 * 33]); o.w = pk2(s[6 * 33], s[7 * 33]);
        asm volatile("global_store_dwordx4 %0, %1, off sc1\n\ts_nop 2" :: "v"(I.WT + (size_t)(I.n0dst + n) * I.K + I.k0 + 8 * c), "v"(o) : "memory"); }
    LDS_WAIT(); asm volatile("" ::: "memory");
}
struct ConvWork {
    unsigned char* ws; const float* const* in; LAS unsigned char* ldsl; int layer, finish, vcu, G;
    __device__ __forceinline__ void reset(volatile LAS unsigned* ctl) const { if (layer < DEPTH && ctl[2] != (unsigned)(layer + 1)) { ctl[2] = (unsigned)(layer + 1); ctl[1] = 0u; } }
    __device__ __forceinline__ void operator()(volatile LAS unsigned* ctl) const {
        if (layer >= DEPTH) return;
        const int tid = opaque_tid(), lane = tid & 63, wave = __builtin_amdgcn_readfirstlane(tid >> 6);
        LAS float* scr = (LAS float*)(ldsl + RING_OFF + wave * 16384);
        for (;;) {
            if (!finish && ctl[0] != 0u) break;
            unsigned k = 0u; if (lane == 0) k = __hip_atomic_fetch_add((LAS unsigned*)(ctl + 1), 1u, __ATOMIC_RELAXED, __HIP_MEMORY_SCOPE_WORKGROUP);
            k = (unsigned)__builtin_amdgcn_readfirstlane((int)k);
            const long j = (long)k * G + vcu; if (j >= EXP_ITEMS) break;
            const ItemSrc J = expert_item(ws, in, layer, (int)j); f32x4 w[8]; item_load(J, w, lane); item_scale(J, w, lane); item_store(J, w, scr, lane);
        }
    }
};
__device__ __forceinline__ void phase_convert(unsigned char* ws, const float* const* in, LAS unsigned char* ldsl, int layer, int nper, int vcu, int G, volatile LAS unsigned* ctl) {
    if (layer >= DEPTH || ctl[2] != (unsigned)(layer + 1)) return;
    const int tid = opaque_tid(), lane = tid & 63, wave = __builtin_amdgcn_readfirstlane(tid >> 6);
    LAS float* scr = (LAS float*)(ldsl + RING_OFF + wave * 16384);
    for (int n = 0; n < nper; ++n) {
        unsigned k = 0u; if (lane == 0) k = __hip_atomic_fetch_add((LAS unsigned*)(ctl + 1), 1u, __ATOMIC_RELAXED, __HIP_MEMORY_SCOPE_WORKGROUP);
        k = (unsigned)__builtin_amdgcn_readfirstlane((int)k);
        const long j = (long)k * G + vcu; if (j >= EXP_ITEMS) break;
        const ItemSrc J = expert_item(ws, in, layer, (int)j); f32x4 w[8]; item_load(J, w, lane); item_scale(J, w, lane); item_store(J, w, scr, lane);
    }
}
#ifndef CV_NIT
#define CV_NIT 4
#endif
#ifndef CV_MAP
#define CV_MAP 1
#endif
__device__ __forceinline__ void convert_share(unsigned char* ws, const float* const* in, LAS unsigned char* ldsl, int layer, int vcu, int G, int part = 0, int nparts = 1) {
    const int tid = opaque_tid(), lane = tid & 63, wave = __builtin_amdgcn_readfirstlane(tid >> 6);
    LAS float* scr = (LAS float*)(ldsl + RING_OFF + wave * 16384);
    const int nk = (EXP_ITEMS - vcu + G - 1) / G;
    const int kspan = ((nk + nparts - 1) / nparts + 8 * CV_NIT - 1) / (8 * CV_NIT) * (8 * CV_NIT), kbeg = part * kspan, kend = min(nk, kbeg + kspan);
#pragma unroll 1
    for (int k0 = kbeg + wave; k0 < kend; k0 += 8 * CV_NIT) {
        ItemSrc I[CV_NIT]; f32x4 v[CV_NIT][8]; bool on[CV_NIT];
#pragma unroll
        for (int t = 0; t < CV_NIT; ++t) { const int k = k0 + 8 * t; on[t] = k < kend; if (on[t]) { I[t] = expert_item(ws, in, layer, (CV_MAP && G == 256) ? (((vcu & 3) * 192 + k) * 64 + (vcu >> 2)) : (k * G + vcu)); item_load(I[t], v[t], lane); } }
#pragma unroll
        for (int t = 0; t < CV_NIT; ++t) if (on[t]) { item_scale(I[t], v[t], lane); item_store(I[t], v[t], scr, lane); }
    }
}
#if defined(CV_MODE)
__device__ __forceinline__ void convert_share_probe(unsigned char* ws, const float* const* in, LAS unsigned char* ldsl, int layer, int vcu, int G) {
    const int tid = opaque_tid(), lane = tid & 63, wave = __builtin_amdgcn_readfirstlane(tid >> 6);
    LAS float* scr = (LAS float*)(ldsl + RING_OFF + wave * 16384);
    const int nk = (EXP_ITEMS - vcu + G - 1) / G; float sink = 0.f;
#pragma unroll 1
    for (int k0 = wave; k0 < nk; k0 += 24) {
        ItemSrc I[3]; f32x4 v[3][8]; bool on[3];
#pragma unroll
        for (int t = 0; t < 3; ++t) { const int k = k0 + 8 * t; on[t] = k < nk; if (on[t]) { I[t] = expert_item(ws, in, layer, k * G + vcu);
#if defined(CV_PAT) && CV_PAT == 1
            { const int lr4 = lane >> 4, lc16 = (lane & 15) * 4; const int c0 = I[t].srccol0 & ~63;
              _Pragma("unroll") for (int i = 0; i < 8; ++i) v[t][i] = __builtin_nontemporal_load((const f32x4*)(I[t].W + (size_t)(I[t].k0 + 4 * i + lr4) * I[t].ldw + c0 + lc16)); }
#elif defined(CV_PAT) && CV_PAT == 2
            { const int lr2 = lane >> 5, lc32 = (lane & 31) * 4; const int c0 = I[t].srccol0 & ~127;
              _Pragma("unroll") for (int i = 0; i < 8; ++i) v[t][i] = __builtin_nontemporal_load((const f32x4*)(I[t].W + (size_t)(I[t].k0 + 2 * i + lr2) * I[t].ldw + c0 + lc32)); }
#else
            item_load(I[t], v[t], lane);
#endif
            } }
#pragma unroll
        for (int t = 0; t < 3; ++t) if (on[t]) {
#if CV_MODE == 1
#pragma unroll
            for (int i = 0; i < 8; ++i) sink += v[t][i].x + v[t][i].y + v[t][i].z + v[t][i].w;
#elif CV_MODE == 2
            { const int lr = lane >> 3, lc = (lane & 7) * 4;
#pragma unroll
              for (int i = 0; i < 8; ++i) { LAS float* d = scr + (8 * i + lr) * 33 + lc; d[0] = v[t][i].x; d[1] = v[t][i].y; d[2] = v[t][i].z; d[3] = v[t][i].w; }
              LDS_WAIT(); asm volatile("" ::: "memory");
              const int c = lane & 7;
#pragma unroll
              for (int j = 0; j < 4; ++j) { const int n = (lane >> 3) + 8 * j; const LAS float* sp = scr + (8 * c) * 33 + n;
                  sink += __uint_as_float(pk2(sp[0 * 33], sp[1 * 33]) ^ pk2(sp[2 * 33], sp[3 * 33]) ^ pk2(sp[4 * 33], sp[5 * 33]) ^ pk2(sp[6 * 33], sp[7 * 33])); }
              LDS_WAIT(); asm volatile("" ::: "memory"); }
#else
            { ItemSrc J = I[t]; J.WT = (bf16*)(ws + WS_ACT) + (J.WT - (bf16*)(ws + (J.K == 1024 ? WS_WGU : WS_WDN))) % (size_t)(120u << 20); item_store(J, v[t], scr, lane); }
#endif
        }
    }
    if (sink == 123.456f) ((float*)(ws + WS_ACT))[tid] = sink;
}
#endif
__device__ __forceinline__ int conv_target(int p) { if (p <= 8) return 0; if (p < 10) return DEPTH; const int q = p - 10; return (q % 12 >= 11) ? DEPTH : q / 12 + 1; }
__device__ __forceinline__ void prologue_convert(const Ctx& C0, const float* const* in, bool defer_experts) {
    const Ctx C = phase_ctx(C0);
    LAS float* scr = (LAS float*)(C.ldsl + RING_OFF + C.wave * 16384);
    unsigned char* ws = C.ws;
    constexpr int N0 = 4 * 1024, N1 = N0 + 4 * 512, N2 = N1 + 4 * 256, N3 = N2 + 4 * 512, N4 = N3 + 4 * 256, N5 = N4 + 64 * 2048, N6 = N5 + 64 * 1024;
    const int nlim = defer_experts ? N4 : N6;
    if (defer_experts) {
        auto small_item = [&](int it) { ItemSrc I; I.ks = nullptr;
            if (it < N0) { const int l = it >> 10, r = it & 1023, kb = r >> 6, nb = r & 63, n0 = nb * 32;
                I.W = in[I_WIN] + (size_t)l * 1024 * 2064; I.ldw = 2064; I.WT = (bf16*)(ws + WS_WIN) + (size_t)l * 2048 * 1024; I.K = 1024; I.n0dst = n0; I.srccol0 = n0 < 1280 ? n0 : n0 + 16; I.k0 = kb * 64; I.ks = in[I_NMIXG] + l * 1024; }
            else if (it < N1) { const int q = it - N0, l = q >> 9, r = q & 511, kb = r >> 5, nb = r & 31;
                I.W = in[I_WOUT] + (size_t)l * 1024 * 1024; I.ldw = 1024; I.WT = (bf16*)(ws + WS_WOUT) + (size_t)l * 1024 * 1024; I.K = 1024; I.n0dst = nb * 32; I.srccol0 = nb * 32; I.k0 = kb * 64; }
            else if (it < N2) { const int q = it - N1, l = q >> 8, r = q & 255, kb = r >> 4, nb = r & 15;
                I.W = in[I_CAWQ] + (size_t)l * 1024 * 512; I.ldw = 512; I.WT = (bf16*)(ws + WS_WCAQ) + (size_t)l * 512 * 1024; I.K = 1024; I.n0dst = nb * 32; I.srccol0 = nb * 32; I.k0 = kb * 64; I.ks = in[I_NMEMG] + l * 1024; }
            else if (it < N3) { const int q = it - N2, l = q >> 9, r = q & 511, kb = r >> 5, nb = r & 31;
                I.W = in[I_CAWKV] + (size_t)l * 1024 * 1024; I.ldw = 1024; I.WT = (bf16*)(ws + WS_WCAKV) + (size_t)l * 1024 * 1024; I.K = 1024; I.n0dst = nb * 32; I.srccol0 = nb * 32; I.k0 = kb * 64; }
            else { const int q = it - N3, l = q >> 8, r = q & 255, kb = r >> 5, nb = r & 31;
                I.W = in[I_CAWO] + (size_t)l * 512 * 1024; I.ldw = 1024; I.WT = (bf16*)(ws + WS_WCAO) + (size_t)l * 1024 * 512; I.K = 512; I.n0dst = nb * 32; I.srccol0 = nb * 32; I.k0 = kb * 64; }
            return I; };
#pragma unroll 1
        for (int it0 = C.gw; it0 < N4; it0 += CV_NIT * C.NGW) {
            ItemSrc I[CV_NIT]; f32x4 v[CV_NIT][8]; bool on[CV_NIT];
#pragma unroll
            for (int t = 0; t < CV_NIT; ++t) { const int it = it0 + t * C.NGW; on[t] = it < N4; if (on[t]) { I[t] = small_item(it); item_load(I[t], v[t], C.lane); } }
#pragma unroll
            for (int t = 0; t < CV_NIT; ++t) if (on[t]) { item_scale(I[t], v[t], C.lane); item_store(I[t], v[t], scr, C.lane); }
        }
    } else
    for (int it = C.gw; it < nlim; it += C.NGW) {
        if (it < N0) { const int l = it >> 10, r = it & 1023, kb = r >> 6, nb = r & 63, n0 = nb * 32;
            transpose_item(in[I_WIN] + (size_t)l * 1024 * 2064, 2064, (bf16*)(ws + WS_WIN) + (size_t)l * 2048 * 1024, 1024, n0, n0 < 1280 ? n0 : n0 + 16, kb * 64, scr, C.lane, in[I_NMIXG] + l * 1024); }
        else if (it < N1) { const int q = it - N0, l = q >> 9, r = q & 511, kb = r >> 5, nb = r & 31;
            transpose_item(in[I_WOUT] + (size_t)l * 1024 * 1024, 1024, (bf16*)(ws + WS_WOUT) + (size_t)l * 1024 * 1024, 1024, nb * 32, nb * 32, kb * 64, scr, C.lane); }
        else if (it < N2) { const int q = it - N1, l = q >> 8, r = q & 255, kb = r >> 4, nb = r & 15;
            transpose_item(in[I_CAWQ] + (size_t)l * 1024 * 512, 512, (bf16*)(ws + WS_WCAQ) + (size_t)l * 512 * 1024, 1024, nb * 32, nb * 32, kb * 64, scr, C.lane, in[I_NMEMG] + l * 1024); }
        else if (it < N3) { const int q = it - N2, l = q >> 9, r = q & 511, kb = r >> 5, nb = r & 31;
            transpose_item(in[I_CAWKV] + (size_t)l * 1024 * 1024, 1024, (bf16*)(ws + WS_WCAKV) + (size_t)l * 1024 * 1024, 1024, nb * 32, nb * 32, kb * 64, scr, C.lane); }
        else if (it < N4) { const int q = it - N3, l = q >> 8, r = q & 255, kb = r >> 5, nb = r & 31;
            transpose_item(in[I_CAWO] + (size_t)l * 512 * 1024, 1024, (bf16*)(ws + WS_WCAO) + (size_t)l * 1024 * 512, 512, nb * 32, nb * 32, kb * 64, scr, C.lane); }
        else if (it < N5) { const int q = it - N4, le = q >> 11, r = q & 2047, kb = r >> 7, nb = r & 127, n0 = nb * 32, pn = n0 >> 8, j = n0 & 255;
            transpose_item(in[I_WGU] + (size_t)le * 1024 * 4096, 4096, (bf16*)(ws + WS_WGU) + (size_t)le * 4096 * 1024, 1024, n0, j < 128 ? pn * 128 + j : 2048 + pn * 128 + (j - 128), kb * 64, scr, C.lane, in[I_NFFNG] + (le >> 4) * 1024); }
        else { const int q = it - N5, le = q >> 10, r = q & 1023, kb = r >> 5, nb = r & 31;
            transpose_item(in[I_WDN] + (size_t)le * 2048 * 1024, 1024, (bf16*)(ws + WS_WDN) + (size_t)le * 1024 * 2048, 2048, nb * 32, nb * 32, kb * 64, scr, C.lane); }
    }
    const int gt = C.gw * 64 + C.lane, NGT = C.NGW * 64;
    for (int i = gt; i < 2048 * 1024 / 8; i += NGT) { const f32x4* s = (const f32x4*)(in[I_MEM]) + 2 * (size_t)i; const f32x4 a = s[0], b = s[1];
        v4u o; o.x = pk2(a.x, a.y); o.y = pk2(a.z, a.w); o.z = pk2(b.x, b.y); o.w = pk2(b.z, b.w); ((v4u*)(ws + WS_MEMB))[i] = o; }
    for (int i = gt; i < 4096 * 32; i += NGT) { const int t = i >> 5, f = i & 31; const int pos = (f < 16) ? (t >> 6) : (t & 63);
        double invd = 1.0; for (int k = 0; k < (f & 15); ++k) invd *= 0.5623413251903491;
        const float inv = (float)invd; const float ang = (float)pos * inv; const double ad = (double)ang;
        const double nq = rint(ad * 0.6366197723675814); const double r = ad - nq * 1.5707963267948966, r2 = r * r;
        const double sr = r * (1.0 + r2 * (-1.0 / 6 + r2 * (1.0 / 120 + r2 * (-1.0 / 5040 + r2 * (1.0 / 362880 + r2 * (-1.0 / 39916800 + r2 * (1.0 / 6227020800.0)))))));
        const double cr = 1.0 + r2 * (-0.5 + r2 * (1.0 / 24 + r2 * (-1.0 / 720 + r2 * (1.0 / 40320 + r2 * (-1.0 / 3628800 + r2 * (1.0 / 479001600.0))))));
        const int qd = ((int)nq) & 3; const double sn = (qd == 0) ? sr : (qd == 1) ? cr : (qd == 2) ? -sr : -cr; const double cs = (qd == 0) ? cr : (qd == 1) ? -sr : (qd == 2) ? -cr : sr;
        ((float*)(ws + WS_ROPE))[i] = (float)cs; ((float*)(ws + WS_ROPE))[4096 * 32 + i] = (float)sn; }
    for (int i = gt; i < 4 * 4 * 64 * 64; i += NGT) { const int c = i & 63, e = (i >> 6) & 63, g = (i >> 12) & 3, l = i >> 14;
        const float v = in[I_POOLW][((size_t)(l * 4 + g) * 64 + c) * 64 + e] * in[I_POOLS][l * 256 + g * 64 + e]; ((bf16*)(ws + WS_POOLW))[i] = (bf16)f2bf(v); }
}

constexpr int RT_PITCH = 1032;
__device__ __forceinline__ void proj16_stage(const Ctx& C, const float* gain, const float* w16, int w16s) {
    LAS bf16* Wh = (LAS bf16*)(C.ldsl + RING_OFF); LAS bf16* Wl = Wh + 16 * RT_PITCH;
    { f32x4 wv[8]; float gq[8];
#pragma unroll
      for (int j = 0; j < 8; ++j) { const int idx = C.tid + 512 * j, k = idx >> 2, e4 = (idx & 3) * 4; wv[j] = *(const f32x4*)(w16 + (size_t)k * w16s + e4); gq[j] = gain[k]; }
#pragma unroll
      for (int j = 0; j < 8; ++j) { const int idx = C.tid + 512 * j, k = idx >> 2, e4 = (idx & 3) * 4;
#pragma unroll
        for (int i = 0; i < 4; ++i) { const float v = wv[j][i] * gq[j]; const unsigned short h = f2bf(v); const unsigned short lo = f2bf(v - bf2f((bf16)h));
            Wh[(e4 + i) * RT_PITCH + k] = (bf16)h; Wl[(e4 + i) * RT_PITCH + k] = (bf16)lo; } } }
    __syncthreads();
}
template <int MODE>
__device__ __forceinline__ void proj16_tile(const Ctx& C, const bf16x8 (&xa)[32], int t, const float* bias16, float* out16, float* rs) {
    const int lane = C.lane, rr = lane & 15, q = lane >> 4;
    LAS bf16* Wh = (LAS bf16*)(C.ldsl + RING_OFF); LAS bf16* Wl = Wh + 16 * RT_PITCH;
    f32x4 acc = (f32x4){0.f, 0.f, 0.f, 0.f}; float ss = 0.f;
#pragma unroll
    for (int s = 0; s < 32; ++s) {
        const bf16x8 bh = *(const LAS bf16x8*)(Wh + rr * RT_PITCH + s * 32 + q * 8), bl = *(const LAS bf16x8*)(Wl + rr * RT_PITCH + s * 32 + q * 8);
        acc = MFMA16(xa[s], bh, acc); acc = MFMA16(xa[s], bl, acc);
        const v4u xw = __builtin_bit_cast(v4u, xa[s]);
        ss += (bf_lo(xw.x) * bf_lo(xw.x) + bf_hi(xw.x) * bf_hi(xw.x)) + (bf_lo(xw.y) * bf_lo(xw.y) + bf_hi(xw.y) * bf_hi(xw.y));
        ss += (bf_lo(xw.z) * bf_lo(xw.z) + bf_hi(xw.z) * bf_hi(xw.z)) + (bf_lo(xw.w) * bf_lo(xw.w) + bf_hi(xw.w) * bf_hi(xw.w));
        if ((s & 3) == 3) asm volatile("" ::: "memory"); }
    ss += __shfl_xor(ss, 16); ss += __shfl_xor(ss, 32);
    const float rstd = __builtin_amdgcn_rsqf(ss * (1.0f / 1024.0f) + EPS);
    if (MODE == 2 && q == 0) rs[(size_t)t * 16 + rr] = rstd;
    if (MODE == 2) { f32x4 pr;
#pragma unroll
        for (int i = 0; i < 4; ++i) { const float r = __shfl(rstd, 4 * q + i); const float val = acc[i] * r; float mx = val;
#pragma unroll
            for (int o = 1; o < 16; o <<= 1) mx = fmaxf(mx, __shfl_xor(mx, o));
            const float ex = fexp(val - mx); float sm = ex;
#pragma unroll
            for (int o = 1; o < 16; o <<= 1) sm += __shfl_xor(sm, o);
            pr[i] = ex * __builtin_amdgcn_rcpf(sm); }
        const int row = t * 16 + 4 * q;
        *(f32x4*)(out16 + ((size_t)((row >> 12) * 16 + rr)) * 4096 + (row & 4095)) = pr; }
    else { const float bs = bias16[rr];
#pragma unroll
        for (int i = 0; i < 4; ++i) { const float r = __shfl(rstd, 4 * q + i); float val = acc[i] * r + bs;
            if (rr >= 8) val = fminf(val, 0.f) - flog(1.0f + fexp(-fabsf(val)));
            out16[(size_t)(t * 16 + 4 * q + i) * 16 + rr] = val; } }
}
__device__ __forceinline__ void router_phase(const Ctx& C0, const bf16* xb, const float* gain, const float* w16, float* aff, float* rs) {
    const Ctx C = phase_ctx(C0);
    const int rr = C.lane & 15, q = C.lane >> 4;
    const int tpg = (NTOK / 16) / C.ng, t0 = C.grp * tpg + C.lb * 8 + C.wave, ts = C.GB * 8, te = (C.grp + 1) * tpg;
    bf16x8 xa[32];
    if (t0 < te) {
#pragma unroll
        for (int s = 0; s < 32; ++s) xa[s] = *(const bf16x8*)(xb + (size_t)(t0 * 16 + rr) * 1024 + s * 32 + q * 8);
    }
    proj16_stage(C, gain, w16, 16);
    for (int t = t0; t < te; t += ts) {
        if (t != t0) {
#pragma unroll
            for (int s = 0; s < 32; ++s) xa[s] = *(const bf16x8*)(xb + (size_t)(t * 16 + rr) * 1024 + s * 32 + q * 8); }
        proj16_tile<2>(C, xa, t, nullptr, aff, rs);
    }
    __syncthreads();
}

template <int MODE, bool COMBINE, bool SRC32 = false>
__device__ __forceinline__ void row_phase(const Ctx& C0, const void* xsrc_, bf16* xdst, const float* gain, float* rsout, const float* w16, int w16s, const float* bias16, float* out16, float* outf,
                                          const int* slotmap, const bf16* ys) {
    const Ctx C = phase_ctx(C0);
    if (MODE == 1) proj16_stage(C, gain, w16, w16s);
    const int lane = C.lane;
    f32x4 gv[4];
#pragma unroll
    for (int j = 0; j < 4; ++j) gv[j] = *(const f32x4*)(gain + 4 * lane + 256 * j);
    const float* xsrc = (const float*)xsrc_; const bf16* xsrb = (const bf16*)xsrc_;
    f32x4 vn[2][4]; uint2 vnb[2][4]; int smc[2] = {-1, -1}, smn[2] = {-1, -1}; unsigned mrem[2] = {0u, 0u}; uint2 yb[2][4][4];
    const int tpg = (NTOK / 16) / C.ng, t0 = C.grp * tpg + C.lb * 8 + C.wave, ts = C.GB * 8, te = (C.grp + 1) * tpg;
#define RP_LOADX(prq) do { _Pragma("unroll") for (int r = 0; r < 2; ++r) { _Pragma("unroll") for (int j = 0; j < 4; ++j) { \
        if (SRC32) vn[r][j] = *(const f32x4*)(xsrc + (size_t)(2 * (prq) + r) * 1024 + 4 * lane + 256 * j); else vnb[r][j] = *(const uint2*)(xsrb + (size_t)(2 * (prq) + r) * 1024 + 4 * lane + 256 * j); } } } while (0)
#define RP_LOADSM(SMQ, prq) do { _Pragma("unroll") for (int r = 0; r < 2; ++r) SMQ[r] = slotmap[(size_t)(2 * (prq) + r) * 16 + (lane & 15)]; } while (0)
#define RP_LOADY(SMQ, prq) do { _Pragma("unroll") for (int r = 0; r < 2; ++r) { unsigned mk = (unsigned)(__ballot(SMQ[r] >= 0) & 0xFFFFull); const int b = (2 * (prq) + r) >> 12; \
        _Pragma("unroll") for (int k = 0; k < 4; ++k) { \
            if (mk) { const int e = __builtin_ctz(mk); mk &= mk - 1u; const int sl = __builtin_amdgcn_readlane(SMQ[r], e); \
                const bf16* yr = ys + ((size_t)(e * ROWS_E + b * CAP + sl)) * 1024 + 4 * lane; \
                _Pragma("unroll") for (int j = 0; j < 4; ++j) yb[r][k][j] = *(const uint2*)(yr + 256 * j); } \
            else { _Pragma("unroll") for (int j = 0; j < 4; ++j) yb[r][k][j] = make_uint2(0u, 0u); } } \
        mrem[r] = mk; } } while (0)
    for (int t = t0; t < te; t += ts) {
      const int prb = 8 * t, pre = prb + 8;
      RP_LOADX(prb);
      if (COMBINE) { RP_LOADSM(smc, prb); RP_LOADSM(smn, prb + 1); RP_LOADY(smc, prb); }
#pragma unroll 1
      for (int pr = prb; pr < pre; ++pr) {
        const int row0 = 2 * pr;
        f32x4 v[2][4]; int smnn[2] = {-1, -1};
#pragma unroll
        for (int r = 0; r < 2; ++r) {
#pragma unroll
            for (int j = 0; j < 4; ++j) { if (SRC32) v[r][j] = vn[r][j]; else { const uint2 w = vnb[r][j]; v[r][j] = (f32x4){bf_lo(w.x), bf_hi(w.x), bf_lo(w.y), bf_hi(w.y)}; } } }
        { const int prn = pr + 1; if (prn < pre) RP_LOADX(prn);
          if (COMBINE) { const int prnn = pr + 2; if (prnn < pre) RP_LOADSM(smnn, prnn); } }
        if (COMBINE) {
#pragma unroll
            for (int r = 0; r < 2; ++r) { const int row = row0 + r, b = row >> 12;
#pragma unroll
                for (int k = 0; k < 4; ++k)
#pragma unroll
                    for (int j = 0; j < 4; ++j) { const uint2 w = yb[r][k][j]; v[r][j] += (f32x4){bf_lo(w.x), bf_hi(w.x), bf_lo(w.y), bf_hi(w.y)}; }
                unsigned mk = mrem[r];
                while (mk) { const int e = __builtin_ctz(mk); mk &= mk - 1u; const int sl = __builtin_amdgcn_readlane(smc[r], e);
                    const bf16* yr = ys + ((size_t)(e * ROWS_E + b * CAP + sl)) * 1024 + 4 * lane;
#pragma unroll
                    for (int j = 0; j < 4; ++j) { const uint2 w = *(const uint2*)(yr + 256 * j); v[r][j] += (f32x4){bf_lo(w.x), bf_hi(w.x), bf_lo(w.y), bf_hi(w.y)}; } } }
            { const int prn = pr + 1; if (prn < pre) RP_LOADY(smn, prn); }
#pragma unroll
            for (int r = 0; r < 2; ++r) { smc[r] = smn[r]; smn[r] = smnn[r]; }
        }
        if ((COMBINE && MODE != 3) || SRC32) {
#pragma unroll
            for (int r = 0; r < 2; ++r)
#pragma unroll
                for (int j = 0; j < 4; ++j) { uint2 o; o.x = pk2(v[r][j].x, v[r][j].y); o.y = pk2(v[r][j].z, v[r][j].w); *(uint2*)(xdst + (size_t)(row0 + r) * 1024 + 4 * lane + 256 * j) = o; }
        }
        float rstd[2];
#pragma unroll
        for (int r = 0; r < 2; ++r) { float ss = 0.f;
#pragma unroll
            for (int j = 0; j < 4; ++j) ss += (v[r][j].x * v[r][j].x + v[r][j].y * v[r][j].y) + (v[r][j].z * v[r][j].z + v[r][j].w * v[r][j].w);
            rstd[r] = __builtin_amdgcn_rsqf(wave_sum(ss) * (1.0f / 1024.0f) + EPS); }
        if (MODE == 3) {
#pragma unroll
            for (int r = 0; r < 2; ++r)
#pragma unroll
                for (int j = 0; j < 4; ++j) { const f32x4 h = v[r][j] * rstd[r] * gv[j]; *(f32x4*)(outf + (size_t)(row0 + r) * 1024 + 4 * lane + 256 * j) = h; } }
        else if (lane < 2) rsout[row0 + lane] = lane ? rstd[1] : rstd[0];
      }
      if (MODE == 1) {
          asm volatile("s_waitcnt vmcnt(0)" ::: "memory"); __builtin_amdgcn_fence(__ATOMIC_ACQUIRE, "agent");
          const int rr = lane & 15, q = lane >> 4; bf16x8 xa[32];
#pragma unroll
          for (int s = 0; s < 32; ++s) xa[s] = *(const bf16x8*)(xdst + (size_t)(t * 16 + rr) * 1024 + s * 32 + q * 8);
          proj16_tile<1>(C, xa, t, bias16, out16, nullptr); }
    }
#undef RP_LOADX
#undef RP_LOADSM
#undef RP_LOADY
    if (MODE == 1) __syncthreads();
}

__device__ __forceinline__ void prep_phase(const Ctx& C0, int layer, const float* const* in, bf16* ropedst, const int secs = 15) {
    const Ctx C = phase_ctx(C0);
    bf16* PROJ = (bf16*)(C.ws + WS_PROJ); bf16* YCAT = (bf16*)(C.ws + WS_YCAT); bf16* MQK = (bf16*)(C.ws + WS_MQK);
    const bf16* PW = (const bf16*)(C.ws + WS_POOLW) + (size_t)layer * 4 * 64 * 64;
    const float* ROPEC = (const float*)(C.ws + WS_ROPE); const float* ROPES = ROPEC + 4096 * 32;
    const float* qg = in[I_QNG] + layer * 64; const float* kg = in[I_KNG] + layer * 64;
    const float* cw = in[I_CONVW] + (size_t)layer * 5 * 512;
    const int lane = C.lane, rr = lane & 15, q = lane >> 4;
    bf16* KT = (bf16*)(C.ws + WS_KT); bf16* VT = (bf16*)(C.ws + WS_VT);
    LAS bf16* tile = (LAS bf16*)(C.ldsl + RING_OFF + C.wave * 16384);
    for (int grp = C.gw; grp < NTOK / 16; grp += C.NGW) {
        const int r0 = grp * 16, brow = r0 & ~4095, t0 = r0 & 4095;
#ifndef NO_POOL
        if (secs & 1)
        { LAS bf16* pst = (LAS bf16*)(C.ldsl + RING_OFF + C.wave * 16384);
          { v4u st[16];
#pragma unroll
            for (int i = 0; i < 16; ++i) { const int id = i * 64 + lane, row = id >> 5, c = id & 31, tu = t0 - 8 + row; st[i] = (v4u){0u, 0u, 0u, 0u};
                if (id < 992 && tu >= 0 && tu < 4096) st[i] = *(const v4u*)(PROJ + (size_t)(brow + tu) * NPROJ + C_POOL + c * 8); }
#pragma unroll
            for (int i = 0; i < 16; ++i) { const int id = i * 64 + lane, row = id >> 5, c = id & 31; if (id < 992) *(LAS v4u*)(pst + row * 264 + c * 8) = st[i]; } }
          LDS_WAIT(); asm volatile("" ::: "memory");
          const int t = t0 + rr;
#pragma unroll 1
          for (int g = 0; g < 4; ++g) { const int half = 1 << g, w = 2 << g; const int lo = max(t - half, 0), hi = min(t + half, 4096); const float inv = __builtin_amdgcn_rcpf((float)(hi - lo));
            bf16x8 bfr[2], afr[4][2]; float sum[2][8];
#pragma unroll
            for (int ks = 0; ks < 2; ++ks) {
#pragma unroll
                for (int i = 0; i < 8; ++i) sum[ks][i] = 0.f;
#pragma unroll
                for (int et = 0; et < 4; ++et) afr[et][ks] = *(const bf16x8*)(PW + ((size_t)(g * 64 + et * 16 + rr)) * 64 + ks * 32 + q * 8); }
            const LAS bf16* wp = pst + (rr + 8 - half) * 264 + g * 64 + q * 8;
#pragma unroll 2
            for (int u = 0; u < w; ++u) {
#pragma unroll
                for (int ks = 0; ks < 2; ++ks) { const v4u x = *(const LAS v4u*)(wp + u * 264 + ks * 32);
                    sum[ks][0] += bf_lo(x.x); sum[ks][1] += bf_hi(x.x); sum[ks][2] += bf_lo(x.y); sum[ks][3] += bf_hi(x.y); sum[ks][4] += bf_lo(x.z); sum[ks][5] += bf_hi(x.z); sum[ks][6] += bf_lo(x.w); sum[ks][7] += bf_hi(x.w); } }
#pragma unroll
            for (int ks = 0; ks < 2; ++ks) { const v4u s = *(const LAS v4u*)(pst + (rr + 8) * 264 + g * 64 + ks * 32 + q * 8);
                const float d0 = sum[ks][0] * inv - bf_lo(s.x), d1 = sum[ks][1] * inv - bf_hi(s.x), d2 = sum[ks][2] * inv - bf_lo(s.y), d3 = sum[ks][3] * inv - bf_hi(s.y);
                const float d4 = sum[ks][4] * inv - bf_lo(s.z), d5 = sum[ks][5] * inv - bf_hi(s.z), d6 = sum[ks][6] * inv - bf_lo(s.w), d7 = sum[ks][7] * inv - bf_hi(s.w);
                v4u pk; pk.x = pk2(d0, d1); pk.y = pk2(d2, d3); pk.z = pk2(d4, d5); pk.w = pk2(d6, d7); bfr[ks] = __builtin_bit_cast(bf16x8, pk); }
#pragma unroll
            for (int et = 0; et < 4; ++et) { f32x4 acc = (f32x4){0.f, 0.f, 0.f, 0.f};
#pragma unroll
                for (int ks = 0; ks < 2; ++ks) acc = MFMA16(afr[et][ks], bfr[ks], acc);
                uint2 o; o.x = pk2(acc.x, acc.y); o.y = pk2(acc.z, acc.w);
                *(uint2*)(YCAT + (size_t)(r0 + rr) * 1024 + g * 64 + et * 16 + 4 * q) = o; } }
          LDS_WAIT(); asm volatile("" ::: "memory"); }
#endif
        asm volatile("" ::: "memory");
#ifndef NO_CONV
        if (secs & 2)
        { float cwv[5][8];
#pragma unroll
          for (int j = 0; j < 5; ++j) { const f32x4 a = *(const f32x4*)(cw + j * 512 + lane * 8), b2 = *(const f32x4*)(cw + j * 512 + lane * 8 + 4);
              cwv[j][0] = a.x; cwv[j][1] = a.y; cwv[j][2] = a.z; cwv[j][3] = a.w; cwv[j][4] = b2.x; cwv[j][5] = b2.y; cwv[j][6] = b2.z; cwv[j][7] = b2.w; }
          const float ksc = (lane >= 32) ? 0.125f : 1.0f;
#pragma unroll
          for (int hf = 0; hf < 2; ++hf) { v4u xr[12];
#pragma unroll
            for (int u = 0; u < 12; ++u) { const int tu = t0 + hf * 8 + u - 2; const int tc = min(max(tu, 0), 4095); xr[u] = *(const v4u*)(PROJ + (size_t)(brow + tc) * NPROJ + C_MQ + lane * 8); }
#pragma unroll
            for (int u = 0; u < 12; ++u) { const int tu = t0 + hf * 8 + u - 2; if (tu < 0 || tu >= 4096) xr[u] = (v4u){0u, 0u, 0u, 0u}; }
#pragma unroll
            for (int r = 0; r < 8; ++r) { float acc[8];
#pragma unroll
                for (int i = 0; i < 8; ++i) acc[i] = 0.f;
#pragma unroll
                for (int j = 0; j < 5; ++j) { const v4u x = xr[r + j];
                    acc[0] += cwv[j][0] * bf_lo(x.x); acc[1] += cwv[j][1] * bf_hi(x.x); acc[2] += cwv[j][2] * bf_lo(x.y); acc[3] += cwv[j][3] * bf_hi(x.y);
                    acc[4] += cwv[j][4] * bf_lo(x.z); acc[5] += cwv[j][5] * bf_hi(x.z); acc[6] += cwv[j][6] * bf_lo(x.w); acc[7] += cwv[j][7] * bf_hi(x.w); }
#pragma unroll
                for (int i = 0; i < 8; ++i) acc[i] = acc[i] * fsigmoid(acc[i]) * ksc;
                v4u o; o.x = pk2(acc[0], acc[1]); o.y = pk2(acc[2], acc[3]); o.z = pk2(acc[4], acc[5]); o.w = pk2(acc[6], acc[7]);
                const int rw = hf * 8 + r;
                *(v4u*)(MQK + (size_t)(r0 + rw) * 512 + lane * 8) = o;
                if (lane >= 32) *(LAS v4u*)(tile + rw * 264 + (lane - 32) * 8) = o; } asm volatile("" ::: "memory"); } }
#endif
        asm volatile("" ::: "memory");
#ifndef NO_ROPE
        if (secs & 4)
        { const int c8 = lane & 7, rl = lane >> 3;
          f32x4 csv[2], snv[2];
#pragma unroll
          for (int hf = 0; hf < 2; ++hf) { const int t = t0 + hf * 8 + rl; csv[hf] = *(const f32x4*)(ROPEC + t * 32 + 4 * c8); snv[hf] = *(const f32x4*)(ROPES + t * 32 + 4 * c8); }
          const f32x4 qg0 = *(const f32x4*)(qg + 8 * c8), qg1 = *(const f32x4*)(qg + 8 * c8 + 4), kg0 = *(const f32x4*)(kg + 8 * c8), kg1 = *(const f32x4*)(kg + 8 * c8 + 4);
#pragma unroll 1
          for (int hb = 0; hb < 10; hb += 5) {
          v4u w[5][2];
#pragma unroll
          for (int h = 0; h < 5; ++h)
#pragma unroll
              for (int hf = 0; hf < 2; ++hf) { const int hh = hb + h; const int col = (hh < 8) ? C_AQ + hh * 64 : C_AK + (hh - 8) * 64; w[h][hf] = *(const v4u*)(PROJ + (size_t)(r0 + hf * 8 + rl) * NPROJ + col + 8 * c8); }
#pragma unroll
          for (int h = 0; h < 5; ++h)
#pragma unroll
              for (int hf = 0; hf < 2; ++hf) { const int hh = hb + h; const v4u x = w[h][hf];
                  const float x0 = bf_lo(x.x), x1 = bf_hi(x.x), x2 = bf_lo(x.y), x3 = bf_hi(x.y), x4 = bf_lo(x.z), x5 = bf_hi(x.z), x6 = bf_lo(x.w), x7 = bf_hi(x.w);
                  float ss = ((x0 * x0 + x1 * x1) + (x2 * x2 + x3 * x3)) + ((x4 * x4 + x5 * x5) + (x6 * x6 + x7 * x7));
                  ss += __shfl_xor(ss, 1); ss += __shfl_xor(ss, 2); ss += __shfl_xor(ss, 4);
                  const float rs = __builtin_amdgcn_rsqf(ss * (1.0f / 64.0f) + EPS); const bool isq = hh < 8; const f32x4 g0 = isq ? qg0 : kg0, g1 = isq ? qg1 : kg1; const float sc = rs * (isq ? attn_body::C2 : 1.0f);
                  const float y0 = x0 * sc * g0.x, y1 = x1 * sc * g0.y, y2 = x2 * sc * g0.z, y3 = x3 * sc * g0.w, y4 = x4 * sc * g1.x, y5 = x5 * sc * g1.y, y6 = x6 * sc * g1.z, y7 = x7 * sc * g1.w;
                  const f32x4 c = csv[hf], sn4 = snv[hf];
                  v4u o; o.x = pk2(y0 * c.x - y1 * sn4.x, y0 * sn4.x + y1 * c.x); o.y = pk2(y2 * c.y - y3 * sn4.y, y2 * sn4.y + y3 * c.y);
                  o.z = pk2(y4 * c.z - y5 * sn4.z, y4 * sn4.z + y5 * c.z); o.w = pk2(y6 * c.w - y7 * sn4.w, y6 * sn4.w + y7 * c.w);
                  w[h][hf] = o; }
#pragma unroll
          for (int h = 0; h < 5; ++h)
#pragma unroll
              for (int hf = 0; hf < 2; ++hf) { const int hh = hb + h; const int col = (hh < 8) ? C_AQ + hh * 64 : C_AK + (hh - 8) * 64; *(v4u*)(ropedst + (size_t)(r0 + hf * 8 + rl) * NPROJ + col + 8 * c8) = w[h][hf]; }
          asm volatile("" ::: "memory"); }
          asm volatile("" ::: "memory"); }
#endif
        if (secs & 8) { const int chunk = grp >> 3, s0 = (grp & 7) * 16;
#pragma unroll 1
          for (int pass = 0; pass < 2; ++pass) {
            if (pass == 1) { v4u tv[8];
#pragma unroll
                for (int r2 = 0; r2 < 8; ++r2) { const int row = 2 * r2 + (lane >> 5), col8 = (lane & 31) * 8; tv[r2] = *(const v4u*)(PROJ + (size_t)(r0 + row) * NPROJ + C_MV + col8); }
#pragma unroll
                for (int r2 = 0; r2 < 8; ++r2) { const int row = 2 * r2 + (lane >> 5), col8 = (lane & 31) * 8; *(LAS v4u*)(tile + row * 264 + col8) = tv[r2]; } }
            LDS_WAIT(); asm volatile("" ::: "memory");
            bf16* dst = pass ? VT : KT;
#pragma unroll
            for (int k = 0; k < 4; ++k) { const int cidx = lane + 64 * k, hh = cidx >> 6, d = cidx & 63;
#pragma unroll
                for (int half = 0; half < 2; ++half) { unsigned w[4];
#pragma unroll
                    for (int i = 0; i < 4; ++i) w[i] = (unsigned)tile[(half * 8 + 2 * i) * 264 + cidx] | ((unsigned)tile[(half * 8 + 2 * i + 1) * 264 + cidx] << 16);
                    v4u o; o.x = w[0]; o.y = w[1]; o.z = w[2]; o.w = w[3];
                    *(v4u*)(dst + ((size_t)(chunk * 4 + hh) * 64 + d) * 128 + s0 + half * 8) = o; } }
            LDS_WAIT(); asm volatile("" ::: "memory");
          } }
    }
}

__device__ __forceinline__ void mlstm_local_phase(const Ctx& C0) {
    const Ctx C = phase_ctx(C0);
    const bf16* KT = (const bf16*)(C.ws + WS_KT); const bf16* VT = (const bf16*)(C.ws + WS_VT); const float* GATES = (const float*)(C.ws + WS_GATES);
    float* CST = (float*)(C.ws + WS_CST); float* MLOC = (float*)(C.ws + WS_MSC); float* BLAST = MLOC + 2048;
    const int lane = C.lane, wave = C.wave, rr = lane & 15, q = lane >> 4, dir = wave >> 2, nt = wave & 3;
    LAS float* wl = (LAS float*)(C.ldsl + RING_OFF) + wave * 128;
    for (int chunk = C.vcu; chunk < NBATCH * 32; chunk += C.G) {
        const int b = chunk >> 5, c = chunk & 31; const size_t row0 = (size_t)chunk * 128;
#pragma unroll 1
        for (int h = 0; h < 4; ++h) {
            const int sidx = ((b * 4 + h) * 2 + dir) * 32 + c; const int s0 = 2 * lane, s1 = s0 + 1;
            const float* g0p = GATES + (row0 + s0) * 16; const float li0 = g0p[dir * 4 + h], li1 = g0p[16 + dir * 4 + h], f0 = g0p[8 + dir * 4 + h], f1 = g0p[24 + dir * 4 + h];
            const bf16* kt = KT + ((size_t)(chunk * 4 + h) * 64 + nt * 16 + rr) * 128 + q * 8; const bf16* vt = VT + ((size_t)(chunk * 4 + h) * 64 + rr) * 128 + q * 8;
            v4u krr[4]; bf16x8 vfr[4][4];
#pragma unroll
            for (int ks = 0; ks < 4; ++ks) { krr[ks] = *(const v4u*)(kt + ks * 32);
#pragma unroll
                for (int m = 0; m < 4; ++m) vfr[ks][m] = *(const bf16x8*)(vt + (size_t)m * 16 * 128 + ks * 32); }
            float bc0, bc1, tot;
            if (dir == 0) { const float inc = wscan_add(f0 + f1, lane); bc1 = inc; bc0 = inc - f1; tot = __shfl(inc, 63); }
            else { const float suf = wscan_add_rev(f0 + f1, lane); bc0 = suf; bc1 = suf - f0; tot = __shfl(suf, 0); }
            const float g0 = tot - bc0 + li0, g1 = tot - bc1 + li1; float mx = fmaxf(g0, g1);
#pragma unroll
            for (int o = 1; o < 64; o <<= 1) mx = fmaxf(mx, __shfl_xor(mx, o));
            *(LAS f32x2v*)(wl + s0) = (f32x2v){fexp(g0 - mx), fexp(g1 - mx)};
            if (nt == 0 && lane == 0) { MLOC[sidx] = mx; BLAST[sidx] = tot; }
            LDS_WAIT(); asm volatile("" ::: "memory");
            f32x4 acc[4]; float nsum = 0.f;
#pragma unroll
            for (int m = 0; m < 4; ++m) acc[m] = (f32x4){0.f, 0.f, 0.f, 0.f};
#pragma unroll
            for (int ks = 0; ks < 4; ++ks) { const v4u kr = krr[ks]; const f32x4 wa = *(const LAS f32x4*)(wl + ks * 32 + q * 8), wb = *(const LAS f32x4*)(wl + ks * 32 + q * 8 + 4);
                const float k0 = bf_lo(kr.x) * wa.x, k1 = bf_hi(kr.x) * wa.y, k2 = bf_lo(kr.y) * wa.z, k3 = bf_hi(kr.y) * wa.w, k4 = bf_lo(kr.z) * wb.x, k5 = bf_hi(kr.z) * wb.y, k6 = bf_lo(kr.w) * wb.z, k7 = bf_hi(kr.w) * wb.w;
                nsum += ((k0 + k1) + (k2 + k3)) + ((k4 + k5) + (k6 + k7));
                v4u pk; pk.x = pk2(k0, k1); pk.y = pk2(k2, k3); pk.z = pk2(k4, k5); pk.w = pk2(k6, k7); const bf16x8 bfr = __builtin_bit_cast(bf16x8, pk);
#pragma unroll
                for (int m = 0; m < 4; ++m) acc[m] = MFMA16(vfr[ks][m], bfr, acc[m]); }
            nsum += __shfl_xor(nsum, 16); nsum += __shfl_xor(nsum, 32);
            float* out = CST + (size_t)sidx * CST_SZ;
#pragma unroll
            for (int m = 0; m < 4; ++m)
#pragma unroll
                for (int j = 0; j < 4; ++j) out[(m * 16 + 4 * q + j) * 64 + nt * 16 + rr] = acc[m][j];
            if (q == 0) out[4096 + nt * 16 + rr] = nsum;
            LDS_WAIT(); asm volatile("" ::: "memory");
        }
    }
}

__device__ __forceinline__ void mlstm_scan_phase(const Ctx& C0) {
    const Ctx C = phase_ctx(C0);
    const float* CST = (const float*)(C.ws + WS_CST); bf16* CSB = (bf16*)(C.ws + WS_CSB); const float* MLOC = (const float*)(C.ws + WS_MSC); const float* BLAST = MLOC + 2048; float* MST = (float*)(C.ws + WS_MSC) + 4096;
    const int spg = 64 / C.ng, lt = C.lb * 512 + C.tid, LT = C.GB * 512;
    LAS float* tb = (LAS float*)(C.ldsl + RING_OFF);
    for (int sq = C.wave; sq < spg; sq += 8) { const int seq = C.grp * spg + sq, dir = seq & 1, ln = C.lane;
        float mlv = 0.f, blv = 0.f; if (ln < 32) { const int cc = dir ? 31 - ln : ln; mlv = MLOC[seq * 32 + cc]; blv = BLAST[seq * 32 + cc]; }
        float m = 0.f;
        for (int s2 = 0; s2 < 32; ++s2) { const float b_ = __shfl(blv, s2), ml_ = __shfl(mlv, s2); const float mn = fmaxf(b_ + m, ml_);
            if (ln == s2) { tb[(sq * 32 + s2) * 4 + 0] = m; tb[(sq * 32 + s2) * 4 + 1] = fexp(b_ + m - mn); tb[(sq * 32 + s2) * 4 + 2] = fexp(ml_ - mn); }
            m = mn; } }
    __syncthreads();
    for (int li = lt; li < spg * CST_SZ; li += LT) {
        const int sq = li / CST_SZ, el = li - sq * CST_SZ, seq = C.grp * spg + sq, dir = seq & 1;
        float loc[32];
#pragma unroll
        for (int s = 0; s < 32; ++s) { const int c = dir ? 31 - s : s; const int idx = seq * 32 + c; loc[s] = CST[(size_t)idx * CST_SZ + el]; }
        float st = 0.f;
#pragma unroll
        for (int s = 0; s < 32; ++s) { const int c = dir ? 31 - s : s; const int idx = seq * 32 + c;
            CSB[(size_t)idx * CST_SZ + el] = (bf16)f2bf(st);
            const f32x4 cf = *(const LAS f32x4*)(tb + (sq * 32 + s) * 4); st = cf.y * st + cf.z * loc[s]; }
    }
    { const float* GATES = (const float*)(C.ws + WS_GATES); float* GV = (float*)(C.ws + WS_GV); const int lane = C.lane;
      for (int task = C.lb * 8 + C.wave; task < spg * 32; task += C.GB * 8) {
        const int sq = task >> 5, c = task & 31, seq = C.grp * spg + sq, dir = seq & 1, bh = seq >> 1, b = bh >> 2, h = bh & 3; const int sidx = seq * 32 + c;
        const int npre = dir ? 31 - c : c; const float mst = tb[(sq * 32 + npre) * 4];
        const size_t row0 = (size_t)b * 4096 + c * 128; const int s0 = 2 * lane, s1 = s0 + 1;
        const float* g0p = GATES + (row0 + s0) * 16; const float li0 = g0p[dir * 4 + h], li1 = g0p[16 + dir * 4 + h], f0 = g0p[8 + dir * 4 + h], f1 = g0p[24 + dir * 4 + h];
        float bc0, bc1;
        if (dir == 0) { const float inc = wscan_add(f0 + f1, lane); bc1 = inc; bc0 = inc - f1; }
        else { const float suf = wscan_add_rev(f0 + f1, lane); bc0 = suf; bc1 = suf - f0; }
        const float cb0 = li0 - bc0, cb1 = li1 - bc1; float mx0, mx1;
        if (dir == 0) { const float inc = wscan_max(fmaxf(cb0, cb1), lane); float prev = __shfl_up(inc, 1); if (lane == 0) prev = -INFINITY; mx1 = inc; mx0 = fmaxf(prev, cb0); }
        else { const float suf = wscan_max_rev(fmaxf(cb0, cb1), lane); float nxt = __shfl_down(suf, 1); if (lane == 63) nxt = -INFINITY; mx0 = suf; mx1 = fmaxf(nxt, cb1); }
        const float m0 = bc0 + fmaxf(mst, mx0), m1 = bc1 + fmaxf(mst, mx1);
        float* gv = GV + (size_t)sidx * 512 + s0;
        *(f32x2v*)(gv) = (f32x2v){cb0, cb1}; *(f32x2v*)(gv + 128) = (f32x2v){bc0 - m0, bc1 - m1};
        *(f32x2v*)(gv + 256) = (f32x2v){fexp(bc0 + mst - m0), fexp(bc1 + mst - m1)}; *(f32x2v*)(gv + 384) = (f32x2v){fexp(-m0), fexp(-m1)};
      } }
}

constexpr int MO_WAVE_BYTES = 2 * 4352;
constexpr int MO_K_OFF = 0, MO_V_OFF = MO_K_OFF + 128 * 144, MO_CF_OFF = MO_V_OFF + 64 * 272, MO_CB_OFF = MO_CF_OFF + 65 * 144, MO_GV_OFF = MO_CB_OFF + 65 * 144, MO_P_OFF = MO_GV_OFF + 4096;
static_assert(MO_P_OFF % 16 == 0 && MO_P_OFF + 8 * MO_WAVE_BYTES <= RING_BYTES, "mlstm_out LDS");
__device__ __forceinline__ void mlstm_out_phase(const Ctx& C0, int layer, const float* const* in) {
    const Ctx C = phase_ctx(C0);
    const bf16* PROJ = (const bf16*)(C.ws + WS_PROJ); const bf16* MQK = (const bf16*)(C.ws + WS_MQK); const bf16* VT = (const bf16*)(C.ws + WS_VT);
    const bf16* CSB = (const bf16*)(C.ws + WS_CSB); const float* GV = (const float*)(C.ws + WS_GV); bf16* YCAT = (bf16*)(C.ws + WS_YCAT);
    const float* ng = in[I_MNORMG] + layer * 256;
    const int tid = C.tid, lane = C.lane, wave = C.wave, rr = lane & 15, q = lane >> 4, j0 = wave * 16;
    LAS bf16* Ks = (LAS bf16*)(C.ldsl + RING_OFF + MO_K_OFF); LAS bf16* Vs = (LAS bf16*)(C.ldsl + RING_OFF + MO_V_OFF);
    LAS bf16* Cfs = (LAS bf16*)(C.ldsl + RING_OFF + MO_CF_OFF); LAS bf16* Cbs = (LAS bf16*)(C.ldsl + RING_OFF + MO_CB_OFF); LAS float* GVs = (LAS float*)(C.ldsl + RING_OFF + MO_GV_OFF);
    LAS bf16* Psf = (LAS bf16*)(C.ldsl + RING_OFF + MO_P_OFF + wave * MO_WAVE_BYTES); LAS bf16* Psb = Psf + 16 * 136;
    const int upg = NBATCH * 4 * 32 / C.ng;
    v4u pk[2], pv[2], pcf[2], pcb[2], pg; bf16x8 qan[2]; bf16 ogn[4][4];
    pcf[1] = (v4u){0u, 0u, 0u, 0u}; pcb[1] = pcf[1]; pg = pcf[1];
#define MO_ISSUE(lu_) do { const int un_ = C.grp * upg + (lu_); const int c_ = un_ & 31, h_ = (un_ >> 5) & 3, b_ = un_ >> 7; const size_t rw_ = (size_t)b_ * 4096 + c_ * 128; const int ch_ = b_ * 32 + c_; \
        const int sf_ = ((b_ * 4 + h_) * 2) * 32 + c_, sb_ = sf_ + 32; \
        _Pragma("unroll") for (int i_ = 0; i_ < 2; ++i_) { const int ix_ = tid + 512 * i_; \
            pk[i_] = *(const v4u*)(MQK + (rw_ + (ix_ >> 3)) * 512 + 256 + h_ * 64 + (ix_ & 7) * 8); \
            pv[i_] = *(const v4u*)(VT + ((size_t)(ch_ * 4 + h_) * 64 + (ix_ >> 4)) * 128 + (ix_ & 15) * 8); } \
        pcf[0] = *(const v4u*)(CSB + (size_t)sf_ * CST_SZ + tid * 8); pcb[0] = *(const v4u*)(CSB + (size_t)sb_ * CST_SZ + tid * 8); \
        if (tid < 8) { pcf[1] = *(const v4u*)(CSB + (size_t)sf_ * CST_SZ + (512 + tid) * 8); pcb[1] = *(const v4u*)(CSB + (size_t)sb_ * CST_SZ + (512 + tid) * 8); } \
        if (tid < 256) pg = *(const v4u*)(GV + (size_t)(tid < 128 ? sf_ : sb_) * 512 + (tid & 127) * 4); \
        _Pragma("unroll") for (int ks_ = 0; ks_ < 2; ++ks_) qan[ks_] = *(const bf16x8*)(MQK + (rw_ + j0 + rr) * 512 + h_ * 64 + ks_ * 32 + q * 8); \
        _Pragma("unroll") for (int i_ = 0; i_ < 4; ++i_) _Pragma("unroll") for (int et_ = 0; et_ < 4; ++et_) ogn[i_][et_] = PROJ[(rw_ + j0 + 4 * q + i_) * NPROJ + C_MO + h_ * 64 + et_ * 16 + rr]; } while (0)
#define MO_COMMIT() do { \
        _Pragma("unroll") for (int i_ = 0; i_ < 2; ++i_) { const int ix_ = tid + 512 * i_; \
            *(LAS v4u*)(Ks + (ix_ >> 3) * 72 + (ix_ & 7) * 8) = pk[i_]; *(LAS v4u*)(Vs + (ix_ >> 4) * 136 + (ix_ & 15) * 8) = pv[i_]; } \
        *(LAS v4u*)(Cfs + (tid >> 3) * 72 + (tid & 7) * 8) = pcf[0]; *(LAS v4u*)(Cbs + (tid >> 3) * 72 + (tid & 7) * 8) = pcb[0]; \
        if (tid < 8) { *(LAS v4u*)(Cfs + 64 * 72 + tid * 8) = pcf[1]; *(LAS v4u*)(Cbs + 64 * 72 + tid * 8) = pcb[1]; } \
        if (tid < 256) *(LAS v4u*)(GVs + tid * 4) = pg; } while (0)
    if (C.lb < upg) { MO_ISSUE(C.lb); MO_COMMIT(); }
    __syncthreads();
    for (int lu = C.lb; lu < upg; lu += C.GB) { const int unit = C.grp * upg + lu;
        const int c = unit & 31, h = (unit >> 5) & 3, b = unit >> 7; const size_t row0 = (size_t)b * 4096 + c * 128;
        bf16x8 qa[2]; bf16 ogr[4][4];
#pragma unroll
        for (int ks = 0; ks < 2; ++ks) qa[ks] = qan[ks];
#pragma unroll
        for (int i = 0; i < 4; ++i)
#pragma unroll
            for (int et = 0; et < 4; ++et) ogr[i][et] = ogn[i][et];
        const bool more = (lu + C.GB < upg);
        if (more) MO_ISSUE(lu + C.GB);
        const f32x4 raf = *(const LAS f32x4*)(GVs + 128 + j0 + 4 * q), aif = *(const LAS f32x4*)(GVs + 256 + j0 + 4 * q), emf = *(const LAS f32x4*)(GVs + 384 + j0 + 4 * q);
        const f32x4 rab = *(const LAS f32x4*)(GVs + 512 + 128 + j0 + 4 * q), aib = *(const LAS f32x4*)(GVs + 512 + 256 + j0 + 4 * q), emb = *(const LAS f32x4*)(GVs + 512 + 384 + j0 + 4 * q);
        float rsf[4] = {0.f, 0.f, 0.f, 0.f}, rsb[4] = {0.f, 0.f, 0.f, 0.f};
#pragma unroll
        for (int nt = 0; nt < 8; ++nt) { const int s = nt * 16 + rr; const bool usef = (nt * 16 <= j0 + 15), useb = (nt * 16 + 15 >= j0);
            const float cbf = GVs[nt * 16 + rr], cbb = GVs[512 + nt * 16 + rr];
            f32x4 acc = (f32x4){0.f, 0.f, 0.f, 0.f};
#pragma unroll
            for (int ks = 0; ks < 2; ++ks) acc = MFMA16(qa[ks], *(const LAS bf16x8*)(Ks + (nt * 16 + rr) * 72 + ks * 32 + q * 8), acc);
#pragma unroll
            for (int i = 0; i < 4; ++i) { const int j = j0 + 4 * q + i;
                float pf = 0.f, pb = 0.f;
                if (usef) { pf = (s <= j) ? acc[i] * fexp(raf[i] + cbf) : 0.f; rsf[i] += pf; }
                if (useb) { pb = (s >= j) ? acc[i] * fexp(rab[i] + cbb) : 0.f; rsb[i] += pb; }
                Psf[(4 * q + i) * 136 + s] = (bf16)f2bf(pf); Psb[(4 * q + i) * 136 + s] = (bf16)f2bf(pb); } }
        LDS_WAIT(); asm volatile("" ::: "memory");
#pragma unroll
        for (int i = 0; i < 4; ++i) {
#pragma unroll
            for (int o = 1; o < 16; o <<= 1) { rsf[i] += __shfl_xor(rsf[i], o); rsb[i] += __shfl_xor(rsb[i], o); } }
        f32x4 hsum[4];
#pragma unroll
        for (int dir = 0; dir < 2; ++dir) { LAS bf16* Cs = dir ? Cbs : Cfs; LAS bf16* Ps = dir ? Psb : Psf; const f32x4 ai = dir ? aib : aif, em = dir ? emb : emf;
          f32x4 o[5];
#pragma unroll
          for (int et = 0; et < 5; ++et) { o[et] = (f32x4){0.f, 0.f, 0.f, 0.f};
#pragma unroll
              for (int ks = 0; ks < 2; ++ks) { bf16x8 cf = (bf16x8){0, 0, 0, 0, 0, 0, 0, 0}; if (et < 4 || rr == 0) cf = *(const LAS bf16x8*)(Cs + (et * 16 + rr) * 72 + ks * 32 + q * 8);
                  o[et] = MFMA16(qa[ks], cf, o[et]); } }
          float qn[4];
#pragma unroll
          for (int i = 0; i < 4; ++i) qn[i] = __shfl(o[4][i], lane & 48);
#pragma unroll
          for (int et = 0; et < 4; ++et)
#pragma unroll
              for (int i = 0; i < 4; ++i) o[et][i] *= ai[i];
#pragma unroll
          for (int ks = 0; ks < 4; ++ks) { const bool on = dir ? (ks * 32 + 31 >= j0) : (ks * 32 <= j0 + 15);
              if (on) { const bf16x8 afr = *(const LAS bf16x8*)(Ps + rr * 136 + ks * 32 + q * 8);
#pragma unroll
              for (int et = 0; et < 4; ++et) o[et] = MFMA16(afr, *(const LAS bf16x8*)(Vs + (et * 16 + rr) * 136 + ks * 32 + q * 8), o[et]); } }
#pragma unroll
          for (int i = 0; i < 4; ++i) { const float den = (dir ? rsb[i] : rsf[i]) + ai[i] * qn[i]; const float rinv = __builtin_amdgcn_rcpf(fmaxf(fabsf(den), em[i]));
#pragma unroll
              for (int et = 0; et < 4; ++et) { const float t = o[et][i] * rinv; hsum[et][i] = dir ? hsum[et][i] + t : t; } } }
#pragma unroll
        for (int i = 0; i < 4; ++i) { float ss = 0.f;
#pragma unroll
            for (int et = 0; et < 4; ++et) ss += hsum[et][i] * hsum[et][i];
#pragma unroll
            for (int o = 1; o < 16; o <<= 1) ss += __shfl_xor(ss, o);
            const float rs = __builtin_amdgcn_rsqf(ss * (1.0f / 64.0f) + EPS); const size_t row = row0 + j0 + 4 * q + i;
#pragma unroll
            for (int et = 0; et < 4; ++et) { const int e = et * 16 + rr; const float og = bf2f(ogr[i][et]);
                const float y = hsum[et][i] * rs * ng[h * 64 + e] * fsigmoid(og); YCAT[row * 1024 + 256 + h * 64 + e] = (bf16)f2bf(y); } }
        LDS_WAIT(); asm volatile("" ::: "memory");
        __syncthreads();
        if (more) MO_COMMIT();
        __syncthreads();
    }
#undef MO_ISSUE
#undef MO_COMMIT
}

__device__ __forceinline__ void topk_phase(const Ctx& C0) {
    const Ctx C = phase_ctx(C0);
    const float* AFF = (const float*)(C.ws + WS_AFF); int* TOKI = (int*)(C.ws + WS_TOKI); float* GATEV = (float*)(C.ws + WS_TOKI + 262144); float* RSTDS = (float*)(C.ws + WS_TOKI + 524288); const float* RSTD3 = (const float*)(C.ws + WS_TOKI + 786432 + 131072); int* SLOTMAP = (int*)(C.ws + WS_SLOTMAP);
    LAS unsigned* hist = (LAS unsigned*)(C.ldsl + RING_OFF); LAS unsigned* sel = hist + 4096; LAS unsigned* wtot = hist + 4104;
    const int tid = C.tid, lane = C.lane, wave = C.wave;
    const int upg = NBATCH * NEXP / C.ng;
    for (int lu = C.lb; lu < upg; lu += C.GB) { const int unit = C.grp * upg + lu;
        const int b = unit >> 4, e = unit & 15; const float* a = AFF + (size_t)unit * 4096;
        unsigned key[8];
#pragma unroll
        for (int i = 0; i < 2; ++i) { const f32x4 v = *(const f32x4*)(a + 8 * tid + 4 * i); key[4 * i] = __float_as_uint(v.x); key[4 * i + 1] = __float_as_uint(v.y); key[4 * i + 2] = __float_as_uint(v.z); key[4 * i + 3] = __float_as_uint(v.w); }
        unsigned prefix = 0u, mask = 0u; int krem = CAP;
#pragma unroll 1
        for (int pass = 0; pass < 3; ++pass) { const int shift = 20 - 10 * pass; const unsigned nbm = pass ? 1023u : 4095u;
#pragma unroll
            for (int j = 0; j < 8; ++j) hist[tid * 8 + j] = 0u;
            __syncthreads();
#pragma unroll
            for (int i = 0; i < 8; ++i) if ((key[i] & mask) == prefix) atomicAdd((unsigned*)&hist[(key[i] >> shift) & nbm], 1u);
            __syncthreads();
            unsigned h[8]; unsigned tsum = 0u;
#pragma unroll
            for (int j = 0; j < 8; ++j) { h[j] = hist[tid * 8 + j]; tsum += h[j]; }
            unsigned sfx = tsum;
#pragma unroll
            for (int o = 1; o < 64; o <<= 1) { const unsigned t2 = __shfl_down(sfx, o); if (lane + o < 64) sfx += t2; }
            if (lane == 0) wtot[wave] = sfx;
            __syncthreads();
            { unsigned s2 = sfx - tsum;
#pragma unroll
              for (int w = 1; w < 8; ++w) if (w > wave) s2 += wtot[w];
#pragma unroll
              for (int j = 7; j >= 0; --j) { if ((int)s2 < krem && (int)(s2 + h[j]) >= krem) { sel[0] = (unsigned)(tid * 8 + j); sel[1] = s2; } s2 += h[j]; } }
            __syncthreads();
            prefix |= sel[0] << shift; mask |= nbm << shift; krem -= (int)sel[1];
            __syncthreads();
        }
        const int cnt_gt = CAP - krem;
        unsigned pk = 0u;
#pragma unroll
        for (int i = 0; i < 8; ++i) pk += (key[i] > prefix ? 1u : 0u) + (key[i] == prefix ? 65536u : 0u);
        unsigned inc = pk;
#pragma unroll
        for (int o = 1; o < 64; o <<= 1) { const unsigned t2 = __shfl_up(inc, o); if (lane >= o) inc += t2; }
        if (lane == 63) wtot[wave] = inc;
        __syncthreads();
        unsigned woff = 0u;
#pragma unroll
        for (int w = 0; w < 8; ++w) { const unsigned x = wtot[w]; if (w < wave) woff += x; }
        const unsigned ex = woff + inc - pk; int pos_gt = (int)(ex & 0xffffu), pos_eq = (int)(ex >> 16);
        int slots[8];
#pragma unroll
        for (int i = 0; i < 8; ++i) { const bool gt = key[i] > prefix, eq = key[i] == prefix; const bool selected = gt || (eq && pos_eq < krem);
            slots[i] = selected ? (gt ? pos_gt : cnt_gt + pos_eq) : -1; pos_gt += gt ? 1 : 0; pos_eq += eq ? 1 : 0;
            if (selected) { TOKI[e * ROWS_E + b * CAP + slots[i]] = b * 4096 + 8 * tid + i; GATEV[e * ROWS_E + b * CAP + slots[i]] = __uint_as_float(key[i]); RSTDS[e * ROWS_E + b * CAP + slots[i]] = RSTD3[b * 4096 + 8 * tid + i]; } }
#pragma unroll
        for (int i = 0; i < 8; ++i) SLOTMAP[((size_t)(b * 4096 + 8 * tid + i)) * 16 + e] = slots[i];
        __syncthreads();
    }
}
#ifndef MK_ONE_LAUNCH
#define MK_ONE_LAUNCH 1
#endif
#ifndef PHM
#define PHM 0xFFFF
#endif
#ifndef STAGGER_ITEMS
#define STAGGER_ITEMS 4
#endif
#ifndef A_ALIGN
#define A_ALIGN true
#endif
#ifndef RES_ALIGN
#define RES_ALIGN false
#endif
#ifndef PREP_SECS
#define PREP_SECS 15
#endif
#ifndef MN_LOCAL
#define MN_LOCAL 0
#endif
#ifndef LOCAL_SEAMS
#define LOCAL_SEAMS 1
#endif
#ifndef CONV_PARTS
#define CONV_PARTS 1
#endif
#ifndef PROBE_N
#define PROBE_N 2
#endif
#ifndef REP_BARL
#define REP_BARL 1
#endif
#ifndef REP_BAR
#define REP_BAR 1
#endif
#ifndef REP_P0
#define REP_P0 1
#endif
#ifndef REP_A
#define REP_A 1
#endif
#ifndef REP_C
#define REP_C 1
#endif
#ifndef REP_E1
#define REP_E1 1
#endif
#ifndef REP_E2
#define REP_E2 1
#endif
#ifndef REP_G
#define REP_G 1
#endif
#ifndef REP_H
#define REP_H 1
#endif
#ifndef REP_K
#define REP_K 1
#endif
#ifndef REP_L
#define REP_L 1
#endif
#ifndef REP_M
#define REP_M 1
#endif
#ifndef REP_N
#define REP_N 1
#endif
#ifndef REP_B
#define REP_B 1
#endif
#ifndef REP_D
#define REP_D 1
#endif
#ifndef REP_F
#define REP_F 1
#endif
#ifndef REP_I
#define REP_I 1
#endif
#ifndef REP_J
#define REP_J 1
#endif
#ifndef REP_O
#define REP_O 1
#endif
#define REPEAT(n) for (int rep_ = 0; rep_ < (n); ++rep_)
constexpr int NWAVES = 8;
constexpr int GU_MAXU = 16;
static_assert(XTRA_OFF + GU_MAXU * (512 + 1024) <= LDS_BYTES, "gather tables");
static_assert(GU_MAXU >= 16, "gather table");
constexpr int PH_PER_LAYER = 12, N_PHASES = 1 + DEPTH * PH_PER_LAYER;
struct Args { const float* in[N_IN]; float* out; unsigned char* ws; int ph_lo, ph_hi; };
static_assert(sizeof(Args) == (N_IN + 2) * 8 + 8, "no padding in Args");

__global__ void __launch_bounds__(NWAVES * 64, 2) mk_fwd(Args args) {
    extern __shared__ __attribute__((aligned(16))) unsigned char lds[];
    Ctx C;
    C.tid = threadIdx.x; C.lane = C.tid & 63; C.wave = __builtin_amdgcn_readfirstlane(C.tid >> 6);
    C.G = gridDim.x; { const int bx = blockIdx.x; C.vcu = (C.G % 8 == 0) ? (bx % 8) * (C.G / 8) + bx / 8 : bx; }
    C.gw = C.vcu * NWAVES + C.wave; C.NGW = C.G * NWAVES; C.ng = (C.G % 8 == 0) ? 8 : 1; C.GB = C.G / C.ng; C.grp = C.vcu / C.GB; C.lb = C.vcu % C.GB; C.lds = lds; C.ws = args.ws; C.ldsl = (LAS unsigned char*)lds;
    unsigned char* ws = args.ws;
    LAS unsigned char* ldsl = (LAS unsigned char*)lds;
    volatile LAS unsigned* MISC = (volatile LAS unsigned*)(ldsl + MISC_OFF);
    for (int u = C.tid; u < (LDS_BYTES - LDSCTL_OFF) / 4; u += NWAVES * 64) ((LAS unsigned*)(ldsl + LDSCTL_OFF))[u] = 0u;
    __syncthreads();
    XcdBarrier bar; bar.bar = (unsigned*)(ws + WS_CTL) + CW_BAR; bar.x = 0; bar.st = nullptr;
    if (MK_ONE_LAUNCH) bar = xcd_barrier_post((unsigned*)(ws + WS_CTL) + CW_BAR, MISC + 8);
    const int lo = args.ph_lo, hi = args.ph_hi;
#define IN(k) (lo <= (k) && (k) < hi)
#define SEAM(k) do { if (IN(k) && IN((k) + 1)) { REPEAT(REP_BAR) xcd_barrier(bar); } } while (0)
#define SEAM_L(k) do { if (IN(k) && IN((k) + 1)) { REPEAT(REP_BARL) { if (fastmode) local_barrier((unsigned*)(ws + WS_CTL) + CW_BAR, (unsigned*)(ws + WS_CTL) + CW_LOC + 64 * C.grp, (unsigned)C.GB, MISC + 20); else xcd_barrier(bar); } } } while (0)
    const float* const* in = args.in;
#define HN ((bf16*)(ws + WS_HN))
#define PROJ ((bf16*)(ws + WS_PROJ))
#define YCAT ((bf16*)(ws + WS_YCAT))
#define QCA ((bf16*)(ws + WS_QCA))
#define X ((float*)(ws + WS_X))
#define XB ((bf16*)(ws + WS_X))
#define RSTD1 ((float*)(ws + WS_TOKI + 786432))
#define RSTD3 ((float*)(ws + WS_TOKI + 786432 + 131072))
#define RSTDS ((float*)(ws + WS_TOKI + 524288))
#define GATES ((float*)(ws + WS_GATES))
#define AFF ((float*)(ws + WS_AFF))
#define TOKI ((int*)(ws + WS_TOKI))
#define GATEV ((float*)(ws + WS_TOKI + 262144))
#define SLOTMAP ((int*)(ws + WS_SLOTMAP))
#define ACT ((bf16*)(ws + WS_ACT))
#define YS ((bf16*)(ws + WS_YS))

    if ((PHM & 1) && IN(0)) {
        REPEAT(REP_P0) { prologue_convert(C, in, MK_ONE_LAUNCH != 0);
        __syncthreads(); }
        row_phase<1, false, true>(C, in[I_X], XB, in[I_NMIXG], RSTD1, in[I_WIN] + 1280, 2064, in[I_GATEB], GATES, nullptr, nullptr, nullptr);
        if (MK_ONE_LAUNCH && LOCAL_SEAMS && C.tid == 0) atomicOr((unsigned*)(ws + WS_CTL) + CW_LOC + 1024 + 64 * C.grp, 1u << bar.x);
        SEAM(0);
    }
    bool fastmode = false;
    const bool mnloc = (C.ng == 8 && C.GB == 32);
    if (MK_ONE_LAUNCH && LOCAL_SEAMS && lo == 0 && hi == N_PHASES) {
        if (C.tid == 0) { unsigned ok = (C.ng == 8) ? 1u : 0u;
            for (int g = 0; g < 8; ++g) { const unsigned m = xb_ld((unsigned*)(ws + WS_CTL) + CW_LOC + 1024 + 64 * g); if (m == 0u || (m & (m - 1u)) != 0u) ok = 0u; }
            MISC[21] = ok; }
        __syncthreads();
        fastmode = (MISC[21] != 0u);
    }
#pragma unroll 1
    for (int l = 0; l < DEPTH; ++l) {
        const int pb = 1 + l * PH_PER_LAYER;
        if ((PHM & (1 << 1)) && IN(pb + 0)) {
            if (l == 0) { pg8::Gemm g{(const pg8::bf16_t*)(ws + WS_MEMB), (const pg8::bf16_t*)(ws + WS_WCAKV), 1024, 0, 1024L * 1024, nullptr, 0, nullptr}; pg8::Sched S; S.init(8, 4, 4, C.G, (int)blockIdx.x);
                pg8::EpiBf16 E{(pg8::bf16_t*)(ws + WS_KVCA), 1024, 2048L * 1024, 1.0f};
                pg8::gemm_phase<pg8::EpiBf16, true, false>(ldsl + RING_OFF, g, S, E); }
            REPEAT(REP_A) { pg8::Gemm g{(const pg8::bf16_t*)XB, (const pg8::bf16_t*)(ws + WS_WIN) + (size_t)l * 2048 * 1024, 1024, 0, 0, nullptr, 0, nullptr}; pg8::Sched S; S.init(NTOK / 256, NPROJ / 256, 1, C.G, (int)blockIdx.x);
              pg8::row_table((LAS float*)(ldsl + XTRA_OFF), RSTD1, 0, S, GU_MAXU);
              pg8::EpiBf16S E{(pg8::bf16_t*)PROJ, NPROJ, (const LAS float*)(ldsl + XTRA_OFF)};
              pg8::gemm_phase<pg8::EpiBf16S, A_ALIGN, false>(ldsl + RING_OFF, g, S, E); }
            if (l == 0) SEAM(pb + 0); else SEAM_L(pb + 0);
        }
        if ((PHM & (1 << 2)) && IN(pb + 1)) { REPEAT(REP_B - 1) prep_phase(C, l, in, ACT, PREP_SECS); prep_phase(C, l, in, PROJ); VM_WAIT(); __syncthreads(); REPEAT(REP_C) mlstm_local_phase(C); SEAM_L(pb + 1); }
        if ((PHM & (1 << 4)) && IN(pb + 2)) { REPEAT(REP_D) mlstm_scan_phase(C); SEAM_L(pb + 2); }
        if ((PHM & (1 << 5)) && IN(pb + 3)) {
#ifndef NO_MOUT
            REPEAT(REP_E1) { mlstm_out_phase(C, l, in);
            __syncthreads(); }
#endif
#ifndef NO_ATTN
            REPEAT(REP_E2) for (int i = 0; i < 4; ++i) { const int u = C.vcu * 4 + i; if (u >= NBATCH * 8 * 16) break; const int qb = u & 15, h = (u >> 4) & 7, b = u >> 7;
                attn_body::attn_unit<8>((long)b * 4096, qb * 256, (const attn_body::bf16*)PROJ + C_AQ + h * 64, (const attn_body::bf16*)PROJ + C_AK + (h >> 2) * 64, (const attn_body::bf16*)PROJ + C_AV + (h >> 2) * 64,
                                        (attn_body::bf16*)YCAT + 512 + h * 64, (char*)lds + RING_OFF);
#if CONV_PARTS == 2
                if (MK_ONE_LAUNCH && (i == (C.vcu & 3) || i == ((C.vcu + 2) & 3))) { convert_share(ws, in, ldsl, l, C.vcu, C.G, (i == (C.vcu & 3)) ? 0 : 1, 2); __syncthreads(); } }
#else
                if (MK_ONE_LAUNCH && i == (C.vcu & 3)) { convert_share(ws, in, ldsl, l, C.vcu, C.G); __syncthreads();
#if defined(CV_MODE)
                    convert_share_probe(ws, in, ldsl, l, C.vcu, C.G); __syncthreads();
#endif
                } }
#endif
#endif
            SEAM_L(pb + 3);
        }
        if ((PHM & (1 << 6)) && IN(pb + 4)) {
            pg8::Gemm g{(const pg8::bf16_t*)YCAT, (const pg8::bf16_t*)(ws + WS_WOUT) + (size_t)l * 1024 * 1024, 1024, 0, 0, nullptr, 0, nullptr}; pg8::Sched S; S.init(NTOK / 256, 4, 1, C.G, (int)blockIdx.x);
            pg8::EpiResidXB E{(const pg8::bf16_t*)XB, (pg8::bf16_t*)XB, (float*)(ws + WS_PART), 1024};
            pg8::gemm_phase<pg8::EpiResidXB, RES_ALIGN, false>(ldsl + RING_OFF, g, S, E);
            SEAM_L(pb + 4);
        }
        if ((PHM & (1 << 8)) && IN(pb + 5)) {
            pg8::Gemm g{(const pg8::bf16_t*)XB, (const pg8::bf16_t*)(ws + WS_WCAQ) + (size_t)l * 512 * 1024, 1024, 0, 0, nullptr, 0, nullptr}; pg8::Sched S; S.init(NTOK / 256, 2, 1, C.G, (int)blockIdx.x);
            pg8::EpiBf16R E{(pg8::bf16_t*)QCA, 512, attn_body::CA_C2, (const float*)(ws + WS_PART), EPS};
            REPEAT(REP_H) pg8::gemm_phase<pg8::EpiBf16R, true, false>(ldsl + RING_OFF, g, S, E);
            VM_WAIT(); __syncthreads();
            { pg8::Unit u;
              for (int rep_ = 0; rep_ < REP_I; ++rep_)
              for (int i = 0; S.next(i, u); ++i) { const int b = u.pm >> 4, qt = u.pm & 15;
                  for (int hh = 0; hh < 2; ++hh)
                      attn_body::ca_tiles<1>(b, 2 * u.pn + hh, qt, (const attn_body::bf16*)QCA, (const attn_body::bf16*)(ws + WS_KVCA) + (size_t)l * 2048 * 1024, (attn_body::bf16*)(rep_ + 1 < REP_I ? ACT : QCA), (char*)lds + RING_OFF, (float*)(lds + XTRA_OFF)); } }
            SEAM_L(pb + 5);
        }
        if ((PHM & (1 << 10)) && IN(pb + 6)) {
            pg8::Gemm g{(const pg8::bf16_t*)QCA, (const pg8::bf16_t*)(ws + WS_WCAO) + (size_t)l * 1024 * 512, 512, 0, 0, nullptr, 0, nullptr}; pg8::Sched S; S.init(NTOK / 256, 4, 1, C.G, (int)blockIdx.x);
            REPEAT(REP_J - 1) { pg8::EpiResidB E2{(const pg8::bf16_t*)XB, (pg8::bf16_t*)ACT, 1024}; pg8::gemm_phase<pg8::EpiResidB, true, false>(ldsl + RING_OFF, g, S, E2); }
            pg8::EpiResidB E{(const pg8::bf16_t*)XB, (pg8::bf16_t*)XB, 1024};
            pg8::gemm_phase<pg8::EpiResidB, RES_ALIGN, false>(ldsl + RING_OFF, g, S, E);
            SEAM_L(pb + 6);
        }
        if ((PHM & (1 << 11)) && IN(pb + 7)) { REPEAT(REP_K) router_phase(C, XB, in[I_NFFNG] + l * 1024, in[I_ROUTER] + (size_t)l * 1024 * 16, AFF, RSTD3); SEAM_L(pb + 7); }
        if ((PHM & (1 << 12)) && IN(pb + 8)) { REPEAT(REP_L) topk_phase(C); SEAM(pb + 8); }
        if ((PHM & (1 << 13)) && IN(pb + 9)) {
            pg8::Gemm g{(const pg8::bf16_t*)XB, (const pg8::bf16_t*)(ws + WS_WGU) + (size_t)l * 16 * 4096 * 1024, 1024, 0, 4096L * 1024, TOKI, ROWS_E, (const LAS unsigned short*)(ldsl + XTRA_OFF)}; pg8::Sched S; if (MN_LOCAL && mnloc) S.init(2, 16, NEXP, C.GB, C.lb, 2 * C.grp); else S.init(ROWS_E / 256, 16, NEXP, C.G, (int)blockIdx.x);
            pg8::gather_table((LAS unsigned short*)(ldsl + XTRA_OFF), TOKI, ROWS_E, S, GU_MAXU, (LAS float*)(ldsl + XTRA_OFF + GU_MAXU * 512), RSTDS);
            pg8::EpiSwiGLU E{(pg8::bf16_t*)ACT, FFE, ROWS_E, (const LAS float*)(ldsl + XTRA_OFF + GU_MAXU * 512)};
            REPEAT(REP_M) pg8::gemm_phase<pg8::EpiSwiGLU, true, true>(ldsl + RING_OFF, g, S, E);
            if (MN_LOCAL && mnloc) SEAM_L(pb + 9); else SEAM(pb + 9);
        }
        if ((PHM & (1 << 14)) && IN(pb + 10)) {
            pg8::Gemm g{(const pg8::bf16_t*)ACT, (const pg8::bf16_t*)(ws + WS_WDN) + (size_t)l * 16 * 1024 * 2048, 2048, (long)ROWS_E * FFE, 1024L * 2048, nullptr, 0, nullptr}; pg8::Sched S; if (MN_LOCAL && mnloc) S.init(2, 4, NEXP, C.GB, C.lb, 2 * C.grp); else S.init(ROWS_E / 256, 4, NEXP, C.G, (int)blockIdx.x);
            pg8::row_table((LAS float*)(ldsl + XTRA_OFF), GATEV, ROWS_E, S, GU_MAXU);
            pg8::EpiDown E{(pg8::bf16_t*)YS, 1024, ROWS_E, (const LAS float*)(ldsl + XTRA_OFF)};
            REPEAT(REP_N) pg8::gemm_phase<pg8::EpiDown, true, false>(ldsl + RING_OFF, g, S, E);
            if (MN_LOCAL && mnloc) SEAM_L(pb + 10); else SEAM(pb + 10);
        }
        if ((PHM & (1 << 15)) && IN(pb + 11)) {
            if (l + 1 < DEPTH) { REPEAT(REP_O - 1) row_phase<1, true>(C, XB, (bf16*)ACT, in[I_NMIXG] + (l + 1) * 1024, RSTD1, in[I_WIN] + (size_t)(l + 1) * 1024 * 2064 + 1280, 2064, in[I_GATEB] + (l + 1) * 16, GATES, nullptr, SLOTMAP, YS);
              row_phase<1, true>(C, XB, XB, in[I_NMIXG] + (l + 1) * 1024, RSTD1, in[I_WIN] + (size_t)(l + 1) * 1024 * 2064 + 1280, 2064, in[I_GATEB] + (l + 1) * 16, GATES, nullptr, SLOTMAP, YS); SEAM_L(pb + 11); }
            else row_phase<3, true>(C, XB, XB, in[I_FNG], nullptr, nullptr, 0, nullptr, nullptr, args.out, SLOTMAP, YS);
        }
    }
#if defined(PROBE_TAIL)
    if (IN(N_PHASES - 1)) {
        __syncthreads();
        const int l = DEPTH - 1;
        for (int rep_ = 0; rep_ < PROBE_N; ++rep_) {
#if PROBE_TAIL == 1
            pg8::Gemm g{(const pg8::bf16_t*)XB, (const pg8::bf16_t*)(ws + WS_WIN) + (size_t)l * 2048 * 1024, 1024, 0, 0, nullptr, 0, nullptr}; pg8::Sched S; S.init(NTOK / 256, NPROJ / 256, 1, C.G, (int)blockIdx.x);
            pg8::EpiBf16 E{(pg8::bf16_t*)PROJ, NPROJ, 0, 1.0f};
            pg8::gemm_phase<pg8::EpiBf16, true, false>(ldsl + RING_OFF, g, S, E);
#elif PROBE_TAIL == 2
            pg8::Gemm g{(const pg8::bf16_t*)YCAT, (const pg8::bf16_t*)(ws + WS_WOUT) + (size_t)l * 1024 * 1024, 1024, 0, 0, nullptr, 0, nullptr}; pg8::Sched S; S.init(NTOK / 256, 4, 1, C.G, (int)blockIdx.x);
            pg8::EpiResidB E{(const pg8::bf16_t*)XB, (pg8::bf16_t*)PROJ, 1024};
            pg8::gemm_phase<pg8::EpiResidB, false, false>(ldsl + RING_OFF, g, S, E);
#elif PROBE_TAIL == 3
            pg8::Gemm g{(const pg8::bf16_t*)XB, (const pg8::bf16_t*)(ws + WS_WGU) + (size_t)l * 16 * 4096 * 1024, 1024, 0, 4096L * 1024, TOKI, ROWS_E, (const LAS unsigned short*)(ldsl + XTRA_OFF)}; pg8::Sched S; S.init(ROWS_E / 256, 16, NEXP, C.G, (int)blockIdx.x);
            pg8::gather_table((LAS unsigned short*)(ldsl + XTRA_OFF), TOKI, ROWS_E, S, GU_MAXU, (LAS float*)(ldsl + XTRA_OFF + GU_MAXU * 512), RSTDS);
            pg8::EpiSwiGLU E{(pg8::bf16_t*)ACT, FFE, ROWS_E, (const LAS float*)(ldsl + XTRA_OFF + GU_MAXU * 512)};
            pg8::gemm_phase<pg8::EpiSwiGLU, true, true>(ldsl + RING_OFF, g, S, E);
#elif PROBE_TAIL == 4
            pg8::Gemm g{(const pg8::bf16_t*)ACT, (const pg8::bf16_t*)(ws + WS_WDN) + (size_t)l * 16 * 1024 * 2048, 2048, (long)ROWS_E * FFE, 1024L * 2048, nullptr, 0, nullptr}; pg8::Sched S; S.init(ROWS_E / 256, 4, NEXP, C.G, (int)blockIdx.x);
            pg8::row_table((LAS float*)(ldsl + XTRA_OFF), GATEV, ROWS_E, S, GU_MAXU);
            pg8::EpiDown E{(pg8::bf16_t*)YS, 1024, ROWS_E, (const LAS float*)(ldsl + XTRA_OFF)};
            pg8::gemm_phase<pg8::EpiDown, true, false>(ldsl + RING_OFF, g, S, E);
#elif PROBE_TAIL == 6
            pg8::Gemm g{(const pg8::bf16_t*)YCAT, (const pg8::bf16_t*)(ws + WS_WOUT) + (size_t)l * 1024 * 1024, 1024, 0, 0, nullptr, 0, nullptr}; pg8::Sched S; S.init(NTOK / 256, 4, 1, C.G, (int)blockIdx.x);
            pg8::EpiBf16 E{(pg8::bf16_t*)PROJ, 1024, 0, 1.0f};
            pg8::gemm_phase<pg8::EpiBf16, true, false>(ldsl + RING_OFF, g, S, E);
#elif PROBE_TAIL == 5
            pg8::Gemm g{(const pg8::bf16_t*)QCA, (const pg8::bf16_t*)(ws + WS_WCAO) + (size_t)l * 1024 * 512, 512, 0, 0, nullptr, 0, nullptr}; pg8::Sched S; S.init(NTOK / 256, 4, 1, C.G, (int)blockIdx.x);
            pg8::EpiResidB E{(const pg8::bf16_t*)XB, (pg8::bf16_t*)PROJ, 1024};
            pg8::gemm_phase<pg8::EpiResidB, false, false>(ldsl + RING_OFF, g, S, E);
#endif
            __syncthreads();
        }
    }
#endif
#undef IN
#undef SEAM
#undef HN
#undef PROJ
#undef YCAT
#undef QCA
#undef X
#undef GATES
#undef AFF
#undef TOKI
#undef GATEV
#undef SLOTMAP
#undef ACT
#undef YS
}

extern "C" void kernel_launch(void* const* d_in, const int* in_sizes, int n_in, void* d_out, int out_size, void* d_ws, size_t ws_size, hipStream_t stream) {
    static int grid = 0;
    if (grid == 0) {
        if (n_in != N_IN || in_sizes[0] != NTOK * DMODEL || out_size != NTOK * DMODEL || ws_size < WS_END) { fprintf(stderr, "kernel_launch: unexpected shapes (n_in %d, in0 %d, out %d, ws %zu); nothing launched\n", n_in, n_in > 0 ? in_sizes[0] : -1, out_size, ws_size); grid = -1; return; }
        int dev = 0, cus = 0, per_cu = 0;
        if (hipGetDevice(&dev) != hipSuccess || hipDeviceGetAttribute(&cus, hipDeviceAttributeMultiprocessorCount, dev) != hipSuccess) { grid = -1; return; }
        if (hipFuncSetAttribute((const void*)mk_fwd, hipFuncAttributeMaxDynamicSharedMemorySize, LDS_BYTES) != hipSuccess) { fprintf(stderr, "kernel_launch: hipFuncSetAttribute failed\n"); grid = -1; return; }
        if (hipOccupancyMaxActiveBlocksPerMultiprocessor(&per_cu, (const void*)mk_fwd, NWAVES * 64, LDS_BYTES) != hipSuccess || per_cu < 1) fprintf(stderr, "kernel_launch: occupancy query reports %d workgroups per CU\n", per_cu);
        (void)hipGetLastError();
        if (cus < 256) { fprintf(stderr, "kernel_launch: built for a 256-CU device (the attention and expert phases deal one unit group per workgroup); found %d CUs; nothing launched\n", cus); grid = -1; return; }
        grid = cus;
    }
    if (grid < 0) return;
    if (hipMemsetAsync((char*)d_ws + WS_CTL, 0, CTL_ZERO_BYTES, stream) != hipSuccess) { fprintf(stderr, "kernel_launch: memset failed\n"); return; }
    Args a{};
    for (int i = 0; i < N_IN; ++i) a.in[i] = (const float*)d_in[i];
    a.out = (float*)d_out; a.ws = (unsigned char*)d_ws;
#if MK_ONE_LAUNCH
    a.ph_lo = 0; a.ph_hi = N_PHASES;
    hipLaunchKernelGGL(mk_fwd, dim3(grid), dim3(NWAVES * 64), LDS_BYTES, stream, a);
#else
    for (int p = 0; p < N_PHASES; ++p) { a.ph_lo = p; a.ph_hi = p + 1; hipLaunchKernelGGL(mk_fwd, dim3(grid), dim3(NWAVES * 64), LDS_BYTES, stream, a); }
#endif
    const hipError_t le = hipPeekAtLastError();
    if (le != hipSuccess) fprintf(stderr, "kernel_launch: launch failed: %s\n", hipGetErrorName(le));
}
```

```cpp
#include <hip/hip_runtime.h>
#include <hip/hip_bf16.h>
#include <cstdio>
#include <cstdint>
#include <cmath>
__device__ __forceinline__ int opaque_tid() { int t = (int)threadIdx.x; asm volatile("" : "+v"(t)); return t; }
#ifndef WGM_SET
#define WGM_SET 8
#endif
namespace pg8 {
#define PG8_LAS __attribute__((address_space(3)))
typedef unsigned short bf16_t;
typedef short bf16x8 __attribute__((ext_vector_type(8)));
typedef float f32x4 __attribute__((ext_vector_type(4)));
typedef unsigned u32x4 __attribute__((ext_vector_type(4)));
constexpr int BM = 256, BK = 64, HALF = 128, HTB = HALF * BK * 2  , STAGE_BYTES = 8 * HTB, NXCD = 8, WGM = WGM_SET;

__host__ __device__ __forceinline__ int lds_byte(int r, int c) { const int st = (r >> 4) * 2 + (c >> 5), rr = r & 15, cc = c & 31, ob = rr * 64 + cc * 2; return st * 1024 + (ob ^ (((ob >> 9) & 1) << 5)); }
__host__ __device__ __forceinline__ void stage_rc(int b, int& R, int& C) { const int st = b / 1024, sb = b % 1024, swz = sb ^ (((sb >> 9) & 1) << 5); R = (st >> 1) * 16 + swz / 64; C = (st & 1) * 32 + (swz % 64) / 2; }
__host__ __device__ __forceinline__ int perm32(int rho) { const int n = rho >> 4, i = rho & 15; return 8 * (i >> 2) + 4 * n + (i & 3); }

struct Unit { int pm, pn, e, i; };
struct Gemm { const bf16_t* A; const bf16_t* Bt; int K; long sAe, sBe; const int* gidx; int rowsPerE; const PG8_LAS unsigned short* ltab; };

struct Sched {
    int nM, nN, P, total, G, c, pm0;
    __device__ __forceinline__ void init(int nM_, int nN_, int nE_, int G_, int c_, int pm0_ = 0) { nM = nM_; nN = nN_; P = nM_ * nN_; total = P * nE_; G = G_; c = c_; pm0 = pm0_; }
    __device__ __forceinline__ bool next(int i, Unit& u) const {
        const long L = (long)i * G + c; if (L >= total) return false;
        const int e = (int)(L / P); int wgid = (int)(L % P);
        { const int q = P / NXCD, r = P % NXCD, xcd = wgid % NXCD, off = wgid / NXCD; wgid = (xcd < r ? xcd * (q + 1) : r * (q + 1) + (xcd - r) * q) + off; }
        const int nig = WGM * nN, gid = wgid / nig, fm = gid * WGM, gsz = (nM - fm) < WGM ? (nM - fm) : WGM;
        u.pm = pm0 + fm + ((wgid % nig) % gsz); u.pn = (wgid % nig) / gsz; u.e = e; u.i = i; return true;
    }
};

__device__ __forceinline__ unsigned cvt_pk_bf16(float lo, float hi) { unsigned r; asm volatile("v_cvt_pk_bf16_f32 %0, %1, %2" : "=v"(r) : "v"(lo), "v"(hi)); return r; }


#ifndef EPI_WT
#define EPI_WT 0
#endif
__device__ __forceinline__ void st16_u(void* p, u32x4 v) {
#if EPI_WT
    asm volatile("global_store_dwordx4 %0, %1, off sc1\n\ts_nop 2" :: "v"(p), "v"(v) : "memory");
#else
    *(u32x4*)p = v;
#endif
}
__device__ __forceinline__ void st16_f(void* p, f32x4 v) {
#if EPI_WT
    asm volatile("global_store_dwordx4 %0, %1, off sc1\n\ts_nop 2" :: "v"(p), "v"(v) : "memory");
#else
    *(f32x4*)p = v;
#endif
}
struct EpiBf16 {
    static constexpr int NST = 16;
    bf16_t* O; int ldc; long strideE; float scale;
    __device__ __forceinline__ void operator()(const f32x4 (&acc)[2][2][4][2], const Unit& u, int wr, int wc, int fr, int fq) const {
        const int row0 = u.pm * BM + wr * 64 + fr; const int col0 = u.pn * BM + wc * 32 + 8 * fq; bf16_t* base = O + (long)u.e * strideE;
#pragma unroll
        for (int ai = 0; ai < 2; ++ai)
#pragma unroll
            for (int m = 0; m < 4; ++m) { bf16_t* rowp = base + (size_t)(row0 + ai * HALF + m * 16) * ldc + col0;
#pragma unroll
                for (int bj = 0; bj < 2; ++bj) { const f32x4 v0 = acc[ai][bj][m][0] * scale, v1 = acc[ai][bj][m][1] * scale;
                    u32x4 w; w.x = cvt_pk_bf16(v0[0], v0[1]); w.y = cvt_pk_bf16(v0[2], v0[3]); w.z = cvt_pk_bf16(v1[0], v1[1]); w.w = cvt_pk_bf16(v1[2], v1[3]);
                    st16_u(rowp + bj * HALF, w); } }
    }
};
struct EpiResid {
    const float* xin; float* xout; int ldc; static constexpr int NST = 32;
    __device__ __forceinline__ void operator()(const f32x4 (&acc)[2][2][4][2], const Unit& u, int wr, int wc, int fr, int fq) const {
        const int row0 = u.pm * BM + wr * 64 + fr; const int col0 = u.pn * BM + wc * 32 + 8 * fq;
#pragma unroll
        for (int ai = 0; ai < 2; ++ai) { f32x4 r[4][2][2];
#pragma unroll
            for (int m = 0; m < 4; ++m) { const size_t ro = (size_t)(row0 + ai * HALF + m * 16) * ldc + col0;
#pragma unroll
                for (int bj = 0; bj < 2; ++bj) { r[m][bj][0] = *(const f32x4*)(xin + ro + bj * HALF); r[m][bj][1] = *(const f32x4*)(xin + ro + bj * HALF + 4); } }
#pragma unroll
            for (int m = 0; m < 4; ++m) { const size_t ro = (size_t)(row0 + ai * HALF + m * 16) * ldc + col0;
#pragma unroll
                for (int bj = 0; bj < 2; ++bj) { st16_f(xout + ro + bj * HALF, r[m][bj][0] + acc[ai][bj][m][0]); st16_f(xout + ro + bj * HALF + 4, r[m][bj][1] + acc[ai][bj][m][1]); } } }
    }
};
struct EpiResidX {
    const float* xin; float* xout; bf16_t* xb; float* part; int ldc; static constexpr int NST = 55;
    __device__ __forceinline__ void operator()(const f32x4 (&acc)[2][2][4][2], const Unit& u, int wr, int wc, int fr, int fq) const {
        const int row0 = u.pm * BM + wr * 64 + fr; const int col0 = u.pn * BM + wc * 32 + 8 * fq;
#pragma unroll
        for (int ai = 0; ai < 2; ++ai) { f32x4 r[4][2][2];
#pragma unroll
            for (int m = 0; m < 4; ++m) { const size_t ro = (size_t)(row0 + ai * HALF + m * 16) * ldc + col0;
#pragma unroll
                for (int bj = 0; bj < 2; ++bj) { r[m][bj][0] = *(const f32x4*)(xin + ro + bj * HALF); r[m][bj][1] = *(const f32x4*)(xin + ro + bj * HALF + 4); } }
#pragma unroll
            for (int m = 0; m < 4; ++m) { const int row = row0 + ai * HALF + m * 16; const size_t ro = (size_t)row * ldc + col0; float ss = 0.f;
#pragma unroll
                for (int bj = 0; bj < 2; ++bj) { const f32x4 n0 = r[m][bj][0] + acc[ai][bj][m][0], n1 = r[m][bj][1] + acc[ai][bj][m][1];
                    st16_f(xout + ro + bj * HALF, n0); st16_f(xout + ro + bj * HALF + 4, n1);
                    u32x4 w; w.x = cvt_pk_bf16(n0[0], n0[1]); w.y = cvt_pk_bf16(n0[2], n0[3]); w.z = cvt_pk_bf16(n1[0], n1[1]); w.w = cvt_pk_bf16(n1[2], n1[3]);
                    st16_u(xb + ro + bj * HALF, w);
                    ss += ((n0[0] * n0[0] + n0[1] * n0[1]) + (n0[2] * n0[2] + n0[3] * n0[3])) + ((n1[0] * n1[0] + n1[1] * n1[1]) + (n1[2] * n1[2] + n1[3] * n1[3])); }
                ss += __shfl_xor(ss, 16); ss += __shfl_xor(ss, 32);
                if (fq == 0) part[(size_t)row * 16 + u.pn * 4 + wc] = ss; } }
    }
};
struct EpiBf16S {
    bf16_t* O; int ldc; const PG8_LAS float* rs; static constexpr int NST = 16;
    __device__ __forceinline__ void operator()(const f32x4 (&acc)[2][2][4][2], const Unit& u, int wr, int wc, int fr, int fq) const {
        const int row0 = u.pm * BM + wr * 64 + fr; const int col0 = u.pn * BM + wc * 32 + 8 * fq;
        float rq[2][4];
#pragma unroll
        for (int ai = 0; ai < 2; ++ai)
#pragma unroll
            for (int m = 0; m < 4; ++m) rq[ai][m] = rs[u.i * BM + wr * 64 + fr + ai * HALF + m * 16];
#pragma unroll
        for (int ai = 0; ai < 2; ++ai)
#pragma unroll
            for (int m = 0; m < 4; ++m) { bf16_t* rowp = O + (size_t)(row0 + ai * HALF + m * 16) * ldc + col0;
#pragma unroll
                for (int bj = 0; bj < 2; ++bj) { const f32x4 v0 = acc[ai][bj][m][0] * rq[ai][m], v1 = acc[ai][bj][m][1] * rq[ai][m];
                    u32x4 w; w.x = cvt_pk_bf16(v0[0], v0[1]); w.y = cvt_pk_bf16(v0[2], v0[3]); w.z = cvt_pk_bf16(v1[0], v1[1]); w.w = cvt_pk_bf16(v1[2], v1[3]);
                    st16_u(rowp + bj * HALF, w); } }
    }
};
struct EpiResidB {
    const bf16_t* xin; bf16_t* xout; int ldc; static constexpr int NST = 16;
    __device__ __forceinline__ void operator()(const f32x4 (&acc)[2][2][4][2], const Unit& u, int wr, int wc, int fr, int fq) const {
        const int row0 = u.pm * BM + wr * 64 + fr; const int col0 = u.pn * BM + wc * 32 + 8 * fq;
#pragma unroll
        for (int ai = 0; ai < 2; ++ai) { u32x4 r[4][2];
#pragma unroll
            for (int m = 0; m < 4; ++m) { const size_t ro = (size_t)(row0 + ai * HALF + m * 16) * ldc + col0;
#pragma unroll
                for (int bj = 0; bj < 2; ++bj) r[m][bj] = *(const u32x4*)(xin + ro + bj * HALF); }
#pragma unroll
            for (int m = 0; m < 4; ++m) { const size_t ro = (size_t)(row0 + ai * HALF + m * 16) * ldc + col0;
#pragma unroll
                for (int bj = 0; bj < 2; ++bj) { const u32x4 q = r[m][bj];
                    const f32x4 n0 = (f32x4){__uint_as_float(q.x << 16), __uint_as_float(q.x & 0xffff0000u), __uint_as_float(q.y << 16), __uint_as_float(q.y & 0xffff0000u)} + acc[ai][bj][m][0];
                    const f32x4 n1 = (f32x4){__uint_as_float(q.z << 16), __uint_as_float(q.z & 0xffff0000u), __uint_as_float(q.w << 16), __uint_as_float(q.w & 0xffff0000u)} + acc[ai][bj][m][1];
                    u32x4 w; w.x = cvt_pk_bf16(n0[0], n0[1]); w.y = cvt_pk_bf16(n0[2], n0[3]); w.z = cvt_pk_bf16(n1[0], n1[1]); w.w = cvt_pk_bf16(n1[2], n1[3]);
                    st16_u(xout + ro + bj * HALF, w); } } }
    }
};
struct EpiResidXB {
    const bf16_t* xin; bf16_t* xout; float* part; int ldc; static constexpr int NST = 24;
    __device__ __forceinline__ void operator()(const f32x4 (&acc)[2][2][4][2], const Unit& u, int wr, int wc, int fr, int fq) const {
        const int row0 = u.pm * BM + wr * 64 + fr; const int col0 = u.pn * BM + wc * 32 + 8 * fq;
#pragma unroll
        for (int ai = 0; ai < 2; ++ai) { u32x4 r[4][2];
#pragma unroll
            for (int m = 0; m < 4; ++m) { const size_t ro = (size_t)(row0 + ai * HALF + m * 16) * ldc + col0;
#pragma unroll
                for (int bj = 0; bj < 2; ++bj) r[m][bj] = *(const u32x4*)(xin + ro + bj * HALF); }
#pragma unroll
            for (int m = 0; m < 4; ++m) { const int row = row0 + ai * HALF + m * 16; const size_t ro = (size_t)row * ldc + col0; float ss = 0.f;
#pragma unroll
                for (int bj = 0; bj < 2; ++bj) { const u32x4 q = r[m][bj];
                    const f32x4 n0 = (f32x4){__uint_as_float(q.x << 16), __uint_as_float(q.x & 0xffff0000u), __uint_as_float(q.y << 16), __uint_as_float(q.y & 0xffff0000u)} + acc[ai][bj][m][0];
                    const f32x4 n1 = (f32x4){__uint_as_float(q.z << 16), __uint_as_float(q.z & 0xffff0000u), __uint_as_float(q.w << 16), __uint_as_float(q.w & 0xffff0000u)} + acc[ai][bj][m][1];
                    u32x4 w; w.x = cvt_pk_bf16(n0[0], n0[1]); w.y = cvt_pk_bf16(n0[2], n0[3]); w.z = cvt_pk_bf16(n1[0], n1[1]); w.w = cvt_pk_bf16(n1[2], n1[3]);
                    st16_u(xout + ro + bj * HALF, w);
                    ss += ((n0[0] * n0[0] + n0[1] * n0[1]) + (n0[2] * n0[2] + n0[3] * n0[3])) + ((n1[0] * n1[0] + n1[1] * n1[1]) + (n1[2] * n1[2] + n1[3] * n1[3])); }
                ss += __shfl_xor(ss, 16); ss += __shfl_xor(ss, 32);
                if (fq == 0) part[(size_t)row * 16 + u.pn * 4 + wc] = ss; } }
    }
};
struct EpiBf16R {
    bf16_t* O; int ldc; float scale; const float* part; float eps; static constexpr int NST = 16;
    __device__ __forceinline__ void operator()(const f32x4 (&acc)[2][2][4][2], const Unit& u, int wr, int wc, int fr, int fq) const {
        const int row0 = u.pm * BM + wr * 64 + fr; const int col0 = u.pn * BM + wc * 32 + 8 * fq;
        f32x4 pq[2][4];
#pragma unroll
        for (int ai = 0; ai < 2; ++ai)
#pragma unroll
            for (int m = 0; m < 4; ++m) pq[ai][m] = *(const f32x4*)(part + (size_t)(row0 + ai * HALF + m * 16) * 16 + 4 * fq);
#pragma unroll
        for (int ai = 0; ai < 2; ++ai)
#pragma unroll
            for (int m = 0; m < 4; ++m) { const int row = row0 + ai * HALF + m * 16; const f32x4 p = pq[ai][m];
                float sq = (p[0] + p[1]) + (p[2] + p[3]); sq += __shfl_xor(sq, 16); sq += __shfl_xor(sq, 32);
                const float rs = scale * __builtin_amdgcn_rsqf(sq * (1.0f / 1024.0f) + eps);
                bf16_t* rowp = O + (size_t)row * ldc + col0;
#pragma unroll
                for (int bj = 0; bj < 2; ++bj) { const f32x4 v0 = acc[ai][bj][m][0] * rs, v1 = acc[ai][bj][m][1] * rs;
                    u32x4 w; w.x = cvt_pk_bf16(v0[0], v0[1]); w.y = cvt_pk_bf16(v0[2], v0[3]); w.z = cvt_pk_bf16(v1[0], v1[1]); w.w = cvt_pk_bf16(v1[2], v1[3]);
                    st16_u(rowp + bj * HALF, w); } }
    }
};
__device__ __forceinline__ float silu_f(float x) { return x * __builtin_amdgcn_rcpf(1.0f + __builtin_amdgcn_exp2f(-1.4426950408889634f * x)); }
struct EpiSwiGLU {
    bf16_t* O; int ldc; int rowsPerE; const PG8_LAS float* rs; static constexpr int NST = 8;
    __device__ __forceinline__ void operator()(const f32x4 (&acc)[2][2][4][2], const Unit& u, int wr, int wc, int fr, int fq) const {
        const int row0 = u.e * rowsPerE + u.pm * BM + wr * 64 + fr; const int col0 = u.pn * HALF + wc * 32 + 8 * fq;
        float rq[2][4];
#pragma unroll
        for (int ai = 0; ai < 2; ++ai)
#pragma unroll
            for (int m = 0; m < 4; ++m) rq[ai][m] = rs[u.i * BM + wr * 64 + fr + ai * HALF + m * 16];
#pragma unroll
        for (int ai = 0; ai < 2; ++ai)
#pragma unroll
            for (int m = 0; m < 4; ++m) { bf16_t* rowp = O + (size_t)(row0 + ai * HALF + m * 16) * ldc + col0; const float r = rq[ai][m];
                const f32x4 g0 = acc[ai][0][m][0] * r, g1 = acc[ai][0][m][1] * r, u0 = acc[ai][1][m][0] * r, u1 = acc[ai][1][m][1] * r;
                u32x4 w; w.x = cvt_pk_bf16(silu_f(g0[0]) * u0[0], silu_f(g0[1]) * u0[1]); w.y = cvt_pk_bf16(silu_f(g0[2]) * u0[2], silu_f(g0[3]) * u0[3]);
                w.z = cvt_pk_bf16(silu_f(g1[0]) * u1[0], silu_f(g1[1]) * u1[1]); w.w = cvt_pk_bf16(silu_f(g1[2]) * u1[2], silu_f(g1[3]) * u1[3]);
                st16_u(rowp, w); }
    }
};
struct EpiDown {
    bf16_t* O; int ldc; int rowsPerE; const PG8_LAS float* gate; static constexpr int NST = 16;
    __device__ __forceinline__ void operator()(const f32x4 (&acc)[2][2][4][2], const Unit& u, int wr, int wc, int fr, int fq) const {
        const int row0 = u.e * rowsPerE + u.pm * BM + wr * 64 + fr; const int col0 = u.pn * BM + wc * 32 + 8 * fq;
        float gt[2][4];
#pragma unroll
        for (int ai = 0; ai < 2; ++ai)
#pragma unroll
            for (int m = 0; m < 4; ++m) gt[ai][m] = gate[u.i * BM + wr * 64 + fr + ai * HALF + m * 16];
#pragma unroll
        for (int ai = 0; ai < 2; ++ai)
#pragma unroll
            for (int m = 0; m < 4; ++m) { const int row = row0 + ai * HALF + m * 16; bf16_t* rowp = O + (size_t)row * ldc + col0;
#pragma unroll
                for (int bj = 0; bj < 2; ++bj) { const f32x4 v0 = acc[ai][bj][m][0] * gt[ai][m], v1 = acc[ai][bj][m][1] * gt[ai][m];
                    u32x4 w; w.x = cvt_pk_bf16(v0[0], v0[1]); w.y = cvt_pk_bf16(v0[2], v0[3]); w.z = cvt_pk_bf16(v1[0], v1[1]); w.w = cvt_pk_bf16(v1[2], v1[3]);
                    st16_u(rowp + bj * HALF, w); } }
    }
};

typedef int i32x4 __attribute__((ext_vector_type(4)));
constexpr int TAB_MAXU = 16;
__device__ __forceinline__ void gather_table(PG8_LAS unsigned short* ltab, const int* gidx, int rowsPerE, const Sched& S, int maxu, PG8_LAS float* rtab, const float* rsrc) {
    const int tid = opaque_tid(), i = tid >> 5, r = (tid & 31) * 8; Unit u;
    if (i < maxu && S.next(i, u)) { const size_t o = (size_t)u.e * rowsPerE + u.pm * BM + r;
        const i32x4 g0 = *(const i32x4*)(gidx + o), g1 = *(const i32x4*)(gidx + o + 4); const f32x4 r0 = *(const f32x4*)(rsrc + o), r1 = *(const f32x4*)(rsrc + o + 4);
        u32x4 pk; pk.x = (unsigned)g0.x | ((unsigned)g0.y << 16); pk.y = (unsigned)g0.z | ((unsigned)g0.w << 16); pk.z = (unsigned)g1.x | ((unsigned)g1.y << 16); pk.w = (unsigned)g1.z | ((unsigned)g1.w << 16);
        *(PG8_LAS u32x4*)(ltab + i * BM + r) = pk; *(PG8_LAS f32x4*)(rtab + i * BM + r) = r0; *(PG8_LAS f32x4*)(rtab + i * BM + r + 4) = r1; }
    __syncthreads();
}
__device__ __forceinline__ void row_table(PG8_LAS float* tab, const float* src, int rowsPerE, const Sched& S, int maxu) {
    const int tid = opaque_tid(), i = tid >> 5, r = (tid & 31) * 8; Unit u;
    if (i < maxu && S.next(i, u)) { const size_t o = (size_t)u.e * rowsPerE + u.pm * BM + r; const f32x4 r0 = *(const f32x4*)(src + o), r1 = *(const f32x4*)(src + o + 4);
        *(PG8_LAS f32x4*)(tab + i * BM + r) = r0; *(PG8_LAS f32x4*)(tab + i * BM + r + 4) = r1; }
    __syncthreads();
}
template <class Epi, bool ALIGN_EPI, bool GATHER>
__device__ __forceinline__ void gemm_phase(PG8_LAS unsigned char* lds, const Gemm g, const Sched& S, const Epi& E) {
    const int tid = opaque_tid(), wid = __builtin_amdgcn_readfirstlane(tid >> 6), lane = tid & 63, wr = wid >> 2, wc = wid & 3, fr = lane & 15, fq = lane >> 4;
    const int K = g.K, nt = K / BK;
    int Rr[2], Cc[2]; unsigned voffB[2];
#pragma unroll
    for (int i = 0; i < 2; ++i) { stage_rc(tid * 16 + i * 8192, Rr[i], Cc[i]); const int Rb = (Rr[i] & ~31) + perm32(Rr[i] & 31); voffB[i] = (unsigned)(Rb * K + Cc[i]) * 2u; }
    const size_t kstep = (size_t)(BK * 2);
    const size_t hstep = (size_t)HALF * K * 2;
    const size_t tstep = 2 * hstep;
    const unsigned ldsw = (unsigned)wid * 1024u;
    const int aoff = lds_byte(wr * 64 + fr, fq * 8), boff = lds_byte(wc * 32 + fr, fq * 8);
#define PG8_SA(b, h) (((b) * 2 + (h)) * HTB)
#define PG8_SB(b, h) ((4 + (b) * 2 + (h)) * HTB)
#define PG8_STAGE(bufoff, gbase, voff) do { _Pragma("unroll") for (int _i = 0; _i < 2; ++_i) \
        __builtin_amdgcn_global_load_lds((const unsigned*)((const char*)(gbase) + (voff)[_i]), (PG8_LAS unsigned*)(lds + (bufoff) + ldsw + _i * 8192), 16, 0, 0); } while (0)
#define PG8_LDA(dst, b, h) do { _Pragma("unroll") for (int m = 0; m < 4; ++m) _Pragma("unroll") for (int k = 0; k < 2; ++k) dst[m][k] = *(const PG8_LAS bf16x8*)(lds + PG8_SA(b, h) + aoff + m * 2048 + k * 1024); } while (0)
#define PG8_LDB(dst, b, h) do { _Pragma("unroll") for (int n = 0; n < 2; ++n) _Pragma("unroll") for (int k = 0; k < 2; ++k) dst[n][k] = *(const PG8_LAS bf16x8*)(lds + PG8_SB(b, h) + boff + n * 2048 + k * 1024); } while (0)
#define PG8_MMA(ai, bj, At, Bt) do { __builtin_amdgcn_s_setprio(1); _Pragma("unroll") for (int m = 0; m < 4; ++m) _Pragma("unroll") for (int n = 0; n < 2; ++n) _Pragma("unroll") for (int k = 0; k < 2; ++k) \
        acc[ai][bj][m][n] = __builtin_amdgcn_mfma_f32_16x16x32_bf16(Bt[n][k], At[m][k], acc[ai][bj][m][n], 0, 0, 0); __builtin_amdgcn_s_setprio(0); } while (0)
#define PG8_WAIT_V(n) asm volatile("s_waitcnt vmcnt(" #n ")" ::: "memory")
#define PG8_WAIT_L(n) asm volatile("s_waitcnt lgkmcnt(" #n ")" ::: "memory")
#define PG8_WAIT_VR(flag, n) asm volatile("s_cmp_lg_u32 %0, 0\n\ts_cbranch_scc1 .Lrlx%=\n\ts_waitcnt vmcnt(8)\n.Lrlx%=:\n\ts_waitcnt vmcnt(%1)" :: "s"(flag), "n"(n) : "memory", "scc")
#define PG8_BAR __builtin_amdgcn_s_barrier()
#define PG8_SCHED __builtin_amdgcn_sched_barrier(0)
#define PG8_AOFF(dst, un, uidx) do { _Pragma("unroll") for (int _h = 0; _h < 2; ++_h) _Pragma("unroll") for (int _i = 0; _i < 2; ++_i) { \
        if constexpr (GATHER) { const int _row = g.ltab[(uidx) * BM + _h * HALF + Rr[_i]]; dst[_h][_i] = (unsigned)(_row * K + Cc[_i]) * 2u; } \
        else dst[_h][_i] = (unsigned)((Rr[_i] + _h * HALF) * K + Cc[_i]) * 2u; } } while (0)
#define PG8_ABASE(un) (GATHER ? (const char*)g.A : (const char*)g.A + ((size_t)(un).e * g.sAe) * 2 + (size_t)(un).pm * tstep)
#define PG8_BBASE(un) ((const char*)g.Bt + ((size_t)(un).e * g.sBe) * 2 + (size_t)(un).pn * tstep)
    Unit cur, nxt; int ui = 0;
    if (!S.next(0, cur)) return;
    f32x4 acc[2][2][4][2];
#pragma unroll
    for (int a = 0; a < 2; ++a)
#pragma unroll
        for (int b = 0; b < 2; ++b)
#pragma unroll
            for (int m = 0; m < 4; ++m)
#pragma unroll
                for (int n = 0; n < 2; ++n) acc[a][b][m][n] = (f32x4){0.f, 0.f, 0.f, 0.f};
    bf16x8 At[4][2], B0[2][2], B1[2][2];
    unsigned vC[2][2], vN[2][2];
    PG8_AOFF(vC, cur, 0);
#pragma unroll
    for (int _h = 0; _h < 2; ++_h) { vN[_h][0] = vC[_h][0]; vN[_h][1] = vC[_h][1]; }
    const char* cA = PG8_ABASE(cur); const char* cB = PG8_BBASE(cur);
    PG8_STAGE(PG8_SB(0, 0), cB, voffB); PG8_STAGE(PG8_SB(0, 1), cB + hstep, voffB); PG8_STAGE(PG8_SA(0, 0), cA, vC[0]); PG8_STAGE(PG8_SA(0, 1), cA, vC[1]);
    if (wr == 1) PG8_BAR;
    PG8_WAIT_V(2); PG8_BAR;
    PG8_STAGE(PG8_SB(1, 0), cB + kstep, voffB); PG8_STAGE(PG8_SA(1, 0), cA + kstep, vC[0]); PG8_STAGE(PG8_SB(1, 1), cB + hstep + kstep, voffB);
    PG8_WAIT_V(6); PG8_BAR;
    for (;;) {
        const bool has_next = S.next(ui + 1, nxt);
        const char* nA = has_next ? PG8_ABASE(nxt) : cA; const char* nB = has_next ? PG8_BBASE(nxt) : cB;
        if constexpr (GATHER) { if (has_next) { PG8_AOFF(vN, nxt, ui + 1); } else {
#pragma unroll
            for (int _h = 0; _h < 2; ++_h) { vN[_h][0] = vC[_h][0]; vN[_h][1] = vC[_h][1]; } } }
        for (int t = 0; t < nt; t += 2) {
            const bool last = (t == nt - 2);
            const char* a1 = cA + (size_t)(t + 1) * kstep;
            const char* a2 = last ? nA : cA + (size_t)(t + 2) * kstep; const char* b2 = last ? nB : cB + (size_t)(t + 2) * kstep;
            const char* a3 = a2 + kstep; const char* b3 = b2 + kstep;
            unsigned v2[2][2];
#pragma unroll
            for (int _h = 0; _h < 2; ++_h)
#pragma unroll
                for (int _i = 0; _i < 2; ++_i) { if constexpr (GATHER) v2[_h][_i] = last ? vN[_h][_i] : vC[_h][_i]; else v2[_h][_i] = vC[_h][_i]; }
            const int relax = __builtin_amdgcn_readfirstlane(((t == 0) && (ui > 0)) ? 1 : 0);
            PG8_LDB(B0, 0, 0); PG8_LDB(B1, 0, 1); PG8_SCHED; PG8_LDA(At, 0, 0); PG8_STAGE(PG8_SA(1, 1), a1, vC[1]);
            PG8_WAIT_VR(relax, 8 + Epi::NST);
            PG8_WAIT_L(0); PG8_BAR; PG8_MMA(0, 0, At, B0); PG8_MMA(0, 1, At, B1); PG8_BAR; PG8_SCHED;
            PG8_LDA(At, 0, 1); PG8_STAGE(PG8_SB(0, 0), b2, voffB); PG8_STAGE(PG8_SB(0, 1), b2 + hstep, voffB); PG8_STAGE(PG8_SA(0, 0), a2, v2[0]);
            PG8_WAIT_VR(relax, 8 + Epi::NST);
            PG8_WAIT_L(0); PG8_BAR; PG8_MMA(1, 0, At, B0); PG8_MMA(1, 1, At, B1); PG8_BAR; PG8_SCHED;
            PG8_LDB(B0, 1, 0); PG8_LDB(B1, 1, 1); PG8_SCHED; PG8_LDA(At, 1, 0); PG8_STAGE(PG8_SA(0, 1), a2, v2[1]);
            PG8_WAIT_V(8); PG8_WAIT_L(0); PG8_BAR; PG8_MMA(0, 0, At, B0); PG8_MMA(0, 1, At, B1); PG8_BAR; PG8_SCHED;
            PG8_LDA(At, 1, 1); PG8_STAGE(PG8_SB(1, 0), b3, voffB); PG8_STAGE(PG8_SB(1, 1), b3 + hstep, voffB); PG8_STAGE(PG8_SA(1, 0), a3, v2[0]);
            PG8_WAIT_V(8); PG8_WAIT_L(0); PG8_BAR; PG8_MMA(1, 0, At, B0); PG8_MMA(1, 1, At, B1); PG8_BAR; PG8_SCHED;
        }
        if constexpr (ALIGN_EPI) { if (wr == 0) PG8_BAR; }
        E(acc, cur, wr, wc, fr, fq);
        if (!has_next) break;
#pragma unroll
        for (int a = 0; a < 2; ++a)
#pragma unroll
            for (int b = 0; b < 2; ++b)
#pragma unroll
                for (int m = 0; m < 4; ++m)
#pragma unroll
                    for (int n = 0; n < 2; ++n) acc[a][b][m][n] = (f32x4){0.f, 0.f, 0.f, 0.f};
        cur = nxt; cA = nA; cB = nB; ++ui;
#pragma unroll
        for (int _h = 0; _h < 2; ++_h) { vC[_h][0] = vN[_h][0]; vC[_h][1] = vN[_h][1]; }
        if constexpr (ALIGN_EPI) { if (wr == 1) PG8_BAR; }
    }
    PG8_WAIT_V(0);
    if constexpr (!ALIGN_EPI) { if (wr == 0) PG8_BAR; }
    PG8_BAR;
#undef PG8_SA
#undef PG8_SB
#undef PG8_STAGE
#undef PG8_LDA
#undef PG8_LDB
#undef PG8_MMA
#undef PG8_WAIT_V
#undef PG8_WAIT_L
#undef PG8_WAIT_VR
#undef PG8_BAR
#undef PG8_SCHED
#undef PG8_AOFF
#undef PG8_ABASE
#undef PG8_BBASE
}
}
namespace attn_body {
using bf16=__hip_bfloat16;
using bf16x8=__attribute__((ext_vector_type(8)))short;
using s16x4=__attribute__((ext_vector_type(4)))short;
using f32x16=__attribute__((ext_vector_type(16)))float;
using u32x4=__attribute__((ext_vector_type(4)))unsigned;
constexpr int SEQ=4096,D=64,QP=2048,KP=2048,VP=2048,OP=1024;
constexpr int NW=8,QBLK=32,QB=QBLK*NW,KVBLK=64;
constexpr int ATTN_UNIT_ROWS=QB;
__device__ __forceinline__ int crow(int r,int hi){return (r&3)+8*(r>>2)+4*hi;}
#define SBAR() __builtin_amdgcn_sched_barrier(0)
__device__ __forceinline__ void cmask(f32x16&p0,f32x16&p1,int jb,int qrel,int hi){
  const float NEG=-INFINITY; int kb=64*jb+4*hi;
  #pragma unroll
  for(int r=0;r<16;++r){int kv=kb+(r&3)+8*(r>>2); if(kv>qrel)p0[r]=NEG; if(kv+32>qrel)p1[r]=NEG;}
}

#ifndef MAXCHK
#define MAXCHK 8
#endif
constexpr int NSLOT=3, SLOTB=8192;
constexpr int LDS_K=0, LDS_V=NSLOT*SLOTB, LDS_WS=2*NSLOT*SLOTB, LDS_OST=LDS_WS+NW*64*4, LDS_BYTES=LDS_OST+NW*4096;
constexpr float C2=0.125f*1.4426950408889634f;
__device__ __forceinline__ void glds16(const void*gsrc,unsigned lds_dst){unsigned keep;
  asm volatile("s_mov_b32 %0, m0\n\ts_mov_b32 m0, %2\n\ts_nop 0\n\tglobal_load_lds_dwordx4 %1, off\n\ts_mov_b32 m0, %0":"=&s"(keep):"v"(gsrc),"s"(lds_dst):"memory");}
__device__ __forceinline__ float max3f(float a,float b,float c){float r;asm("v_max3_f32 %0, %1, %2, %3":"=v"(r):"v"(a),"v"(b),"v"(c));return r;}
__device__ __forceinline__ float max2f(float a,float b){float r;asm("v_max_f32_e32 %0, %1, %2":"=v"(r):"v"(a),"v"(b));return r;}
__device__ __forceinline__ float fadd_s(float a,float b){float r;asm("v_add_f32_e32 %0, %1, %2":"=v"(r):"v"(a),"v"(b));return r;}
__device__ __forceinline__ float fsub_s(float a,float b){float r;asm("v_sub_f32_e32 %0, %1, %2":"=v"(r):"v"(a),"v"(b));return r;}
typedef float f32x2_t __attribute__((ext_vector_type(2))); typedef __bf16 bf16x2_t __attribute__((ext_vector_type(2)));
__device__ __forceinline__ unsigned cvtpk_s(float lo,float hi){f32x2_t v={lo,hi};bf16x2_t b=__builtin_convertvector(v,bf16x2_t);return __builtin_bit_cast(unsigned,b);}
#define WAIT_BAR(N) asm volatile("s_waitcnt vmcnt(" #N ") lgkmcnt(0)\n\ts_barrier":::"memory")

__device__ __forceinline__ void qkt(f32x16&p0,f32x16&p1,const char*Kslot,const bf16x8*qr,const f32x16&negm,int r32,int hi){
  const char*kb=Kslot+hi*1024+r32*16;
  #pragma unroll
  for(int d0=0;d0<4;++d0){
    const bf16x8 b0=*reinterpret_cast<const bf16x8*>(kb+d0*2048);
    const bf16x8 b1=*reinterpret_cast<const bf16x8*>(kb+d0*2048+512);
    if(d0==0){p0=__builtin_amdgcn_mfma_f32_32x32x16_bf16(b0,qr[0],negm,0,0,0);p1=__builtin_amdgcn_mfma_f32_32x32x16_bf16(b1,qr[0],negm,0,0,0);}
    else{p0=__builtin_amdgcn_mfma_f32_32x32x16_bf16(b0,qr[d0],p0,0,0,0);p1=__builtin_amdgcn_mfma_f32_32x32x16_bf16(b1,qr[d0],p1,0,0,0);}}
}
typedef __attribute__((address_space(3))) const char* lds_cptr;
typedef short v4i16_t __attribute__((ext_vector_type(4)));
__device__ __forceinline__ void kload8(bf16x8*kf,lds_cptr kp){
  kf[0]=*(const __attribute__((address_space(3))) bf16x8*)(kp);      kf[1]=*(const __attribute__((address_space(3))) bf16x8*)(kp+512);
  kf[2]=*(const __attribute__((address_space(3))) bf16x8*)(kp+2048); kf[3]=*(const __attribute__((address_space(3))) bf16x8*)(kp+2560);
  kf[4]=*(const __attribute__((address_space(3))) bf16x8*)(kp+4096); kf[5]=*(const __attribute__((address_space(3))) bf16x8*)(kp+4608);
  kf[6]=*(const __attribute__((address_space(3))) bf16x8*)(kp+6144); kf[7]=*(const __attribute__((address_space(3))) bf16x8*)(kp+6656);
}
__device__ __forceinline__ void kload2(bf16x8*kf,lds_cptr kp,int j){ kf[2*j]=*(const __attribute__((address_space(3))) bf16x8*)(kp+j*2048); kf[2*j+1]=*(const __attribute__((address_space(3))) bf16x8*)(kp+j*2048+512); }
__device__ __forceinline__ s16x4 vtr(lds_cptr p){ return __builtin_bit_cast(s16x4,__builtin_amdgcn_ds_read_tr16_b64_v4i16((__attribute__((address_space(3))) v4i16_t*)p)); }
__device__ __forceinline__ float rowmax(const f32x16&p0,const f32x16&p1){
  float a=max3f(p0[0],p0[1],p1[0]),b=max3f(p0[2],p0[3],p1[1]);a=max3f(a,p1[2],p1[3]);
  #pragma unroll
  for(int r=4;r<16;r+=4){a=max3f(a,p0[r],p0[r+1]);b=max3f(b,p0[r+2],p0[r+3]);a=max3f(a,p1[r],p1[r+1]);b=max3f(b,p1[r+2],p1[r+3]);}
  const float m=max2f(a,b);
  auto rr=__builtin_amdgcn_permlane32_swap(__float_as_uint(m),__float_as_uint(m),false,false);
  return max2f(__uint_as_float(rr[0]),__uint_as_float(rr[1]));
}
__device__ __forceinline__ void pv(f32x16*o,int vb,bf16x8 pa0,bf16x8 pa1,bf16x8 pa2,bf16x8 pa3){
  #pragma unroll
  for(int d0=0;d0<2;++d0){s16x4 lo[4],hi[4];
    #pragma unroll
    for(int ks=0;ks<4;++ks){
      asm volatile("ds_read_b64_tr_b16 %0,%1 offset:%c2":"=&v"(lo[ks]):"v"(vb),"i"(d0*4096+ks*1024):"memory");
      asm volatile("ds_read_b64_tr_b16 %0,%1 offset:%c2":"=&v"(hi[ks]):"v"(vb),"i"(d0*4096+ks*1024+512):"memory");}
    asm volatile("s_waitcnt lgkmcnt(0)":::"memory");SBAR();
    #define PK(k) (bf16x8){lo[k][0],lo[k][1],lo[k][2],lo[k][3],hi[k][0],hi[k][1],hi[k][2],hi[k][3]}
    o[d0]=__builtin_amdgcn_mfma_f32_32x32x16_bf16(pa0,PK(0),o[d0],0,0,0);
    o[d0]=__builtin_amdgcn_mfma_f32_32x32x16_bf16(pa1,PK(1),o[d0],0,0,0);
    o[d0]=__builtin_amdgcn_mfma_f32_32x32x16_bf16(pa2,PK(2),o[d0],0,0,0);
    o[d0]=__builtin_amdgcn_mfma_f32_32x32x16_bf16(pa3,PK(3),o[d0],0,0,0);
    #undef PK
  }
}

#ifndef ATTN_STORE16
#define ATTN_STORE16(p,v) (*(u32x4*)(p)=(v))
#endif
template<int THRL> __device__ __forceinline__ void attn_unit(long rowbase,int q0,const bf16*Qh,const bf16*__restrict__ Kh,const bf16*__restrict__ Vh,bf16*Oh,char*shm){
  const int tid=opaque_tid(),lane=tid&63,r32=lane&31,hi=lane>>5; const int wid=__builtin_amdgcn_readfirstlane(tid>>6);
  const bf16*Qw=Qh+(rowbase+q0+wid*QBLK)*QP;
  const bf16*Kb=Kh+rowbase*KP,*Vb=Vh+rowbase*VP;
  const unsigned lds0=(unsigned)(uintptr_t)shm;
  float*wsf=(float*)(shm+LDS_WS)+wid*64;
  const bf16*ksrc=Kb+(long)lane*KP+wid*8;
  const bf16*vsrc=Vb+(long)(16*(wid&3)+(lane>>2))*VP+(wid>>2)*32+(lane&3)*8;
  const unsigned kdst=lds0+LDS_K+wid*1024, vdst=lds0+LDS_V+wid*1024;
  #define DMA_K(t,slot) glds16(ksrc+(long)(t)*KVBLK*KP,(unsigned)__builtin_amdgcn_readfirstlane(kdst+(slot)))
  #define DMA_V(t,slot) glds16(vsrc+(long)(t)*KVBLK*VP,(unsigned)__builtin_amdgcn_readfirstlane(vdst+(slot)))
  const int vb0=(int)(lds0+LDS_V)+((lane>>4)&1)*32+(lane&3)*8+(4*hi+((lane&15)>>2))*64;
  const char*Kbase=shm+LDS_K; bf16x8 kf[8];
  const lds_cptr shm3=(lds_cptr)shm; const lds_cptr kp0=shm3+LDS_K+hi*1024+r32*16; const lds_cptr vp0=shm3+LDS_V+((lane>>4)&1)*32+(lane&3)*8+(4*hi+((lane&15)>>2))*64;
  constexpr int NT=SEQ/KVBLK;
  DMA_K(0,0);DMA_V(0,0);DMA_K(1,SLOTB);
  bf16x8 qr[4];
  #pragma unroll
  for(int d0=0;d0<4;++d0)qr[d0]=*reinterpret_cast<const bf16x8*>(&Qw[(long)r32*QP+d0*16+hi*8]);
  float mhat=0.f,l_reg=0.f;f32x16 o[2];o[0]=f32x16{};o[1]=f32x16{};f32x16 negm=f32x16{};asm volatile("":"+v"(negm));
  const int qrel=wid*QBLK+r32;
  #define CMASK(P0,P1,t) do{}while(0)
  bool resc=false;
  #define START(P0,P1) do{ const float rm=rowmax(P0,P1); resc=false; \
    { const float dl=rm; mhat=fadd_s(mhat,dl); \
      _Pragma("unroll") for(int r=0;r<16;++r){P0[r]=fsub_s(P0[r],dl);P1[r]=fsub_s(P1[r],dl);} \
      _Pragma("unroll") for(int r=0;r<16;++r)negm[r]=-mhat; asm volatile("":"+v"(negm)); } \
    _Pragma("unroll") for(int r=0;r<16;++r)P0[r]=__builtin_amdgcn_exp2f(P0[r]); }while(0)
  #define RESC() do{ if(resc){ asm volatile("s_waitcnt lgkmcnt(0)":::"memory"); \
      _Pragma("unroll") for(int d_=0;d_<2;++d_) _Pragma("unroll") for(int r=0;r<16;++r)o[d_][r]*=wsf[crow(r,hi)]; } }while(0)
  f32x16 pA0,pA1,pB0,pB1;
  int sl_prev=0,sl_cur=0,sl_next=SLOTB;
  #define ROT() do{sl_prev=sl_cur;sl_cur=sl_next;sl_next=(sl_next==(NSLOT-1)*SLOTB)?0:sl_next+SLOTB;}while(0)
  DMA_K(2,2*SLOTB);
  WAIT_BAR(3);
  qkt(pA0,pA1,Kbase,qr,negm,r32,hi);asm volatile("s_nop 15\n\ts_nop 7":"+v"(pA0),"+v"(pA1));CMASK(pA0,pA1,0);
  START(pA0,pA1);
  _Pragma("unroll") for(int r=0;r<16;++r)pA1[r]=__builtin_amdgcn_exp2f(pA1[r]);
  WAIT_BAR(0);
  DMA_K(3,0);DMA_V(1,SLOTB);
  ROT();
  kload8(kf,kp0+sl_cur);
  WAIT_BAR(2);
  s16x4 vlo[8],vhi[8]; u32x4 pw0,pw1,pw2,pw3;
  #define PKW(P,B) cvtpk_s(P[B],P[B+1])
  #define PAF(k) __builtin_bit_cast(bf16x8,pw##k)
  #define VFR(i) (bf16x8){vlo[i][0],vlo[i][1],vlo[i][2],vlo[i][3],vhi[i][0],vhi[i][1],vhi[i][2],vhi[i][3]}
  #define PIN(x) asm volatile("":"+v"(x))
  #define MX3(a,b,c) __builtin_fmaxf(__builtin_fmaxf((a),(b)),(c))
  #define GAPA(MF,A0,A1,A2,A3,W0,W1,PW) do{ MF; sacc+=A0; sacc+=A1; sacc+=A2; sacc+=A3; PIN(sacc); W0; W1; PIN(PW); SBAR(); }while(0)
  #define EX(v) __builtin_amdgcn_exp2f(v)
  #define GAPB(MF,X,B) do{ MF; X[B]=EX(X[B]); X[B+1]=EX(X[B+1]); X[B+2]=EX(X[B+2]); X[B+3]=EX(X[B+3]); PIN(X); SBAR(); }while(0)
  #define VRD(i) do{ vlo[i]=vtr(vp_+(((i)>>2)*4096+((i)&3)*1024)); vhi[i]=vtr(vp_+(((i)>>2)*4096+((i)&3)*1024+512)); }while(0)
  #define KRD(G,j) do{ if(G){ kload2(kf,kp0+sl_next,j); SBAR(); } }while(0)
  #define STEP(C0,C1,P0,P1,t,GK,GV,GL) do{ SBAR(); \
    const lds_cptr vp_=vp0+sl_prev; \
    VRD(0); SBAR(); float sacc=(P0[0]+P0[1]); \
    GAPA(C0=__builtin_amdgcn_mfma_f32_32x32x16_bf16(kf[0],qr[0],negm,0,0,0), P0[2],P0[3],P0[4],P0[5],     pw0[0]=PKW(P0,0), pw0[1]=PKW(P0,2), pw0); \
    VRD(4); SBAR(); GAPA(C1=__builtin_amdgcn_mfma_f32_32x32x16_bf16(kf[1],qr[0],negm,0,0,0), P0[6],P0[7],P0[8],P0[9],     pw0[2]=PKW(P0,4), pw0[3]=PKW(P0,6), pw0); \
    VRD(1); SBAR(); GAPA(C0=__builtin_amdgcn_mfma_f32_32x32x16_bf16(kf[2],qr[1],C0,0,0,0),   P0[10],P0[11],P0[12],P0[13], pw1[0]=PKW(P0,8), pw1[1]=PKW(P0,10), pw1); \
    VRD(5); SBAR(); GAPA(C1=__builtin_amdgcn_mfma_f32_32x32x16_bf16(kf[3],qr[1],C1,0,0,0),   P0[14],P0[15],P1[0],P1[1],   pw1[2]=PKW(P0,12),pw1[3]=PKW(P0,14), pw1); \
    VRD(2); SBAR(); GAPA(C0=__builtin_amdgcn_mfma_f32_32x32x16_bf16(kf[4],qr[2],C0,0,0,0),   P1[2],P1[3],P1[4],P1[5],     pw2[0]=PKW(P1,0), pw2[1]=PKW(P1,2), pw2); \
    VRD(6); SBAR(); GAPA(C1=__builtin_amdgcn_mfma_f32_32x32x16_bf16(kf[5],qr[2],C1,0,0,0),   P1[6],P1[7],P1[8],P1[9],     pw2[2]=PKW(P1,4), pw2[3]=PKW(P1,6), pw2); \
    VRD(3); SBAR(); GAPA(C0=__builtin_amdgcn_mfma_f32_32x32x16_bf16(kf[6],qr[3],C0,0,0,0),   P1[10],P1[11],P1[12],P1[13], pw3[0]=PKW(P1,8), pw3[1]=PKW(P1,10), pw3); \
    VRD(7); SBAR(); GAPA(C1=__builtin_amdgcn_mfma_f32_32x32x16_bf16(kf[7],qr[3],C1,0,0,0),   P1[14],P1[15],0.f,0.f,       pw3[2]=PKW(P1,12),pw3[3]=PKW(P1,14), pw3); \
    l_reg+=sacc; \
    if(GK){DMA_K((t)+3,sl_cur);} if(GV){DMA_V((t)+1,sl_next);} \
    CMASK(C0,C1,t); \
    resc=false; \
    if((((t)&(MAXCHK-1))==0)){ float a=MX3(C0[0],C0[1],C1[0]),b=MX3(C0[2],C0[3],C1[1]); a=MX3(a,C1[2],C1[3]); \
      _Pragma("unroll") for(int r=4;r<16;r+=4){a=MX3(a,C0[r],C0[r+1]);b=MX3(b,C0[r+2],C0[r+3]);a=MX3(a,C1[r],C1[r+1]);b=MX3(b,C1[r+2],C1[r+3]);} \
      float rm=__builtin_fmaxf(a,b); { auto rr=__builtin_amdgcn_permlane32_swap(__float_as_uint(rm),__float_as_uint(rm),false,false); rm=__builtin_fmaxf(__uint_as_float(rr[0]),__uint_as_float(rr[1])); } \
      if(__builtin_expect(__any(rm>(float)THRL),0)){ const float dl=__builtin_fmaxf(rm,0.f); mhat+=dl; \
        _Pragma("unroll") for(int r=0;r<16;++r){C0[r]-=dl;C1[r]-=dl;} \
        _Pragma("unroll") for(int r=0;r<16;++r)negm[r]=-mhat; asm volatile("":"+v"(negm)); \
        const float f=__builtin_amdgcn_exp2f(-dl); l_reg*=f; if(hi==0)wsf[r32]=f; resc=true; } } \
    SBAR(); \
    GAPB(o[0]=__builtin_amdgcn_mfma_f32_32x32x16_bf16(PAF(0),VFR(0),o[0],0,0,0), C0,0); \
    GAPB(o[1]=__builtin_amdgcn_mfma_f32_32x32x16_bf16(PAF(0),VFR(4),o[1],0,0,0), C0,4); \
    KRD(GL,0); GAPB(o[0]=__builtin_amdgcn_mfma_f32_32x32x16_bf16(PAF(1),VFR(1),o[0],0,0,0), C0,8); \
    KRD(GL,1); GAPB(o[1]=__builtin_amdgcn_mfma_f32_32x32x16_bf16(PAF(1),VFR(5),o[1],0,0,0), C0,12); \
    KRD(GL,2); GAPB(o[0]=__builtin_amdgcn_mfma_f32_32x32x16_bf16(PAF(2),VFR(2),o[0],0,0,0), C1,0); \
    KRD(GL,3); GAPB(o[1]=__builtin_amdgcn_mfma_f32_32x32x16_bf16(PAF(2),VFR(6),o[1],0,0,0), C1,4); \
    GAPB(o[0]=__builtin_amdgcn_mfma_f32_32x32x16_bf16(PAF(3),VFR(3),o[0],0,0,0), C1,8); \
    GAPB(o[1]=__builtin_amdgcn_mfma_f32_32x32x16_bf16(PAF(3),VFR(7),o[1],0,0,0), C1,12); \
    }while(0)
  int t=1;
  #undef CMASK
  #define CMASK(P0,P1,t) do{}while(0)
  for(;t+5<NT;t+=2){
    STEP(pB0,pB1,pA0,pA1,t,true,true,true);     WAIT_BAR(2); RESC(); ROT();
    STEP(pA0,pA1,pB0,pB1,t+1,true,true,true);   WAIT_BAR(2); RESC(); ROT();
  }
  #undef CMASK
  #define CMASK(P0,P1,t) do{}while(0)
  #define ENDW(tt) do{ if((tt)+3<NT){WAIT_BAR(2);} else if((tt)+2<NT){WAIT_BAR(1);} else {WAIT_BAR(0);} }while(0)
  for(;t+1<NT;t+=2){
    STEP(pB0,pB1,pA0,pA1,t,(t+3<NT),(t+1<NT),(t+1<NT));       ENDW(t);   RESC(); ROT();
    STEP(pA0,pA1,pB0,pB1,t+1,(t+4<NT),(t+2<NT),(t+2<NT));     ENDW(t+1); RESC(); ROT();
  }
  STEP(pB0,pB1,pA0,pA1,NT-1,false,false,false); RESC();
  { float sacc=pB0[0]+pB0[1]; _Pragma("unroll") for(int r=2;r<16;++r)sacc+=pB0[r]; _Pragma("unroll") for(int r=0;r<16;++r)sacc+=pB1[r]; l_reg+=sacc;
    pw0=(u32x4){PKW(pB0,0),PKW(pB0,2),PKW(pB0,4),PKW(pB0,6)};pw1=(u32x4){PKW(pB0,8),PKW(pB0,10),PKW(pB0,12),PKW(pB0,14)};pw2=(u32x4){PKW(pB1,0),PKW(pB1,2),PKW(pB1,4),PKW(pB1,6)};pw3=(u32x4){PKW(pB1,8),PKW(pB1,10),PKW(pB1,12),PKW(pB1,14)};
    SBAR(); pv(o,vb0+sl_cur,PAF(0),PAF(1),PAF(2),PAF(3)); }
  #undef PKW
  #undef PAF
  #undef VFR
  #undef PIN
  #undef MX3
  #undef GAPA
  #undef GAPB
  #undef EX
  #undef VRD
  #undef KRD
  #undef STEP
  #undef ENDW
  {auto rr=__builtin_amdgcn_permlane32_swap(__float_as_uint(l_reg),__float_as_uint(l_reg),false,false);l_reg=__uint_as_float(rr[0])+__uint_as_float(rr[1]);}
  if(hi==0)wsf[32+r32]=l_reg;asm volatile("s_waitcnt lgkmcnt(0)":::"memory");
  float rli[16];
  #pragma unroll
  for(int r=0;r<16;++r)rli[r]=__builtin_amdgcn_rcpf(wsf[32+crow(r,hi)]);
  bf16*Ow=Oh+(rowbase+q0+wid*QBLK)*OP;
  { bf16*stg=(bf16*)(shm+LDS_OST)+wid*2048;
    #pragma unroll
    for(int r=0;r<16;++r){const int orow=crow(r,hi);
      #pragma unroll
      for(int d0=0;d0<2;++d0)stg[orow*64+d0*32+r32]=__float2bfloat16(o[d0][r]*rli[r]);}
    asm volatile("s_waitcnt lgkmcnt(0)":::"memory");
    #pragma unroll
    for(int i=0;i<4;++i){const int row=i*8+(lane>>3),ch=lane&7; const u32x4 v=*(const u32x4*)(stg+row*64+ch*8); ATTN_STORE16(Ow+(long)row*OP+ch*8,v);} }
  asm volatile("s_waitcnt lgkmcnt(0)\n\ts_barrier":::"memory");
  #undef DMA_K
  #undef DMA_V
  #undef CMASK
  #undef START
  #undef RESC
  #undef ROT
}
constexpr int CA_K=0, CA_V=65536, CA_BYTES=131072;
constexpr int CQP=512, CKP=1024;
constexpr float CA_C2=0.08838834764831845f*1.4426950408889634f;
__device__ __forceinline__ void ca_qkt(f32x16&p0,f32x16&p1,const char*Kslot,const bf16x8*qr,const f32x16&init,int r32,int hi){
  #pragma unroll
  for(int dh=0;dh<2;++dh){ const char*kb=Kslot+dh*8192+hi*1024+r32*16;
    #pragma unroll
    for(int d0=0;d0<4;++d0){
      const bf16x8 b0=*reinterpret_cast<const bf16x8*>(kb+d0*2048);
      const bf16x8 b1=*reinterpret_cast<const bf16x8*>(kb+d0*2048+512);
      if(dh==0&&d0==0){p0=__builtin_amdgcn_mfma_f32_32x32x16_bf16(b0,qr[0],init,0,0,0);p1=__builtin_amdgcn_mfma_f32_32x32x16_bf16(b1,qr[0],init,0,0,0);}
      else{p0=__builtin_amdgcn_mfma_f32_32x32x16_bf16(b0,qr[dh*4+d0],p0,0,0,0);p1=__builtin_amdgcn_mfma_f32_32x32x16_bf16(b1,qr[dh*4+d0],p1,0,0,0);}}}
}
template<int NQ> __device__ __forceinline__ void ca_tiles(int b,int hd,int qt0,const bf16*Q,const bf16*__restrict__ KV,bf16*O,char*shm,float*wsf_all){
  const int tid=opaque_tid(),lane=tid&63,r32=lane&31,hi=lane>>5; const int wid=__builtin_amdgcn_readfirstlane(tid>>6);
  const unsigned lds0=(unsigned)(uintptr_t)shm;
  float*wsf=wsf_all+wid*64;
  const bf16*Kg=KV+(long)(b*256)*CKP+hd*128; const bf16*Vg=Kg+512;
  #pragma unroll
  for(int kt=0;kt<4;++kt){
    #pragma unroll
    for(int dh=0;dh<2;++dh) glds16(Kg+(long)(kt*64+lane)*CKP+dh*64+wid*8,(unsigned)__builtin_amdgcn_readfirstlane(lds0+CA_K+(kt*2+dh)*8192+wid*1024)); }

  const int vb0=(int)(lds0+CA_V)+((lane>>4)&1)*32+(lane&3)*8+(4*hi+((lane&15)>>2))*64;
  for(int qi=0;qi<NQ;++qi){
    const long rowq=(long)b*4096+(qt0+qi)*256+wid*32;
    const bf16*Qw=Q+rowq*CQP+hd*128;
    bf16x8 qr[8];
    #pragma unroll
    for(int d0=0;d0<8;++d0)qr[d0]=*reinterpret_cast<const bf16x8*>(&Qw[(long)r32*CQP+d0*16+hi*8]);
    if(qi==0){
      #pragma unroll
      for(int kt=0;kt<4;++kt){
        #pragma unroll
        for(int dh=0;dh<2;++dh) glds16(Vg+(long)(kt*64+16*(wid&3)+(lane>>2))*CKP+dh*64+(wid>>2)*32+(lane&3)*8,(unsigned)__builtin_amdgcn_readfirstlane(lds0+CA_V+(kt*2+dh)*8192+wid*1024)); }
      WAIT_BAR(8); }
    f32x16 zero=f32x16{};
    f32x16 sc[4][2];
    #pragma unroll
    for(int kt=0;kt<4;++kt) ca_qkt(sc[kt][0],sc[kt][1],shm+CA_K+kt*2*8192,qr,zero,r32,hi);
    float mx=-INFINITY;
    #pragma unroll
    for(int kt=0;kt<4;++kt){
      #pragma unroll
      for(int r=0;r<16;++r)mx=__builtin_fmaxf(mx,__builtin_fmaxf(sc[kt][0][r],sc[kt][1][r])); }
    { auto rr=__builtin_amdgcn_permlane32_swap(__float_as_uint(mx),__float_as_uint(mx),false,false); mx=__builtin_fmaxf(__uint_as_float(rr[0]),__uint_as_float(rr[1])); }
    float l=0.f; u32x4 pw[4][4];
    #pragma unroll
    for(int kt=0;kt<4;++kt){ f32x16&p0=sc[kt][0]; f32x16&p1=sc[kt][1];
      #pragma unroll
      for(int r=0;r<16;++r){p0[r]=__builtin_amdgcn_exp2f(p0[r]-mx);p1[r]=__builtin_amdgcn_exp2f(p1[r]-mx);}
      float sacc=0.f;
      #pragma unroll
      for(int r=0;r<16;++r)sacc+=p0[r]+p1[r];
      l+=sacc;
      pw[kt][0]=(u32x4){cvtpk_s(p0[0],p0[1]),cvtpk_s(p0[2],p0[3]),cvtpk_s(p0[4],p0[5]),cvtpk_s(p0[6],p0[7])};
      pw[kt][1]=(u32x4){cvtpk_s(p0[8],p0[9]),cvtpk_s(p0[10],p0[11]),cvtpk_s(p0[12],p0[13]),cvtpk_s(p0[14],p0[15])};
      pw[kt][2]=(u32x4){cvtpk_s(p1[0],p1[1]),cvtpk_s(p1[2],p1[3]),cvtpk_s(p1[4],p1[5]),cvtpk_s(p1[6],p1[7])};
      pw[kt][3]=(u32x4){cvtpk_s(p1[8],p1[9]),cvtpk_s(p1[10],p1[11]),cvtpk_s(p1[12],p1[13]),cvtpk_s(p1[14],p1[15])}; }
    f32x16 o[4]; o[0]=f32x16{};o[1]=f32x16{};o[2]=f32x16{};o[3]=f32x16{};
    if(qi==0){ WAIT_BAR(0); }
    SBAR();
    #pragma unroll
    for(int kt=0;kt<4;++kt){
      pv(o,vb0+(kt*2)*8192,__builtin_bit_cast(bf16x8,pw[kt][0]),__builtin_bit_cast(bf16x8,pw[kt][1]),__builtin_bit_cast(bf16x8,pw[kt][2]),__builtin_bit_cast(bf16x8,pw[kt][3]));
      pv(o+2,vb0+(kt*2+1)*8192,__builtin_bit_cast(bf16x8,pw[kt][0]),__builtin_bit_cast(bf16x8,pw[kt][1]),__builtin_bit_cast(bf16x8,pw[kt][2]),__builtin_bit_cast(bf16x8,pw[kt][3]));
    }
    { auto rr=__builtin_amdgcn_permlane32_swap(__float_as_uint(l),__float_as_uint(l),false,false); l=__uint_as_float(rr[0])+__uint_as_float(rr[1]); }
    if(hi==0)wsf[r32]=l;
    asm volatile("s_waitcnt lgkmcnt(0)":::"memory");
    bf16*Ow=O+rowq*CQP+hd*128;
    float rli[16];
    #pragma unroll
    for(int r=0;r<16;++r)rli[r]=__builtin_amdgcn_rcpf(wsf[crow(r,hi)]);
    bf16*stg=(bf16*)(wsf_all+8*64)+wid*1024;
    #pragma unroll
    for(int d0=0;d0<4;++d0){
      #pragma unroll
      for(int r=0;r<16;++r)stg[crow(r,hi)*32+r32]=__float2bfloat16(o[d0][r]*rli[r]);
      asm volatile("s_waitcnt lgkmcnt(0)":::"memory");
      #pragma unroll
      for(int i=0;i<2;++i){const int idx=i*64+lane,row=idx>>2,ch=idx&3; const u32x4 v=*(const u32x4*)(stg+row*32+ch*8); *(u32x4*)(Ow+(long)row*CQP+d0*32+ch*8)=v;}
      asm volatile("s_waitcnt lgkmcnt(0)":::"memory");
    }
  }
  asm volatile("s_waitcnt lgkmcnt(0)\n\ts_barrier":::"memory");
}
#undef SBAR
#undef WAIT_BAR
}
#define GAS __attribute__((address_space(1)))
#define LAS __attribute__((address_space(3)))
typedef unsigned short bf16;
typedef unsigned v4u __attribute__((ext_vector_type(4)));
typedef float f32x4 __attribute__((ext_vector_type(4)));
typedef short bf16x8 __attribute__((ext_vector_type(8)));
typedef GAS unsigned gu32;
typedef GAS unsigned long long gu64;
#define RLX_AGENT __ATOMIC_RELAXED, __HIP_MEMORY_SCOPE_AGENT
#define LDS_WAIT() asm volatile("s_waitcnt lgkmcnt(0)" ::: "memory")
#define VM_WAIT() asm volatile("s_waitcnt vmcnt(0)" ::: "memory")
__device__ __forceinline__ unsigned long long rt() { return __builtin_amdgcn_s_memrealtime(); }
typedef float f32x2h __attribute__((ext_vector_type(2))); typedef __bf16 bf16x2h __attribute__((ext_vector_type(2)));
__device__ __forceinline__ unsigned pk2(float lo, float hi) { f32x2h v = {lo, hi}; bf16x2h b = __builtin_convertvector(v, bf16x2h); return __builtin_bit_cast(unsigned, b); }
__device__ __forceinline__ unsigned f2bf(float f) { return pk2(f, 0.f) & 0xffffu; }

#define XB_TMO      128
#define XB_XCNT(j)  (256  + 64 * (j))
#define XB_XSUB(j)  (1280 + 64 * (j))
#define XB_XGEN(j)  (2304 + 64 * (j))
#define XB_TOP      3328
#define XB_TOPGEN   3392
#define XCD_BAR_WORDS 3456
#define XB_SPIN_CAP (1u << 18)

__device__ __forceinline__ unsigned xb_ld(unsigned* p)              { return __hip_atomic_load(p, __ATOMIC_RELAXED, __HIP_MEMORY_SCOPE_AGENT); }
__device__ __forceinline__ unsigned xb_add(unsigned* p, unsigned v) { return __hip_atomic_fetch_add(p, v, __ATOMIC_RELAXED, __HIP_MEMORY_SCOPE_AGENT); }
__device__ __forceinline__ unsigned xb_xcc_id() { return (unsigned)__builtin_amdgcn_s_getreg((3 << 11) | 20) & 0xFu; }
__device__ __forceinline__ unsigned xb_poll(unsigned* p) { unsigned r; const unsigned z = 0u; asm volatile("global_atomic_add %0, %1, %2, off sc0\n\ts_waitcnt vmcnt(0)" : "=&v"(r) : "v"(p), "v"(z) : "memory"); return r; }
#define XB_SPIN(cond, bar) do { unsigned _sp = 0; while (cond) { __builtin_amdgcn_s_sleep(1); \
    if ((++_sp & 255u) == 0u) { if (xb_ld(&(bar)[XB_TMO])) break; if (_sp > XB_SPIN_CAP) { atomicAdd(&(bar)[XB_TMO], 1u); break; } } } } while (0)

struct XcdBarrier {
    unsigned* bar; unsigned x;
    volatile LAS unsigned* st;
};

__device__ __forceinline__ XcdBarrier xcd_barrier_post(unsigned* bar, volatile LAS unsigned* st) {
    XcdBarrier b; b.bar = bar; b.x = xb_xcc_id(); b.st = st;
    if (threadIdx.x == 0) (void)xb_add(&bar[XB_XCNT(b.x)], 1u);
    return b;
}
__device__ __forceinline__ void xcd_barrier_complete(unsigned* bar, unsigned x, unsigned& nloc, unsigned& nx) {
    const unsigned G = gridDim.x * gridDim.y * gridDim.z;
    unsigned sum, cnt, mine, sp = 0u;
    for (;;) {
        sum = 0u; cnt = 0u; mine = 0u;
#pragma unroll
        for (unsigned j = 0; j < 16; ++j) { const unsigned c = xb_ld(&bar[XB_XCNT(j)]); sum += c; cnt += (c > 0u) ? 1u : 0u; mine = (j == x) ? c : mine; }
        if (sum == G) break;
        __builtin_amdgcn_s_sleep(1);
        if ((++sp & 255u) == 0u) { if (xb_ld(&bar[XB_TMO])) break; if (sp > XB_SPIN_CAP) { atomicAdd(&bar[XB_TMO], 1u); break; } }
    }
    nloc = mine > 0u ? mine : 1u; nx = cnt > 0u ? cnt : 1u;
}

__device__ __forceinline__ void xcd_barrier(const XcdBarrier& b) {
    asm volatile("s_waitcnt vmcnt(0)" ::: "memory");
    __syncthreads();
    if (threadIdx.x == 0) {
        unsigned* bar = b.bar;
        __builtin_amdgcn_s_waitcnt(0);
        unsigned nloc = b.st[0], nx = b.st[1];
        if (nloc == 0u) { xcd_barrier_complete(bar, b.x, nloc, nx); b.st[0] = nloc; b.st[1] = nx; }
        const unsigned old = xb_add(&bar[XB_XSUB(b.x)], 1u);
        const unsigned gen = old / nloc;
        if (old + 1u == (gen + 1u) * nloc) {
            __builtin_amdgcn_fence(__ATOMIC_RELEASE, "agent");
            asm volatile("s_waitcnt vmcnt(0)" ::: "memory");
            const unsigned og = xb_add(&bar[XB_TOP], 1u);
            const unsigned tg = og / nx;
            if (og + 1u == (tg + 1u) * nx) xb_add(&bar[XB_TOPGEN], 1u);
            else XB_SPIN(xb_poll(&bar[XB_TOPGEN]) == tg, bar);
            __builtin_amdgcn_fence(__ATOMIC_ACQUIRE, "agent");
            xb_add(&bar[XB_XGEN(b.x)], 1u);
            asm volatile("s_waitcnt vmcnt(0)" ::: "memory");
        } else {
            XB_SPIN(xb_poll(&bar[XB_XGEN(b.x)]) == gen, bar);
            __builtin_amdgcn_fence(__ATOMIC_ACQUIRE, "agent");
            asm volatile("s_waitcnt vmcnt(0)" ::: "memory");
        }
    }
    __syncthreads();
}

template <class Work>
__device__ __forceinline__ void xcd_barrier_w(const XcdBarrier& b, const Work& work, volatile LAS unsigned* ctl) {
    asm volatile("s_waitcnt vmcnt(0)" ::: "memory");
    if (threadIdx.x == 0) { ctl[0] = 0u; work.reset(ctl); }
    __syncthreads();
    if (__builtin_amdgcn_readfirstlane(threadIdx.x >> 6) != 0) { work(ctl); }
    else if (threadIdx.x == 0) {
        unsigned* bar = b.bar;
        __builtin_amdgcn_s_waitcnt(0);
        unsigned nloc = b.st[0], nx = b.st[1];
        if (nloc == 0u) { xcd_barrier_complete(bar, b.x, nloc, nx); b.st[0] = nloc; b.st[1] = nx; }
        const unsigned old = xb_add(&bar[XB_XSUB(b.x)], 1u);
        const unsigned gen = old / nloc;
        if (old + 1u == (gen + 1u) * nloc) {
            __builtin_amdgcn_fence(__ATOMIC_RELEASE, "agent");
            asm volatile("s_waitcnt vmcnt(0)" ::: "memory");
            const unsigned og = xb_add(&bar[XB_TOP], 1u);
            const unsigned tg = og / nx;
            if (og + 1u == (tg + 1u) * nx) xb_add(&bar[XB_TOPGEN], 1u);
            else XB_SPIN(xb_ld(&bar[XB_TOPGEN]) == tg, bar);
            __builtin_amdgcn_fence(__ATOMIC_ACQUIRE, "agent");
            xb_add(&bar[XB_XGEN(b.x)], 1u);
            asm volatile("s_waitcnt vmcnt(0)" ::: "memory");
        } else {
            XB_SPIN(xb_ld(&bar[XB_XGEN(b.x)]) == gen, bar);
            __builtin_amdgcn_fence(__ATOMIC_ACQUIRE, "agent");
            asm volatile("s_waitcnt vmcnt(0)" ::: "memory");
        }
        ctl[0] = 1u;
    }
    __syncthreads();
}

__device__ __forceinline__ void local_barrier(unsigned* bar, unsigned* cnt, unsigned nblk, volatile LAS unsigned* genw) {
    asm volatile("s_waitcnt vmcnt(0)" ::: "memory");
    __syncthreads();
    if (threadIdx.x == 0) {
        __builtin_amdgcn_s_waitcnt(0);
        const unsigned gen = genw[0] + 1u; genw[0] = gen;
        (void)xb_add(cnt, 1u);
        XB_SPIN(xb_poll(cnt) < gen * nblk, bar);
        __builtin_amdgcn_fence(__ATOMIC_ACQUIRE, "agent");
        asm volatile("s_waitcnt vmcnt(0)" ::: "memory");
    }
    __syncthreads();
}

constexpr int DMODEL = 1024, NBATCH = 8, SEQL = 4096, DEPTH = 4, NTOK = NBATCH * SEQL;
constexpr int NPROJ = 2048;
constexpr int C_POOL = 0, C_MQ = 256, C_MK = 512, C_MV = 768, C_MO = 1024, C_AQ = 1280, C_AK = 1792, C_AV = 1920;
constexpr int NEXP = 16, CAP = 512, FFE = 2048, ROWS_E = NBATCH * CAP  , NSLOTS = NEXP * ROWS_E;
constexpr float EPS = 1e-6f;
enum { I_X = 0, I_MEM, I_NMIXG, I_WIN, I_POOLW, I_POOLS, I_CONVW, I_GATEB, I_MNORMG, I_QNG, I_KNG, I_WOUT, I_NMEMG, I_CAWQ, I_CAWKV, I_CAWO, I_NFFNG, I_ROUTER, I_WGU, I_WDN, I_FNG, N_IN };

constexpr size_t MiB = 1u << 20;
constexpr size_t WS_CTL = 0, CTL_ZERO_BYTES = 1 * MiB;
constexpr size_t WS_ROPE = 1 * MiB;
constexpr size_t WS_POOLW = 2 * MiB;
constexpr size_t WS_MEMB = 3 * MiB;
constexpr size_t WS_WIN = 8 * MiB;
constexpr size_t WS_WOUT = 24 * MiB;
constexpr size_t WS_WCAQ = 32 * MiB;
constexpr size_t WS_WCAKV = 36 * MiB;
constexpr size_t WS_WCAO = 44 * MiB;
constexpr size_t WS_KVCA = 48 * MiB;
constexpr size_t WS_WGU = 64 * MiB;
constexpr size_t WS_WDN = 576 * MiB;
constexpr size_t WS_X = 832 * MiB;
constexpr size_t WS_HN = 960 * MiB;
constexpr size_t WS_PROJ = 1024 * MiB;
constexpr size_t WS_MQK = 1152 * MiB;
constexpr size_t WS_YCAT = 1184 * MiB;
constexpr size_t WS_QCA = 1248 * MiB;
constexpr size_t WS_GATES = 1280 * MiB;
constexpr size_t WS_AFF = 1282 * MiB;
constexpr size_t WS_TOKI = 1284 * MiB;
constexpr size_t WS_SLOTMAP = 1285 * MiB;
constexpr size_t WS_MSC = 1287 * MiB;
constexpr size_t WS_CST = 1288 * MiB;
constexpr size_t WS_ACT = 1322 * MiB;
constexpr size_t WS_YS = 1578 * MiB;
constexpr size_t WS_KT = 1706 * MiB;
constexpr size_t WS_VT = 1722 * MiB;
constexpr size_t WS_CSB = 1738 * MiB;
constexpr size_t WS_PART = 1756 * MiB;
constexpr size_t WS_GV = 1758 * MiB;
constexpr size_t WS_END = 1762 * MiB;
constexpr int CST_SZ = 65 * 64;
constexpr int CW_BAR = 4096;
constexpr int CW_LOC = 8192;

constexpr int RING_OFF = 0, RING_BYTES = 131072;
constexpr int LDSCTL_OFF = RING_BYTES, MISC_OFF = LDSCTL_OFF + 320;
constexpr int XTRA_OFF = MISC_OFF + 128;
constexpr int LDS_BYTES = 156672;

template <int CTRL> __device__ __forceinline__ float dpp_mov(float x) { return __builtin_bit_cast(float, __builtin_amdgcn_update_dpp(0, __builtin_bit_cast(int, x), CTRL, 0xF, 0xF, true)); }
__device__ __forceinline__ float quad_sum(float v) { v += dpp_mov<0xB1>(v); v += dpp_mov<0x4E>(v); return v; }
__device__ __forceinline__ float oct_sum(float v) { v = quad_sum(v); v += dpp_mov<0x141>(v); return v; }
__device__ __forceinline__ float row_sum(float v) { v = oct_sum(v); v += dpp_mov<0x140>(v); return v; }
__device__ __forceinline__ float row_max(float v) { v = fmaxf(v, dpp_mov<0xB1>(v)); v = fmaxf(v, dpp_mov<0x4E>(v)); v = fmaxf(v, dpp_mov<0x141>(v)); v = fmaxf(v, dpp_mov<0x140>(v)); return v; }
__device__ __forceinline__ float wave_sum(float v) { v = row_sum(v);
    const float a = __builtin_bit_cast(float, __builtin_amdgcn_readlane(__builtin_bit_cast(int, v), 0)), b = __builtin_bit_cast(float, __builtin_amdgcn_readlane(__builtin_bit_cast(int, v), 16));
    const float c = __builtin_bit_cast(float, __builtin_amdgcn_readlane(__builtin_bit_cast(int, v), 32)), d = __builtin_bit_cast(float, __builtin_amdgcn_readlane(__builtin_bit_cast(int, v), 48));
    return (a + b) + (c + d); }
__device__ __forceinline__ float bf_lo(unsigned w) { return __uint_as_float(w << 16); }
__device__ __forceinline__ float bf_hi(unsigned w) { return __uint_as_float(w & 0xffff0000u); }
__device__ __forceinline__ float bf2f(bf16 h) { return __uint_as_float(((unsigned)h) << 16); }
__device__ __forceinline__ float wscan_add(float v, int lane) {
#pragma unroll
    for (int o = 1; o < 64; o <<= 1) { const float t = __shfl_up(v, o); if (lane >= o) v += t; }
    return v;
}
__device__ __forceinline__ float wscan_add_rev(float v, int lane) {
#pragma unroll
    for (int o = 1; o < 64; o <<= 1) { const float t = __shfl_down(v, o); if (lane + o < 64) v += t; }
    return v;
}
__device__ __forceinline__ float wscan_max(float v, int lane) {
#pragma unroll
    for (int o = 1; o < 64; o <<= 1) { const float t = __shfl_up(v, o); if (lane >= o) v = fmaxf(v, t); }
    return v;
}
__device__ __forceinline__ float wscan_max_rev(float v, int lane) {
#pragma unroll
    for (int o = 1; o < 64; o <<= 1) { const float t = __shfl_down(v, o); if (lane + o < 64) v = fmaxf(v, t); }
    return v;
}
__device__ __forceinline__ float fexp(float x) { return __builtin_amdgcn_exp2f(x * 1.4426950408889634f); }
__device__ __forceinline__ float flog(float x) { return __builtin_amdgcn_logf(x) * 0.6931471805599453f; }
__device__ __forceinline__ float fsigmoid(float x) { return __builtin_amdgcn_rcpf(1.0f + fexp(-x)); }
typedef float f32x2v __attribute__((ext_vector_type(2)));
#define MFMA16(a, b, c) __builtin_amdgcn_mfma_f32_16x16x32_bf16((a), (b), (c), 0, 0, 0)

struct Ctx { int tid, lane, wave, G, vcu, gw, NGW; unsigned char* lds; unsigned char* ws; LAS unsigned char* ldsl; int ng, GB, grp, lb; };
__device__ __forceinline__ Ctx phase_ctx(const Ctx& C0) { Ctx C = C0; C.tid = opaque_tid(); C.lane = C.tid & 63; return C; }

__device__ __forceinline__ void transpose_item(const float* W, int ldw, bf16* WT, int K, int n0dst, int srccol0, int k0, LAS float* scr, int lane, const float* kscale = nullptr) {
    f32x4 v[8]; const int lr = lane >> 3, lc = (lane & 7) * 4;
#pragma unroll
    for (int i = 0; i < 8; ++i) v[i] = __builtin_nontemporal_load((const f32x4*)(W + (size_t)(k0 + 8 * i + lr) * ldw + srccol0 + lc));
    if (kscale) { float kq[8];
#pragma unroll
        for (int i = 0; i < 8; ++i) kq[i] = kscale[k0 + 8 * i + lr];
#pragma unroll
        for (int i = 0; i < 8; ++i) v[i] = v[i] * kq[i]; }
#pragma unroll
    for (int i = 0; i < 8; ++i) { LAS float* d = scr + (8 * i + lr) * 33 + lc; d[0] = v[i].x; d[1] = v[i].y; d[2] = v[i].z; d[3] = v[i].w; }
    LDS_WAIT(); asm volatile("" ::: "memory");
    const int c = lane & 7;
#pragma unroll
    for (int j = 0; j < 4; ++j) { const int n = (lane >> 3) + 8 * j; const LAS float* s = scr + (8 * c) * 33 + n;
        v4u o; o.x = pk2(s[0 * 33], s[1 * 33]); o.y = pk2(s[2 * 33], s[3 * 33]); o.z = pk2(s[4 * 33], s[5 * 33]); o.w = pk2(s[6 * 33], s[7 * 33]);
        *(v4u*)(WT + (size_t)(n0dst + n) * K + k0 + 8 * c) = o; }
    LDS_WAIT(); asm volatile("" ::: "memory");
}
#ifndef CV_NT
#define CV_NT 1
#endif
constexpr int EXP_ITEMS = 16 * 2048 + 16 * 1024;
struct ItemSrc { const float* W; int ldw; bf16* WT; int K, n0dst, srccol0, k0; const float* ks; };
__device__ __forceinline__ ItemSrc expert_item(unsigned char* ws, const float* const* in, int layer, int j) {
    ItemSrc I;
    if (j < 32768) { const int le = layer * 16 + (j >> 11), r = j & 2047, kb = r >> 7, nb = r & 127, n0 = nb * 32, pn = n0 >> 8, jj = n0 & 255;
        I.W = in[I_WGU] + (size_t)le * 1024 * 4096; I.ldw = 4096; I.WT = (bf16*)(ws + WS_WGU) + (size_t)le * 4096 * 1024; I.K = 1024; I.n0dst = n0; I.srccol0 = jj < 128 ? pn * 128 + jj : 2048 + pn * 128 + (jj - 128); I.k0 = kb * 64; I.ks = in[I_NFFNG] + layer * 1024; }
    else { const int q = j - 32768, le = layer * 16 + (q >> 10), r = q & 1023, kb = r >> 5, nb = r & 31;
        I.W = in[I_WDN] + (size_t)le * 2048 * 1024; I.ldw = 1024; I.WT = (bf16*)(ws + WS_WDN) + (size_t)le * 1024 * 2048; I.K = 2048; I.n0dst = nb * 32; I.srccol0 = nb * 32; I.k0 = kb * 64; I.ks = nullptr; }
    return I;
}
__device__ __forceinline__ void item_load(const ItemSrc& I, f32x4 (&v)[8], int lane) {
    const int lr = lane >> 3, lc = (lane & 7) * 4;
#pragma unroll
    for (int i = 0; i < 8; ++i) { const f32x4* p_ = (const f32x4*)(I.W + (size_t)(I.k0 + 8 * i + lr) * I.ldw + I.srccol0 + lc); v[i] = CV_NT ? __builtin_nontemporal_load(p_) : *p_; }
}
__device__ __forceinline__ void item_scale(const ItemSrc& I, f32x4 (&v)[8], int lane) {
    if (I.ks) { const int lr = lane >> 3; float kq[8];
#pragma unroll
        for (int i = 0; i < 8; ++i) kq[i] = I.ks[I.k0 + 8 * i + lr];
#pragma unroll
        for (int i = 0; i < 8; ++i) v[i] = v[i] * kq[i]; }
}
__device__ __forceinline__ void item_store(const ItemSrc& I, const f32x4 (&v)[8], LAS float* scr, int lane) {
    const int lr = lane >> 3, lc = (lane & 7) * 4;
#pragma unroll
    for (int i = 0; i < 8; ++i) { LAS float* d = scr + (8 * i + lr) * 33 + lc; d[0] = v[i].x; d[1] = v[i].y; d[2] = v[i].z; d[3] = v[i].w; }
    LDS_WAIT(); asm volatile("" ::: "memory");
    const int c = lane & 7;
#pragma unroll
    for (int j = 0; j < 4; ++j) { const int n = (lane >> 3) + 8 * j; const LAS float* s = scr + (8 * c) * 33 + n;
        v4u o; o.x = pk2(s[0 * 33], s[1 * 33]); o.y = pk2(s[2 * 33], s[3 * 33]); o.z = pk2(s[4 * 33], s[5 * 33]); o.w = pk2(s[6 * 33], s[7 * 33]);
        asm volatile("global_store_dwordx4 %0, %1, off sc1\n\ts_nop 2" :: "v"(I.WT + (size_t)(I.n0dst + n) * I.K + I.k0 + 8 * c), "v"(o) : "memory"); }
    LDS_WAIT(); asm volatile("" ::: "memory");
}
struct ConvWork {
    unsigned char* ws; const float* const* in; LAS unsigned char* ldsl; int layer, finish, vcu, G;
    __device__ __forceinline__ void reset(volatile LAS unsigned* ctl) const { if (layer < DEPTH && ctl[2] != (unsigned)(layer + 1)) { ctl[2] = (unsigned)(layer + 1); ctl[1] = 0u; } }
    __device__ __forceinline__ void operator()(volatile LAS unsigned* ctl) const {
        if (layer >= DEPTH) return;
        const int tid = opaque_tid(), lane = tid & 63, wave = __builtin_amdgcn_readfirstlane(tid >> 6);
        LAS float* scr = (LAS float*)(ldsl + RING_OFF + wave * 16384);
        for (;;) {
            if (!finish && ctl[0] != 0u) break;
            unsigned k = 0u; if (lane == 0) k = __hip_atomic_fetch_add((LAS unsigned*)(ctl + 1), 1u, __ATOMIC_RELAXED, __HIP_MEMORY_SCOPE_WORKGROUP);
            k = (unsigned)__builtin_amdgcn_readfirstlane((int)k);
            const long j = (long)k * G + vcu; if (j >= EXP_ITEMS) break;
            const ItemSrc J = expert_item(ws, in, layer, (int)j); f32x4 w[8]; item_load(J, w, lane); item_scale(J, w, lane); item_store(J, w, scr, lane);
        }
    }
};
__device__ __forceinline__ void phase_convert(unsigned char* ws, const float* const* in, LAS unsigned char* ldsl, int layer, int nper, int vcu, int G, volatile LAS unsigned* ctl) {
    if (layer >= DEPTH || ctl[2] != (unsigned)(layer + 1)) return;
    const int tid = opaque_tid(), lane = tid & 63, wave = __builtin_amdgcn_readfirstlane(tid >> 6);
    LAS float* scr = (LAS float*)(ldsl + RING_OFF + wave * 16384);
    for (int n = 0; n < nper; ++n) {
        unsigned k = 0u; if (lane == 0) k = __hip_atomic_fetch_add((LAS unsigned*)(ctl + 1), 1u, __ATOMIC_RELAXED, __HIP_MEMORY_SCOPE_WORKGROUP);
        k = (unsigned)__builtin_amdgcn_readfirstlane((int)k);
        const long j = (long)k * G + vcu; if (j >= EXP_ITEMS) break;
        const ItemSrc J = expert_item(ws, in, layer, (int)j); f32x4 w[8]; item_load(J, w, lane); item_scale(J, w, lane); item_store(J, w, scr, lane);
    }
}
#ifndef CV_NIT
#define CV_NIT 4
#endif
#ifndef CV_MAP
#define CV_MAP 1
#endif
__device__ __forceinline__ void convert_share(unsigned char* ws, const float* const* in, LAS unsigned char* ldsl, int layer, int vcu, int G, int part = 0, int nparts = 1) {
    const int tid = opaque_tid(), lane = tid & 63, wave = __builtin_amdgcn_readfirstlane(tid >> 6);
    LAS float* scr = (LAS float*)(ldsl + RING_OFF + wave * 16384);
    const int nk = (EXP_ITEMS - vcu + G - 1) / G;
    const int kspan = ((nk + nparts - 1) / nparts + 8 * CV_NIT - 1) / (8 * CV_NIT) * (8 * CV_NIT), kbeg = part * kspan, kend = min(nk, kbeg + kspan);
#pragma unroll 1
    for (int k0 = kbeg + wave; k0 < kend; k0 += 8 * CV_NIT) {
        ItemSrc I[CV_NIT]; f32x4 v[CV_NIT][8]; bool on[CV_NIT];
#pragma unroll
        for (int t = 0; t < CV_NIT; ++t) { const int k = k0 + 8 * t; on[t] = k < kend; if (on[t]) { I[t] = expert_item(ws, in, layer, (CV_MAP && G == 256) ? (((vcu & 3) * 192 + k) * 64 + (vcu >> 2)) : (k * G + vcu)); item_load(I[t], v[t], lane); } }
#pragma unroll
        for (int t = 0; t < CV_NIT; ++t) if (on[t]) { item_scale(I[t], v[t], lane); item_store(I[t], v[t], scr, lane); }
    }
}
#if defined(CV_MODE)
__device__ __forceinline__ void convert_share_probe(unsigned char* ws, const float* const* in, LAS unsigned char* ldsl, int layer, int vcu, int G) {
    const int tid = opaque_tid(), lane = tid & 63, wave = __builtin_amdgcn_readfirstlane(tid >> 6);
    LAS float* scr = (LAS float*)(ldsl + RING_OFF + wave * 16384);
    const int nk = (EXP_ITEMS - vcu + G - 1) / G; float sink = 0.f;
#pragma unroll 1
    for (int k0 = wave; k0 < nk; k0 += 24) {
        ItemSrc I[3]; f32x4 v[3][8]; bool on[3];
#pragma unroll
        for (int t = 0; t < 3; ++t) { const int k = k0 + 8 * t; on[t] = k < nk; if (on[t]) { I[t] = expert_item(ws, in, layer, k * G + vcu);
#if defined(CV_PAT) && CV_PAT == 1
            { const int lr4 = lane >> 4, lc16 = (lane & 15) * 4; const int c0 = I[t].srccol0 & ~63;
              _Pragma("unroll") for (int i = 0; i < 8; ++i) v[t][i] = __builtin_nontemporal_load((const f32x4*)(I[t].W + (size_t)(I[t].k0 + 4 * i + lr4) * I[t].ldw + c0 + lc16)); }
#elif defined(CV_PAT) && CV_PAT == 2
            { const int lr2 = lane >> 5, lc32 = (lane & 31) * 4; const int c0 = I[t].srccol0 & ~127;
              _Pragma("unroll") for (int i = 0; i < 8; ++i) v[t][i] = __builtin_nontemporal_load((const f32x4*)(I[t].W + (size_t)(I[t].k0 + 2 * i + lr2) * I[t].ldw + c0 + lc32)); }
#else
            item_load(I[t], v[t], lane);
#endif
            } }
#pragma unroll
        for (int t = 0; t < 3; ++t) if (on[t]) {
#if CV_MODE == 1
#pragma unroll
            for (int i = 0; i < 8; ++i) sink += v[t][i].x + v[t][i].y + v[t][i].z + v[t][i].w;
#elif CV_MODE == 2
            { const int lr = lane >> 3, lc = (lane & 7) * 4;
#pragma unroll
              for (int i = 0; i < 8; ++i) { LAS float* d = scr + (8 * i + lr) * 33 + lc; d[0] = v[t][i].x; d[1] = v[t][i].y; d[2] = v[t][i].z; d[3] = v[t][i].w; }
              LDS_WAIT(); asm volatile("" ::: "memory");
              const int c = lane & 7;
#pragma unroll
              for (int j = 0; j < 4; ++j) { const int n = (lane >> 3) + 8 * j; const LAS float* sp = scr + (8 * c) * 33 + n;
                  sink += __uint_as_float(pk2(sp[0 * 33], sp[1 * 33]) ^ pk2(sp[2 * 33], sp[3 * 33]) ^ pk2(sp[4 * 33], sp[5 * 33]) ^ pk2(sp[6 * 33], sp[7 * 33])); }
              LDS_WAIT(); asm volatile("" ::: "memory"); }
#else
            { ItemSrc J = I[t]; J.WT = (bf16*)(ws + WS_ACT) + (J.WT - (bf16*)(ws + (J.K == 1024 ? WS_WGU : WS_WDN))) % (size_t)(120u << 20); item_store(J, v[t], scr, lane); }
#endif
        }
    }
    if (sink == 123.456f) ((float*)(ws + WS_ACT))[tid] = sink;
}
#endif
__device__ __forceinline__ int conv_target(int p) { if (p <= 8) return 0; if (p < 10) return DEPTH; const int q = p - 10; return (q % 12 >= 11) ? DEPTH : q / 12 + 1; }
__device__ __forceinline__ void prologue_convert(const Ctx& C0, const float* const* in, bool defer_experts) {
    const Ctx C = phase_ctx(C0);
    LAS float* scr = (LAS float*)(C.ldsl + RING_OFF + C.wave * 16384);
    unsigned char* ws = C.ws;
    constexpr int N0 = 4 * 1024, N1 = N0 + 4 * 512, N2 = N1 + 4 * 256, N3 = N2 + 4 * 512, N4 = N3 + 4 * 256, N5 = N4 + 64 * 2048, N6 = N5 + 64 * 1024;
    const int nlim = defer_experts ? N4 : N6;
    if (defer_experts) {
        auto small_item = [&](int it) { ItemSrc I; I.ks = nullptr;
            if (it < N0) { const int l = it >> 10, r = it & 1023, kb = r >> 6, nb = r & 63, n0 = nb * 32;
                I.W = in[I_WIN] + (size_t)l * 1024 * 2064; I.ldw = 2064; I.WT = (bf16*)(ws + WS_WIN) + (size_t)l * 2048 * 1024; I.K = 1024; I.n0dst = n0; I.srccol0 = n0 < 1280 ? n0 : n0 + 16; I.k0 = kb * 64; I.ks = in[I_NMIXG] + l * 1024; }
            else if (it < N1) { const int q = it - N0, l = q >> 9, r = q & 511, kb = r >> 5, nb = r & 31;
                I.W = in[I_WOUT] + (size_t)l * 1024 * 1024; I.ldw = 1024; I.WT = (bf16*)(ws + WS_WOUT) + (size_t)l * 1024 * 1024; I.K = 1024; I.n0dst = nb * 32; I.srccol0 = nb * 32; I.k0 = kb * 64; }
            else if (it < N2) { const int q = it - N1, l = q >> 8, r = q & 255, kb = r >> 4, nb = r & 15;
                I.W = in[I_CAWQ] + (size_t)l * 1024 * 512; I.ldw = 512; I.WT = (bf16*)(ws + WS_WCAQ) + (size_t)l * 512 * 1024; I.K = 1024; I.n0dst = nb * 32; I.srccol0 = nb * 32; I.k0 = kb * 64; I.ks = in[I_NMEMG] + l * 1024; }
            else if (it < N3) { const int q = it - N2, l = q >> 9, r = q & 511, kb = r >> 5, nb = r & 31;
                I.W = in[I_CAWKV] + (size_t)l * 1024 * 1024; I.ldw = 1024; I.WT = (bf16*)(ws + WS_WCAKV) + (size_t)l * 1024 * 1024; I.K = 1024; I.n0dst = nb * 32; I.srccol0 = nb * 32; I.k0 = kb * 64; }
            else { const int q = it - N3, l = q >> 8, r = q & 255, kb = r >> 5, nb = r & 31;
                I.W = in[I_CAWO] + (size_t)l * 512 * 1024; I.ldw = 1024; I.WT = (bf16*)(ws + WS_WCAO) + (size_t)l * 1024 * 512; I.K = 512; I.n0dst = nb * 32; I.srccol0 = nb * 32; I.k0 = kb * 64; }
            return I; };
#pragma unroll 1
        for (int it0 = C.gw; it0 < N4; it0 += CV_NIT * C.NGW) {
            ItemSrc I[CV_NIT]; f32x4 v[CV_NIT][8]; bool on[CV_NIT];
#pragma unroll
            for (int t = 0; t < CV_NIT; ++t) { const int it = it0 + t * C.NGW; on[t] = it < N4; if (on[t]) { I[t] = small_item(it); item_load(I[t], v[t], C.lane); } }
#pragma unroll
            for (int t = 0; t < CV_NIT; ++t) if (on[t]) { item_scale(I[t], v[t], C.lane); item_store(I[t], v[t], scr, C.lane); }
        }
    } else
    for (int it = C.gw; it < nlim; it += C.NGW) {
        if (it < N0) { const int l = it >> 10, r = it & 1023, kb = r >> 6, nb = r & 63, n0 = nb * 32;
            transpose_item(in[I_WIN] + (size_t)l * 1024 * 2064, 2064, (bf16*)(ws + WS_WIN) + (size_t)l * 2048 * 1024, 1024, n0, n0 < 1280 ? n0 : n0 + 16, kb * 64, scr, C.lane, in[I_NMIXG] + l * 1024); }
        else if (it < N1) { const int q = it - N0, l = q >> 9, r = q & 511, kb = r >> 5, nb = r & 31;
            transpose_item(in[I_WOUT] + (size_t)l * 1024 * 1024, 1024, (bf16*)(ws + WS_WOUT) + (size_t)l * 1024 * 1024, 1024, nb * 32, nb * 32, kb * 64, scr, C.lane); }
        else if (it < N2) { const int q = it - N1, l = q >> 8, r = q & 255, kb = r >> 4, nb = r & 15;
            transpose_item(in[I_CAWQ] + (size_t)l * 1024 * 512, 512, (bf16*)(ws + WS_WCAQ) + (size_t)l * 512 * 1024, 1024, nb * 32, nb * 32, kb * 64, scr, C.lane, in[I_NMEMG] + l * 1024); }
        else if (it < N3) { const int q = it - N2, l = q >> 9, r = q & 511, kb = r >> 5, nb = r & 31;
            transpose_item(in[I_CAWKV] + (size_t)l * 1024 * 1024, 1024, (bf16*)(ws + WS_WCAKV) + (size_t)l * 1024 * 1024, 1024, nb * 32, nb * 32, kb * 64, scr, C.lane); }
        else if (it < N4) { const int q = it - N3, l = q >> 8, r = q & 255, kb = r >> 5, nb = r & 31;
            transpose_item(in[I_CAWO] + (size_t)l * 512 * 1024, 1024, (bf16*)(ws + WS_WCAO) + (size_t)l * 1024 * 512, 512, nb * 32, nb * 32, kb * 64, scr, C.lane); }
        else if (it < N5) { const int q = it - N4, le = q >> 11, r = q & 2047, kb = r >> 7, nb = r & 127, n0 = nb * 32, pn = n0 >> 8, j = n0 & 255;
            transpose_item(in[I_WGU] + (size_t)le * 1024 * 4096, 4096, (bf16*)(ws + WS_WGU) + (size_t)le * 4096 * 1024, 1024, n0, j < 128 ? pn * 128 + j : 2048 + pn * 128 + (j - 128), kb * 64, scr, C.lane, in[I_NFFNG] + (le >> 4) * 1024); }
        else { const int q = it - N5, le = q >> 10, r = q & 1023, kb = r >> 5, nb = r & 31;
            transpose_item(in[I_WDN] + (size_t)le * 2048 * 1024, 1024, (bf16*)(ws + WS_WDN) + (size_t)le * 1024 * 2048, 2048, nb * 32, nb * 32, kb * 64, scr, C.lane); }
    }
    const int gt = C.gw * 64 + C.lane, NGT = C.NGW * 64;
    for (int i = gt; i < 2048 * 1024 / 8; i += NGT) { const f32x4* s = (const f32x4*)(in[I_MEM]) + 2 * (size_t)i; const f32x4 a = s[0], b = s[1];
        v4u o; o.x = pk2(a.x, a.y); o.y = pk2(a.z, a.w); o.z = pk2(b.x, b.y); o.w = pk2(b.z, b.w); ((v4u*)(ws + WS_MEMB))[i] = o; }
    for (int i = gt; i < 4096 * 32; i += NGT) { const int t = i >> 5, f = i & 31; const int pos = (f < 16) ? (t >> 6) : (t & 63);
        double invd = 1.0; for (int k = 0; k < (f & 15); ++k) invd *= 0.5623413251903491;
        const float inv = (float)invd; const float ang = (float)pos * inv; const double ad = (double)ang;
        const double nq = rint(ad * 0.6366197723675814); const double r = ad - nq * 1.5707963267948966, r2 = r * r;
        const double sr = r * (1.0 + r2 * (-1.0 / 6 + r2 * (1.0 / 120 + r2 * (-1.0 / 5040 + r2 * (1.0 / 362880 + r2 * (-1.0 / 39916800 + r2 * (1.0 / 6227020800.0)))))));
        const double cr = 1.0 + r2 * (-0.5 + r2 * (1.0 / 24 + r2 * (-1.0 / 720 + r2 * (1.0 / 40320 + r2 * (-1.0 / 3628800 + r2 * (1.0 / 479001600.0))))));
        const int qd = ((int)nq) & 3; const double sn = (qd == 0) ? sr : (qd == 1) ? cr : (qd == 2) ? -sr : -cr; const double cs = (qd == 0) ? cr : (qd == 1) ? -sr : (qd == 2) ? -cr : sr;
        ((float*)(ws + WS_ROPE))[i] = (float)cs; ((float*)(ws + WS_ROPE))[4096 * 32 + i] = (float)sn; }
    for (int i = gt; i < 4 * 4 * 64 * 64; i += NGT) { const int c = i & 63, e = (i >> 6) & 63, g = (i >> 12) & 3, l = i >> 14;
        const float v = in[I_POOLW][((size_t)(l * 4 + g) * 64 + c) * 64 + e] * in[I_POOLS][l * 256 + g * 64 + e]; ((bf16*)(ws + WS_POOLW))[i] = (bf16)f2bf(v); }
}

constexpr int RT_PITCH = 1032;
__device__ __forceinline__ void proj16_stage(const Ctx& C, const float* gain, const float* w16, int w16s) {
    LAS bf16* Wh = (LAS bf16*)(C.ldsl + RING_OFF); LAS bf16* Wl = Wh + 16 * RT_PITCH;
    { f32x4 wv[8]; float gq[8];
#pragma unroll
      for (int j = 0; j < 8; ++j) { const int idx = C.tid + 512 * j, k = idx >> 2, e4 = (idx & 3) * 4; wv[j] = *(const f32x4*)(w16 + (size_t)k * w16s + e4); gq[j] = gain[k]; }
#pragma unroll
      for (int j = 0; j < 8; ++j) { const int idx = C.tid + 512 * j, k = idx >> 2, e4 = (idx & 3) * 4;
#pragma unroll
        for (int i = 0; i < 4; ++i) { const float v = wv[j][i] * gq[j]; const unsigned short h = f2bf(v); const unsigned short lo = f2bf(v - bf2f((bf16)h));
            Wh[(e4 + i) * RT_PITCH + k] = (bf16)h; Wl[(e4 + i) * RT_PITCH + k] = (bf16)lo; } } }
    __syncthreads();
}
template <int MODE>
__device__ __forceinline__ void proj16_tile(const Ctx& C, const bf16x8 (&xa)[32], int t, const float* bias16, float* out16, float* rs) {
    const int lane = C.lane, rr = lane & 15, q = lane >> 4;
    LAS bf16* Wh = (LAS bf16*)(C.ldsl + RING_OFF); LAS bf16* Wl = Wh + 16 * RT_PITCH;
    f32x4 acc = (f32x4){0.f, 0.f, 0.f, 0.f}; float ss = 0.f;
#pragma unroll
    for (int s = 0; s < 32; ++s) {
        const bf16x8 bh = *(const LAS bf16x8*)(Wh + rr * RT_PITCH + s * 32 + q * 8), bl = *(const LAS bf16x8*)(Wl + rr * RT_PITCH + s * 32 + q * 8);
        acc = MFMA16(xa[s], bh, acc); acc = MFMA16(xa[s], bl, acc);
        const v4u xw = __builtin_bit_cast(v4u, xa[s]);
        ss += (bf_lo(xw.x) * bf_lo(xw.x) + bf_hi(xw.x) * bf_hi(xw.x)) + (bf_lo(xw.y) * bf_lo(xw.y) + bf_hi(xw.y) * bf_hi(xw.y));
        ss += (bf_lo(xw.z) * bf_lo(xw.z) + bf_hi(xw.z) * bf_hi(xw.z)) + (bf_lo(xw.w) * bf_lo(xw.w) + bf_hi(xw.w) * bf_hi(xw.w));
        if ((s & 3) == 3) asm volatile("" ::: "memory"); }
    ss += __shfl_xor(ss, 16); ss += __shfl_xor(ss, 32);
    const float rstd = __builtin_amdgcn_rsqf(ss * (1.0f / 1024.0f) + EPS);
    if (MODE == 2 && q == 0) rs[(size_t)t * 16 + rr] = rstd;
    if (MODE == 2) { f32x4 pr;
#pragma unroll
        for (int i = 0; i < 4; ++i) { const float r = __shfl(rstd, 4 * q + i); const float val = acc[i] * r; float mx = val;
#pragma unroll
            for (int o = 1; o < 2; o <<= 1) mx = row_max(mx);
            const float ex = fexp(val - mx); float sm = row_sum(ex);
            pr[i] = ex * __builtin_amdgcn_rcpf(sm); }
        const int row = t * 16 + 4 * q;
        *(f32x4*)(out16 + ((size_t)((row >> 12) * 16 + rr)) * 4096 + (row & 4095)) = pr; }
    else { const float bs = bias16[rr];
#pragma unroll
        for (int i = 0; i < 4; ++i) { const float r = __shfl(rstd, 4 * q + i); float val = acc[i] * r + bs;
            if (rr >= 8) val = fminf(val, 0.f) - flog(1.0f + fexp(-fabsf(val)));
            out16[(size_t)(t * 16 + 4 * q + i) * 16 + rr] = val; } }
}
__device__ __forceinline__ void router_phase(const Ctx& C0, const bf16* xb, const float* gain, const float* w16, float* aff, float* rs) {
    const Ctx C = phase_ctx(C0);
    const int rr = C.lane & 15, q = C.lane >> 4;
    const int tpg = (NTOK / 16) / C.ng, t0 = C.grp * tpg + C.lb * 8 + C.wave, ts = C.GB * 8, te = (C.grp + 1) * tpg;
    bf16x8 xa[32];
    if (t0 < te) {
#pragma unroll
        for (int s = 0; s < 32; ++s) xa[s] = *(const bf16x8*)(xb + (size_t)(t0 * 16 + rr) * 1024 + s * 32 + q * 8);
    }
    proj16_stage(C, gain, w16, 16);
    for (int t = t0; t < te; t += ts) {
        if (t != t0) {
#pragma unroll
            for (int s = 0; s < 32; ++s) xa[s] = *(const bf16x8*)(xb + (size_t)(t * 16 + rr) * 1024 + s * 32 + q * 8); }
        proj16_tile<2>(C, xa, t, nullptr, aff, rs);
    }
    __syncthreads();
}

template <int MODE, bool COMBINE, bool SRC32 = false>
__device__ __forceinline__ void row_phase(const Ctx& C0, const void* xsrc_, bf16* xdst, const float* gain, float* rsout, const float* w16, int w16s, const float* bias16, float* out16, float* outf,
                                          const int* slotmap, const bf16* ys) {
    const Ctx C = phase_ctx(C0);
    if (MODE == 1) proj16_stage(C, gain, w16, w16s);
    const int lane = C.lane;
    f32x4 gv[4];
#pragma unroll
    for (int j = 0; j < 4; ++j) gv[j] = *(const f32x4*)(gain + 4 * lane + 256 * j);
    const float* xsrc = (const float*)xsrc_; const bf16* xsrb = (const bf16*)xsrc_;
    f32x4 vn[2][4]; uint2 vnb[2][4]; int smc[2] = {-1, -1}, smn[2] = {-1, -1}; unsigned mrem[2] = {0u, 0u}; uint2 yb[2][4][4];
    const int tpg = (NTOK / 16) / C.ng, t0 = C.grp * tpg + C.lb * 8 + C.wave, ts = C.GB * 8, te = (C.grp + 1) * tpg;
#define RP_LOADX(prq) do { _Pragma("unroll") for (int r = 0; r < 2; ++r) { _Pragma("unroll") for (int j = 0; j < 4; ++j) { \
        if (SRC32) vn[r][j] = *(const f32x4*)(xsrc + (size_t)(2 * (prq) + r) * 1024 + 4 * lane + 256 * j); else vnb[r][j] = *(const uint2*)(xsrb + (size_t)(2 * (prq) + r) * 1024 + 4 * lane + 256 * j); } } } while (0)
#define RP_LOADSM(SMQ, prq) do { _Pragma("unroll") for (int r = 0; r < 2; ++r) SMQ[r] = slotmap[(size_t)(2 * (prq) + r) * 16 + (lane & 15)]; } while (0)
#define RP_LOADY(SMQ, prq) do { _Pragma("unroll") for (int r = 0; r < 2; ++r) { unsigned mk = (unsigned)(__ballot(SMQ[r] >= 0) & 0xFFFFull); const int b = (2 * (prq) + r) >> 12; \
        _Pragma("unroll") for (int k = 0; k < 4; ++k) { \
            if (mk) { const int e = __builtin_ctz(mk); mk &= mk - 1u; const int sl = __builtin_amdgcn_readlane(SMQ[r], e); \
                const bf16* yr = ys + ((size_t)(e * ROWS_E + b * CAP + sl)) * 1024 + 4 * lane; \
                _Pragma("unroll") for (int j = 0; j < 4; ++j) yb[r][k][j] = *(const uint2*)(yr + 256 * j); } \
            else { _Pragma("unroll") for (int j = 0; j < 4; ++j) yb[r][k][j] = make_uint2(0u, 0u); } } \
        mrem[r] = mk; } } while (0)
    for (int t = t0; t < te; t += ts) {
      const int prb = 8 * t, pre = prb + 8;
      RP_LOADX(prb);
      if (COMBINE) { RP_LOADSM(smc, prb); RP_LOADSM(smn, prb + 1); RP_LOADY(smc, prb); }
#pragma unroll 1
      for (int pr = prb; pr < pre; ++pr) {
        const int row0 = 2 * pr;
        f32x4 v[2][4]; int smnn[2] = {-1, -1};
#pragma unroll
        for (int r = 0; r < 2; ++r) {
#pragma unroll
            for (int j = 0; j < 4; ++j) { if (SRC32) v[r][j] = vn[r][j]; else { const uint2 w = vnb[r][j]; v[r][j] = (f32x4){bf_lo(w.x), bf_hi(w.x), bf_lo(w.y), bf_hi(w.y)}; } } }
        { const int prn = pr + 1; if (prn < pre) RP_LOADX(prn);
          if (COMBINE) { const int prnn = pr + 2; if (prnn < pre) RP_LOADSM(smnn, prnn); } }
        if (COMBINE) {
#pragma unroll
            for (int r = 0; r < 2; ++r) { const int row = row0 + r, b = row >> 12;
#pragma unroll
                for (int k = 0; k < 4; ++k)
#pragma unroll
                    for (int j = 0; j < 4; ++j) { const uint2 w = yb[r][k][j]; v[r][j] += (f32x4){bf_lo(w.x), bf_hi(w.x), bf_lo(w.y), bf_hi(w.y)}; }
                unsigned mk = mrem[r];
                while (mk) { const int e = __builtin_ctz(mk); mk &= mk - 1u; const int sl = __builtin_amdgcn_readlane(smc[r], e);
                    const bf16* yr = ys + ((size_t)(e * ROWS_E + b * CAP + sl)) * 1024 + 4 * lane;
#pragma unroll
                    for (int j = 0; j < 4; ++j) { const uint2 w = *(const uint2*)(yr + 256 * j); v[r][j] += (f32x4){bf_lo(w.x), bf_hi(w.x), bf_lo(w.y), bf_hi(w.y)}; } } }
            { const int prn = pr + 1; if (prn < pre) RP_LOADY(smn, prn); }
#pragma unroll
            for (int r = 0; r < 2; ++r) { smc[r] = smn[r]; smn[r] = smnn[r]; }
        }
        if ((COMBINE && MODE != 3) || SRC32) {
#pragma unroll
            for (int r = 0; r < 2; ++r)
#pragma unroll
                for (int j = 0; j < 4; ++j) { uint2 o; o.x = pk2(v[r][j].x, v[r][j].y); o.y = pk2(v[r][j].z, v[r][j].w); *(uint2*)(xdst + (size_t)(row0 + r) * 1024 + 4 * lane + 256 * j) = o; }
        }
        float rstd[2];
#pragma unroll
        for (int r = 0; r < 2; ++r) { float ss = 0.f;
#pragma unroll
            for (int j = 0; j < 4; ++j) ss += (v[r][j].x * v[r][j].x + v[r][j].y * v[r][j].y) + (v[r][j].z * v[r][j].z + v[r][j].w * v[r][j].w);
            rstd[r] = __builtin_amdgcn_rsqf(wave_sum(ss) * (1.0f / 1024.0f) + EPS); }
        if (MODE == 3) {
#pragma unroll
            for (int r = 0; r < 2; ++r)
#pragma unroll
                for (int j = 0; j < 4; ++j) { const f32x4 h = v[r][j] * rstd[r] * gv[j]; *(f32x4*)(outf + (size_t)(row0 + r) * 1024 + 4 * lane + 256 * j) = h; } }
        else if (lane < 2) rsout[row0 + lane] = lane ? rstd[1] : rstd[0];
      }
      if (MODE == 1) {
          asm volatile("s_waitcnt vmcnt(0)" ::: "memory"); __builtin_amdgcn_fence(__ATOMIC_ACQUIRE, "agent");
          const int rr = lane & 15, q = lane >> 4; bf16x8 xa[32];
#pragma unroll
          for (int s = 0; s < 32; ++s) xa[s] = *(const bf16x8*)(xdst + (size_t)(t * 16 + rr) * 1024 + s * 32 + q * 8);
          proj16_tile<1>(C, xa, t, bias16, out16, nullptr); }
    }
#undef RP_LOADX
#undef RP_LOADSM
#undef RP_LOADY
    if (MODE == 1) __syncthreads();
}

__device__ __forceinline__ void prep_phase(const Ctx& C0, int layer, const float* const* in, bf16* ropedst, const int secs = 15) {
    const Ctx C = phase_ctx(C0);
    bf16* PROJ = (bf16*)(C.ws + WS_PROJ); bf16* YCAT = (bf16*)(C.ws + WS_YCAT); bf16* MQK = (bf16*)(C.ws + WS_MQK);
    const bf16* PW = (const bf16*)(C.ws + WS_POOLW) + (size_t)layer * 4 * 64 * 64;
    const float* ROPEC = (const float*)(C.ws + WS_ROPE); const float* ROPES = ROPEC + 4096 * 32;
    const float* qg = in[I_QNG] + layer * 64; const float* kg = in[I_KNG] + layer * 64;
    const float* cw = in[I_CONVW] + (size_t)layer * 5 * 512;
    const int lane = C.lane, rr = lane & 15, q = lane >> 4;
    bf16* KT = (bf16*)(C.ws + WS_KT); bf16* VT = (bf16*)(C.ws + WS_VT);
    LAS bf16* tile = (LAS bf16*)(C.ldsl + RING_OFF + C.wave * 16384);
    for (int grp = C.gw; grp < NTOK / 16; grp += C.NGW) {
        const int r0 = grp * 16, brow = r0 & ~4095, t0 = r0 & 4095;
#ifndef NO_POOL
        if (secs & 1)
        { LAS bf16* pst = (LAS bf16*)(C.ldsl + RING_OFF + C.wave * 16384);
          { v4u st[16];
#pragma unroll
            for (int i = 0; i < 16; ++i) { const int id = i * 64 + lane, row = id >> 5, c = id & 31, tu = t0 - 8 + row; st[i] = (v4u){0u, 0u, 0u, 0u};
                if (id < 992 && tu >= 0 && tu < 4096) st[i] = *(const v4u*)(PROJ + (size_t)(brow + tu) * NPROJ + C_POOL + c * 8); }
#pragma unroll
            for (int i = 0; i < 16; ++i) { const int id = i * 64 + lane, row = id >> 5, c = id & 31; if (id < 992) *(LAS v4u*)(pst + row * 264 + c * 8) = st[i]; } }
          LDS_WAIT(); asm volatile("" ::: "memory");
          const int t = t0 + rr;
#pragma unroll 1
          for (int g = 0; g < 4; ++g) { const int half = 1 << g, w = 2 << g; const int lo = max(t - half, 0), hi = min(t + half, 4096); const float inv = __builtin_amdgcn_rcpf((float)(hi - lo));
            bf16x8 bfr[2], afr[4][2]; float sum[2][8];
#pragma unroll
            for (int ks = 0; ks < 2; ++ks) {
#pragma unroll
                for (int i = 0; i < 8; ++i) sum[ks][i] = 0.f;
#pragma unroll
                for (int et = 0; et < 4; ++et) afr[et][ks] = *(const bf16x8*)(PW + ((size_t)(g * 64 + et * 16 + rr)) * 64 + ks * 32 + q * 8); }
            const LAS bf16* wp = pst + (rr + 8 - half) * 264 + g * 64 + q * 8;
#pragma unroll 2
            for (int u = 0; u < w; ++u) {
#pragma unroll
                for (int ks = 0; ks < 2; ++ks) { const v4u x = *(const LAS v4u*)(wp + u * 264 + ks * 32);
                    sum[ks][0] += bf_lo(x.x); sum[ks][1] += bf_hi(x.x); sum[ks][2] += bf_lo(x.y); sum[ks][3] += bf_hi(x.y); sum[ks][4] += bf_lo(x.z); sum[ks][5] += bf_hi(x.z); sum[ks][6] += bf_lo(x.w); sum[ks][7] += bf_hi(x.w); } }
#pragma unroll
            for (int ks = 0; ks < 2; ++ks) { const v4u s = *(const LAS v4u*)(pst + (rr + 8) * 264 + g * 64 + ks * 32 + q * 8);
                const float d0 = sum[ks][0] * inv - bf_lo(s.x), d1 = sum[ks][1] * inv - bf_hi(s.x), d2 = sum[ks][2] * inv - bf_lo(s.y), d3 = sum[ks][3] * inv - bf_hi(s.y);
                const float d4 = sum[ks][4] * inv - bf_lo(s.z), d5 = sum[ks][5] * inv - bf_hi(s.z), d6 = sum[ks][6] * inv - bf_lo(s.w), d7 = sum[ks][7] * inv - bf_hi(s.w);
                v4u pk; pk.x = pk2(d0, d1); pk.y = pk2(d2, d3); pk.z = pk2(d4, d5); pk.w = pk2(d6, d7); bfr[ks] = __builtin_bit_cast(bf16x8, pk); }
#pragma unroll
            for (int et = 0; et < 4; ++et) { f32x4 acc = (f32x4){0.f, 0.f, 0.f, 0.f};
#pragma unroll
                for (int ks = 0; ks < 2; ++ks) acc = MFMA16(afr[et][ks], bfr[ks], acc);
                uint2 o; o.x = pk2(acc.x, acc.y); o.y = pk2(acc.z, acc.w);
                *(uint2*)(YCAT + (size_t)(r0 + rr) * 1024 + g * 64 + et * 16 + 4 * q) = o; } }
          LDS_WAIT(); asm volatile("" ::: "memory"); }
#endif
        asm volatile("" ::: "memory");
#ifndef NO_CONV
        if (secs & 2)
        { float cwv[5][8];
#pragma unroll
          for (int j = 0; j < 5; ++j) { const f32x4 a = *(const f32x4*)(cw + j * 512 + lane * 8), b2 = *(const f32x4*)(cw + j * 512 + lane * 8 + 4);
              cwv[j][0] = a.x; cwv[j][1] = a.y; cwv[j][2] = a.z; cwv[j][3] = a.w; cwv[j][4] = b2.x; cwv[j][5] = b2.y; cwv[j][6] = b2.z; cwv[j][7] = b2.w; }
          const float ksc = (lane >= 32) ? 0.125f : 1.0f;
#pragma unroll
          for (int hf = 0; hf < 2; ++hf) { v4u xr[12];
#pragma unroll
            for (int u = 0; u < 12; ++u) { const int tu = t0 + hf * 8 + u - 2; const int tc = min(max(tu, 0), 4095); xr[u] = *(const v4u*)(PROJ + (size_t)(brow + tc) * NPROJ + C_MQ + lane * 8); }
#pragma unroll
            for (int u = 0; u < 12; ++u) { const int tu = t0 + hf * 8 + u - 2; if (tu < 0 || tu >= 4096) xr[u] = (v4u){0u, 0u, 0u, 0u}; }
#pragma unroll
            for (int r = 0; r < 8; ++r) { float acc[8];
#pragma unroll
                for (int i = 0; i < 8; ++i) acc[i] = 0.f;
#pragma unroll
                for (int j = 0; j < 5; ++j) { const v4u x = xr[r + j];
                    acc[0] += cwv[j][0] * bf_lo(x.x); acc[1] += cwv[j][1] * bf_hi(x.x); acc[2] += cwv[j][2] * bf_lo(x.y); acc[3] += cwv[j][3] * bf_hi(x.y);
                    acc[4] += cwv[j][4] * bf_lo(x.z); acc[5] += cwv[j][5] * bf_hi(x.z); acc[6] += cwv[j][6] * bf_lo(x.w); acc[7] += cwv[j][7] * bf_hi(x.w); }
#pragma unroll
                for (int i = 0; i < 8; ++i) acc[i] = acc[i] * fsigmoid(acc[i]) * ksc;
                v4u o; o.x = pk2(acc[0], acc[1]); o.y = pk2(acc[2], acc[3]); o.z = pk2(acc[4], acc[5]); o.w = pk2(acc[6], acc[7]);
                const int rw = hf * 8 + r;
                *(v4u*)(MQK + (size_t)(r0 + rw) * 512 + lane * 8) = o;
                if (lane >= 32) *(LAS v4u*)(tile + rw * 264 + (lane - 32) * 8) = o; } asm volatile("" ::: "memory"); } }
#endif
        asm volatile("" ::: "memory");
#ifndef NO_ROPE
        if (secs & 4)
        { const int c8 = lane & 7, rl = lane >> 3;
          f32x4 csv[2], snv[2];
#pragma unroll
          for (int hf = 0; hf < 2; ++hf) { const int t = t0 + hf * 8 + rl; csv[hf] = *(const f32x4*)(ROPEC + t * 32 + 4 * c8); snv[hf] = *(const f32x4*)(ROPES + t * 32 + 4 * c8); }
          const f32x4 qg0 = *(const f32x4*)(qg + 8 * c8), qg1 = *(const f32x4*)(qg + 8 * c8 + 4), kg0 = *(const f32x4*)(kg + 8 * c8), kg1 = *(const f32x4*)(kg + 8 * c8 + 4);
#pragma unroll 1
          for (int hb = 0; hb < 10; hb += 5) {
          v4u w[5][2];
#pragma unroll
          for (int h = 0; h < 5; ++h)
#pragma unroll
              for (int hf = 0; hf < 2; ++hf) { const int hh = hb + h; const int col = (hh < 8) ? C_AQ + hh * 64 : C_AK + (hh - 8) * 64; w[h][hf] = *(const v4u*)(PROJ + (size_t)(r0 + hf * 8 + rl) * NPROJ + col + 8 * c8); }
#pragma unroll
          for (int h = 0; h < 5; ++h)
#pragma unroll
              for (int hf = 0; hf < 2; ++hf) { const int hh = hb + h; const v4u x = w[h][hf];
                  const float x0 = bf_lo(x.x), x1 = bf_hi(x.x), x2 = bf_lo(x.y), x3 = bf_hi(x.y), x4 = bf_lo(x.z), x5 = bf_hi(x.z), x6 = bf_lo(x.w), x7 = bf_hi(x.w);
                  float ss = ((x0 * x0 + x1 * x1) + (x2 * x2 + x3 * x3)) + ((x4 * x4 + x5 * x5) + (x6 * x6 + x7 * x7));
                  ss = oct_sum(ss);
                  const float rs = __builtin_amdgcn_rsqf(ss * (1.0f / 64.0f) + EPS); const bool isq = hh < 8; const f32x4 g0 = isq ? qg0 : kg0, g1 = isq ? qg1 : kg1; const float sc = rs * (isq ? attn_body::C2 : 1.0f);
                  const float y0 = x0 * sc * g0.x, y1 = x1 * sc * g0.y, y2 = x2 * sc * g0.z, y3 = x3 * sc * g0.w, y4 = x4 * sc * g1.x, y5 = x5 * sc * g1.y, y6 = x6 * sc * g1.z, y7 = x7 * sc * g1.w;
                  const f32x4 c = csv[hf], sn4 = snv[hf];
                  v4u o; o.x = pk2(y0 * c.x - y1 * sn4.x, y0 * sn4.x + y1 * c.x); o.y = pk2(y2 * c.y - y3 * sn4.y, y2 * sn4.y + y3 * c.y);
                  o.z = pk2(y4 * c.z - y5 * sn4.z, y4 * sn4.z + y5 * c.z); o.w = pk2(y6 * c.w - y7 * sn4.w, y6 * sn4.w + y7 * c.w);
                  w[h][hf] = o; }
#pragma unroll
          for (int h = 0; h < 5; ++h)
#pragma unroll
              for (int hf = 0; hf < 2; ++hf) { const int hh = hb + h; const int col = (hh < 8) ? C_AQ + hh * 64 : C_AK + (hh - 8) * 64; *(v4u*)(ropedst + (size_t)(r0 + hf * 8 + rl) * NPROJ + col + 8 * c8) = w[h][hf]; }
          asm volatile("" ::: "memory"); }
          asm volatile("" ::: "memory"); }
#endif
        if (secs & 8) { const int chunk = grp >> 3, s0 = (grp & 7) * 16;
#pragma unroll 1
          for (int pass = 0; pass < 2; ++pass) {
            if (pass == 1) { v4u tv[8];
#pragma unroll
                for (int r2 = 0; r2 < 8; ++r2) { const int row = 2 * r2 + (lane >> 5), col8 = (lane & 31) * 8; tv[r2] = *(const v4u*)(PROJ + (size_t)(r0 + row) * NPROJ + C_MV + col8); }
#pragma unroll
                for (int r2 = 0; r2 < 8; ++r2) { const int row = 2 * r2 + (lane >> 5), col8 = (lane & 31) * 8; *(LAS v4u*)(tile + row * 264 + col8) = tv[r2]; } }
            LDS_WAIT(); asm volatile("" ::: "memory");
            bf16* dst = pass ? VT : KT;
#pragma unroll
            for (int k = 0; k < 4; ++k) { const int cidx = lane + 64 * k, hh = cidx >> 6, d = cidx & 63;
#pragma unroll
                for (int half = 0; half < 2; ++half) { unsigned w[4];
#pragma unroll
                    for (int i = 0; i < 4; ++i) w[i] = (unsigned)tile[(half * 8 + 2 * i) * 264 + cidx] | ((unsigned)tile[(half * 8 + 2 * i + 1) * 264 + cidx] << 16);
                    v4u o; o.x = w[0]; o.y = w[1]; o.z = w[2]; o.w = w[3];
                    *(v4u*)(dst + ((size_t)(chunk * 4 + hh) * 64 + d) * 128 + s0 + half * 8) = o; } }
            LDS_WAIT(); asm volatile("" ::: "memory");
          } }
    }
}

__device__ __forceinline__ void mlstm_local_phase(const Ctx& C0) {
    const Ctx C = phase_ctx(C0);
    const bf16* KT = (const bf16*)(C.ws + WS_KT); const bf16* VT = (const bf16*)(C.ws + WS_VT); const float* GATES = (const float*)(C.ws + WS_GATES);
    float* CST = (float*)(C.ws + WS_CST); float* MLOC = (float*)(C.ws + WS_MSC); float* BLAST = MLOC + 2048;
    const int lane = C.lane, wave = C.wave, rr = lane & 15, q = lane >> 4, dir = wave >> 2, nt = wave & 3;
    LAS float* wl = (LAS float*)(C.ldsl + RING_OFF) + wave * 128;
    for (int chunk = C.vcu; chunk < NBATCH * 32; chunk += C.G) {
        const int b = chunk >> 5, c = chunk & 31; const size_t row0 = (size_t)chunk * 128;
#pragma unroll 1
        for (int h = 0; h < 4; ++h) {
            const int sidx = ((b * 4 + h) * 2 + dir) * 32 + c; const int s0 = 2 * lane, s1 = s0 + 1;
            const float* g0p = GATES + (row0 + s0) * 16; const float li0 = g0p[dir * 4 + h], li1 = g0p[16 + dir * 4 + h], f0 = g0p[8 + dir * 4 + h], f1 = g0p[24 + dir * 4 + h];
            const bf16* kt = KT + ((size_t)(chunk * 4 + h) * 64 + nt * 16 + rr) * 128 + q * 8; const bf16* vt = VT + ((size_t)(chunk * 4 + h) * 64 + rr) * 128 + q * 8;
            v4u krr[4]; bf16x8 vfr[4][4];
#pragma unroll
            for (int ks = 0; ks < 4; ++ks) { krr[ks] = *(const v4u*)(kt + ks * 32);
#pragma unroll
                for (int m = 0; m < 4; ++m) vfr[ks][m] = *(const bf16x8*)(vt + (size_t)m * 16 * 128 + ks * 32); }
            float bc0, bc1, tot;
            if (dir == 0) { const float inc = wscan_add(f0 + f1, lane); bc1 = inc; bc0 = inc - f1; tot = __shfl(inc, 63); }
            else { const float suf = wscan_add_rev(f0 + f1, lane); bc0 = suf; bc1 = suf - f0; tot = __shfl(suf, 0); }
            const float g0 = tot - bc0 + li0, g1 = tot - bc1 + li1; float mx = fmaxf(g0, g1);
#pragma unroll
            for (int o = 1; o < 64; o <<= 1) mx = fmaxf(mx, __shfl_xor(mx, o));
            *(LAS f32x2v*)(wl + s0) = (f32x2v){fexp(g0 - mx), fexp(g1 - mx)};
            if (nt == 0 && lane == 0) { MLOC[sidx] = mx; BLAST[sidx] = tot; }
            LDS_WAIT(); asm volatile("" ::: "memory");
            f32x4 acc[4]; float nsum = 0.f;
#pragma unroll
            for (int m = 0; m < 4; ++m) acc[m] = (f32x4){0.f, 0.f, 0.f, 0.f};
#pragma unroll
            for (int ks = 0; ks < 4; ++ks) { const v4u kr = krr[ks]; const f32x4 wa = *(const LAS f32x4*)(wl + ks * 32 + q * 8), wb = *(const LAS f32x4*)(wl + ks * 32 + q * 8 + 4);
                const float k0 = bf_lo(kr.x) * wa.x, k1 = bf_hi(kr.x) * wa.y, k2 = bf_lo(kr.y) * wa.z, k3 = bf_hi(kr.y) * wa.w, k4 = bf_lo(kr.z) * wb.x, k5 = bf_hi(kr.z) * wb.y, k6 = bf_lo(kr.w) * wb.z, k7 = bf_hi(kr.w) * wb.w;
                nsum += ((k0 + k1) + (k2 + k3)) + ((k4 + k5) + (k6 + k7));
                v4u pk; pk.x = pk2(k0, k1); pk.y = pk2(k2, k3); pk.z = pk2(k4, k5); pk.w = pk2(k6, k7); const bf16x8 bfr = __builtin_bit_cast(bf16x8, pk);
#pragma unroll
                for (int m = 0; m < 4; ++m) acc[m] = MFMA16(vfr[ks][m], bfr, acc[m]); }
            nsum += __shfl_xor(nsum, 16); nsum += __shfl_xor(nsum, 32);
            float* out = CST + (size_t)sidx * CST_SZ;
#pragma unroll
            for (int m = 0; m < 4; ++m)
#pragma unroll
                for (int j = 0; j < 4; ++j) out[(m * 16 + 4 * q + j) * 64 + nt * 16 + rr] = acc[m][j];
            if (q == 0) out[4096 + nt * 16 + rr] = nsum;
            LDS_WAIT(); asm volatile("" ::: "memory");
        }
    }
}

__device__ __forceinline__ void mlstm_scan_phase(const Ctx& C0) {
    const Ctx C = phase_ctx(C0);
    const float* CST = (const float*)(C.ws + WS_CST); bf16* CSB = (bf16*)(C.ws + WS_CSB); const float* MLOC = (const float*)(C.ws + WS_MSC); const float* BLAST = MLOC + 2048; float* MST = (float*)(C.ws + WS_MSC) + 4096;
    const int spg = 64 / C.ng, lt = C.lb * 512 + C.tid, LT = C.GB * 512;
    LAS float* tb = (LAS float*)(C.ldsl + RING_OFF);
    for (int sq = C.wave; sq < spg; sq += 8) { const int seq = C.grp * spg + sq, dir = seq & 1, ln = C.lane;
        float mlv = 0.f, blv = 0.f; if (ln < 32) { const int cc = dir ? 31 - ln : ln; mlv = MLOC[seq * 32 + cc]; blv = BLAST[seq * 32 + cc]; }
        float m = 0.f;
        for (int s2 = 0; s2 < 32; ++s2) { const float b_ = __shfl(blv, s2), ml_ = __shfl(mlv, s2); const float mn = fmaxf(b_ + m, ml_);
            if (ln == s2) { tb[(sq * 32 + s2) * 4 + 0] = m; tb[(sq * 32 + s2) * 4 + 1] = fexp(b_ + m - mn); tb[(sq * 32 + s2) * 4 + 2] = fexp(ml_ - mn); }
            m = mn; } }
    __syncthreads();
    for (int li = lt; li < spg * CST_SZ; li += LT) {
        const int sq = li / CST_SZ, el = li - sq * CST_SZ, seq = C.grp * spg + sq, dir = seq & 1;
        float loc[32];
#pragma unroll
        for (int s = 0; s < 32; ++s) { const int c = dir ? 31 - s : s; const int idx = seq * 32 + c; loc[s] = CST[(size_t)idx * CST_SZ + el]; }
        float st = 0.f;
#pragma unroll
        for (int s = 0; s < 32; ++s) { const int c = dir ? 31 - s : s; const int idx = seq * 32 + c;
            CSB[(size_t)idx * CST_SZ + el] = (bf16)f2bf(st);
            const f32x4 cf = *(const LAS f32x4*)(tb + (sq * 32 + s) * 4); st = cf.y * st + cf.z * loc[s]; }
    }
    { const float* GATES = (const float*)(C.ws + WS_GATES); float* GV = (float*)(C.ws + WS_GV); const int lane = C.lane;
      for (int task = C.lb * 8 + C.wave; task < spg * 32; task += C.GB * 8) {
        const int sq = task >> 5, c = task & 31, seq = C.grp * spg + sq, dir = seq & 1, bh = seq >> 1, b = bh >> 2, h = bh & 3; const int sidx = seq * 32 + c;
        const int npre = dir ? 31 - c : c; const float mst = tb[(sq * 32 + npre) * 4];
        const size_t row0 = (size_t)b * 4096 + c * 128; const int s0 = 2 * lane, s1 = s0 + 1;
        const float* g0p = GATES + (row0 + s0) * 16; const float li0 = g0p[dir * 4 + h], li1 = g0p[16 + dir * 4 + h], f0 = g0p[8 + dir * 4 + h], f1 = g0p[24 + dir * 4 + h];
        float bc0, bc1;
        if (dir == 0) { const float inc = wscan_add(f0 + f1, lane); bc1 = inc; bc0 = inc - f1; }
        else { const float suf = wscan_add_rev(f0 + f1, lane); bc0 = suf; bc1 = suf - f0; }
        const float cb0 = li0 - bc0, cb1 = li1 - bc1; float mx0, mx1;
        if (dir == 0) { const float inc = wscan_max(fmaxf(cb0, cb1), lane); float prev = __shfl_up(inc, 1); if (lane == 0) prev = -INFINITY; mx1 = inc; mx0 = fmaxf(prev, cb0); }
        else { const float suf = wscan_max_rev(fmaxf(cb0, cb1), lane); float nxt = __shfl_down(suf, 1); if (lane == 63) nxt = -INFINITY; mx0 = suf; mx1 = fmaxf(nxt, cb1); }
        const float m0 = bc0 + fmaxf(mst, mx0), m1 = bc1 + fmaxf(mst, mx1);
        float* gv = GV + (size_t)sidx * 512 + s0;
        *(f32x2v*)(gv) = (f32x2v){cb0, cb1}; *(f32x2v*)(gv + 128) = (f32x2v){bc0 - m0, bc1 - m1};
        *(f32x2v*)(gv + 256) = (f32x2v){fexp(bc0 + mst - m0), fexp(bc1 + mst - m1)}; *(f32x2v*)(gv + 384) = (f32x2v){fexp(-m0), fexp(-m1)};
      } }
}

constexpr int MO_WAVE_BYTES = 2 * 4352;
constexpr int MO_K_OFF = 0, MO_V_OFF = MO_K_OFF + 128 * 144, MO_CF_OFF = MO_V_OFF + 64 * 272, MO_CB_OFF = MO_CF_OFF + 65 * 144, MO_GV_OFF = MO_CB_OFF + 65 * 144, MO_P_OFF = MO_GV_OFF + 4096;
static_assert(MO_P_OFF % 16 == 0 && MO_P_OFF + 8 * MO_WAVE_BYTES <= RING_BYTES, "mlstm_out LDS");
__device__ __forceinline__ void mlstm_out_phase(const Ctx& C0, int layer, const float* const* in) {
    const Ctx C = phase_ctx(C0);
    const bf16* PROJ = (const bf16*)(C.ws + WS_PROJ); const bf16* MQK = (const bf16*)(C.ws + WS_MQK); const bf16* VT = (const bf16*)(C.ws + WS_VT);
    const bf16* CSB = (const bf16*)(C.ws + WS_CSB); const float* GV = (const float*)(C.ws + WS_GV); bf16* YCAT = (bf16*)(C.ws + WS_YCAT);
    const float* ng = in[I_MNORMG] + layer * 256;
    const int tid = C.tid, lane = C.lane, wave = C.wave, rr = lane & 15, q = lane >> 4, j0 = wave * 16;
    LAS bf16* Ks = (LAS bf16*)(C.ldsl + RING_OFF + MO_K_OFF); LAS bf16* Vs = (LAS bf16*)(C.ldsl + RING_OFF + MO_V_OFF);
    LAS bf16* Cfs = (LAS bf16*)(C.ldsl + RING_OFF + MO_CF_OFF); LAS bf16* Cbs = (LAS bf16*)(C.ldsl + RING_OFF + MO_CB_OFF); LAS float* GVs = (LAS float*)(C.ldsl + RING_OFF + MO_GV_OFF);
    LAS bf16* Psf = (LAS bf16*)(C.ldsl + RING_OFF + MO_P_OFF + wave * MO_WAVE_BYTES); LAS bf16* Psb = Psf + 16 * 136;
    const int upg = NBATCH * 4 * 32 / C.ng;
    v4u pk[2], pv[2], pcf[2], pcb[2], pg; bf16x8 qan[2]; bf16 ogn[4][4];
    pcf[1] = (v4u){0u, 0u, 0u, 0u}; pcb[1] = pcf[1]; pg = pcf[1];
#define MO_ISSUE(lu_) do { const int un_ = C.grp * upg + (lu_); const int c_ = un_ & 31, h_ = (un_ >> 5) & 3, b_ = un_ >> 7; const size_t rw_ = (size_t)b_ * 4096 + c_ * 128; const int ch_ = b_ * 32 + c_; \
        const int sf_ = ((b_ * 4 + h_) * 2) * 32 + c_, sb_ = sf_ + 32; \
        _Pragma("unroll") for (int i_ = 0; i_ < 2; ++i_) { const int ix_ = tid + 512 * i_; \
            pk[i_] = *(const v4u*)(MQK + (rw_ + (ix_ >> 3)) * 512 + 256 + h_ * 64 + (ix_ & 7) * 8); \
            pv[i_] = *(const v4u*)(VT + ((size_t)(ch_ * 4 + h_) * 64 + (ix_ >> 4)) * 128 + (ix_ & 15) * 8); } \
        pcf[0] = *(const v4u*)(CSB + (size_t)sf_ * CST_SZ + tid * 8); pcb[0] = *(const v4u*)(CSB + (size_t)sb_ * CST_SZ + tid * 8); \
        if (tid < 8) { pcf[1] = *(const v4u*)(CSB + (size_t)sf_ * CST_SZ + (512 + tid) * 8); pcb[1] = *(const v4u*)(CSB + (size_t)sb_ * CST_SZ + (512 + tid) * 8); } \
        if (tid < 256) pg = *(const v4u*)(GV + (size_t)(tid < 128 ? sf_ : sb_) * 512 + (tid & 127) * 4); \
        _Pragma("unroll") for (int ks_ = 0; ks_ < 2; ++ks_) qan[ks_] = *(const bf16x8*)(MQK + (rw_ + j0 + rr) * 512 + h_ * 64 + ks_ * 32 + q * 8); \
        _Pragma("unroll") for (int i_ = 0; i_ < 4; ++i_) _Pragma("unroll") for (int et_ = 0; et_ < 4; ++et_) ogn[i_][et_] = PROJ[(rw_ + j0 + 4 * q + i_) * NPROJ + C_MO + h_ * 64 + et_ * 16 + rr]; } while (0)
#define MO_COMMIT() do { \
        _Pragma("unroll") for (int i_ = 0; i_ < 2; ++i_) { const int ix_ = tid + 512 * i_; \
            *(LAS v4u*)(Ks + (ix_ >> 3) * 72 + (ix_ & 7) * 8) = pk[i_]; *(LAS v4u*)(Vs + (ix_ >> 4) * 136 + (ix_ & 15) * 8) = pv[i_]; } \
        *(LAS v4u*)(Cfs + (tid >> 3) * 72 + (tid & 7) * 8) = pcf[0]; *(LAS v4u*)(Cbs + (tid >> 3) * 72 + (tid & 7) * 8) = pcb[0]; \
        if (tid < 8) { *(LAS v4u*)(Cfs + 64 * 72 + tid * 8) = pcf[1]; *(LAS v4u*)(Cbs + 64 * 72 + tid * 8) = pcb[1]; } \
        if (tid < 256) *(LAS v4u*)(GVs + tid * 4) = pg; } while (0)
    if (C.lb < upg) { MO_ISSUE(C.lb); MO_COMMIT(); }
    __syncthreads();
    for (int lu = C.lb; lu < upg; lu += C.GB) { const int unit = C.grp * upg + lu;
        const int c = unit & 31, h = (unit >> 5) & 3, b = unit >> 7; const size_t row0 = (size_t)b * 4096 + c * 128;
        bf16x8 qa[2]; bf16 ogr[4][4];
#pragma unroll
        for (int ks = 0; ks < 2; ++ks) qa[ks] = qan[ks];
#pragma unroll
        for (int i = 0; i < 4; ++i)
#pragma unroll
            for (int et = 0; et < 4; ++et) ogr[i][et] = ogn[i][et];
        const bool more = (lu + C.GB < upg);
        if (more) MO_ISSUE(lu + C.GB);
        const f32x4 raf = *(const LAS f32x4*)(GVs + 128 + j0 + 4 * q), aif = *(const LAS f32x4*)(GVs + 256 + j0 + 4 * q), emf = *(const LAS f32x4*)(GVs + 384 + j0 + 4 * q);
        const f32x4 rab = *(const LAS f32x4*)(GVs + 512 + 128 + j0 + 4 * q), aib = *(const LAS f32x4*)(GVs + 512 + 256 + j0 + 4 * q), emb = *(const LAS f32x4*)(GVs + 512 + 384 + j0 + 4 * q);
        float rsf[4] = {0.f, 0.f, 0.f, 0.f}, rsb[4] = {0.f, 0.f, 0.f, 0.f};
#pragma unroll
        for (int nt = 0; nt < 8; ++nt) { const int s = nt * 16 + rr; const bool usef = (nt * 16 <= j0 + 15), useb = (nt * 16 + 15 >= j0);
            const float cbf = GVs[nt * 16 + rr], cbb = GVs[512 + nt * 16 + rr];
            f32x4 acc = (f32x4){0.f, 0.f, 0.f, 0.f};
#pragma unroll
            for (int ks = 0; ks < 2; ++ks) acc = MFMA16(qa[ks], *(const LAS bf16x8*)(Ks + (nt * 16 + rr) * 72 + ks * 32 + q * 8), acc);
#pragma unroll
            for (int i = 0; i < 4; ++i) { const int j = j0 + 4 * q + i;
                float pf = 0.f, pb = 0.f;
                if (usef) { pf = (s <= j) ? acc[i] * fexp(raf[i] + cbf) : 0.f; rsf[i] += pf; }
                if (useb) { pb = (s >= j) ? acc[i] * fexp(rab[i] + cbb) : 0.f; rsb[i] += pb; }
                Psf[(4 * q + i) * 136 + s] = (bf16)f2bf(pf); Psb[(4 * q + i) * 136 + s] = (bf16)f2bf(pb); } }
        LDS_WAIT(); asm volatile("" ::: "memory");
#pragma unroll
        for (int i = 0; i < 4; ++i) {
#pragma unroll
            for (int o = 1; o < 2; o <<= 1) { rsf[i] = row_sum(rsf[i]); rsb[i] = row_sum(rsb[i]); } }
        f32x4 hsum[4];
#pragma unroll
        for (int dir = 0; dir < 2; ++dir) { LAS bf16* Cs = dir ? Cbs : Cfs; LAS bf16* Ps = dir ? Psb : Psf; const f32x4 ai = dir ? aib : aif, em = dir ? emb : emf;
          f32x4 o[5];
#pragma unroll
          for (int et = 0; et < 5; ++et) { o[et] = (f32x4){0.f, 0.f, 0.f, 0.f};
#pragma unroll
              for (int ks = 0; ks < 2; ++ks) { bf16x8 cf = (bf16x8){0, 0, 0, 0, 0, 0, 0, 0}; if (et < 4 || rr == 0) cf = *(const LAS bf16x8*)(Cs + (et * 16 + rr) * 72 + ks * 32 + q * 8);
                  o[et] = MFMA16(qa[ks], cf, o[et]); } }
          float qn[4];
#pragma unroll
          for (int i = 0; i < 4; ++i) qn[i] = __shfl(o[4][i], lane & 48);
#pragma unroll
          for (int et = 0; et < 4; ++et)
#pragma unroll
              for (int i = 0; i < 4; ++i) o[et][i] *= ai[i];
#pragma unroll
          for (int ks = 0; ks < 4; ++ks) { const bool on = dir ? (ks * 32 + 31 >= j0) : (ks * 32 <= j0 + 15);
              if (on) { const bf16x8 afr = *(const LAS bf16x8*)(Ps + rr * 136 + ks * 32 + q * 8);
#pragma unroll
              for (int et = 0; et < 4; ++et) o[et] = MFMA16(afr, *(const LAS bf16x8*)(Vs + (et * 16 + rr) * 136 + ks * 32 + q * 8), o[et]); } }
#pragma unroll
          for (int i = 0; i < 4; ++i) { const float den = (dir ? rsb[i] : rsf[i]) + ai[i] * qn[i]; const float rinv = __builtin_amdgcn_rcpf(fmaxf(fabsf(den), em[i]));
#pragma unroll
              for (int et = 0; et < 4; ++et) { const float t = o[et][i] * rinv; hsum[et][i] = dir ? hsum[et][i] + t : t; } } }
#pragma unroll
        for (int i = 0; i < 4; ++i) { float ss = 0.f;
#pragma unroll
            for (int et = 0; et < 4; ++et) ss += hsum[et][i] * hsum[et][i];
#pragma unroll
            for (int o = 1; o < 2; o <<= 1) ss = row_sum(ss);
            const float rs = __builtin_amdgcn_rsqf(ss * (1.0f / 64.0f) + EPS); const size_t row = row0 + j0 + 4 * q + i;
#pragma unroll
            for (int et = 0; et < 4; ++et) { const int e = et * 16 + rr; const float og = bf2f(ogr[i][et]);
                const float y = hsum[et][i] * rs * ng[h * 64 + e] * fsigmoid(og); YCAT[row * 1024 + 256 + h * 64 + e] = (bf16)f2bf(y); } }
        LDS_WAIT(); asm volatile("" ::: "memory");
        __syncthreads();
        if (more) MO_COMMIT();
        __syncthreads();
    }
#undef MO_ISSUE
#undef MO_COMMIT
}

__device__ __forceinline__ void topk_phase(const Ctx& C0) {
    const Ctx C = phase_ctx(C0);
    const float* AFF = (const float*)(C.ws + WS_AFF); int* TOKI = (int*)(C.ws + WS_TOKI); float* GATEV = (float*)(C.ws + WS_TOKI + 262144); float* RSTDS = (float*)(C.ws + WS_TOKI + 524288); const float* RSTD3 = (const float*)(C.ws + WS_TOKI + 786432 + 131072); int* SLOTMAP = (int*)(C.ws + WS_SLOTMAP);
    LAS unsigned* hist = (LAS unsigned*)(C.ldsl + RING_OFF); LAS unsigned* sel = hist + 4096; LAS unsigned* wtot = hist + 4104;
    const int tid = C.tid, lane = C.lane, wave = C.wave;
    const int upg = NBATCH * NEXP / C.ng;
    for (int lu = C.lb; lu < upg; lu += C.GB) { const int unit = C.grp * upg + lu;
        const int b = unit >> 4, e = unit & 15; const float* a = AFF + (size_t)unit * 4096;
        unsigned key[8];
#pragma unroll
        for (int i = 0; i < 2; ++i) { const f32x4 v = *(const f32x4*)(a + 8 * tid + 4 * i); key[4 * i] = __float_as_uint(v.x); key[4 * i + 1] = __float_as_uint(v.y); key[4 * i + 2] = __float_as_uint(v.z); key[4 * i + 3] = __float_as_uint(v.w); }
        unsigned prefix = 0u, mask = 0u; int krem = CAP;
#pragma unroll 1
        for (int pass = 0; pass < 3; ++pass) { const int shift = 20 - 10 * pass; const unsigned nbm = pass ? 1023u : 4095u;
#pragma unroll
            for (int j = 0; j < 8; ++j) hist[tid * 8 + j] = 0u;
            __syncthreads();
#pragma unroll
            for (int i = 0; i < 8; ++i) if ((key[i] & mask) == prefix) atomicAdd((unsigned*)&hist[(key[i] >> shift) & nbm], 1u);
            __syncthreads();
            unsigned h[8]; unsigned tsum = 0u;
#pragma unroll
            for (int j = 0; j < 8; ++j) { h[j] = hist[tid * 8 + j]; tsum += h[j]; }
            unsigned sfx = tsum;
#pragma unroll
            for (int o = 1; o < 64; o <<= 1) { const unsigned t2 = __shfl_down(sfx, o); if (lane + o < 64) sfx += t2; }
            if (lane == 0) wtot[wave] = sfx;
            __syncthreads();
            { unsigned s2 = sfx - tsum;
#pragma unroll
              for (int w = 1; w < 8; ++w) if (w > wave) s2 += wtot[w];
#pragma unroll
              for (int j = 7; j >= 0; --j) { if ((int)s2 < krem && (int)(s2 + h[j]) >= krem) { sel[0] = (unsigned)(tid * 8 + j); sel[1] = s2; } s2 += h[j]; } }
            __syncthreads();
            prefix |= sel[0] << shift; mask |= nbm << shift; krem -= (int)sel[1];
            __syncthreads();
        }
        const int cnt_gt = CAP - krem;
        unsigned pk = 0u;
#pragma unroll
        for (int i = 0; i < 8; ++i) pk += (key[i] > prefix ? 1u : 0u) + (key[i] == prefix ? 65536u : 0u);
        unsigned inc = pk;
#pragma unroll
        for (int o = 1; o < 64; o <<= 1) { const unsigned t2 = __shfl_up(inc, o); if (lane >= o) inc += t2; }
        if (lane == 63) wtot[wave] = inc;
        __syncthreads();
        unsigned woff = 0u;
#pragma unroll
        for (int w = 0; w < 8; ++w) { const unsigned x = wtot[w]; if (w < wave) woff += x; }
        const unsigned ex = woff + inc - pk; int pos_gt = (int)(ex & 0xffffu), pos_eq = (int)(ex >> 16);
        int slots[8];
#pragma unroll
        for (int i = 0; i < 8; ++i) { const bool gt = key[i] > prefix, eq = key[i] == prefix; const bool selected = gt || (eq && pos_eq < krem);
            slots[i] = selected ? (gt ? pos_gt : cnt_gt + pos_eq) : -1; pos_gt += gt ? 1 : 0; pos_eq += eq ? 1 : 0;
            if (selected) { TOKI[e * ROWS_E + b * CAP + slots[i]] = b * 4096 + 8 * tid + i; GATEV[e * ROWS_E + b * CAP + slots[i]] = __uint_as_float(key[i]); RSTDS[e * ROWS_E + b * CAP + slots[i]] = RSTD3[b * 4096 + 8 * tid + i]; } }
#pragma unroll
        for (int i = 0; i < 8; ++i) SLOTMAP[((size_t)(b * 4096 + 8 * tid + i)) * 16 + e] = slots[i];
        __syncthreads();
    }
}
#ifndef MK_ONE_LAUNCH
#define MK_ONE_LAUNCH 1
#endif
#ifndef PHM
#define PHM 0xFFFF
#endif
#ifndef STAGGER_ITEMS
#define STAGGER_ITEMS 4
#endif
#ifndef A_ALIGN
#define A_ALIGN true
#endif
#ifndef RES_ALIGN
#define RES_ALIGN false
#endif
#ifndef PREP_SECS
#define PREP_SECS 15
#endif
#ifndef MN_LOCAL
#define MN_LOCAL 0
#endif
#ifndef LOCAL_SEAMS
#define LOCAL_SEAMS 1
#endif
#ifndef CONV_PARTS
#define CONV_PARTS 1
#endif
#ifndef PROBE_N
#define PROBE_N 2
#endif
#ifndef REP_BARL
#define REP_BARL 1
#endif
#ifndef REP_BAR
#define REP_BAR 1
#endif
#ifndef REP_P0
#define REP_P0 1
#endif
#ifndef REP_A
#define REP_A 1
#endif
#ifndef REP_C
#define REP_C 1
#endif
#ifndef REP_E1
#define REP_E1 1
#endif
#ifndef REP_E2
#define REP_E2 1
#endif
#ifndef REP_G
#define REP_G 1
#endif
#ifndef REP_H
#define REP_H 1
#endif
#ifndef REP_K
#define REP_K 1
#endif
#ifndef REP_L
#define REP_L 1
#endif
#ifndef REP_M
#define REP_M 1
#endif
#ifndef REP_N
#define REP_N 1
#endif
#ifndef REP_B
#define REP_B 1
#endif
#ifndef REP_D
#define REP_D 1
#endif
#ifndef REP_F
#define REP_F 1
#endif
#ifndef REP_I
#define REP_I 1
#endif
#ifndef REP_J
#define REP_J 1
#endif
#ifndef REP_O
#define REP_O 1
#endif
#define REPEAT(n) for (int rep_ = 0; rep_ < (n); ++rep_)
constexpr int NWAVES = 8;
constexpr int GU_MAXU = 16;
static_assert(XTRA_OFF + GU_MAXU * (512 + 1024) <= LDS_BYTES, "gather tables");
static_assert(GU_MAXU >= 16, "gather table");
constexpr int PH_PER_LAYER = 12, N_PHASES = 1 + DEPTH * PH_PER_LAYER;
struct Args { const float* in[N_IN]; float* out; unsigned char* ws; int ph_lo, ph_hi; };
static_assert(sizeof(Args) == (N_IN + 2) * 8 + 8, "no padding in Args");

__global__ void __launch_bounds__(NWAVES * 64, 2) mk_fwd(Args args) {
    extern __shared__ __attribute__((aligned(16))) unsigned char lds[];
    Ctx C;
    C.tid = threadIdx.x; C.lane = C.tid & 63; C.wave = __builtin_amdgcn_readfirstlane(C.tid >> 6);
    C.G = gridDim.x; { const int bx = blockIdx.x; C.vcu = (C.G % 8 == 0) ? (bx % 8) * (C.G / 8) + bx / 8 : bx; }
    C.gw = C.vcu * NWAVES + C.wave; C.NGW = C.G * NWAVES; C.ng = (C.G % 8 == 0) ? 8 : 1; C.GB = C.G / C.ng; C.grp = C.vcu / C.GB; C.lb = C.vcu % C.GB; C.lds = lds; C.ws = args.ws; C.ldsl = (LAS unsigned char*)lds;
    unsigned char* ws = args.ws;
    LAS unsigned char* ldsl = (LAS unsigned char*)lds;
    volatile LAS unsigned* MISC = (volatile LAS unsigned*)(ldsl + MISC_OFF);
    for (int u = C.tid; u < (LDS_BYTES - LDSCTL_OFF) / 4; u += NWAVES * 64) ((LAS unsigned*)(ldsl + LDSCTL_OFF))[u] = 0u;
    __syncthreads();
    XcdBarrier bar; bar.bar = (unsigned*)(ws + WS_CTL) + CW_BAR; bar.x = 0; bar.st = nullptr;
    if (MK_ONE_LAUNCH) bar = xcd_barrier_post((unsigned*)(ws + WS_CTL) + CW_BAR, MISC + 8);
    const int lo = args.ph_lo, hi = args.ph_hi;
#define IN(k) (lo <= (k) && (k) < hi)
#define SEAM(k) do { if (IN(k) && IN((k) + 1)) { REPEAT(REP_BAR) xcd_barrier(bar); } } while (0)
#define SEAM_L(k) do { if (IN(k) && IN((k) + 1)) { REPEAT(REP_BARL) { if (fastmode) local_barrier((unsigned*)(ws + WS_CTL) + CW_BAR, (unsigned*)(ws + WS_CTL) + CW_LOC + 64 * C.grp, (unsigned)C.GB, MISC + 20); else xcd_barrier(bar); } } } while (0)
    const float* const* in = args.in;
#define HN ((bf16*)(ws + WS_HN))
#define PROJ ((bf16*)(ws + WS_PROJ))
#define YCAT ((bf16*)(ws + WS_YCAT))
#define QCA ((bf16*)(ws + WS_QCA))
#define X ((float*)(ws + WS_X))
#define XB ((bf16*)(ws + WS_X))
#define RSTD1 ((float*)(ws + WS_TOKI + 786432))
#define RSTD3 ((float*)(ws + WS_TOKI + 786432 + 131072))
#define RSTDS ((float*)(ws + WS_TOKI + 524288))
#define GATES ((float*)(ws + WS_GATES))
#define AFF ((float*)(ws + WS_AFF))
#define TOKI ((int*)(ws + WS_TOKI))
#define GATEV ((float*)(ws + WS_TOKI + 262144))
#define SLOTMAP ((int*)(ws + WS_SLOTMAP))
#define ACT ((bf16*)(ws + WS_ACT))
#define YS ((bf16*)(ws + WS_YS))

    if ((PHM & 1) && IN(0)) {
        REPEAT(REP_P0) { prologue_convert(C, in, MK_ONE_LAUNCH != 0);
        __syncthreads(); }
        row_phase<1, false, true>(C, in[I_X], XB, in[I_NMIXG], RSTD1, in[I_WIN] + 1280, 2064, in[I_GATEB], GATES, nullptr, nullptr, nullptr);
        if (MK_ONE_LAUNCH && LOCAL_SEAMS && C.tid == 0) atomicOr((unsigned*)(ws + WS_CTL) + CW_LOC + 1024 + 64 * C.grp, 1u << bar.x);
        SEAM(0);
    }
    bool fastmode = false;
    const bool mnloc = (C.ng == 8 && C.GB == 32);
    if (MK_ONE_LAUNCH && LOCAL_SEAMS && lo == 0 && hi == N_PHASES) {
        if (C.tid == 0) { unsigned ok = (C.ng == 8) ? 1u : 0u;
            for (int g = 0; g < 8; ++g) { const unsigned m = xb_ld((unsigned*)(ws + WS_CTL) + CW_LOC + 1024 + 64 * g); if (m == 0u || (m & (m - 1u)) != 0u) ok = 0u; }
            MISC[21] = ok; }
        __syncthreads();
        fastmode = (MISC[21] != 0u);
    }
#pragma unroll 1
    for (int l = 0; l < DEPTH; ++l) {
        const int pb = 1 + l * PH_PER_LAYER;
        if ((PHM & (1 << 1)) && IN(pb + 0)) {
            if (l == 0) { pg8::Gemm g{(const pg8::bf16_t*)(ws + WS_MEMB), (const pg8::bf16_t*)(ws + WS_WCAKV), 1024, 0, 1024L * 1024, nullptr, 0, nullptr}; pg8::Sched S; S.init(8, 4, 4, C.G, (int)blockIdx.x);
                pg8::EpiBf16 E{(pg8::bf16_t*)(ws + WS_KVCA), 1024, 2048L * 1024, 1.0f};
                pg8::gemm_phase<pg8::EpiBf16, true, false>(ldsl + RING_OFF, g, S, E); }
            REPEAT(REP_A) { pg8::Gemm g{(const pg8::bf16_t*)XB, (const pg8::bf16_t*)(ws + WS_WIN) + (size_t)l * 2048 * 1024, 1024, 0, 0, nullptr, 0, nullptr}; pg8::Sched S; S.init(NTOK / 256, NPROJ / 256, 1, C.G, (int)blockIdx.x);
              pg8::row_table((LAS float*)(ldsl + XTRA_OFF), RSTD1, 0, S, GU_MAXU);
              pg8::EpiBf16S E{(pg8::bf16_t*)PROJ, NPROJ, (const LAS float*)(ldsl + XTRA_OFF)};
              pg8::gemm_phase<pg8::EpiBf16S, A_ALIGN, false>(ldsl + RING_OFF, g, S, E); }
            if (l == 0) SEAM(pb + 0); else SEAM_L(pb + 0);
        }
        if ((PHM & (1 << 2)) && IN(pb + 1)) { REPEAT(REP_B - 1) prep_phase(C, l, in, ACT, PREP_SECS); prep_phase(C, l, in, PROJ); VM_WAIT(); __syncthreads(); REPEAT(REP_C) mlstm_local_phase(C); SEAM_L(pb + 1); }
        if ((PHM & (1 << 4)) && IN(pb + 2)) { REPEAT(REP_D) mlstm_scan_phase(C); SEAM_L(pb + 2); }
        if ((PHM & (1 << 5)) && IN(pb + 3)) {
#ifndef NO_MOUT
            REPEAT(REP_E1) { mlstm_out_phase(C, l, in);
            __syncthreads(); }
#endif
#ifndef NO_ATTN
            REPEAT(REP_E2) for (int i = 0; i < 4; ++i) { const int u = C.vcu * 4 + i; if (u >= NBATCH * 8 * 16) break; const int qb = u & 15, h = (u >> 4) & 7, b = u >> 7;
                attn_body::attn_unit<8>((long)b * 4096, qb * 256, (const attn_body::bf16*)PROJ + C_AQ + h * 64, (const attn_body::bf16*)PROJ + C_AK + (h >> 2) * 64, (const attn_body::bf16*)PROJ + C_AV + (h >> 2) * 64,
                                        (attn_body::bf16*)YCAT + 512 + h * 64, (char*)lds + RING_OFF);
#if CONV_PARTS == 2
                if (MK_ONE_LAUNCH && (i == (C.vcu & 3) || i == ((C.vcu + 2) & 3))) { convert_share(ws, in, ldsl, l, C.vcu, C.G, (i == (C.vcu & 3)) ? 0 : 1, 2); __syncthreads(); } }
#else
                if (MK_ONE_LAUNCH && i == (C.vcu & 3)) { convert_share(ws, in, ldsl, l, C.vcu, C.G); __syncthreads();
#if defined(CV_MODE)
                    convert_share_probe(ws, in, ldsl, l, C.vcu, C.G); __syncthreads();
#endif
                } }
#endif
#endif
            SEAM_L(pb + 3);
        }
        if ((PHM & (1 << 6)) && IN(pb + 4)) {
            pg8::Gemm g{(const pg8::bf16_t*)YCAT, (const pg8::bf16_t*)(ws + WS_WOUT) + (size_t)l * 1024 * 1024, 1024, 0, 0, nullptr, 0, nullptr}; pg8::Sched S; S.init(NTOK / 256, 4, 1, C.G, (int)blockIdx.x);
            pg8::EpiResidXB E{(const pg8::bf16_t*)XB, (pg8::bf16_t*)XB, (float*)(ws + WS_PART), 1024};
            pg8::gemm_phase<pg8::EpiResidXB, RES_ALIGN, false>(ldsl + RING_OFF, g, S, E);
            SEAM_L(pb + 4);
        }
        if ((PHM & (1 << 8)) && IN(pb + 5)) {
            pg8::Gemm g{(const pg8::bf16_t*)XB, (const pg8::bf16_t*)(ws + WS_WCAQ) + (size_t)l * 512 * 1024, 1024, 0, 0, nullptr, 0, nullptr}; pg8::Sched S; S.init(NTOK / 256, 2, 1, C.G, (int)blockIdx.x);
            pg8::EpiBf16R E{(pg8::bf16_t*)QCA, 512, attn_body::CA_C2, (const float*)(ws + WS_PART), EPS};
            REPEAT(REP_H) pg8::gemm_phase<pg8::EpiBf16R, true, false>(ldsl + RING_OFF, g, S, E);
            VM_WAIT(); __syncthreads();
            { pg8::Unit u;
              for (int rep_ = 0; rep_ < REP_I; ++rep_)
              for (int i = 0; S.next(i, u); ++i) { const int b = u.pm >> 4, qt = u.pm & 15;
                  for (int hh = 0; hh < 2; ++hh)
                      attn_body::ca_tiles<1>(b, 2 * u.pn + hh, qt, (const attn_body::bf16*)QCA, (const attn_body::bf16*)(ws + WS_KVCA) + (size_t)l * 2048 * 1024, (attn_body::bf16*)(rep_ + 1 < REP_I ? ACT : QCA), (char*)lds + RING_OFF, (float*)(lds + XTRA_OFF)); } }
            SEAM_L(pb + 5);
        }
        if ((PHM & (1 << 10)) && IN(pb + 6)) {
            pg8::Gemm g{(const pg8::bf16_t*)QCA, (const pg8::bf16_t*)(ws + WS_WCAO) + (size_t)l * 1024 * 512, 512, 0, 0, nullptr, 0, nullptr}; pg8::Sched S; S.init(NTOK / 256, 4, 1, C.G, (int)blockIdx.x);
            REPEAT(REP_J - 1) { pg8::EpiResidB E2{(const pg8::bf16_t*)XB, (pg8::bf16_t*)ACT, 1024}; pg8::gemm_phase<pg8::EpiResidB, true, false>(ldsl + RING_OFF, g, S, E2); }
            pg8::EpiResidB E{(const pg8::bf16_t*)XB, (pg8::bf16_t*)XB, 1024};
            pg8::gemm_phase<pg8::EpiResidB, RES_ALIGN, false>(ldsl + RING_OFF, g, S, E);
            SEAM_L(pb + 6);
        }
        if ((PHM & (1 << 11)) && IN(pb + 7)) { REPEAT(REP_K) router_phase(C, XB, in[I_NFFNG] + l * 1024, in[I_ROUTER] + (size_t)l * 1024 * 16, AFF, RSTD3); SEAM_L(pb + 7); }
        if ((PHM & (1 << 12)) && IN(pb + 8)) { REPEAT(REP_L) topk_phase(C); SEAM(pb + 8); }
        if ((PHM & (1 << 13)) && IN(pb + 9)) {
            pg8::Gemm g{(const pg8::bf16_t*)XB, (const pg8::bf16_t*)(ws + WS_WGU) + (size_t)l * 16 * 4096 * 1024, 1024, 0, 4096L * 1024, TOKI, ROWS_E, (const LAS unsigned short*)(ldsl + XTRA_OFF)}; pg8::Sched S; if (MN_LOCAL && mnloc) S.init(2, 16, NEXP, C.GB, C.lb, 2 * C.grp); else S.init(ROWS_E / 256, 16, NEXP, C.G, (int)blockIdx.x);
            pg8::gather_table((LAS unsigned short*)(ldsl + XTRA_OFF), TOKI, ROWS_E, S, GU_MAXU, (LAS float*)(ldsl + XTRA_OFF + GU_MAXU * 512), RSTDS);
            pg8::EpiSwiGLU E{(pg8::bf16_t*)ACT, FFE, ROWS_E, (const LAS float*)(ldsl + XTRA_OFF + GU_MAXU * 512)};
            REPEAT(REP_M) pg8::gemm_phase<pg8::EpiSwiGLU, true, true>(ldsl + RING_OFF, g, S, E);
            if (MN_LOCAL && mnloc) SEAM_L(pb + 9); else SEAM(pb + 9);
        }
        if ((PHM & (1 << 14)) && IN(pb + 10)) {
            pg8::Gemm g{(const pg8::bf16_t*)ACT, (const pg8::bf16_t*)(ws + WS_WDN) + (size_t)l * 16 * 1024 * 2048, 2048, (long)ROWS_E * FFE, 1024L * 2048, nullptr, 0, nullptr}; pg8::Sched S; if (MN_LOCAL && mnloc) S.init(2, 4, NEXP, C.GB, C.lb, 2 * C.grp); else S.init(ROWS_E / 256, 4, NEXP, C.G, (int)blockIdx.x);
            pg8::row_table((LAS float*)(ldsl + XTRA_OFF), GATEV, ROWS_E, S, GU_MAXU);
            pg8::EpiDown E{(pg8::bf16_t*)YS, 1024, ROWS_E, (const LAS float*)(ldsl + XTRA_OFF)};
            REPEAT(REP_N) pg8::gemm_phase<pg8::EpiDown, true, false>(ldsl + RING_OFF, g, S, E);
            if (MN_LOCAL && mnloc) SEAM_L(pb + 10); else SEAM(pb + 10);
        }
        if ((PHM & (1 << 15)) && IN(pb + 11)) {
            if (l + 1 < DEPTH) { REPEAT(REP_O - 1) row_phase<1, true>(C, XB, (bf16*)ACT, in[I_NMIXG] + (l + 1) * 1024, RSTD1, in[I_WIN] + (size_t)(l + 1) * 1024 * 2064 + 1280, 2064, in[I_GATEB] + (l + 1) * 16, GATES, nullptr, SLOTMAP, YS);
              row_phase<1, true>(C, XB, XB, in[I_NMIXG] + (l + 1) * 1024, RSTD1, in[I_WIN] + (size_t)(l + 1) * 1024 * 2064 + 1280, 2064, in[I_GATEB] + (l + 1) * 16, GATES, nullptr, SLOTMAP, YS); SEAM_L(pb + 11); }
            else row_phase<3, true>(C, XB, XB, in[I_FNG], nullptr, nullptr, 0, nullptr, nullptr, args.out, SLOTMAP, YS);
        }
    }
#if defined(PROBE_TAIL)
    if (IN(N_PHASES - 1)) {
        __syncthreads();
        const int l = DEPTH - 1;
        for (int rep_ = 0; rep_ < PROBE_N; ++rep_) {
#if PROBE_TAIL == 1
            pg8::Gemm g{(const pg8::bf16_t*)XB, (const pg8::bf16_t*)(ws + WS_WIN) + (size_t)l * 2048 * 1024, 1024, 0, 0, nullptr, 0, nullptr}; pg8::Sched S; S.init(NTOK / 256, NPROJ / 256, 1, C.G, (int)blockIdx.x);
            pg8::EpiBf16 E{(pg8::bf16_t*)PROJ, NPROJ, 0, 1.0f};
            pg8::gemm_phase<pg8::EpiBf16, true, false>(ldsl + RING_OFF, g, S, E);
#elif PROBE_TAIL == 2
            pg8::Gemm g{(const pg8::bf16_t*)YCAT, (const pg8::bf16_t*)(ws + WS_WOUT) + (size_t)l * 1024 * 1024, 1024, 0, 0, nullptr, 0, nullptr}; pg8::Sched S; S.init(NTOK / 256, 4, 1, C.G, (int)blockIdx.x);
            pg8::EpiResidB E{(const pg8::bf16_t*)XB, (pg8::bf16_t*)PROJ, 1024};
            pg8::gemm_phase<pg8::EpiResidB, false, false>(ldsl + RING_OFF, g, S, E);
#elif PROBE_TAIL == 3
            pg8::Gemm g{(const pg8::bf16_t*)XB, (const pg8::bf16_t*)(ws + WS_WGU) + (size_t)l * 16 * 4096 * 1024, 1024, 0, 4096L * 1024, TOKI, ROWS_E, (const LAS unsigned short*)(ldsl + XTRA_OFF)}; pg8::Sched S; S.init(ROWS_E / 256, 16, NEXP, C.G, (int)blockIdx.x);
            pg8::gather_table((LAS unsigned short*)(ldsl + XTRA_OFF), TOKI, ROWS_E, S, GU_MAXU, (LAS float*)(ldsl + XTRA_OFF + GU_MAXU * 512), RSTDS);
            pg8::EpiSwiGLU E{(pg8::bf16_t*)ACT, FFE, ROWS_E, (const LAS float*)(ldsl + XTRA_OFF + GU_MAXU * 512)};
            pg8::gemm_phase<pg8::EpiSwiGLU, true, true>(ldsl + RING_OFF, g, S, E);
#elif PROBE_TAIL == 4
            pg8::Gemm g{(const pg8::bf16_t*)ACT, (const pg8::bf16_t*)(ws + WS_WDN) + (size_t)l * 16 * 1024 * 2048, 2048, (long)ROWS_E * FFE, 1024L * 2048, nullptr, 0, nullptr}; pg8::Sched S; S.init(ROWS_E / 256, 4, NEXP, C.G, (int)blockIdx.x);
            pg8::row_table((LAS float*)(ldsl + XTRA_OFF), GATEV, ROWS_E, S, GU_MAXU);
            pg8::EpiDown E{(pg8::bf16_t*)YS, 1024, ROWS_E, (const LAS float*)(ldsl + XTRA_OFF)};
            pg8::gemm_phase<pg8::EpiDown, true, false>(ldsl + RING_OFF, g, S, E);
#elif PROBE_TAIL == 6
            pg8::Gemm g{(const pg8::bf16_t*)YCAT, (const pg8::bf16_t*)(ws + WS_WOUT) + (size_t)l * 1024 * 1024, 1024, 0, 0, nullptr, 0, nullptr}; pg8::Sched S; S.init(NTOK / 256, 4, 1, C.G, (int)blockIdx.x);
            pg8::EpiBf16 E{(pg8::bf16_t*)PROJ, 1024, 0, 1.0f};
            pg8::gemm_phase<pg8::EpiBf16, true, false>(ldsl + RING_OFF, g, S, E);
#elif PROBE_TAIL == 5
            pg8::Gemm g{(const pg8::bf16_t*)QCA, (const pg8::bf16_t*)(ws + WS_WCAO) + (size_t)l * 1024 * 512, 512, 0, 0, nullptr, 0, nullptr}; pg8::Sched S; S.init(NTOK / 256, 4, 1, C.G, (int)blockIdx.x);
            pg8::EpiResidB E{(const pg8::bf16_t*)XB, (pg8::bf16_t*)PROJ, 1024};
            pg8::gemm_phase<pg8::EpiResidB, false, false>(ldsl + RING_OFF, g, S, E);
#endif
            __syncthreads();
        }
    }
#endif
#undef IN
#undef SEAM
#undef HN
#undef PROJ
#undef YCAT
#undef QCA
#undef X
#undef GATES
#undef AFF
#undef TOKI
#undef GATEV
#undef SLOTMAP
#undef ACT
#undef YS
}

extern "C" void kernel_launch(void* const* d_in, const int* in_sizes, int n_in, void* d_out, int out_size, void* d_ws, size_t ws_size, hipStream_t stream) {
    static int grid = 0;
    if (grid == 0) {
        if (n_in != N_IN || in_sizes[0] != NTOK * DMODEL || out_size != NTOK * DMODEL || ws_size < WS_END) { fprintf(stderr, "kernel_launch: unexpected shapes (n_in %d, in0 %d, out %d, ws %zu); nothing launched\n", n_in, n_in > 0 ? in_sizes[0] : -1, out_size, ws_size); grid = -1; return; }
        int dev = 0, cus = 0, per_cu = 0;
        if (hipGetDevice(&dev) != hipSuccess || hipDeviceGetAttribute(&cus, hipDeviceAttributeMultiprocessorCount, dev) != hipSuccess) { grid = -1; return; }
        if (hipFuncSetAttribute((const void*)mk_fwd, hipFuncAttributeMaxDynamicSharedMemorySize, LDS_BYTES) != hipSuccess) { fprintf(stderr, "kernel_launch: hipFuncSetAttribute failed\n"); grid = -1; return; }
        if (hipOccupancyMaxActiveBlocksPerMultiprocessor(&per_cu, (const void*)mk_fwd, NWAVES * 64, LDS_BYTES) != hipSuccess || per_cu < 1) fprintf(stderr, "kernel_launch: occupancy query reports %d workgroups per CU\n", per_cu);
        (void)hipGetLastError();
        if (cus < 256) { fprintf(stderr, "kernel_launch: built for a 256-CU device (the attention and expert phases deal one unit group per workgroup); found %d CUs; nothing launched\n", cus); grid = -1; return; }
        grid = cus;
    }
    if (grid < 0) return;
    if (hipMemsetAsync((char*)d_ws + WS_CTL, 0, CTL_ZERO_BYTES, stream) != hipSuccess) { fprintf(stderr, "kernel_launch: memset failed\n"); return; }
    Args a{};
    for (int i = 0; i < N_IN; ++i) a.in[i] = (const float*)d_in[i];
    a.out = (float*)d_out; a.ws = (unsigned char*)d_ws;
#if MK_ONE_LAUNCH
    a.ph_lo = 0; a.ph_hi = N_PHASES;
    hipLaunchKernelGGL(mk_fwd, dim3(grid), dim3(NWAVES * 64), LDS_BYTES, stream, a);
#else
    for (int p = 0; p < N_PHASES; ++p) { a.ph_lo = p; a.ph_hi = p + 1; hipLaunchKernelGGL(mk_fwd, dim3(grid), dim3(NWAVES * 64), LDS_BYTES, stream, a); }
#endif
    const hipError_t le = hipPeekAtLastError();
    if (le != hipSuccess) fprintf(stderr, "kernel_launch: launch failed: %s\n", hipGetErrorName(le));
}
```

```cpp
#include <hip/hip_runtime.h>
#include <hip/hip_bf16.h>
#include <cstdio>
#include <cstdint>
#include <cmath>
__device__ __forceinline__ int opaque_tid() { int t = (int)threadIdx.x; asm volatile("" : "+v"(t)); return t; }
#ifndef WGM_SET
#define WGM_SET 8
#endif
namespace pg8 {
#define PG8_LAS __attribute__((address_space(3)))
typedef unsigned short bf16_t;
typedef short bf16x8 __attribute__((ext_vector_type(8)));
typedef float f32x4 __attribute__((ext_vector_type(4)));
typedef unsigned u32x4 __attribute__((ext_vector_type(4)));
constexpr int BM = 256, BK = 64, HALF = 128, HTB = HALF * BK * 2  , STAGE_BYTES = 8 * HTB, NXCD = 8, WGM = WGM_SET;

__host__ __device__ __forceinline__ int lds_byte(int r, int c) { const int st = (r >> 4) * 2 + (c >> 5), rr = r & 15, cc = c & 31, ob = rr * 64 + cc * 2; return st * 1024 + (ob ^ (((ob >> 9) & 1) << 5)); }
__host__ __device__ __forceinline__ void stage_rc(int b, int& R, int& C) { const int st = b / 1024, sb = b % 1024, swz = sb ^ (((sb >> 9) & 1) << 5); R = (st >> 1) * 16 + swz / 64; C = (st & 1) * 32 + (swz % 64) / 2; }
__host__ __device__ __forceinline__ int perm32(int rho) { const int n = rho >> 4, i = rho & 15; return 8 * (i >> 2) + 4 * n + (i & 3); }

struct Unit { int pm, pn, e, i; };
struct Gemm { const bf16_t* A; const bf16_t* Bt; int K; long sAe, sBe; const int* gidx; int rowsPerE; const PG8_LAS unsigned short* ltab; };

struct Sched {
    int nM, nN, P, total, G, c, pm0;
    __device__ __forceinline__ void init(int nM_, int nN_, int nE_, int G_, int c_, int pm0_ = 0) { nM = nM_; nN = nN_; P = nM_ * nN_; total = P * nE_; G = G_; c = c_; pm0 = pm0_; }
    __device__ __forceinline__ bool next(int i, Unit& u) const {
        const long L = (long)i * G + c; if (L >= total) return false;
        const int e = (int)(L / P); int wgid = (int)(L % P);
        { const int q = P / NXCD, r = P % NXCD, xcd = wgid % NXCD, off = wgid / NXCD; wgid = (xcd < r ? xcd * (q + 1) : r * (q + 1) + (xcd - r) * q) + off; }
        const int nig = WGM * nN, gid = wgid / nig, fm = gid * WGM, gsz = (nM - fm) < WGM ? (nM - fm) : WGM;
        u.pm = pm0 + fm + ((wgid % nig) % gsz); u.pn = (wgid % nig) / gsz; u.e = e; u.i = i; return true;
    }
};

__device__ __forceinline__ unsigned cvt_pk_bf16(float lo, float hi) { unsigned r; asm volatile("v_cvt_pk_bf16_f32 %0, %1, %2" : "=v"(r) : "v"(lo), "v"(hi)); return r; }


#ifndef EPI_WT
#define EPI_WT 0
#endif
__device__ __forceinline__ void st16_u(void* p, u32x4 v) {
#if EPI_WT
    asm volatile("global_store_dwordx4 %0, %1, off sc1\n\ts_nop 2" :: "v"(p), "v"(v) : "memory");
#else
    *(u32x4*)p = v;
#endif
}
__device__ __forceinline__ void st16_f(void* p, f32x4 v) {
#if EPI_WT
    asm volatile("global_store_dwordx4 %0, %1, off sc1\n\ts_nop 2" :: "v"(p), "v"(v) : "memory");
#else
    *(f32x4*)p = v;
#endif
}
struct EpiBf16 {
    static constexpr int NST = 16;
    bf16_t* O; int ldc; long strideE; float scale;
    __device__ __forceinline__ void operator()(const f32x4 (&acc)[2][2][4][2], const Unit& u, int wr, int wc, int fr, int fq) const {
        const int row0 = u.pm * BM + wr * 64 + fr; const int col0 = u.pn * BM + wc * 32 + 8 * fq; bf16_t* base = O + (long)u.e * strideE;
#pragma unroll
        for (int ai = 0; ai < 2; ++ai)
#pragma unroll
            for (int m = 0; m < 4; ++m) { bf16_t* rowp = base + (size_t)(row0 + ai * HALF + m * 16) * ldc + col0;
#pragma unroll
                for (int bj = 0; bj < 2; ++bj) { const f32x4 v0 = acc[ai][bj][m][0] * scale, v1 = acc[ai][bj][m][1] * scale;
                    u32x4 w; w.x = cvt_pk_bf16(v0[0], v0[1]); w.y = cvt_pk_bf16(v0[2], v0[3]); w.z = cvt_pk_bf16(v1[0], v1[1]); w.w = cvt_pk_bf16(v1[2], v1[3]);
                    st16_u(rowp + bj * HALF, w); } }
    }
};
struct EpiResid {
    const float* xin; float* xout; int ldc; static constexpr int NST = 32;
    __device__ __forceinline__ void operator()(const f32x4 (&acc)[2][2][4][2], const Unit& u, int wr, int wc, int fr, int fq) const {
        const int row0 = u.pm * BM + wr * 64 + fr; const int col0 = u.pn * BM + wc * 32 + 8 * fq;
#pragma unroll
        for (int ai = 0; ai < 2; ++ai) { f32x4 r[4][2][2];
#pragma unroll
            for (int m = 0; m < 4; ++m) { const size_t ro = (size_t)(row0 + ai * HALF + m * 16) * ldc + col0;
#pragma unroll
                for (int bj = 0; bj < 2; ++bj) { r[m][bj][0] = *(const f32x4*)(xin + ro + bj * HALF); r[m][bj][1] = *(const f32x4*)(xin + ro + bj * HALF + 4); } }
#pragma unroll
            for (int m = 0; m < 4; ++m) { const size_t ro = (size_t)(row0 + ai * HALF + m * 16) * ldc + col0;
#pragma unroll
                for (int bj = 0; bj < 2; ++bj) { st16_f(xout + ro + bj * HALF, r[m][bj][0] + acc[ai][bj][m][0]); st16_f(xout + ro + bj * HALF + 4, r[m][bj][1] + acc[ai][bj][m][1]); } } }
    }
};
struct EpiResidX {
    const float* xin; float* xout; bf16_t* xb; float* part; int ldc; static constexpr int NST = 55;
    __device__ __forceinline__ void operator()(const f32x4 (&acc)[2][2][4][2], const Unit& u, int wr, int wc, int fr, int fq) const {
        const int row0 = u.pm * BM + wr * 64 + fr; const int col0 = u.pn * BM + wc * 32 + 8 * fq;
#pragma unroll
        for (int ai = 0; ai < 2; ++ai) { f32x4 r[4][2][2];
#pragma unroll
            for (int m = 0; m < 4; ++m) { const size_t ro = (size_t)(row0 + ai * HALF + m * 16) * ldc + col0;
#pragma unroll
                for (int bj = 0; bj < 2; ++bj) { r[m][bj][0] = *(const f32x4*)(xin + ro + bj * HALF); r[m][bj][1] = *(const f32x4*)(xin + ro + bj * HALF + 4); } }
#pragma unroll
            for (int m = 0; m < 4; ++m) { const int row = row0 + ai * HALF + m * 16; const size_t ro = (size_t)row * ldc + col0; float ss = 0.f;
#pragma unroll
                for (int bj = 0; bj < 2; ++bj) { const f32x4 n0 = r[m][bj][0] + acc[ai][bj][m][0], n1 = r[m][bj][1] + acc[ai][bj][m][1];
                    st16_f(xout + ro + bj * HALF, n0); st16_f(xout + ro + bj * HALF + 4, n1);
                    u32x4 w; w.x = cvt_pk_bf16(n0[0], n0[1]); w.y = cvt_pk_bf16(n0[2], n0[3]); w.z = cvt_pk_bf16(n1[0], n1[1]); w.w = cvt_pk_bf16(n1[2], n1[3]);
                    st16_u(xb + ro + bj * HALF, w);
                    ss += ((n0[0] * n0[0] + n0[1] * n0[1]) + (n0[2] * n0[2] + n0[3] * n0[3])) + ((n1[0] * n1[0] + n1[1] * n1[1]) + (n1[2] * n1[2] + n1[3] * n1[3])); }
                ss += __shfl_xor(ss, 16); ss += __shfl_xor(ss, 32);
                if (fq == 0) part[(size_t)row * 16 + u.pn * 4 + wc] = ss; } }
    }
};
struct EpiBf16S {
    bf16_t* O; int ldc; const PG8_LAS float* rs; static constexpr int NST = 16;
    __device__ __forceinline__ void operator()(const f32x4 (&acc)[2][2][4][2], const Unit& u, int wr, int wc, int fr, int fq) const {
        const int row0 = u.pm * BM + wr * 64 + fr; const int col0 = u.pn * BM + wc * 32 + 8 * fq;
        float rq[2][4];
#pragma unroll
        for (int ai = 0; ai < 2; ++ai)
#pragma unroll
            for (int m = 0; m < 4; ++m) rq[ai][m] = rs[u.i * BM + wr * 64 + fr + ai * HALF + m * 16];
#pragma unroll
        for (int ai = 0; ai < 2; ++ai)
#pragma unroll
            for (int m = 0; m < 4; ++m) { bf16_t* rowp = O + (size_t)(row0 + ai * HALF + m * 16) * ldc + col0;
#pragma unroll
                for (int bj = 0; bj < 2; ++bj) { const f32x4 v0 = acc[ai][bj][m][0] * rq[ai][m], v1 = acc[ai][bj][m][1] * rq[ai][m];
                    u32x4 w; w.x = cvt_pk_bf16(v0[0], v0[1]); w.y = cvt_pk_bf16(v0[2], v0[3]); w.z = cvt_pk_bf16(v1[0], v1[1]); w.w = cvt_pk_bf16(v1[2], v1[3]);
                    st16_u(rowp + bj * HALF, w); } }
    }
};
struct EpiResidB {
    const bf16_t* xin; bf16_t* xout; int ldc; static constexpr int NST = 16;
    __device__ __forceinline__ void operator()(const f32x4 (&acc)[2][2][4][2], const Unit& u, int wr, int wc, int fr, int fq) const {
        const int row0 = u.pm * BM + wr * 64 + fr; const int col0 = u.pn * BM + wc * 32 + 8 * fq;
#pragma unroll
        for (int ai = 0; ai < 2; ++ai) { u32x4 r[4][2];
#pragma unroll
            for (int m = 0; m < 4; ++m) { const size_t ro = (size_t)(row0 + ai * HALF + m * 16) * ldc + col0;
#pragma unroll
                for (int bj = 0; bj < 2; ++bj) r[m][bj] = *(const u32x4*)(xin + ro + bj * HALF); }
#pragma unroll
            for (int m = 0; m < 4; ++m) { const size_t ro = (size_t)(row0 + ai * HALF + m * 16) * ldc + col0;
#pragma unroll
                for (int bj = 0; bj < 2; ++bj) { const u32x4 q = r[m][bj];
                    const f32x4 n0 = (f32x4){__uint_as_float(q.x << 16), __uint_as_float(q.x & 0xffff0000u), __uint_as_float(q.y << 16), __uint_as_float(q.y & 0xffff0000u)} + acc[ai][bj][m][0];
                    const f32x4 n1 = (f32x4){__uint_as_float(q.z << 16), __uint_as_float(q.z & 0xffff0000u), __uint_as_float(q.w << 16), __uint_as_float(q.w & 0xffff0000u)} + acc[ai][bj][m][1];
                    u32x4 w; w.x = cvt_pk_bf16(n0[0], n0[1]); w.y = cvt_pk_bf16(n0[2], n0[3]); w.z = cvt_pk_bf16(n1[0], n1[1]); w.w = cvt_pk_bf16(n1[2], n1[3]);
                    st16_u(xout + ro + bj * HALF, w); } } }
    }
};
struct EpiResidXB {
    const bf16_t* xin; bf16_t* xout; float* part; int ldc; static constexpr int NST = 24;
    __device__ __forceinline__ void operator()(const f32x4 (&acc)[2][2][4][2], const Unit& u, int wr, int wc, int fr, int fq) const {
        const int row0 = u.pm * BM + wr * 64 + fr; const int col0 = u.pn * BM + wc * 32 + 8 * fq;
#pragma unroll
        for (int ai = 0; ai < 2; ++ai) { u32x4 r[4][2];
#pragma unroll
            for (int m = 0; m < 4; ++m) { const size_t ro = (size_t)(row0 + ai * HALF + m * 16) * ldc + col0;
#pragma unroll
                for (int bj = 0; bj < 2; ++bj) r[m][bj] = *(const u32x4*)(xin + ro + bj * HALF); }
#pragma unroll
            for (int m = 0; m < 4; ++m) { const int row = row0 + ai * HALF + m * 16; const size_t ro = (size_t)row * ldc + col0; float ss = 0.f;
#pragma unroll
                for (int bj = 0; bj < 2; ++bj) { const u32x4 q = r[m][bj];
                    const f32x4 n0 = (f32x4){__uint_as_float(q.x << 16), __uint_as_float(q.x & 0xffff0000u), __uint_as_float(q.y << 16), __uint_as_float(q.y & 0xffff0000u)} + acc[ai][bj][m][0];
                    const f32x4 n1 = (f32x4){__uint_as_float(q.z << 16), __uint_as_float(q.z & 0xffff0000u), __uint_as_float(q.w << 16), __uint_as_float(q.w & 0xffff0000u)} + acc[ai][bj][m][1];
                    u32x4 w; w.x = cvt_pk_bf16(n0[0], n0[1]); w.y = cvt_pk_bf16(n0[2], n0[3]); w.z = cvt_pk_bf16(n1[0], n1[1]); w.w = cvt_pk_bf16(n1[2], n1[3]);
                    st16_u(xout + ro + bj * HALF, w);
                    ss += ((n0[0] * n0[0] + n0[1] * n0[1]) + (n0[2] * n0[2] + n0[3] * n0[3])) + ((n1[0] * n1[0] + n1[1] * n1[1]) + (n1[2] * n1[2] + n1[3] * n1[3])); }
                ss += __shfl_xor(ss, 16); ss += __shfl_xor(ss, 32);
                if (fq == 0) part[(size_t)row * 16 + u.pn * 4 + wc] = ss; } }
    }
};
struct EpiBf16R {
    bf16_t* O; int ldc; float scale; const float* part; float eps; static constexpr int NST = 16;
    __device__ __forceinline__ void operator()(const f32x4 (&acc)[2][2][4][2], const Unit& u, int wr, int wc, int fr, int fq) const {
        const int row0 = u.pm * BM + wr * 64 + fr; const int col0 = u.pn * BM + wc * 32 + 8 * fq;
        f32x4 pq[2][4];
#pragma unroll
        for (int ai = 0; ai < 2; ++ai)
#pragma unroll
            for (int m = 0; m < 4; ++m) pq[ai][m] = *(const f32x4*)(part + (size_t)(row0 + ai * HALF + m * 16) * 16 + 4 * fq);
#pragma unroll
        for (int ai = 0; ai < 2; ++ai)
#pragma unroll
            for (int m = 0; m < 4; ++m) { const int row = row0 + ai * HALF + m * 16; const f32x4 p = pq[ai][m];
                float sq = (p[0] + p[1]) + (p[2] + p[3]); sq += __shfl_xor(sq, 16); sq += __shfl_xor(sq, 32);
                const float rs = scale * __builtin_amdgcn_rsqf(sq * (1.0f / 1024.0f) + eps);
                bf16_t* rowp = O + (size_t)row * ldc + col0;
#pragma unroll
                for (int bj = 0; bj < 2; ++bj) { const f32x4 v0 = acc[ai][bj][m][0] * rs, v1 = acc[ai][bj][m][1] * rs;
                    u32x4 w; w.x = cvt_pk_bf16(v0[0], v0[1]); w.y = cvt_pk_bf16(v0[2], v0[3]); w.z = cvt_pk_bf16(v1[0], v1[1]); w.w = cvt_pk_bf16(v1[2], v1[3]);
                    st16_u(rowp + bj * HALF, w); } }
    }
};
__device__ __forceinline__ float silu_f(float x) { return x * __builtin_amdgcn_rcpf(1.0f + __builtin_amdgcn_exp2f(-1.4426950408889634f * x)); }
struct EpiSwiGLU {
    bf16_t* O; int ldc; int rowsPerE; const PG8_LAS float* rs; static constexpr int NST = 8;
    __device__ __forceinline__ void operator()(const f32x4 (&acc)[2][2][4][2], const Unit& u, int wr, int wc, int fr, int fq) const {
        const int row0 = u.e * rowsPerE + u.pm * BM + wr * 64 + fr; const int col0 = u.pn * HALF + wc * 32 + 8 * fq;
        float rq[2][4];
#pragma unroll
        for (int ai = 0; ai < 2; ++ai)
#pragma unroll
            for (int m = 0; m < 4; ++m) rq[ai][m] = rs[u.i * BM + wr * 64 + fr + ai * HALF + m * 16];
#pragma unroll
        for (int ai = 0; ai < 2; ++ai)
#pragma unroll
            for (int m = 0; m < 4; ++m) { bf16_t* rowp = O + (size_t)(row0 + ai * HALF + m * 16) * ldc + col0; const float r = rq[ai][m];
                const f32x4 g0 = acc[ai][0][m][0] * r, g1 = acc[ai][0][m][1] * r, u0 = acc[ai][1][m][0] * r, u1 = acc[ai][1][m][1] * r;
                u32x4 w; w.x = cvt_pk_bf16(silu_f(g0[0]) * u0[0], silu_f(g0[1]) * u0[1]); w.y = cvt_pk_bf16(silu_f(g0[2]) * u0[2], silu_f(g0[3]) * u0[3]);
                w.z = cvt_pk_bf16(silu_f(g1[0]) * u1[0], silu_f(g1[1]) * u1[1]); w.w = cvt_pk_bf16(silu_f(g1[2]) * u1[2], silu_f(g1[3]) * u1[3]);
                st16_u(rowp, w); }
    }
};
struct EpiDown {
    bf16_t* O; int ldc; int rowsPerE; const PG8_LAS float* gate; static constexpr int NST = 16;
    __device__ __forceinline__ void operator()(const f32x4 (&acc)[2][2][4][2], const Unit& u, int wr, int wc, int fr, int fq) const {
        const int row0 = u.e * rowsPerE + u.pm * BM + wr * 64 + fr; const int col0 = u.pn * BM + wc * 32 + 8 * fq;
        float gt[2][4];
#pragma unroll
        for (int ai = 0; ai < 2; ++ai)
#pragma unroll
            for (int m = 0; m < 4; ++m) gt[ai][m] = gate[u.i * BM + wr * 64 + fr + ai * HALF + m * 16];
#pragma unroll
        for (int ai = 0; ai < 2; ++ai)
#pragma unroll
            for (int m = 0; m < 4; ++m) { const int row = row0 + ai * HALF + m * 16; bf16_t* rowp = O + (size_t)row * ldc + col0;
#pragma unroll
                for (int bj = 0; bj < 2; ++bj) { const f32x4 v0 = acc[ai][bj][m][0] * gt[ai][m], v1 = acc[ai][bj][m][1] * gt[ai][m];
                    u32x4 w; w.x = cvt_pk_bf16(v0[0], v0[1]); w.y = cvt_pk_bf16(v0[2], v0[3]); w.z = cvt_pk_bf16(v1[0], v1[1]); w.w = cvt_pk_bf16(v1[2], v1[3]);
                    st16_u(rowp + bj * HALF, w); } }
    }
};

typedef int i32x4 __attribute__((ext_vector_type(4)));
constexpr int TAB_MAXU = 16;
__device__ __forceinline__ void gather_table(PG8_LAS unsigned short* ltab, const int* gidx, int rowsPerE, const Sched& S, int maxu, PG8_LAS float* rtab, const float* rsrc) {
    const int tid = opaque_tid(), i = tid >> 5, r = (tid & 31) * 8; Unit u;
    if (i < maxu && S.next(i, u)) { const size_t o = (size_t)u.e * rowsPerE + u.pm * BM + r;
        const i32x4 g0 = *(const i32x4*)(gidx + o), g1 = *(const i32x4*)(gidx + o + 4); const f32x4 r0 = *(const f32x4*)(rsrc + o), r1 = *(const f32x4*)(rsrc + o + 4);
        u32x4 pk; pk.x = (unsigned)g0.x | ((unsigned)g0.y << 16); pk.y = (unsigned)g0.z | ((unsigned)g0.w << 16); pk.z = (unsigned)g1.x | ((unsigned)g1.y << 16); pk.w = (unsigned)g1.z | ((unsigned)g1.w << 16);
        *(PG8_LAS u32x4*)(ltab + i * BM + r) = pk; *(PG8_LAS f32x4*)(rtab + i * BM + r) = r0; *(PG8_LAS f32x4*)(rtab + i * BM + r + 4) = r1; }
    __syncthreads();
}
__device__ __forceinline__ void row_table(PG8_LAS float* tab, const float* src, int rowsPerE, const Sched& S, int maxu) {
    const int tid = opaque_tid(), i = tid >> 5, r = (tid & 31) * 8; Unit u;
    if (i < maxu && S.next(i, u)) { const size_t o = (size_t)u.e * rowsPerE + u.pm * BM + r; const f32x4 r0 = *(const f32x4*)(src + o), r1 = *(const f32x4*)(src + o + 4);
        *(PG8_LAS f32x4*)(tab + i * BM + r) = r0; *(PG8_LAS f32x4*)(tab + i * BM + r + 4) = r1; }
    __syncthreads();
}
template <class Epi, bool ALIGN_EPI, bool GATHER>
__device__ __forceinline__ void gemm_phase(PG8_LAS unsigned char* lds, const Gemm g, const Sched& S, const Epi& E) {
    const int tid = opaque_tid(), wid = __builtin_amdgcn_readfirstlane(tid >> 6), lane = tid & 63, wr = wid >> 2, wc = wid & 3, fr = lane & 15, fq = lane >> 4;
    const int K = g.K, nt = K / BK;
    int Rr[2], Cc[2]; unsigned voffB[2];
#pragma unroll
    for (int i = 0; i < 2; ++i) { stage_rc(tid * 16 + i * 8192, Rr[i], Cc[i]); const int Rb = (Rr[i] & ~31) + perm32(Rr[i] & 31); voffB[i] = (unsigned)(Rb * K + Cc[i]) * 2u; }
    const size_t kstep = (size_t)(BK * 2);
    const size_t hstep = (size_t)HALF * K * 2;
    const size_t tstep = 2 * hstep;
    const unsigned ldsw = (unsigned)wid * 1024u;
    const int aoff = lds_byte(wr * 64 + fr, fq * 8), boff = lds_byte(wc * 32 + fr, fq * 8);
#define PG8_SA(b, h) (((b) * 2 + (h)) * HTB)
#define PG8_SB(b, h) ((4 + (b) * 2 + (h)) * HTB)
#define PG8_STAGE(bufoff, gbase, voff) do { _Pragma("unroll") for (int _i = 0; _i < 2; ++_i) \
        __builtin_amdgcn_global_load_lds((const unsigned*)((const char*)(gbase) + (voff)[_i]), (PG8_LAS unsigned*)(lds + (bufoff) + ldsw + _i * 8192), 16, 0, 0); } while (0)
#define PG8_LDA(dst, b, h) do { _Pragma("unroll") for (int m = 0; m < 4; ++m) _Pragma("unroll") for (int k = 0; k < 2; ++k) dst[m][k] = *(const PG8_LAS bf16x8*)(lds + PG8_SA(b, h) + aoff + m * 2048 + k * 1024); } while (0)
#define PG8_LDB(dst, b, h) do { _Pragma("unroll") for (int n = 0; n < 2; ++n) _Pragma("unroll") for (int k = 0; k < 2; ++k) dst[n][k] = *(const PG8_LAS bf16x8*)(lds + PG8_SB(b, h) + boff + n * 2048 + k * 1024); } while (0)
#define PG8_MMA(ai, bj, At, Bt) do { __builtin_amdgcn_s_setprio(1); _Pragma("unroll") for (int m = 0; m < 4; ++m) _Pragma("unroll") for (int n = 0; n < 2; ++n) _Pragma("unroll") for (int k = 0; k < 2; ++k) \
        acc[ai][bj][m][n] = __builtin_amdgcn_mfma_f32_16x16x32_bf16(Bt[n][k], At[m][k], acc[ai][bj][m][n], 0, 0, 0); __builtin_amdgcn_s_setprio(0); } while (0)
#define PG8_WAIT_V(n) asm volatile("s_waitcnt vmcnt(" #n ")" ::: "memory")
#define PG8_WAIT_L(n) asm volatile("s_waitcnt lgkmcnt(" #n ")" ::: "memory")
#define PG8_WAIT_VR(flag, n) asm volatile("s_cmp_lg_u32 %0, 0\n\ts_cbranch_scc1 .Lrlx%=\n\ts_waitcnt vmcnt(8)\n.Lrlx%=:\n\ts_waitcnt vmcnt(%1)" :: "s"(flag), "n"(n) : "memory", "scc")
#define PG8_BAR __builtin_amdgcn_s_barrier()
#define PG8_SCHED __builtin_amdgcn_sched_barrier(0)
#define PG8_AOFF(dst, un, uidx) do { _Pragma("unroll") for (int _h = 0; _h < 2; ++_h) _Pragma("unroll") for (int _i = 0; _i < 2; ++_i) { \
        if constexpr (GATHER) { const int _row = g.ltab[(uidx) * BM + _h * HALF + Rr[_i]]; dst[_h][_i] = (unsigned)(_row * K + Cc[_i]) * 2u; } \
        else dst[_h][_i] = (unsigned)((Rr[_i] + _h * HALF) * K + Cc[_i]) * 2u; } } while (0)
#define PG8_ABASE(un) (GATHER ? (const char*)g.A : (const char*)g.A + ((size_t)(un).e * g.sAe) * 2 + (size_t)(un).pm * tstep)
#define PG8_BBASE(un) ((const char*)g.Bt + ((size_t)(un).e * g.sBe) * 2 + (size_t)(un).pn * tstep)
    Unit cur, nxt; int ui = 0;
    if (!S.next(0, cur)) return;
    f32x4 acc[2][2][4][2];
#pragma unroll
    for (int a = 0; a < 2; ++a)
#pragma unroll
        for (int b = 0; b < 2; ++b)
#pragma unroll
            for (int m = 0; m < 4; ++m)
#pragma unroll
                for (int n = 0; n < 2; ++n) acc[a][b][m][n] = (f32x4){0.f, 0.f, 0.f, 0.f};
    bf16x8 At[4][2], B0[2][2], B1[2][2];
    unsigned vC[2][2], vN[2][2];
    PG8_AOFF(vC, cur, 0);
#pragma unroll
    for (int _h = 0; _h < 2; ++_h) { vN[_h][0] = vC[_h][0]; vN[_h][1] = vC[_h][1]; }
    const char* cA = PG8_ABASE(cur); const char* cB = PG8_BBASE(cur);
    PG8_STAGE(PG8_SB(0, 0), cB, voffB); PG8_STAGE(PG8_SB(0, 1), cB + hstep, voffB); PG8_STAGE(PG8_SA(0, 0), cA, vC[0]); PG8_STAGE(PG8_SA(0, 1), cA, vC[1]);
    if (wr == 1) PG8_BAR;
    PG8_WAIT_V(2); PG8_BAR;
    PG8_STAGE(PG8_SB(1, 0), cB + kstep, voffB); PG8_STAGE(PG8_SA(1, 0), cA + kstep, vC[0]); PG8_STAGE(PG8_SB(1, 1), cB + hstep + kstep, voffB);
    PG8_WAIT_V(6); PG8_BAR;
    for (;;) {
        const bool has_next = S.next(ui + 1, nxt);
        const char* nA = has_next ? PG8_ABASE(nxt) : cA; const char* nB = has_next ? PG8_BBASE(nxt) : cB;
        if constexpr (GATHER) { if (has_next) { PG8_AOFF(vN, nxt, ui + 1); } else {
#pragma unroll
            for (int _h = 0; _h < 2; ++_h) { vN[_h][0] = vC[_h][0]; vN[_h][1] = vC[_h][1]; } } }
        for (int t = 0; t < nt; t += 2) {
            const bool last = (t == nt - 2);
            const char* a1 = cA + (size_t)(t + 1) * kstep;
            const char* a2 = last ? nA : cA + (size_t)(t + 2) * kstep; const char* b2 = last ? nB : cB + (size_t)(t + 2) * kstep;
            const char* a3 = a2 + kstep; const char* b3 = b2 + kstep;
            unsigned v2[2][2];
#pragma unroll
            for (int _h = 0; _h < 2; ++_h)
#pragma unroll
                for (int _i = 0; _i < 2; ++_i) { if constexpr (GATHER) v2[_h][_i] = last ? vN[_h][_i] : vC[_h][_i]; else v2[_h][_i] = vC[_h][_i]; }
            const int relax = __builtin_amdgcn_readfirstlane(((t == 0) && (ui > 0)) ? 1 : 0);
            PG8_LDB(B0, 0, 0); PG8_LDB(B1, 0, 1); PG8_SCHED; PG8_LDA(At, 0, 0); PG8_STAGE(PG8_SA(1, 1), a1, vC[1]);
            PG8_WAIT_VR(relax, 8 + Epi::NST);
            PG8_WAIT_L(0); PG8_BAR; PG8_MMA(0, 0, At, B0); PG8_MMA(0, 1, At, B1); PG8_BAR; PG8_SCHED;
            PG8_LDA(At, 0, 1); PG8_STAGE(PG8_SB(0, 0), b2, voffB); PG8_STAGE(PG8_SB(0, 1), b2 + hstep, voffB); PG8_STAGE(PG8_SA(0, 0), a2, v2[0]);
            PG8_WAIT_VR(relax, 8 + Epi::NST);
            PG8_WAIT_L(0); PG8_BAR; PG8_MMA(1, 0, At, B0); PG8_MMA(1, 1, At, B1); PG8_BAR; PG8_SCHED;
            PG8_LDB(B0, 1, 0); PG8_LDB(B1, 1, 1); PG8_SCHED; PG8_LDA(At, 1, 0); PG8_STAGE(PG8_SA(0, 1), a2, v2[1]);
            PG8_WAIT_V(8); PG8_WAIT_L(0); PG8_BAR; PG8_MMA(0, 0, At, B0); PG8_MMA(0, 1, At, B1); PG8_BAR; PG8_SCHED;
            PG8_LDA(At, 1, 1); PG8_STAGE(PG8_SB(1, 0), b3, voffB); PG8_STAGE(PG8_SB(1, 1), b3 + hstep, voffB); PG8_STAGE(PG8_SA(1, 0), a3, v2[0]);
            PG8_WAIT_V(8); PG8_WAIT_L(0); PG8_BAR; PG8_MMA(1, 0, At, B0); PG8_MMA(1, 1, At, B1); PG8_BAR; PG8_SCHED;
        }
        if constexpr (ALIGN_EPI) { if (wr == 0) PG8_BAR; }
        E(acc, cur, wr, wc, fr, fq);
        if (!has_next) break;
#pragma unroll
        for (int a = 0; a < 2; ++a)
#pragma unroll
            for (int b = 0; b < 2; ++b)
#pragma unroll
                for (int m = 0; m < 4; ++m)
#pragma unroll
                    for (int n = 0; n < 2; ++n) acc[a][b][m][n] = (f32x4){0.f, 0.f, 0.f, 0.f};
        cur = nxt; cA = nA; cB = nB; ++ui;
#pragma unroll
        for (int _h = 0; _h < 2; ++_h) { vC[_h][0] = vN[_h][0]; vC[_h][1] = vN[_h][1]; }
        if constexpr (ALIGN_EPI) { if (wr == 1) PG8_BAR; }
    }
    PG8_WAIT_V(0);
    if constexpr (!ALIGN_EPI) { if (wr == 0) PG8_BAR; }
    PG8_BAR;
#undef PG8_SA
#undef PG8_SB
#undef PG8_STAGE
#undef PG8_LDA
#undef PG8_LDB
#undef PG8_MMA
#undef PG8_WAIT_V
#undef PG8_WAIT_L
#undef PG8_WAIT_VR
#undef PG8_BAR
#undef PG8_SCHED
#undef PG8_AOFF
#undef PG8_ABASE
#undef PG8_BBASE
}
}
namespace attn_body {
using bf16=__hip_bfloat16;
using bf16x8=__attribute__((ext_vector_type(8)))short;
using s16x4=__attribute__((ext_vector_type(4)))short;
using f32x16=__attribute__((ext_vector_type(16)))float;
using u32x4=__attribute__((ext_vector_type(4)))unsigned;
constexpr int SEQ=4096,D=64,QP=2048,KP=2048,VP=2048,OP=1024;
constexpr int NW=8,QBLK=32,QB=QBLK*NW,KVBLK=64;
constexpr int ATTN_UNIT_ROWS=QB;
__device__ __forceinline__ int crow(int r,int hi){return (r&3)+8*(r>>2)+4*hi;}
#define SBAR() __builtin_amdgcn_sched_barrier(0)
__device__ __forceinline__ void cmask(f32x16&p0,f32x16&p1,int jb,int qrel,int hi){
  const float NEG=-INFINITY; int kb=64*jb+4*hi;
  #pragma unroll
  for(int r=0;r<16;++r){int kv=kb+(r&3)+8*(r>>2); if(kv>qrel)p0[r]=NEG; if(kv+32>qrel)p1[r]=NEG;}
}

#ifndef MAXCHK
#define MAXCHK 8
#endif
constexpr int NSLOT=3, SLOTB=8192;
constexpr int LDS_K=0, LDS_V=NSLOT*SLOTB, LDS_WS=2*NSLOT*SLOTB, LDS_OST=LDS_WS+NW*64*4, LDS_BYTES=LDS_OST+NW*4096;
constexpr float C2=0.125f*1.4426950408889634f;
__device__ __forceinline__ void glds16(const void*gsrc,unsigned lds_dst){unsigned keep;
  asm volatile("s_mov_b32 %0, m0\n\ts_mov_b32 m0, %2\n\ts_nop 0\n\tglobal_load_lds_dwordx4 %1, off\n\ts_mov_b32 m0, %0":"=&s"(keep):"v"(gsrc),"s"(lds_dst):"memory");}
__device__ __forceinline__ float max3f(float a,float b,float c){float r;asm("v_max3_f32 %0, %1, %2, %3":"=v"(r):"v"(a),"v"(b),"v"(c));return r;}
__device__ __forceinline__ float max2f(float a,float b){float r;asm("v_max_f32_e32 %0, %1, %2":"=v"(r):"v"(a),"v"(b));return r;}
__device__ __forceinline__ float fadd_s(float a,float b){float r;asm("v_add_f32_e32 %0, %1, %2":"=v"(r):"v"(a),"v"(b));return r;}
__device__ __forceinline__ float fsub_s(float a,float b){float r;asm("v_sub_f32_e32 %0, %1, %2":"=v"(r):"v"(a),"v"(b));return r;}
typedef float f32x2_t __attribute__((ext_vector_type(2))); typedef __bf16 bf16x2_t __attribute__((ext_vector_type(2)));
__device__ __forceinline__ unsigned cvtpk_s(float lo,float hi){f32x2_t v={lo,hi};bf16x2_t b=__builtin_convertvector(v,bf16x2_t);return __builtin_bit_cast(unsigned,b);}
#define WAIT_BAR(N) asm volatile("s_waitcnt vmcnt(" #N ") lgkmcnt(0)\n\ts_barrier":::"memory")

__device__ __forceinline__ void qkt(f32x16&p0,f32x16&p1,const char*Kslot,const bf16x8*qr,const f32x16&negm,int r32,int hi){
  const char*kb=Kslot+hi*1024+r32*16;
  #pragma unroll
  for(int d0=0;d0<4;++d0){
    const bf16x8 b0=*reinterpret_cast<const bf16x8*>(kb+d0*2048);
    const bf16x8 b1=*reinterpret_cast<const bf16x8*>(kb+d0*2048+512);
    if(d0==0){p0=__builtin_amdgcn_mfma_f32_32x32x16_bf16(b0,qr[0],negm,0,0,0);p1=__builtin_amdgcn_mfma_f32_32x32x16_bf16(b1,qr[0],negm,0,0,0);}
    else{p0=__builtin_amdgcn_mfma_f32_32x32x16_bf16(b0,qr[d0],p0,0,0,0);p1=__builtin_amdgcn_mfma_f32_32x32x16_bf16(b1,qr[d0],p1,0,0,0);}}
}
typedef __attribute__((address_space(3))) const char* lds_cptr;
typedef short v4i16_t __attribute__((ext_vector_type(4)));
__device__ __forceinline__ void kload8(bf16x8*kf,lds_cptr kp){
  kf[0]=*(const __attribute__((address_space(3))) bf16x8*)(kp);      kf[1]=*(const __attribute__((address_space(3))) bf16x8*)(kp+512);
  kf[2]=*(const __attribute__((address_space(3))) bf16x8*)(kp+2048); kf[3]=*(const __attribute__((address_space(3))) bf16x8*)(kp+2560);
  kf[4]=*(const __attribute__((address_space(3))) bf16x8*)(kp+4096); kf[5]=*(const __attribute__((address_space(3))) bf16x8*)(kp+4608);
  kf[6]=*(const __attribute__((address_space(3))) bf16x8*)(kp+6144); kf[7]=*(const __attribute__((address_space(3))) bf16x8*)(kp+6656);
}
__device__ __forceinline__ void kload2(bf16x8*kf,lds_cptr kp,int j){ kf[2*j]=*(const __attribute__((address_space(3))) bf16x8*)(kp+j*2048); kf[2*j+1]=*(const __attribute__((address_space(3))) bf16x8*)(kp+j*2048+512); }
__device__ __forceinline__ s16x4 vtr(lds_cptr p){ return __builtin_bit_cast(s16x4,__builtin_amdgcn_ds_read_tr16_b64_v4i16((__attribute__((address_space(3))) v4i16_t*)p)); }
__device__ __forceinline__ float rowmax(const f32x16&p0,const f32x16&p1){
  float a=max3f(p0[0],p0[1],p1[0]),b=max3f(p0[2],p0[3],p1[1]);a=max3f(a,p1[2],p1[3]);
  #pragma unroll
  for(int r=4;r<16;r+=4){a=max3f(a,p0[r],p0[r+1]);b=max3f(b,p0[r+2],p0[r+3]);a=max3f(a,p1[r],p1[r+1]);b=max3f(b,p1[r+2],p1[r+3]);}
  const float m=max2f(a,b);
  auto rr=__builtin_amdgcn_permlane32_swap(__float_as_uint(m),__float_as_uint(m),false,false);
  return max2f(__uint_as_float(rr[0]),__uint_as_float(rr[1]));
}
__device__ __forceinline__ void pv(f32x16*o,int vb,bf16x8 pa0,bf16x8 pa1,bf16x8 pa2,bf16x8 pa3){
  #pragma unroll
  for(int d0=0;d0<2;++d0){s16x4 lo[4],hi[4];
    #pragma unroll
    for(int ks=0;ks<4;++ks){
      asm volatile("ds_read_b64_tr_b16 %0,%1 offset:%c2":"=&v"(lo[ks]):"v"(vb),"i"(d0*4096+ks*1024):"memory");
      asm volatile("ds_read_b64_tr_b16 %0,%1 offset:%c2":"=&v"(hi[ks]):"v"(vb),"i"(d0*4096+ks*1024+512):"memory");}
    asm volatile("s_waitcnt lgkmcnt(0)":::"memory");SBAR();
    #define PK(k) (bf16x8){lo[k][0],lo[k][1],lo[k][2],lo[k][3],hi[k][0],hi[k][1],hi[k][2],hi[k][3]}
    o[d0]=__builtin_amdgcn_mfma_f32_32x32x16_bf16(pa0,PK(0),o[d0],0,0,0);
    o[d0]=__builtin_amdgcn_mfma_f32_32x32x16_bf16(pa1,PK(1),o[d0],0,0,0);
    o[d0]=__builtin_amdgcn_mfma_f32_32x32x16_bf16(pa2,PK(2),o[d0],0,0,0);
    o[d0]=__builtin_amdgcn_mfma_f32_32x32x16_bf16(pa3,PK(3),o[d0],0,0,0);
    #undef PK
  }
}

#ifndef ATTN_STORE16
#define ATTN_STORE16(p,v) (*(u32x4*)(p)=(v))
#endif
template<int THRL> __device__ __forceinline__ void attn_unit(long rowbase,int q0,const bf16*Qh,const bf16*__restrict__ Kh,const bf16*__restrict__ Vh,bf16*Oh,char*shm){
  const int tid=opaque_tid(),lane=tid&63,r32=lane&31,hi=lane>>5; const int wid=__builtin_amdgcn_readfirstlane(tid>>6);
  const bf16*Qw=Qh+(rowbase+q0+wid*QBLK)*QP;
  const bf16*Kb=Kh+rowbase*KP,*Vb=Vh+rowbase*VP;
  const unsigned lds0=(unsigned)(uintptr_t)shm;
  float*wsf=(float*)(shm+LDS_WS)+wid*64;
  const bf16*ksrc=Kb+(long)lane*KP+wid*8;
  const bf16*vsrc=Vb+(long)(16*(wid&3)+(lane>>2))*VP+(wid>>2)*32+(lane&3)*8;
  const unsigned kdst=lds0+LDS_K+wid*1024, vdst=lds0+LDS_V+wid*1024;
  #define DMA_K(t,slot) glds16(ksrc+(long)(t)*KVBLK*KP,(unsigned)__builtin_amdgcn_readfirstlane(kdst+(slot)))
  #define DMA_V(t,slot) glds16(vsrc+(long)(t)*KVBLK*VP,(unsigned)__builtin_amdgcn_readfirstlane(vdst+(slot)))
  const int vb0=(int)(lds0+LDS_V)+((lane>>4)&1)*32+(lane&3)*8+(4*hi+((lane&15)>>2))*64;
  const char*Kbase=shm+LDS_K; bf16x8 kf[8];
  const lds_cptr shm3=(lds_cptr)shm; const lds_cptr kp0=shm3+LDS_K+hi*1024+r32*16; const lds_cptr vp0=shm3+LDS_V+((lane>>4)&1)*32+(lane&3)*8+(4*hi+((lane&15)>>2))*64;
  constexpr int NT=SEQ/KVBLK;
  DMA_K(0,0);DMA_V(0,0);DMA_K(1,SLOTB);
  bf16x8 qr[4];
  #pragma unroll
  for(int d0=0;d0<4;++d0)qr[d0]=*reinterpret_cast<const bf16x8*>(&Qw[(long)r32*QP+d0*16+hi*8]);
  float mhat=0.f,l_reg=0.f;f32x16 o[2];o[0]=f32x16{};o[1]=f32x16{};f32x16 negm=f32x16{};asm volatile("":"+v"(negm));
  const int qrel=wid*QBLK+r32;
  #define CMASK(P0,P1,t) do{}while(0)
  bool resc=false;
  #define START(P0,P1) do{ const float rm=rowmax(P0,P1); resc=false; \
    { const float dl=rm; mhat=fadd_s(mhat,dl); \
      _Pragma("unroll") for(int r=0;r<16;++r){P0[r]=fsub_s(P0[r],dl);P1[r]=fsub_s(P1[r],dl);} \
      _Pragma("unroll") for(int r=0;r<16;++r)negm[r]=-mhat; asm volatile("":"+v"(negm)); } \
    _Pragma("unroll") for(int r=0;r<16;++r)P0[r]=__builtin_amdgcn_exp2f(P0[r]); }while(0)
  #define RESC() do{ if(resc){ asm volatile("s_waitcnt lgkmcnt(0)":::"memory"); \
      _Pragma("unroll") for(int d_=0;d_<2;++d_) _Pragma("unroll") for(int r=0;r<16;++r)o[d_][r]*=wsf[crow(r,hi)]; } }while(0)
  f32x16 pA0,pA1,pB0,pB1;
  int sl_prev=0,sl_cur=0,sl_next=SLOTB;
  #define ROT() do{sl_prev=sl_cur;sl_cur=sl_next;sl_next=(sl_next==(NSLOT-1)*SLOTB)?0:sl_next+SLOTB;}while(0)
  DMA_K(2,2*SLOTB);
  WAIT_BAR(3);
  qkt(pA0,pA1,Kbase,qr,negm,r32,hi);asm volatile("s_nop 15\n\ts_nop 7":"+v"(pA0),"+v"(pA1));CMASK(pA0,pA1,0);
  START(pA0,pA1);
  _Pragma("unroll") for(int r=0;r<16;++r)pA1[r]=__builtin_amdgcn_exp2f(pA1[r]);
  WAIT_BAR(0);
  DMA_K(3,0);DMA_V(1,SLOTB);
  ROT();
  kload8(kf,kp0+sl_cur);
  WAIT_BAR(2);
  s16x4 vlo[8],vhi[8]; u32x4 pw0,pw1,pw2,pw3;
  #define PKW(P,B) cvtpk_s(P[B],P[B+1])
  #define PAF(k) __builtin_bit_cast(bf16x8,pw##k)
  #define VFR(i) (bf16x8){vlo[i][0],vlo[i][1],vlo[i][2],vlo[i][3],vhi[i][0],vhi[i][1],vhi[i][2],vhi[i][3]}
  #define PIN(x) asm volatile("":"+v"(x))
  #define MX3(a,b,c) __builtin_fmaxf(__builtin_fmaxf((a),(b)),(c))
  #define GAPA(MF,A0,A1,A2,A3,W0,W1,PW) do{ MF; sacc+=A0; sacc+=A1; sacc+=A2; sacc+=A3; PIN(sacc); W0; W1; PIN(PW); SBAR(); }while(0)
  #define EX(v) __builtin_amdgcn_exp2f(v)
  #define GAPB(MF,X,B) do{ MF; X[B]=EX(X[B]); X[B+1]=EX(X[B+1]); X[B+2]=EX(X[B+2]); X[B+3]=EX(X[B+3]); PIN(X); SBAR(); }while(0)
  #define VRD(i) do{ vlo[i]=vtr(vp_+(((i)>>2)*4096+((i)&3)*1024)); vhi[i]=vtr(vp_+(((i)>>2)*4096+((i)&3)*1024+512)); }while(0)
  #define KRD(G,j) do{ if(G){ kload2(kf,kp0+sl_next,j); SBAR(); } }while(0)
  #define STEP(C0,C1,P0,P1,t,GK,GV,GL) do{ SBAR(); \
    const lds_cptr vp_=vp0+sl_prev; \
    VRD(0); SBAR(); float sacc=(P0[0]+P0[1]); \
    GAPA(C0=__builtin_amdgcn_mfma_f32_32x32x16_bf16(kf[0],qr[0],negm,0,0,0), P0[2],P0[3],P0[4],P0[5],     pw0[0]=PKW(P0,0), pw0[1]=PKW(P0,2), pw0); \
    VRD(4); SBAR(); GAPA(C1=__builtin_amdgcn_mfma_f32_32x32x16_bf16(kf[1],qr[0],negm,0,0,0), P0[6],P0[7],P0[8],P0[9],     pw0[2]=PKW(P0,4), pw0[3]=PKW(P0,6), pw0); \
    VRD(1); SBAR(); GAPA(C0=__builtin_amdgcn_mfma_f32_32x32x16_bf16(kf[2],qr[1],C0,0,0,0),   P0[10],P0[11],P0[12],P0[13], pw1[0]=PKW(P0,8), pw1[1]=PKW(P0,10), pw1); \
    VRD(5); SBAR(); GAPA(C1=__builtin_amdgcn_mfma_f32_32x32x16_bf16(kf[3],qr[1],C1,0,0,0),   P0[14],P0[15],P1[0],P1[1],   pw1[2]=PKW(P0,12),pw1[3]=PKW(P0,14), pw1); \
    VRD(2); SBAR(); GAPA(C0=__builtin_amdgcn_mfma_f32_32x32x16_bf16(kf[4],qr[2],C0,0,0,0),   P1[2],P1[3],P1[4],P1[5],     pw2[0]=PKW(P1,0), pw2[1]=PKW(P1,2), pw2); \
    VRD(6); SBAR(); GAPA(C1=__builtin_amdgcn_mfma_f32_32x32x16_bf16(kf[5],qr[2],C1,0,0,0),   P1[6],P1[7],P1[8],P1[9],     pw2[2]=PKW(P1,4), pw2[3]=PKW(P1,6), pw2); \
    VRD(3); SBAR(); GAPA(C0=__builtin_amdgcn_mfma_f32_32x32x16_bf16(kf[6],qr[3],C0,0,0,0),   P1[10],P1[11],P1[12],P1[13], pw3[0]=PKW(P1,8), pw3[1]=PKW(P1,10), pw3); \
    VRD(7); SBAR(); GAPA(C1=__builtin_amdgcn_mfma_f32_32x32x16_bf16(kf[7],qr[3],C1,0,0,0),   P1[14],P1[15],0.f,0.f,       pw3[2]=PKW(P1,12),pw3[3]=PKW(P1,14), pw3); \
    l_reg+=sacc; \
    if(GK){DMA_K((t)+3,sl_cur);} if(GV){DMA_V((t)+1,sl_next);} \
    CMASK(C0,C1,t); \
    resc=false; \
    if((((t)&(MAXCHK-1))==0)){ float a=MX3(C0[0],C0[1],C1[0]),b=MX3(C0[2],C0[3],C1[1]); a=MX3(a,C1[2],C1[3]); \
      _Pragma("unroll") for(int r=4;r<16;r+=4){a=MX3(a,C0[r],C0[r+1]);b=MX3(b,C0[r+2],C0[r+3]);a=MX3(a,C1[r],C1[r+1]);b=MX3(b,C1[r+2],C1[r+3]);} \
      float rm=__builtin_fmaxf(a,b); { auto rr=__builtin_amdgcn_permlane32_swap(__float_as_uint(rm),__float_as_uint(rm),false,false); rm=__builtin_fmaxf(__uint_as_float(rr[0]),__uint_as_float(rr[1])); } \
      if(__builtin_expect(__any(rm>(float)THRL),0)){ const float dl=__builtin_fmaxf(rm,0.f); mhat+=dl; \
        _Pragma("unroll") for(int r=0;r<16;++r){C0[r]-=dl;C1[r]-=dl;} \
        _Pragma("unroll") for(int r=0;r<16;++r)negm[r]=-mhat; asm volatile("":"+v"(negm)); \
        const float f=__builtin_amdgcn_exp2f(-dl); l_reg*=f; if(hi==0)wsf[r32]=f; resc=true; } } \
    SBAR(); \
    GAPB(o[0]=__builtin_amdgcn_mfma_f32_32x32x16_bf16(PAF(0),VFR(0),o[0],0,0,0), C0,0); \
    GAPB(o[1]=__builtin_amdgcn_mfma_f32_32x32x16_bf16(PAF(0),VFR(4),o[1],0,0,0), C0,4); \
    KRD(GL,0); GAPB(o[0]=__builtin_amdgcn_mfma_f32_32x32x16_bf16(PAF(1),VFR(1),o[0],0,0,0), C0,8); \
    KRD(GL,1); GAPB(o[1]=__builtin_amdgcn_mfma_f32_32x32x16_bf16(PAF(1),VFR(5),o[1],0,0,0), C0,12); \
    KRD(GL,2); GAPB(o[0]=__builtin_amdgcn_mfma_f32_32x32x16_bf16(PAF(2),VFR(2),o[0],0,0,0), C1,0); \
    KRD(GL,3); GAPB(o[1]=__builtin_amdgcn_mfma_f32_32x32x16_bf16(PAF(2),VFR(6),o[1],0,0,0), C1,4); \
    GAPB(o[0]=__builtin_amdgcn_mfma_f32_32x32x16_bf16(PAF(3),VFR(3),o[0],0,0,0), C1,8); \
    GAPB(o[1]=__builtin_amdgcn_mfma_f32_32x32x16_bf16(PAF(3),VFR(7),o[1],0,0,0), C1,12); \
    }while(0)
  int t=1;
  #undef CMASK
  #define CMASK(P0,P1,t) do{}while(0)
  for(;t+5<NT;t+=2){
    STEP(pB0,pB1,pA0,pA1,t,true,true,true);     WAIT_BAR(2); RESC(); ROT();
    STEP(pA0,pA1,pB0,pB1,t+1,true,true,true);   WAIT_BAR(2); RESC(); ROT();
  }
  #undef CMASK
  #define CMASK(P0,P1,t) do{}while(0)
  #define ENDW(tt) do{ if((tt)+3<NT){WAIT_BAR(2);} else if((tt)+2<NT){WAIT_BAR(1);} else {WAIT_BAR(0);} }while(0)
  for(;t+1<NT;t+=2){
    STEP(pB0,pB1,pA0,pA1,t,(t+3<NT),(t+1<NT),(t+1<NT));       ENDW(t);   RESC(); ROT();
    STEP(pA0,pA1,pB0,pB1,t+1,(t+4<NT),(t+2<NT),(t+2<NT));     ENDW(t+1); RESC(); ROT();
  }
  STEP(pB0,pB1,pA0,pA1,NT-1,false,false,false); RESC();
  { float sacc=pB0[0]+pB0[1]; _Pragma("unroll") for(int r=2;r<16;++r)sacc+=pB0[r]; _Pragma("unroll") for(int r=0;r<16;++r)sacc+=pB1[r]; l_reg+=sacc;
    pw0=(u32x4){PKW(pB0,0),PKW(pB0,2),PKW(pB0,4),PKW(pB0,6)};pw1=(u32x4){PKW(pB0,8),PKW(pB0,10),PKW(pB0,12),PKW(pB0,14)};pw2=(u32x4){PKW(pB1,0),PKW(pB1,2),PKW(pB1,4),PKW(pB1,6)};pw3=(u32x4){PKW(pB1,8),PKW(pB1,10),PKW(pB1,12),PKW(pB1,14)};
    SBAR(); pv(o,vb0+sl_cur,PAF(0),PAF(1),PAF(2),PAF(3)); }
  #undef PKW
  #undef PAF
  #undef VFR
  #undef PIN
  #undef MX3
  #undef GAPA
  #undef GAPB
  #undef EX
  #undef VRD
  #undef KRD
  #undef STEP
  #undef ENDW
  {auto rr=__builtin_amdgcn_permlane32_swap(__float_as_uint(l_reg),__float_as_uint(l_reg),false,false);l_reg=__uint_as_float(rr[0])+__uint_as_float(rr[1]);}
  if(hi==0)wsf[32+r32]=l_reg;asm volatile("s_waitcnt lgkmcnt(0)":::"memory");
  float rli[16];
  #pragma unroll
  for(int r=0;r<16;++r)rli[r]=__builtin_amdgcn_rcpf(wsf[32+crow(r,hi)]);
  bf16*Ow=Oh+(rowbase+q0+wid*QBLK)*OP;
  { bf16*stg=(bf16*)(shm+LDS_OST)+wid*2048;
    #pragma unroll
    for(int r=0;r<16;++r){const int orow=crow(r,hi);
      #pragma unroll
      for(int d0=0;d0<2;++d0)stg[orow*64+d0*32+r32]=__float2bfloat16(o[d0][r]*rli[r]);}
    asm volatile("s_waitcnt lgkmcnt(0)":::"memory");
    #pragma unroll
    for(int i=0;i<4;++i){const int row=i*8+(lane>>3),ch=lane&7; const u32x4 v=*(const u32x4*)(stg+row*64+ch*8); ATTN_STORE16(Ow+(long)row*OP+ch*8,v);} }
  asm volatile("s_waitcnt lgkmcnt(0)\n\ts_barrier":::"memory");
  #undef DMA_K
  #undef DMA_V
  #undef CMASK
  #undef START
  #undef RESC
  #undef ROT
}
constexpr int CA_K=0, CA_V=65536, CA_BYTES=131072;
constexpr int CQP=512, CKP=1024;
constexpr float CA_C2=0.08838834764831845f*1.4426950408889634f;
__device__ __forceinline__ void ca_qkt(f32x16&p0,f32x16&p1,const char*Kslot,const bf16x8*qr,const f32x16&init,int r32,int hi){
  #pragma unroll
  for(int dh=0;dh<2;++dh){ const char*kb=Kslot+dh*8192+hi*1024+r32*16;
    #pragma unroll
    for(int d0=0;d0<4;++d0){
      const bf16x8 b0=*reinterpret_cast<const bf16x8*>(kb+d0*2048);
      const bf16x8 b1=*reinterpret_cast<const bf16x8*>(kb+d0*2048+512);
      if(dh==0&&d0==0){p0=__builtin_amdgcn_mfma_f32_32x32x16_bf16(b0,qr[0],init,0,0,0);p1=__builtin_amdgcn_mfma_f32_32x32x16_bf16(b1,qr[0],init,0,0,0);}
      else{p0=__builtin_amdgcn_mfma_f32_32x32x16_bf16(b0,qr[dh*4+d0],p0,0,0,0);p1=__builtin_amdgcn_mfma_f32_32x32x16_bf16(b1,qr[dh*4+d0],p1,0,0,0);}}}
}
template<int NQ> __device__ __forceinline__ void ca_tiles(int b,int hd,int qt0,const bf16*Q,const bf16*__restrict__ KV,bf16*O,char*shm,float*wsf_all){
  const int tid=opaque_tid(),lane=tid&63,r32=lane&31,hi=lane>>5; const int wid=__builtin_amdgcn_readfirstlane(tid>>6);
  const unsigned lds0=(unsigned)(uintptr_t)shm;
  float*wsf=wsf_all+wid*64;
  const bf16*Kg=KV+(long)(b*256)*CKP+hd*128; const bf16*Vg=Kg+512;
  #pragma unroll
  for(int kt=0;kt<4;++kt){
    #pragma unroll
    for(int dh=0;dh<2;++dh) glds16(Kg+(long)(kt*64+lane)*CKP+dh*64+wid*8,(unsigned)__builtin_amdgcn_readfirstlane(lds0+CA_K+(kt*2+dh)*8192+wid*1024)); }

  const int vb0=(int)(lds0+CA_V)+((lane>>4)&1)*32+(lane&3)*8+(4*hi+((lane&15)>>2))*64;
  for(int qi=0;qi<NQ;++qi){
    const long rowq=(long)b*4096+(qt0+qi)*256+wid*32;
    const bf16*Qw=Q+rowq*CQP+hd*128;
    bf16x8 qr[8];
    #pragma unroll
    for(int d0=0;d0<8;++d0)qr[d0]=*reinterpret_cast<const bf16x8*>(&Qw[(long)r32*CQP+d0*16+hi*8]);
    if(qi==0){
      #pragma unroll
      for(int kt=0;kt<4;++kt){
        #pragma unroll
        for(int dh=0;dh<2;++dh) glds16(Vg+(long)(kt*64+16*(wid&3)+(lane>>2))*CKP+dh*64+(wid>>2)*32+(lane&3)*8,(unsigned)__builtin_amdgcn_readfirstlane(lds0+CA_V+(kt*2+dh)*8192+wid*1024)); }
      WAIT_BAR(8); }
    f32x16 zero=f32x16{};
    f32x16 sc[4][2];
    #pragma unroll
    for(int kt=0;kt<4;++kt) ca_qkt(sc[kt][0],sc[kt][1],shm+CA_K+kt*2*8192,qr,zero,r32,hi);
    float mx=-INFINITY;
    #pragma unroll
    for(int kt=0;kt<4;++kt){
      #pragma unroll
      for(int r=0;r<16;++r)mx=__builtin_fmaxf(mx,__builtin_fmaxf(sc[kt][0][r],sc[kt][1][r])); }
    { auto rr=__builtin_amdgcn_permlane32_swap(__float_as_uint(mx),__float_as_uint(mx),false,false); mx=__builtin_fmaxf(__uint_as_float(rr[0]),__uint_as_float(rr[1])); }
    float l=0.f; u32x4 pw[4][4];
    #pragma unroll
    for(int kt=0;kt<4;++kt){ f32x16&p0=sc[kt][0]; f32x16&p1=sc[kt][1];
      #pragma unroll
      for(int r=0;r<16;++r){p0[r]=__builtin_amdgcn_exp2f(p0[r]-mx);p1[r]=__builtin_amdgcn_exp2f(p1[r]-mx);}
      float sacc=0.f;
      #pragma unroll
      for(int r=0;r<16;++r)sacc+=p0[r]+p1[r];
      l+=sacc;
      pw[kt][0]=(u32x4){cvtpk_s(p0[0],p0[1]),cvtpk_s(p0[2],p0[3]),cvtpk_s(p0[4],p0[5]),cvtpk_s(p0[6],p0[7])};
      pw[kt][1]=(u32x4){cvtpk_s(p0[8],p0[9]),cvtpk_s(p0[10],p0[11]),cvtpk_s(p0[12],p0[13]),cvtpk_s(p0[14],p0[15])};
      pw[kt][2]=(u32x4){cvtpk_s(p1[0],p1[1]),cvtpk_s(p1[2],p1[3]),cvtpk_s(p1[4],p1[5]),cvtpk_s(p1[6],p1[7])};
      pw[kt][3]=(u32x4){cvtpk_s(p1[8],p1[9]),cvtpk_s(p1[10],p1[11]),cvtpk_s(p1[12],p1[13]),cvtpk_s(p1[14],p1[15])}; }
    f32x16 o[4]; o[0]=f32x16{};o[1]=f32x16{};o[2]=f32x16{};o[3]=f32x16{};
    if(qi==0){ WAIT_BAR(0); }
    SBAR();
    #pragma unroll
    for(int kt=0;kt<4;++kt){
      pv(o,vb0+(kt*2)*8192,__builtin_bit_cast(bf16x8,pw[kt][0]),__builtin_bit_cast(bf16x8,pw[kt][1]),__builtin_bit_cast(bf16x8,pw[kt][2]),__builtin_bit_cast(bf16x8,pw[kt][3]));
      pv(o+2,vb0+(kt*2+1)*8192,__builtin_bit_cast(bf16x8,pw[kt][0]),__builtin_bit_cast(bf16x8,pw[kt][1]),__builtin_bit_cast(bf16x8,pw[kt][2]),__builtin_bit_cast(bf16x8,pw[kt][3]));
    }
    { auto rr=__builtin_amdgcn_permlane32_swap(__float_as_uint(l),__float_as_uint(l),false,false); l=__uint_as_float(rr[0])+__uint_as_float(rr[1]); }
    if(hi==0)wsf[r32]=l;
    asm volatile("s_waitcnt lgkmcnt(0)":::"memory");
    bf16*Ow=O+rowq*CQP+hd*128;
    float rli[16];
    #pragma unroll
    for(int r=0;r<16;++r)rli[r]=__builtin_amdgcn_rcpf(wsf[crow(r,hi)]);
    bf16*stg=(bf16*)(wsf_all+8*64)+wid*1024;
    #pragma unroll
    for(int d0=0;d0<4;++d0){
      #pragma unroll
      for(int r=0;r<16;++r)stg[crow(r,hi)*32+r32]=__float2bfloat16(o[d0][r]*rli[r]);
      asm volatile("s_waitcnt lgkmcnt(0)":::"memory");
      #pragma unroll
      for(int i=0;i<2;++i){const int idx=i*64+lane,row=idx>>2,ch=idx&3; const u32x4 v=*(const u32x4*)(stg+row*32+ch*8); *(u32x4*)(Ow+(long)row*CQP+d0*32+ch*8)=v;}
      asm volatile("s_waitcnt lgkmcnt(0)":::"memory");
    }
  }
  asm volatile("s_waitcnt lgkmcnt(0)\n\ts_barrier":::"memory");
}
#undef SBAR
#undef WAIT_BAR
}
#define GAS __attribute__((address_space(1)))
#define LAS __attribute__((address_space(3)))
typedef unsigned short bf16;
typedef unsigned v4u __attribute__((ext_vector_type(4)));
typedef float f32x4 __attribute__((ext_vector_type(4)));
typedef short bf16x8 __attribute__((ext_vector_type(8)));
typedef GAS unsigned gu32;
typedef GAS unsigned long long gu64;
#define RLX_AGENT __ATOMIC_RELAXED, __HIP_MEMORY_SCOPE_AGENT
#define LDS_WAIT() asm volatile("s_waitcnt lgkmcnt(0)" ::: "memory")
#define VM_WAIT() asm volatile("s_waitcnt vmcnt(0)" ::: "memory")
__device__ __forceinline__ unsigned long long rt() { return __builtin_amdgcn_s_memrealtime(); }
typedef float f32x2h __attribute__((ext_vector_type(2))); typedef __bf16 bf16x2h __attribute__((ext_vector_type(2)));
__device__ __forceinline__ unsigned pk2(float lo, float hi) { f32x2h v = {lo, hi}; bf16x2h b = __builtin_convertvector(v, bf16x2h); return __builtin_bit_cast(unsigned, b); }
__device__ __forceinline__ unsigned f2bf(float f) { return pk2(f, 0.f) & 0xffffu; }

#define XB_TMO      128
#define XB_XCNT(j)  (256  + 64 * (j))
#define XB_XSUB(j)  (1280 + 64 * (j))
#define XB_XGEN(j)  (2304 + 64 * (j))
#define XB_TOP      3328
#define XB_TOPGEN   3392
#define XCD_BAR_WORDS 3456
#define XB_SPIN_CAP (1u << 18)

__device__ __forceinline__ unsigned xb_ld(unsigned* p)              { return __hip_atomic_load(p, __ATOMIC_RELAXED, __HIP_MEMORY_SCOPE_AGENT); }
__device__ __forceinline__ unsigned xb_add(unsigned* p, unsigned v) { return __hip_atomic_fetch_add(p, v, __ATOMIC_RELAXED, __HIP_MEMORY_SCOPE_AGENT); }
__device__ __forceinline__ unsigned xb_xcc_id() { return (unsigned)__builtin_amdgcn_s_getreg((3 << 11) | 20) & 0xFu; }
__device__ __forceinline__ unsigned xb_poll(unsigned* p) { unsigned r; const unsigned z = 0u; asm volatile("global_atomic_add %0, %1, %2, off sc0\n\ts_waitcnt vmcnt(0)" : "=&v"(r) : "v"(p), "v"(z) : "memory"); return r; }
#define XB_SPIN(cond, bar) do { unsigned _sp = 0; while (cond) { __builtin_amdgcn_s_sleep(1); \
    if ((++_sp & 255u) == 0u) { if (xb_ld(&(bar)[XB_TMO])) break; if (_sp > XB_SPIN_CAP) { atomicAdd(&(bar)[XB_TMO], 1u); break; } } } } while (0)

struct XcdBarrier {
    unsigned* bar; unsigned x;
    volatile LAS unsigned* st;
};

__device__ __forceinline__ XcdBarrier xcd_barrier_post(unsigned* bar, volatile LAS unsigned* st) {
    XcdBarrier b; b.bar = bar; b.x = xb_xcc_id(); b.st = st;
    if (threadIdx.x == 0) (void)xb_add(&bar[XB_XCNT(b.x)], 1u);
    return b;
}
__device__ __forceinline__ void xcd_barrier_complete(unsigned* bar, unsigned x, unsigned& nloc, unsigned& nx) {
    const unsigned G = gridDim.x * gridDim.y * gridDim.z;
    unsigned sum, cnt, mine, sp = 0u;
    for (;;) {
        sum = 0u; cnt = 0u; mine = 0u;
#pragma unroll
        for (unsigned j = 0; j < 16; ++j) { const unsigned c = xb_ld(&bar[XB_XCNT(j)]); sum += c; cnt += (c > 0u) ? 1u : 0u; mine = (j == x) ? c : mine; }
        if (sum == G) break;
        __builtin_amdgcn_s_sleep(1);
        if ((++sp & 255u) == 0u) { if (xb_ld(&bar[XB_TMO])) break; if (sp > XB_SPIN_CAP) { atomicAdd(&bar[XB_TMO], 1u); break; } }
    }
    nloc = mine > 0u ? mine : 1u; nx = cnt > 0u ? cnt : 1u;
}

__device__ __forceinline__ void xcd_barrier(const XcdBarrier& b) {
    asm volatile("s_waitcnt vmcnt(0)" ::: "memory");
    __syncthreads();
    if (threadIdx.x == 0) {
        unsigned* bar = b.bar;
        __builtin_amdgcn_s_waitcnt(0);
        unsigned nloc = b.st[0], nx = b.st[1];
        if (nloc == 0u) { xcd_barrier_complete(bar, b.x, nloc, nx); b.st[0] = nloc; b.st[1] = nx; }
        const unsigned old = xb_add(&bar[XB_XSUB(b.x)], 1u);
        const unsigned gen = old / nloc;
        if (old + 1u == (gen + 1u) * nloc) {
            __builtin_amdgcn_fence(__ATOMIC_RELEASE, "agent");
            asm volatile("s_waitcnt vmcnt(0)" ::: "memory");
            const unsigned og = xb_add(&bar[XB_TOP], 1u);
            const unsigned tg = og / nx;
            if (og + 1u == (tg + 1u) * nx) xb_add(&bar[XB_TOPGEN], 1u);
            else XB_SPIN(xb_poll(&bar[XB_TOPGEN]) == tg, bar);
            __builtin_amdgcn_fence(__ATOMIC_ACQUIRE, "agent");
            xb_add(&bar[XB_XGEN(b.x)], 1u);
            asm volatile("s_waitcnt vmcnt(0)" ::: "memory");
        } else {
            XB_SPIN(xb_poll(&bar[XB_XGEN(b.x)]) == gen, bar);
            __builtin_amdgcn_fence(__ATOMIC_ACQUIRE, "agent");
            asm volatile("s_waitcnt vmcnt(0)" ::: "memory");
        }
    }
    __syncthreads();
}

template <class Work>
__device__ __forceinline__ void xcd_barrier_w(const XcdBarrier& b, const Work& work, volatile LAS unsigned* ctl) {
    asm volatile("s_waitcnt vmcnt(0)" ::: "memory");
    if (threadIdx.x == 0) { ctl[0] = 0u; work.reset(ctl); }
    __syncthreads();
    if (__builtin_amdgcn_readfirstlane(threadIdx.x >> 6) != 0) { work(ctl); }
    else if (threadIdx.x == 0) {
        unsigned* bar = b.bar;
        __builtin_amdgcn_s_waitcnt(0);
        unsigned nloc = b.st[0], nx = b.st[1];
        if (nloc == 0u) { xcd_barrier_complete(bar, b.x, nloc, nx); b.st[0] = nloc; b.st[1] = nx; }
        const unsigned old = xb_add(&bar[XB_XSUB(b.x)], 1u);
        const unsigned gen = old / nloc;
        if (old + 1u == (gen + 1u) * nloc) {
            __builtin_amdgcn_fence(__ATOMIC_RELEASE, "agent");
            asm volatile("s_waitcnt vmcnt(0)" ::: "memory");
            const unsigned og = xb_add(&bar[XB_TOP], 1u);
            const unsigned tg = og / nx;
            if (og + 1u == (tg + 1u) * nx) xb_add(&bar[XB_TOPGEN], 1u);
            else XB_SPIN(xb_ld(&bar[XB_TOPGEN]) == tg, bar);
            __builtin_amdgcn_fence(__ATOMIC_ACQUIRE, "agent");
            xb_add(&bar[XB_XGEN(b.x)], 1u);
            asm volatile("s_waitcnt vmcnt(0)" ::: "memory");
        } else {
            XB_SPIN(xb_ld(&bar[XB_XGEN(b.x)]) == gen, bar);
            __builtin_amdgcn_fence(__ATOMIC_ACQUIRE, "agent");
            asm volatile("s_waitcnt vmcnt(0)" ::: "memory");
        }
        ctl[0] = 1u;
    }
    __syncthreads();
}

__device__ __forceinline__ void local_barrier(unsigned* bar, unsigned* cnt, unsigned nblk, volatile LAS unsigned* genw) {
    asm volatile("s_waitcnt vmcnt(0)" ::: "memory");
    __syncthreads();
    if (threadIdx.x == 0) {
        __builtin_amdgcn_s_waitcnt(0);
        const unsigned gen = genw[0] + 1u; genw[0] = gen;
        (void)xb_add(cnt, 1u);
        XB_SPIN(xb_poll(cnt) < gen * nblk, bar);
        __builtin_amdgcn_fence(__ATOMIC_ACQUIRE, "agent");
        asm volatile("s_waitcnt vmcnt(0)" ::: "memory");
    }
    __syncthreads();
}

constexpr int DMODEL = 1024, NBATCH = 8, SEQL = 4096, DEPTH = 4, NTOK = NBATCH * SEQL;
constexpr int NPROJ = 2048;
constexpr int C_POOL = 0, C_MQ = 256, C_MK = 512, C_MV = 768, C_MO = 1024, C_AQ = 1280, C_AK = 1792, C_AV = 1920;
constexpr int NEXP = 16, CAP = 512, FFE = 2048, ROWS_E = NBATCH * CAP  , NSLOTS = NEXP * ROWS_E;
constexpr float EPS = 1e-6f;
enum { I_X = 0, I_MEM, I_NMIXG, I_WIN, I_POOLW, I_POOLS, I_CONVW, I_GATEB, I_MNORMG, I_QNG, I_KNG, I_WOUT, I_NMEMG, I_CAWQ, I_CAWKV, I_CAWO, I_NFFNG, I_ROUTER, I_WGU, I_WDN, I_FNG, N_IN };

constexpr size_t MiB = 1u << 20;
constexpr size_t WS_CTL = 0, CTL_ZERO_BYTES = 1 * MiB;
constexpr size_t WS_ROPE = 1 * MiB;
constexpr size_t WS_POOLW = 2 * MiB;
constexpr size_t WS_MEMB = 3 * MiB;
constexpr size_t WS_WIN = 8 * MiB;
constexpr size_t WS_WOUT = 24 * MiB;
constexpr size_t WS_WCAQ = 32 * MiB;
constexpr size_t WS_WCAKV = 36 * MiB;
constexpr size_t WS_WCAO = 44 * MiB;
constexpr size_t WS_KVCA = 48 * MiB;
constexpr size_t WS_WGU = 64 * MiB;
constexpr size_t WS_WDN = 576 * MiB;
constexpr size_t WS_X = 832 * MiB;
constexpr size_t WS_HN = 960 * MiB;
constexpr size_t WS_PROJ = 1024 * MiB;
constexpr size_t WS_MQK = 1152 * MiB;
constexpr size_t WS_YCAT = 1184 * MiB;
constexpr size_t WS_QCA = 1248 * MiB;
constexpr size_t WS_GATES = 1280 * MiB;
constexpr size_t WS_AFF = 1282 * MiB;
constexpr size_t WS_TOKI = 1284 * MiB;
constexpr size_t WS_SLOTMAP = 1285 * MiB;
constexpr size_t WS_MSC = 1287 * MiB;
constexpr size_t WS_CST = 1288 * MiB;
constexpr size_t WS_ACT = 1322 * MiB;
constexpr size_t WS_YS = 1578 * MiB;
constexpr size_t WS_KT = 1706 * MiB;
constexpr size_t WS_VT = 1722 * MiB;
constexpr size_t WS_CSB = 1738 * MiB;
constexpr size_t WS_PART = 1756 * MiB;
constexpr size_t WS_GV = 1758 * MiB;
constexpr size_t WS_END = 1762 * MiB;
constexpr int CST_SZ = 65 * 64;
constexpr int CW_BAR = 4096;
constexpr int CW_LOC = 8192;

constexpr int RING_OFF = 0, RING_BYTES = 131072;
constexpr int LDSCTL_OFF = RING_BYTES, MISC_OFF = LDSCTL_OFF + 320;
constexpr int XTRA_OFF = MISC_OFF + 128;
constexpr int LDS_BYTES = 156672;

template <int CTRL> __device__ __forceinline__ float dpp_mov(float x) { return __builtin_bit_cast(float, __builtin_amdgcn_update_dpp(0, __builtin_bit_cast(int, x), CTRL, 0xF, 0xF, true)); }
__device__ __forceinline__ float quad_sum(float v) { v += dpp_mov<0xB1>(v); v += dpp_mov<0x4E>(v); return v; }
__device__ __forceinline__ float oct_sum(float v) { v = quad_sum(v); v += dpp_mov<0x141>(v); return v; }
__device__ __forceinline__ float row_sum(float v) { v = oct_sum(v); v += dpp_mov<0x140>(v); return v; }
__device__ __forceinline__ float row_max(float v) { v = fmaxf(v, dpp_mov<0xB1>(v)); v = fmaxf(v, dpp_mov<0x4E>(v)); v = fmaxf(v, dpp_mov<0x141>(v)); v = fmaxf(v, dpp_mov<0x140>(v)); return v; }
__device__ __forceinline__ float wave_sum(float v) { v = row_sum(v);
    const float a = __builtin_bit_cast(float, __builtin_amdgcn_readlane(__builtin_bit_cast(int, v), 0)), b = __builtin_bit_cast(float, __builtin_amdgcn_readlane(__builtin_bit_cast(int, v), 16));
    const float c = __builtin_bit_cast(float, __builtin_amdgcn_readlane(__builtin_bit_cast(int, v), 32)), d = __builtin_bit_cast(float, __builtin_amdgcn_readlane(__builtin_bit_cast(int, v), 48));
    return (a + b) + (c + d); }
__device__ __forceinline__ float lane_bcast(float v, int l) { return __builtin_bit_cast(float, __builtin_amdgcn_readlane(__builtin_bit_cast(int, v), l)); }
__device__ __forceinline__ float wave_max(float v) { v = row_max(v); return fmaxf(fmaxf(lane_bcast(v, 0), lane_bcast(v, 16)), fmaxf(lane_bcast(v, 32), lane_bcast(v, 48))); }
__device__ __forceinline__ float bf_lo(unsigned w) { return __uint_as_float(w << 16); }
__device__ __forceinline__ float bf_hi(unsigned w) { return __uint_as_float(w & 0xffff0000u); }
__device__ __forceinline__ float bf2f(bf16 h) { return __uint_as_float(((unsigned)h) << 16); }
__device__ __forceinline__ float wscan_add(float v, int lane) {
#pragma unroll
    for (int o = 1; o < 64; o <<= 1) { const float t = __shfl_up(v, o); if (lane >= o) v += t; }
    return v;
}
__device__ __forceinline__ float wscan_add_rev(float v, int lane) {
#pragma unroll
    for (int o = 1; o < 64; o <<= 1) { const float t = __shfl_down(v, o); if (lane + o < 64) v += t; }
    return v;
}
__device__ __forceinline__ float wscan_max(float v, int lane) {
#pragma unroll
    for (int o = 1; o < 64; o <<= 1) { const float t = __shfl_up(v, o); if (lane >= o) v = fmaxf(v, t); }
    return v;
}
__device__ __forceinline__ float wscan_max_rev(float v, int lane) {
#pragma unroll
    for (int o = 1; o < 64; o <<= 1) { const float t = __shfl_down(v, o); if (lane + o < 64) v = fmaxf(v, t); }
    return v;
}
__device__ __forceinline__ float fexp(float x) { return __builtin_amdgcn_exp2f(x * 1.4426950408889634f); }
__device__ __forceinline__ float flog(float x) { return __builtin_amdgcn_logf(x) * 0.6931471805599453f; }
__device__ __forceinline__ float fsigmoid(float x) { return __builtin_amdgcn_rcpf(1.0f + fexp(-x)); }
typedef float f32x2v __attribute__((ext_vector_type(2)));
#define MFMA16(a, b, c) __builtin_amdgcn_mfma_f32_16x16x32_bf16((a), (b), (c), 0, 0, 0)

struct Ctx { int tid, lane, wave, G, vcu, gw, NGW; unsigned char* lds; unsigned char* ws; LAS unsigned char* ldsl; int ng, GB, grp, lb; };
__device__ __forceinline__ Ctx phase_ctx(const Ctx& C0) { Ctx C = C0; C.tid = opaque_tid(); C.lane = C.tid & 63; return C; }

__device__ __forceinline__ void transpose_item(const float* W, int ldw, bf16* WT, int K, int n0dst, int srccol0, int k0, LAS float* scr, int lane, const float* kscale = nullptr) {
    f32x4 v[8]; const int lr = lane >> 3, lc = (lane & 7) * 4;
#pragma unroll
    for (int i = 0; i < 8; ++i) v[i] = __builtin_nontemporal_load((const f32x4*)(W + (size_t)(k0 + 8 * i + lr) * ldw + srccol0 + lc));
    if (kscale) { float kq[8];
#pragma unroll
        for (int i = 0; i < 8; ++i) kq[i] = kscale[k0 + 8 * i + lr];
#pragma unroll
        for (int i = 0; i < 8; ++i) v[i] = v[i] * kq[i]; }
#pragma unroll
    for (int i = 0; i < 8; ++i) { LAS float* d = scr + (8 * i + lr) * 33 + lc; d[0] = v[i].x; d[1] = v[i].y; d[2] = v[i].z; d[3] = v[i].w; }
    LDS_WAIT(); asm volatile("" ::: "memory");
    const int c = lane & 7;
#pragma unroll
    for (int j = 0; j < 4; ++j) { const int n = (lane >> 3) + 8 * j; const LAS float* s = scr + (8 * c) * 33 + n;
        v4u o; o.x = pk2(s[0 * 33], s[1 * 33]); o.y = pk2(s[2 * 33], s[3 * 33]); o.z = pk2(s[4 * 33], s[5 * 33]); o.w = pk2(s[6 * 33], s[7 * 33]);
        *(v4u*)(WT + (size_t)(n0dst + n) * K + k0 + 8 * c) = o; }
    LDS_WAIT(); asm volatile("" ::: "memory");
}
#ifndef CV_NT
#define CV_NT 1
#endif
constexpr int EXP_ITEMS = 16 * 2048 + 16 * 1024;
struct ItemSrc { const float* W; int ldw; bf16* WT; int K, n0dst, srccol0, k0; const float* ks; };
__device__ __forceinline__ ItemSrc expert_item(unsigned char* ws, const float* const* in, int layer, int j) {
    ItemSrc I;
    if (j < 32768) { const int le = layer * 16 + (j >> 11), r = j & 2047, kb = r >> 7, nb = r & 127, n0 = nb * 32, pn = n0 >> 8, jj = n0 & 255;
        I.W = in[I_WGU] + (size_t)le * 1024 * 4096; I.ldw = 4096; I.WT = (bf16*)(ws + WS_WGU) + (size_t)le * 4096 * 1024; I.K = 1024; I.n0dst = n0; I.srccol0 = jj < 128 ? pn * 128 + jj : 2048 + pn * 128 + (jj - 128); I.k0 = kb * 64; I.ks = in[I_NFFNG] + layer * 1024; }
    else { const int q = j - 32768, le = layer * 16 + (q >> 10), r = q & 1023, kb = r >> 5, nb = r & 31;
        I.W = in[I_WDN] + (size_t)le * 2048 * 1024; I.ldw = 1024; I.WT = (bf16*)(ws + WS_WDN) + (size_t)le * 1024 * 2048; I.K = 2048; I.n0dst = nb * 32; I.srccol0 = nb * 32; I.k0 = kb * 64; I.ks = nullptr; }
    return I;
}
__device__ __forceinline__ void item_load(const ItemSrc& I, f32x4 (&v)[8], int lane) {
    const int lr = lane >> 3, lc = (lane & 7) * 4;
#pragma unroll
    for (int i = 0; i < 8; ++i) { const f32x4* p_ = (const f32x4*)(I.W + (size_t)(I.k0 + 8 * i + lr) * I.ldw + I.srccol0 + lc); v[i] = CV_NT ? __builtin_nontemporal_load(p_) : *p_; }
}
__device__ __forceinline__ void item_scale(const ItemSrc& I, f32x4 (&v)[8], int lane) {
    if (I.ks) { const int lr = lane >> 3; float kq[8];
#pragma unroll
        for (int i = 0; i < 8; ++i) kq[i] = I.ks[I.k0 + 8 * i + lr];
#pragma unroll
        for (int i = 0; i < 8; ++i) v[i] = v[i] * kq[i]; }
}
__device__ __forceinline__ void item_store(const ItemSrc& I, const f32x4 (&v)[8], LAS float* scr, int lane) {
    const int lr = lane >> 3, lc = (lane & 7) * 4;
#pragma unroll
    for (int i = 0; i < 8; ++i) { LAS float* d = scr + (8 * i + lr) * 33 + lc; d[0] = v[i].x; d[1] = v[i].y; d[2] = v[i].z; d[3] = v[i].w; }
    LDS_WAIT(); asm volatile("" ::: "memory");
    const int c = lane & 7;
#pragma unroll
    for (int j = 0; j < 4; ++j) { const int n = (lane >> 3) + 8 * j; const LAS float* s = scr + (8 * c) * 33 + n;
        v4u o; o.x = pk2(s[0 * 33], s[1 * 33]); o.y = pk2(s[2 * 33], s[3 * 33]); o.z = pk2(s[4 * 33], s[5 * 33]); o.w = pk2(s[6 * 33], s[7 * 33]);
        asm volatile("global_store_dwordx4 %0, %1, off sc1\n\ts_nop 2" :: "v"(I.WT + (size_t)(I.n0dst + n) * I.K + I.k0 + 8 * c), "v"(o) : "memory"); }
    LDS_WAIT(); asm volatile("" ::: "memory");
}
struct ConvWork {
    unsigned char* ws; const float* const* in; LAS unsigned char* ldsl; int layer, finish, vcu, G;
    __device__ __forceinline__ void reset(volatile LAS unsigned* ctl) const { if (layer < DEPTH && ctl[2] != (unsigned)(layer + 1)) { ctl[2] = (unsigned)(layer + 1); ctl[1] = 0u; } }
    __device__ __forceinline__ void operator()(volatile LAS unsigned* ctl) const {
        if (layer >= DEPTH) return;
        const int tid = opaque_tid(), lane = tid & 63, wave = __builtin_amdgcn_readfirstlane(tid >> 6);
        LAS float* scr = (LAS float*)(ldsl + RING_OFF + wave * 16384);
        for (;;) {
            if (!finish && ctl[0] != 0u) break;
            unsigned k = 0u; if (lane == 0) k = __hip_atomic_fetch_add((LAS unsigned*)(ctl + 1), 1u, __ATOMIC_RELAXED, __HIP_MEMORY_SCOPE_WORKGROUP);
            k = (unsigned)__builtin_amdgcn_readfirstlane((int)k);
            const long j = (long)k * G + vcu; if (j >= EXP_ITEMS) break;
            const ItemSrc J = expert_item(ws, in, layer, (int)j); f32x4 w[8]; item_load(J, w, lane); item_scale(J, w, lane); item_store(J, w, scr, lane);
        }
    }
};
__device__ __forceinline__ void phase_convert(unsigned char* ws, const float* const* in, LAS unsigned char* ldsl, int layer, int nper, int vcu, int G, volatile LAS unsigned* ctl) {
    if (layer >= DEPTH || ctl[2] != (unsigned)(layer + 1)) return;
    const int tid = opaque_tid(), lane = tid & 63, wave = __builtin_amdgcn_readfirstlane(tid >> 6);
    LAS float* scr = (LAS float*)(ldsl + RING_OFF + wave * 16384);
    for (int n = 0; n < nper; ++n) {
        unsigned k = 0u; if (lane == 0) k = __hip_atomic_fetch_add((LAS unsigned*)(ctl + 1), 1u, __ATOMIC_RELAXED, __HIP_MEMORY_SCOPE_WORKGROUP);
        k = (unsigned)__builtin_amdgcn_readfirstlane((int)k);
        const long j = (long)k * G + vcu; if (j >= EXP_ITEMS) break;
        const ItemSrc J = expert_item(ws, in, layer, (int)j); f32x4 w[8]; item_load(J, w, lane); item_scale(J, w, lane); item_store(J, w, scr, lane);
    }
}
#ifndef CV_NIT
#define CV_NIT 4
#endif
#ifndef CV_MAP
#define CV_MAP 1
#endif
__device__ __forceinline__ void convert_share(unsigned char* ws, const float* const* in, LAS unsigned char* ldsl, int layer, int vcu, int G, int part = 0, int nparts = 1) {
    const int tid = opaque_tid(), lane = tid & 63, wave = __builtin_amdgcn_readfirstlane(tid >> 6);
    LAS float* scr = (LAS float*)(ldsl + RING_OFF + wave * 16384);
    const int nk = (EXP_ITEMS - vcu + G - 1) / G;
    const int kspan = ((nk + nparts - 1) / nparts + 8 * CV_NIT - 1) / (8 * CV_NIT) * (8 * CV_NIT), kbeg = part * kspan, kend = min(nk, kbeg + kspan);
#pragma unroll 1
    for (int k0 = kbeg + wave; k0 < kend; k0 += 8 * CV_NIT) {
        ItemSrc I[CV_NIT]; f32x4 v[CV_NIT][8]; bool on[CV_NIT];
#pragma unroll
        for (int t = 0; t < CV_NIT; ++t) { const int k = k0 + 8 * t; on[t] = k < kend; if (on[t]) { I[t] = expert_item(ws, in, layer, (CV_MAP && G == 256) ? (((vcu & 3) * 192 + k) * 64 + (vcu >> 2)) : (k * G + vcu)); item_load(I[t], v[t], lane); } }
#pragma unroll
        for (int t = 0; t < CV_NIT; ++t) if (on[t]) { item_scale(I[t], v[t], lane); item_store(I[t], v[t], scr, lane); }
    }
}
#if defined(CV_MODE)
__device__ __forceinline__ void convert_share_probe(unsigned char* ws, const float* const* in, LAS unsigned char* ldsl, int layer, int vcu, int G) {
    const int tid = opaque_tid(), lane = tid & 63, wave = __builtin_amdgcn_readfirstlane(tid >> 6);
    LAS float* scr = (LAS float*)(ldsl + RING_OFF + wave * 16384);
    const int nk = (EXP_ITEMS - vcu + G - 1) / G; float sink = 0.f;
#pragma unroll 1
    for (int k0 = wave; k0 < nk; k0 += 24) {
        ItemSrc I[3]; f32x4 v[3][8]; bool on[3];
#pragma unroll
        for (int t = 0; t < 3; ++t) { const int k = k0 + 8 * t; on[t] = k < nk; if (on[t]) { I[t] = expert_item(ws, in, layer, k * G + vcu);
#if defined(CV_PAT) && CV_PAT == 1
            { const int lr4 = lane >> 4, lc16 = (lane & 15) * 4; const int c0 = I[t].srccol0 & ~63;
              _Pragma("unroll") for (int i = 0; i < 8; ++i) v[t][i] = __builtin_nontemporal_load((const f32x4*)(I[t].W + (size_t)(I[t].k0 + 4 * i + lr4) * I[t].ldw + c0 + lc16)); }
#elif defined(CV_PAT) && CV_PAT == 2
            { const int lr2 = lane >> 5, lc32 = (lane & 31) * 4; const int c0 = I[t].srccol0 & ~127;
              _Pragma("unroll") for (int i = 0; i < 8; ++i) v[t][i] = __builtin_nontemporal_load((const f32x4*)(I[t].W + (size_t)(I[t].k0 + 2 * i + lr2) * I[t].ldw + c0 + lc32)); }
#else
            item_load(I[t], v[t], lane);
#endif
            } }
#pragma unroll
        for (int t = 0; t < 3; ++t) if (on[t]) {
#if CV_MODE == 1
#pragma unroll
            for (int i = 0; i < 8; ++i) sink += v[t][i].x + v[t][i].y + v[t][i].z + v[t][i].w;
#elif CV_MODE == 2
            { const int lr = lane >> 3, lc = (lane & 7) * 4;
#pragma unroll
              for (int i = 0; i < 8; ++i) { LAS float* d = scr + (8 * i + lr) * 33 + lc; d[0] = v[t][i].x; d[1] = v[t][i].y; d[2] = v[t][i].z; d[3] = v[t][i].w; }
              LDS_WAIT(); asm volatile("" ::: "memory");
              const int c = lane & 7;
#pragma unroll
              for (int j = 0; j < 4; ++j) { const int n = (lane >> 3) + 8 * j; const LAS float* sp = scr + (8 * c) * 33 + n;
                  sink += __uint_as_float(pk2(sp[0 * 33], sp[1 * 33]) ^ pk2(sp[2 * 33], sp[3 * 33]) ^ pk2(sp[4 * 33], sp[5 * 33]) ^ pk2(sp[6 * 33], sp[7 * 33])); }
              LDS_WAIT(); asm volatile("" ::: "memory"); }
#else
            { ItemSrc J = I[t]; J.WT = (bf16*)(ws + WS_ACT) + (J.WT - (bf16*)(ws + (J.K == 1024 ? WS_WGU : WS_WDN))) % (size_t)(120u << 20); item_store(J, v[t], scr, lane); }
#endif
        }
    }
    if (sink == 123.456f) ((float*)(ws + WS_ACT))[tid] = sink;
}
#endif
__device__ __forceinline__ int conv_target(int p) { if (p <= 8) return 0; if (p < 10) return DEPTH; const int q = p - 10; return (q % 12 >= 11) ? DEPTH : q / 12 + 1; }
__device__ __forceinline__ void prologue_convert(const Ctx& C0, const float* const* in, bool defer_experts) {
    const Ctx C = phase_ctx(C0);
    LAS float* scr = (LAS float*)(C.ldsl + RING_OFF + C.wave * 16384);
    unsigned char* ws = C.ws;
    constexpr int N0 = 4 * 1024, N1 = N0 + 4 * 512, N2 = N1 + 4 * 256, N3 = N2 + 4 * 512, N4 = N3 + 4 * 256, N5 = N4 + 64 * 2048, N6 = N5 + 64 * 1024;
    const int nlim = defer_experts ? N4 : N6;
    if (defer_experts) {
        auto small_item = [&](int it) { ItemSrc I; I.ks = nullptr;
            if (it < N0) { const int l = it >> 10, r = it & 1023, kb = r >> 6, nb = r & 63, n0 = nb * 32;
                I.W = in[I_WIN] + (size_t)l * 1024 * 2064; I.ldw = 2064; I.WT = (bf16*)(ws + WS_WIN) + (size_t)l * 2048 * 1024; I.K = 1024; I.n0dst = n0; I.srccol0 = n0 < 1280 ? n0 : n0 + 16; I.k0 = kb * 64; I.ks = in[I_NMIXG] + l * 1024; }
            else if (it < N1) { const int q = it - N0, l = q >> 9, r = q & 511, kb = r >> 5, nb = r & 31;
                I.W = in[I_WOUT] + (size_t)l * 1024 * 1024; I.ldw = 1024; I.WT = (bf16*)(ws + WS_WOUT) + (size_t)l * 1024 * 1024; I.K = 1024; I.n0dst = nb * 32; I.srccol0 = nb * 32; I.k0 = kb * 64; }
            else if (it < N2) { const int q = it - N1, l = q >> 8, r = q & 255, kb = r >> 4, nb = r & 15;
                I.W = in[I_CAWQ] + (size_t)l * 1024 * 512; I.ldw = 512; I.WT = (bf16*)(ws + WS_WCAQ) + (size_t)l * 512 * 1024; I.K = 1024; I.n0dst = nb * 32; I.srccol0 = nb * 32; I.k0 = kb * 64; I.ks = in[I_NMEMG] + l * 1024; }
            else if (it < N3) { const int q = it - N2, l = q >> 9, r = q & 511, kb = r >> 5, nb = r & 31;
                I.W = in[I_CAWKV] + (size_t)l * 1024 * 1024; I.ldw = 1024; I.WT = (bf16*)(ws + WS_WCAKV) + (size_t)l * 1024 * 1024; I.K = 1024; I.n0dst = nb * 32; I.srccol0 = nb * 32; I.k0 = kb * 64; }
            else { const int q = it - N3, l = q >> 8, r = q & 255, kb = r >> 5, nb = r & 31;
                I.W = in[I_CAWO] + (size_t)l * 512 * 1024; I.ldw = 1024; I.WT = (bf16*)(ws + WS_WCAO) + (size_t)l * 1024 * 512; I.K = 512; I.n0dst = nb * 32; I.srccol0 = nb * 32; I.k0 = kb * 64; }
            return I; };
#pragma unroll 1
        for (int it0 = C.gw; it0 < N4; it0 += CV_NIT * C.NGW) {
            ItemSrc I[CV_NIT]; f32x4 v[CV_NIT][8]; bool on[CV_NIT];
#pragma unroll
            for (int t = 0; t < CV_NIT; ++t) { const int it = it0 + t * C.NGW; on[t] = it < N4; if (on[t]) { I[t] = small_item(it); item_load(I[t], v[t], C.lane); } }
#pragma unroll
            for (int t = 0; t < CV_NIT; ++t) if (on[t]) { item_scale(I[t], v[t], C.lane); item_store(I[t], v[t], scr, C.lane); }
        }
    } else
    for (int it = C.gw; it < nlim; it += C.NGW) {
        if (it < N0) { const int l = it >> 10, r = it & 1023, kb = r >> 6, nb = r & 63, n0 = nb * 32;
            transpose_item(in[I_WIN] + (size_t)l * 1024 * 2064, 2064, (bf16*)(ws + WS_WIN) + (size_t)l * 2048 * 1024, 1024, n0, n0 < 1280 ? n0 : n0 + 16, kb * 64, scr, C.lane, in[I_NMIXG] + l * 1024); }
        else if (it < N1) { const int q = it - N0, l = q >> 9, r = q & 511, kb = r >> 5, nb = r & 31;
            transpose_item(in[I_WOUT] + (size_t)l * 1024 * 1024, 1024, (bf16*)(ws + WS_WOUT) + (size_t)l * 1024 * 1024, 1024, nb * 32, nb * 32, kb * 64, scr, C.lane); }
        else if (it < N2) { const int q = it - N1, l = q >> 8, r = q & 255, kb = r >> 4, nb = r & 15;
            transpose_item(in[I_CAWQ] + (size_t)l * 1024 * 512, 512, (bf16*)(ws + WS_WCAQ) + (size_t)l * 512 * 1024, 1024, nb * 32, nb * 32, kb * 64, scr, C.lane, in[I_NMEMG] + l * 1024); }
        else if (it < N3) { const int q = it - N2, l = q >> 9, r = q & 511, kb = r >> 5, nb = r & 31;
            transpose_item(in[I_CAWKV] + (size_t)l * 1024 * 1024, 1024, (bf16*)(ws + WS_WCAKV) + (size_t)l * 1024 * 1024, 1024, nb * 32, nb * 32, kb * 64, scr, C.lane); }
        else if (it < N4) { const int q = it - N3, l = q >> 8, r = q & 255, kb = r >> 5, nb = r & 31;
            transpose_item(in[I_CAWO] + (size_t)l * 512 * 1024, 1024, (bf16*)(ws + WS_WCAO) + (size_t)l * 1024 * 512, 512, nb * 32, nb * 32, kb * 64, scr, C.lane); }
        else if (it < N5) { const int q = it - N4, le = q >> 11, r = q & 2047, kb = r >> 7, nb = r & 127, n0 = nb * 32, pn = n0 >> 8, j = n0 & 255;
            transpose_item(in[I_WGU] + (size_t)le * 1024 * 4096, 4096, (bf16*)(ws + WS_WGU) + (size_t)le * 4096 * 1024, 1024, n0, j < 128 ? pn * 128 + j : 2048 + pn * 128 + (j - 128), kb * 64, scr, C.lane, in[I_NFFNG] + (le >> 4) * 1024); }
        else { const int q = it - N5, le = q >> 10, r = q & 1023, kb = r >> 5, nb = r & 31;
            transpose_item(in[I_WDN] + (size_t)le * 2048 * 1024, 1024, (bf16*)(ws + WS_WDN) + (size_t)le * 1024 * 2048, 2048, nb * 32, nb * 32, kb * 64, scr, C.lane); }
    }
    const int gt = C.gw * 64 + C.lane, NGT = C.NGW * 64;
    for (int i = gt; i < 2048 * 1024 / 8; i += NGT) { const f32x4* s = (const f32x4*)(in[I_MEM]) + 2 * (size_t)i; const f32x4 a = s[0], b = s[1];
        v4u o; o.x = pk2(a.x, a.y); o.y = pk2(a.z, a.w); o.z = pk2(b.x, b.y); o.w = pk2(b.z, b.w); ((v4u*)(ws + WS_MEMB))[i] = o; }
    for (int i = gt; i < 4096 * 32; i += NGT) { const int t = i >> 5, f = i & 31; const int pos = (f < 16) ? (t >> 6) : (t & 63);
        double invd = 1.0; for (int k = 0; k < (f & 15); ++k) invd *= 0.5623413251903491;
        const float inv = (float)invd; const float ang = (float)pos * inv; const double ad = (double)ang;
        const double nq = rint(ad * 0.6366197723675814); const double r = ad - nq * 1.5707963267948966, r2 = r * r;
        const double sr = r * (1.0 + r2 * (-1.0 / 6 + r2 * (1.0 / 120 + r2 * (-1.0 / 5040 + r2 * (1.0 / 362880 + r2 * (-1.0 / 39916800 + r2 * (1.0 / 6227020800.0)))))));
        const double cr = 1.0 + r2 * (-0.5 + r2 * (1.0 / 24 + r2 * (-1.0 / 720 + r2 * (1.0 / 40320 + r2 * (-1.0 / 3628800 + r2 * (1.0 / 479001600.0))))));
        const int qd = ((int)nq) & 3; const double sn = (qd == 0) ? sr : (qd == 1) ? cr : (qd == 2) ? -sr : -cr; const double cs = (qd == 0) ? cr : (qd == 1) ? -sr : (qd == 2) ? -cr : sr;
        ((float*)(ws + WS_ROPE))[i] = (float)cs; ((float*)(ws + WS_ROPE))[4096 * 32 + i] = (float)sn; }
    for (int i = gt; i < 4 * 4 * 64 * 64; i += NGT) { const int c = i & 63, e = (i >> 6) & 63, g = (i >> 12) & 3, l = i >> 14;
        const float v = in[I_POOLW][((size_t)(l * 4 + g) * 64 + c) * 64 + e] * in[I_POOLS][l * 256 + g * 64 + e]; ((bf16*)(ws + WS_POOLW))[i] = (bf16)f2bf(v); }
}

constexpr int RT_PITCH = 1032;
__device__ __forceinline__ void proj16_stage(const Ctx& C, const float* gain, const float* w16, int w16s) {
    LAS bf16* Wh = (LAS bf16*)(C.ldsl + RING_OFF); LAS bf16* Wl = Wh + 16 * RT_PITCH;
    { f32x4 wv[8]; float gq[8];
#pragma unroll
      for (int j = 0; j < 8; ++j) { const int idx = C.tid + 512 * j, k = idx >> 2, e4 = (idx & 3) * 4; wv[j] = *(const f32x4*)(w16 + (size_t)k * w16s + e4); gq[j] = gain[k]; }
#pragma unroll
      for (int j = 0; j < 8; ++j) { const int idx = C.tid + 512 * j, k = idx >> 2, e4 = (idx & 3) * 4;
#pragma unroll
        for (int i = 0; i < 4; ++i) { const float v = wv[j][i] * gq[j]; const unsigned short h = f2bf(v); const unsigned short lo = f2bf(v - bf2f((bf16)h));
            Wh[(e4 + i) * RT_PITCH + k] = (bf16)h; Wl[(e4 + i) * RT_PITCH + k] = (bf16)lo; } } }
    __syncthreads();
}
template <int MODE>
__device__ __forceinline__ void proj16_tile(const Ctx& C, const bf16x8 (&xa)[32], int t, const float* bias16, float* out16, float* rs) {
    const int lane = C.lane, rr = lane & 15, q = lane >> 4;
    LAS bf16* Wh = (LAS bf16*)(C.ldsl + RING_OFF); LAS bf16* Wl = Wh + 16 * RT_PITCH;
    f32x4 acc = (f32x4){0.f, 0.f, 0.f, 0.f}; float ss = 0.f;
#pragma unroll
    for (int s = 0; s < 32; ++s) {
        const bf16x8 bh = *(const LAS bf16x8*)(Wh + rr * RT_PITCH + s * 32 + q * 8), bl = *(const LAS bf16x8*)(Wl + rr * RT_PITCH + s * 32 + q * 8);
        acc = MFMA16(xa[s], bh, acc); acc = MFMA16(xa[s], bl, acc);
        const v4u xw = __builtin_bit_cast(v4u, xa[s]);
        ss += (bf_lo(xw.x) * bf_lo(xw.x) + bf_hi(xw.x) * bf_hi(xw.x)) + (bf_lo(xw.y) * bf_lo(xw.y) + bf_hi(xw.y) * bf_hi(xw.y));
        ss += (bf_lo(xw.z) * bf_lo(xw.z) + bf_hi(xw.z) * bf_hi(xw.z)) + (bf_lo(xw.w) * bf_lo(xw.w) + bf_hi(xw.w) * bf_hi(xw.w));
        if ((s & 3) == 3) asm volatile("" ::: "memory"); }
    ss += __shfl_xor(ss, 16); ss += __shfl_xor(ss, 32);
    const float rstd = __builtin_amdgcn_rsqf(ss * (1.0f / 1024.0f) + EPS);
    if (MODE == 2 && q == 0) rs[(size_t)t * 16 + rr] = rstd;
    if (MODE == 2) { f32x4 pr;
#pragma unroll
        for (int i = 0; i < 4; ++i) { const float r = __shfl(rstd, 4 * q + i); const float val = acc[i] * r; float mx = val;
#pragma unroll
            for (int o = 1; o < 2; o <<= 1) mx = row_max(mx);
            const float ex = fexp(val - mx); float sm = row_sum(ex);
            pr[i] = ex * __builtin_amdgcn_rcpf(sm); }
        const int row = t * 16 + 4 * q;
        *(f32x4*)(out16 + ((size_t)((row >> 12) * 16 + rr)) * 4096 + (row & 4095)) = pr; }
    else { const float bs = bias16[rr];
#pragma unroll
        for (int i = 0; i < 4; ++i) { const float r = __shfl(rstd, 4 * q + i); float val = acc[i] * r + bs;
            if (rr >= 8) val = fminf(val, 0.f) - flog(1.0f + fexp(-fabsf(val)));
            out16[(size_t)(t * 16 + 4 * q + i) * 16 + rr] = val; } }
}
__device__ __forceinline__ void router_phase(const Ctx& C0, const bf16* xb, const float* gain, const float* w16, float* aff, float* rs) {
    const Ctx C = phase_ctx(C0);
    const int rr = C.lane & 15, q = C.lane >> 4;
    const int tpg = (NTOK / 16) / C.ng, t0 = C.grp * tpg + C.lb * 8 + C.wave, ts = C.GB * 8, te = (C.grp + 1) * tpg;
    bf16x8 xa[32];
    if (t0 < te) {
#pragma unroll
        for (int s = 0; s < 32; ++s) xa[s] = *(const bf16x8*)(xb + (size_t)(t0 * 16 + rr) * 1024 + s * 32 + q * 8);
    }
    proj16_stage(C, gain, w16, 16);
    for (int t = t0; t < te; t += ts) {
        if (t != t0) {
#pragma unroll
            for (int s = 0; s < 32; ++s) xa[s] = *(const bf16x8*)(xb + (size_t)(t * 16 + rr) * 1024 + s * 32 + q * 8); }
        proj16_tile<2>(C, xa, t, nullptr, aff, rs);
    }
    __syncthreads();
}

template <int MODE, bool COMBINE, bool SRC32 = false>
__device__ __forceinline__ void row_phase(const Ctx& C0, const void* xsrc_, bf16* xdst, const float* gain, float* rsout, const float* w16, int w16s, const float* bias16, float* out16, float* outf,
                                          const int* slotmap, const bf16* ys) {
    const Ctx C = phase_ctx(C0);
    if (MODE == 1) proj16_stage(C, gain, w16, w16s);
    const int lane = C.lane;
    f32x4 gv[4];
#pragma unroll
    for (int j = 0; j < 4; ++j) gv[j] = *(const f32x4*)(gain + 4 * lane + 256 * j);
    const float* xsrc = (const float*)xsrc_; const bf16* xsrb = (const bf16*)xsrc_;
    f32x4 vn[2][4]; uint2 vnb[2][4]; int smc[2] = {-1, -1}, smn[2] = {-1, -1}; unsigned mrem[2] = {0u, 0u}; uint2 yb[2][4][4];
    const int tpg = (NTOK / 16) / C.ng, t0 = C.grp * tpg + C.lb * 8 + C.wave, ts = C.GB * 8, te = (C.grp + 1) * tpg;
#define RP_LOADX(prq) do { _Pragma("unroll") for (int r = 0; r < 2; ++r) { _Pragma("unroll") for (int j = 0; j < 4; ++j) { \
        if (SRC32) vn[r][j] = *(const f32x4*)(xsrc + (size_t)(2 * (prq) + r) * 1024 + 4 * lane + 256 * j); else vnb[r][j] = *(const uint2*)(xsrb + (size_t)(2 * (prq) + r) * 1024 + 4 * lane + 256 * j); } } } while (0)
#define RP_LOADSM(SMQ, prq) do { _Pragma("unroll") for (int r = 0; r < 2; ++r) SMQ[r] = slotmap[(size_t)(2 * (prq) + r) * 16 + (lane & 15)]; } while (0)
#define RP_LOADY(SMQ, prq) do { _Pragma("unroll") for (int r = 0; r < 2; ++r) { unsigned mk = (unsigned)(__ballot(SMQ[r] >= 0) & 0xFFFFull); const int b = (2 * (prq) + r) >> 12; \
        _Pragma("unroll") for (int k = 0; k < 4; ++k) { \
            if (mk) { const int e = __builtin_ctz(mk); mk &= mk - 1u; const int sl = __builtin_amdgcn_readlane(SMQ[r], e); \
                const bf16* yr = ys + ((size_t)(e * ROWS_E + b * CAP + sl)) * 1024 + 4 * lane; \
                _Pragma("unroll") for (int j = 0; j < 4; ++j) yb[r][k][j] = *(const uint2*)(yr + 256 * j); } \
            else { _Pragma("unroll") for (int j = 0; j < 4; ++j) yb[r][k][j] = make_uint2(0u, 0u); } } \
        mrem[r] = mk; } } while (0)
    for (int t = t0; t < te; t += ts) {
      const int prb = 8 * t, pre = prb + 8;
      RP_LOADX(prb);
      if (COMBINE) { RP_LOADSM(smc, prb); RP_LOADSM(smn, prb + 1); RP_LOADY(smc, prb); }
#pragma unroll 1
      for (int pr = prb; pr < pre; ++pr) {
        const int row0 = 2 * pr;
        f32x4 v[2][4]; int smnn[2] = {-1, -1};
#pragma unroll
        for (int r = 0; r < 2; ++r) {
#pragma unroll
            for (int j = 0; j < 4; ++j) { if (SRC32) v[r][j] = vn[r][j]; else { const uint2 w = vnb[r][j]; v[r][j] = (f32x4){bf_lo(w.x), bf_hi(w.x), bf_lo(w.y), bf_hi(w.y)}; } } }
        { const int prn = pr + 1; if (prn < pre) RP_LOADX(prn);
          if (COMBINE) { const int prnn = pr + 2; if (prnn < pre) RP_LOADSM(smnn, prnn); } }
        if (COMBINE) {
#pragma unroll
            for (int r = 0; r < 2; ++r) { const int row = row0 + r, b = row >> 12;
#pragma unroll
                for (int k = 0; k < 4; ++k)
#pragma unroll
                    for (int j = 0; j < 4; ++j) { const uint2 w = yb[r][k][j]; v[r][j] += (f32x4){bf_lo(w.x), bf_hi(w.x), bf_lo(w.y), bf_hi(w.y)}; }
                unsigned mk = mrem[r];
                while (mk) { const int e = __builtin_ctz(mk); mk &= mk - 1u; const int sl = __builtin_amdgcn_readlane(smc[r], e);
                    const bf16* yr = ys + ((size_t)(e * ROWS_E + b * CAP + sl)) * 1024 + 4 * lane;
#pragma unroll
                    for (int j = 0; j < 4; ++j) { const uint2 w = *(const uint2*)(yr + 256 * j); v[r][j] += (f32x4){bf_lo(w.x), bf_hi(w.x), bf_lo(w.y), bf_hi(w.y)}; } } }
            { const int prn = pr + 1; if (prn < pre) RP_LOADY(smn, prn); }
#pragma unroll
            for (int r = 0; r < 2; ++r) { smc[r] = smn[r]; smn[r] = smnn[r]; }
        }
        if ((COMBINE && MODE != 3) || SRC32) {
#pragma unroll
            for (int r = 0; r < 2; ++r)
#pragma unroll
                for (int j = 0; j < 4; ++j) { uint2 o; o.x = pk2(v[r][j].x, v[r][j].y); o.y = pk2(v[r][j].z, v[r][j].w); *(uint2*)(xdst + (size_t)(row0 + r) * 1024 + 4 * lane + 256 * j) = o; }
        }
        float rstd[2];
#pragma unroll
        for (int r = 0; r < 2; ++r) { float ss = 0.f;
#pragma unroll
            for (int j = 0; j < 4; ++j) ss += (v[r][j].x * v[r][j].x + v[r][j].y * v[r][j].y) + (v[r][j].z * v[r][j].z + v[r][j].w * v[r][j].w);
            rstd[r] = __builtin_amdgcn_rsqf(wave_sum(ss) * (1.0f / 1024.0f) + EPS); }
        if (MODE == 3) {
#pragma unroll
            for (int r = 0; r < 2; ++r)
#pragma unroll
                for (int j = 0; j < 4; ++j) { const f32x4 h = v[r][j] * rstd[r] * gv[j]; *(f32x4*)(outf + (size_t)(row0 + r) * 1024 + 4 * lane + 256 * j) = h; } }
        else if (lane < 2) rsout[row0 + lane] = lane ? rstd[1] : rstd[0];
      }
      if (MODE == 1) {
          asm volatile("s_waitcnt vmcnt(0)" ::: "memory"); __builtin_amdgcn_fence(__ATOMIC_ACQUIRE, "agent");
          const int rr = lane & 15, q = lane >> 4; bf16x8 xa[32];
#pragma unroll
          for (int s = 0; s < 32; ++s) xa[s] = *(const bf16x8*)(xdst + (size_t)(t * 16 + rr) * 1024 + s * 32 + q * 8);
          proj16_tile<1>(C, xa, t, bias16, out16, nullptr); }
    }
#undef RP_LOADX
#undef RP_LOADSM
#undef RP_LOADY
    if (MODE == 1) __syncthreads();
}

__device__ __forceinline__ void prep_phase(const Ctx& C0, int layer, const float* const* in, bf16* ropedst, const int secs = 15) {
    const Ctx C = phase_ctx(C0);
    bf16* PROJ = (bf16*)(C.ws + WS_PROJ); bf16* YCAT = (bf16*)(C.ws + WS_YCAT); bf16* MQK = (bf16*)(C.ws + WS_MQK);
    const bf16* PW = (const bf16*)(C.ws + WS_POOLW) + (size_t)layer * 4 * 64 * 64;
    const float* ROPEC = (const float*)(C.ws + WS_ROPE); const float* ROPES = ROPEC + 4096 * 32;
    const float* qg = in[I_QNG] + layer * 64; const float* kg = in[I_KNG] + layer * 64;
    const float* cw = in[I_CONVW] + (size_t)layer * 5 * 512;
    const int lane = C.lane, rr = lane & 15, q = lane >> 4;
    bf16* KT = (bf16*)(C.ws + WS_KT); bf16* VT = (bf16*)(C.ws + WS_VT);
    LAS bf16* tile = (LAS bf16*)(C.ldsl + RING_OFF + C.wave * 16384);
    for (int grp = C.gw; grp < NTOK / 16; grp += C.NGW) {
        const int r0 = grp * 16, brow = r0 & ~4095, t0 = r0 & 4095;
#ifndef NO_POOL
        if (secs & 1)
        { LAS bf16* pst = (LAS bf16*)(C.ldsl + RING_OFF + C.wave * 16384);
          { v4u st[16];
#pragma unroll
            for (int i = 0; i < 16; ++i) { const int id = i * 64 + lane, row = id >> 5, c = id & 31, tu = t0 - 8 + row; st[i] = (v4u){0u, 0u, 0u, 0u};
                if (id < 992 && tu >= 0 && tu < 4096) st[i] = *(const v4u*)(PROJ + (size_t)(brow + tu) * NPROJ + C_POOL + c * 8); }
#pragma unroll
            for (int i = 0; i < 16; ++i) { const int id = i * 64 + lane, row = id >> 5, c = id & 31; if (id < 992) *(LAS v4u*)(pst + row * 264 + c * 8) = st[i]; } }
          LDS_WAIT(); asm volatile("" ::: "memory");
          const int t = t0 + rr;
#pragma unroll 1
          for (int g = 0; g < 4; ++g) { const int half = 1 << g, w = 2 << g; const int lo = max(t - half, 0), hi = min(t + half, 4096); const float inv = __builtin_amdgcn_rcpf((float)(hi - lo));
            bf16x8 bfr[2], afr[4][2]; float sum[2][8];
#pragma unroll
            for (int ks = 0; ks < 2; ++ks) {
#pragma unroll
                for (int i = 0; i < 8; ++i) sum[ks][i] = 0.f;
#pragma unroll
                for (int et = 0; et < 4; ++et) afr[et][ks] = *(const bf16x8*)(PW + ((size_t)(g * 64 + et * 16 + rr)) * 64 + ks * 32 + q * 8); }
            const LAS bf16* wp = pst + (rr + 8 - half) * 264 + g * 64 + q * 8;
#pragma unroll 2
            for (int u = 0; u < w; ++u) {
#pragma unroll
                for (int ks = 0; ks < 2; ++ks) { const v4u x = *(const LAS v4u*)(wp + u * 264 + ks * 32);
                    sum[ks][0] += bf_lo(x.x); sum[ks][1] += bf_hi(x.x); sum[ks][2] += bf_lo(x.y); sum[ks][3] += bf_hi(x.y); sum[ks][4] += bf_lo(x.z); sum[ks][5] += bf_hi(x.z); sum[ks][6] += bf_lo(x.w); sum[ks][7] += bf_hi(x.w); } }
#pragma unroll
            for (int ks = 0; ks < 2; ++ks) { const v4u s = *(const LAS v4u*)(pst + (rr + 8) * 264 + g * 64 + ks * 32 + q * 8);
                const float d0 = sum[ks][0] * inv - bf_lo(s.x), d1 = sum[ks][1] * inv - bf_hi(s.x), d2 = sum[ks][2] * inv - bf_lo(s.y), d3 = sum[ks][3] * inv - bf_hi(s.y);
                const float d4 = sum[ks][4] * inv - bf_lo(s.z), d5 = sum[ks][5] * inv - bf_hi(s.z), d6 = sum[ks][6] * inv - bf_lo(s.w), d7 = sum[ks][7] * inv - bf_hi(s.w);
                v4u pk; pk.x = pk2(d0, d1); pk.y = pk2(d2, d3); pk.z = pk2(d4, d5); pk.w = pk2(d6, d7); bfr[ks] = __builtin_bit_cast(bf16x8, pk); }
#pragma unroll
            for (int et = 0; et < 4; ++et) { f32x4 acc = (f32x4){0.f, 0.f, 0.f, 0.f};
#pragma unroll
                for (int ks = 0; ks < 2; ++ks) acc = MFMA16(afr[et][ks], bfr[ks], acc);
                uint2 o; o.x = pk2(acc.x, acc.y); o.y = pk2(acc.z, acc.w);
                *(uint2*)(YCAT + (size_t)(r0 + rr) * 1024 + g * 64 + et * 16 + 4 * q) = o; } }
          LDS_WAIT(); asm volatile("" ::: "memory"); }
#endif
        asm volatile("" ::: "memory");
#ifndef NO_CONV
        if (secs & 2)
        { float cwv[5][8];
#pragma unroll
          for (int j = 0; j < 5; ++j) { const f32x4 a = *(const f32x4*)(cw + j * 512 + lane * 8), b2 = *(const f32x4*)(cw + j * 512 + lane * 8 + 4);
              cwv[j][0] = a.x; cwv[j][1] = a.y; cwv[j][2] = a.z; cwv[j][3] = a.w; cwv[j][4] = b2.x; cwv[j][5] = b2.y; cwv[j][6] = b2.z; cwv[j][7] = b2.w; }
          const float ksc = (lane >= 32) ? 0.125f : 1.0f;
#pragma unroll
          for (int hf = 0; hf < 2; ++hf) { v4u xr[12];
#pragma unroll
            for (int u = 0; u < 12; ++u) { const int tu = t0 + hf * 8 + u - 2; const int tc = min(max(tu, 0), 4095); xr[u] = *(const v4u*)(PROJ + (size_t)(brow + tc) * NPROJ + C_MQ + lane * 8); }
#pragma unroll
            for (int u = 0; u < 12; ++u) { const int tu = t0 + hf * 8 + u - 2; if (tu < 0 || tu >= 4096) xr[u] = (v4u){0u, 0u, 0u, 0u}; }
#pragma unroll
            for (int r = 0; r < 8; ++r) { float acc[8];
#pragma unroll
                for (int i = 0; i < 8; ++i) acc[i] = 0.f;
#pragma unroll
                for (int j = 0; j < 5; ++j) { const v4u x = xr[r + j];
                    acc[0] += cwv[j][0] * bf_lo(x.x); acc[1] += cwv[j][1] * bf_hi(x.x); acc[2] += cwv[j][2] * bf_lo(x.y); acc[3] += cwv[j][3] * bf_hi(x.y);
                    acc[4] += cwv[j][4] * bf_lo(x.z); acc[5] += cwv[j][5] * bf_hi(x.z); acc[6] += cwv[j][6] * bf_lo(x.w); acc[7] += cwv[j][7] * bf_hi(x.w); }
#pragma unroll
                for (int i = 0; i < 8; ++i) acc[i] = acc[i] * fsigmoid(acc[i]) * ksc;
                v4u o; o.x = pk2(acc[0], acc[1]); o.y = pk2(acc[2], acc[3]); o.z = pk2(acc[4], acc[5]); o.w = pk2(acc[6], acc[7]);
                const int rw = hf * 8 + r;
                *(v4u*)(MQK + (size_t)(r0 + rw) * 512 + lane * 8) = o;
                if (lane >= 32) *(LAS v4u*)(tile + rw * 264 + (lane - 32) * 8) = o; } asm volatile("" ::: "memory"); } }
#endif
        asm volatile("" ::: "memory");
#ifndef NO_ROPE
        if (secs & 4)
        { const int c8 = lane & 7, rl = lane >> 3;
          f32x4 csv[2], snv[2];
#pragma unroll
          for (int hf = 0; hf < 2; ++hf) { const int t = t0 + hf * 8 + rl; csv[hf] = *(const f32x4*)(ROPEC + t * 32 + 4 * c8); snv[hf] = *(const f32x4*)(ROPES + t * 32 + 4 * c8); }
          const f32x4 qg0 = *(const f32x4*)(qg + 8 * c8), qg1 = *(const f32x4*)(qg + 8 * c8 + 4), kg0 = *(const f32x4*)(kg + 8 * c8), kg1 = *(const f32x4*)(kg + 8 * c8 + 4);
#pragma unroll 1
          for (int hb = 0; hb < 10; hb += 5) {
          v4u w[5][2];
#pragma unroll
          for (int h = 0; h < 5; ++h)
#pragma unroll
              for (int hf = 0; hf < 2; ++hf) { const int hh = hb + h; const int col = (hh < 8) ? C_AQ + hh * 64 : C_AK + (hh - 8) * 64; w[h][hf] = *(const v4u*)(PROJ + (size_t)(r0 + hf * 8 + rl) * NPROJ + col + 8 * c8); }
#pragma unroll
          for (int h = 0; h < 5; ++h)
#pragma unroll
              for (int hf = 0; hf < 2; ++hf) { const int hh = hb + h; const v4u x = w[h][hf];
                  const float x0 = bf_lo(x.x), x1 = bf_hi(x.x), x2 = bf_lo(x.y), x3 = bf_hi(x.y), x4 = bf_lo(x.z), x5 = bf_hi(x.z), x6 = bf_lo(x.w), x7 = bf_hi(x.w);
                  float ss = ((x0 * x0 + x1 * x1) + (x2 * x2 + x3 * x3)) + ((x4 * x4 + x5 * x5) + (x6 * x6 + x7 * x7));
                  ss = oct_sum(ss);
                  const float rs = __builtin_amdgcn_rsqf(ss * (1.0f / 64.0f) + EPS); const bool isq = hh < 8; const f32x4 g0 = isq ? qg0 : kg0, g1 = isq ? qg1 : kg1; const float sc = rs * (isq ? attn_body::C2 : 1.0f);
                  const float y0 = x0 * sc * g0.x, y1 = x1 * sc * g0.y, y2 = x2 * sc * g0.z, y3 = x3 * sc * g0.w, y4 = x4 * sc * g1.x, y5 = x5 * sc * g1.y, y6 = x6 * sc * g1.z, y7 = x7 * sc * g1.w;
                  const f32x4 c = csv[hf], sn4 = snv[hf];
                  v4u o; o.x = pk2(y0 * c.x - y1 * sn4.x, y0 * sn4.x + y1 * c.x); o.y = pk2(y2 * c.y - y3 * sn4.y, y2 * sn4.y + y3 * c.y);
                  o.z = pk2(y4 * c.z - y5 * sn4.z, y4 * sn4.z + y5 * c.z); o.w = pk2(y6 * c.w - y7 * sn4.w, y6 * sn4.w + y7 * c.w);
                  w[h][hf] = o; }
#pragma unroll
          for (int h = 0; h < 5; ++h)
#pragma unroll
              for (int hf = 0; hf < 2; ++hf) { const int hh = hb + h; const int col = (hh < 8) ? C_AQ + hh * 64 : C_AK + (hh - 8) * 64; *(v4u*)(ropedst + (size_t)(r0 + hf * 8 + rl) * NPROJ + col + 8 * c8) = w[h][hf]; }
          asm volatile("" ::: "memory"); }
          asm volatile("" ::: "memory"); }
#endif
        if (secs & 8) { const int chunk = grp >> 3, s0 = (grp & 7) * 16;
#pragma unroll 1
          for (int pass = 0; pass < 2; ++pass) {
            if (pass == 1) { v4u tv[8];
#pragma unroll
                for (int r2 = 0; r2 < 8; ++r2) { const int row = 2 * r2 + (lane >> 5), col8 = (lane & 31) * 8; tv[r2] = *(const v4u*)(PROJ + (size_t)(r0 + row) * NPROJ + C_MV + col8); }
#pragma unroll
                for (int r2 = 0; r2 < 8; ++r2) { const int row = 2 * r2 + (lane >> 5), col8 = (lane & 31) * 8; *(LAS v4u*)(tile + row * 264 + col8) = tv[r2]; } }
            LDS_WAIT(); asm volatile("" ::: "memory");
            bf16* dst = pass ? VT : KT;
#pragma unroll
            for (int k = 0; k < 4; ++k) { const int cidx = lane + 64 * k, hh = cidx >> 6, d = cidx & 63;
#pragma unroll
                for (int half = 0; half < 2; ++half) { unsigned w[4];
#pragma unroll
                    for (int i = 0; i < 4; ++i) w[i] = (unsigned)tile[(half * 8 + 2 * i) * 264 + cidx] | ((unsigned)tile[(half * 8 + 2 * i + 1) * 264 + cidx] << 16);
                    v4u o; o.x = w[0]; o.y = w[1]; o.z = w[2]; o.w = w[3];
                    *(v4u*)(dst + ((size_t)(chunk * 4 + hh) * 64 + d) * 128 + s0 + half * 8) = o; } }
            LDS_WAIT(); asm volatile("" ::: "memory");
          } }
    }
}

__device__ __forceinline__ void mlstm_local_phase(const Ctx& C0) {
    const Ctx C = phase_ctx(C0);
    const bf16* KT = (const bf16*)(C.ws + WS_KT); const bf16* VT = (const bf16*)(C.ws + WS_VT); const float* GATES = (const float*)(C.ws + WS_GATES);
    float* CST = (float*)(C.ws + WS_CST); float* MLOC = (float*)(C.ws + WS_MSC); float* BLAST = MLOC + 2048;
    const int lane = C.lane, wave = C.wave, rr = lane & 15, q = lane >> 4, dir = wave >> 2, nt = wave & 3;
    LAS float* wl = (LAS float*)(C.ldsl + RING_OFF) + wave * 128;
    for (int chunk = C.vcu; chunk < NBATCH * 32; chunk += C.G) {
        const int b = chunk >> 5, c = chunk & 31; const size_t row0 = (size_t)chunk * 128;
#pragma unroll 1
        for (int h = 0; h < 4; ++h) {
            const int sidx = ((b * 4 + h) * 2 + dir) * 32 + c; const int s0 = 2 * lane, s1 = s0 + 1;
            const float* g0p = GATES + (row0 + s0) * 16; const float li0 = g0p[dir * 4 + h], li1 = g0p[16 + dir * 4 + h], f0 = g0p[8 + dir * 4 + h], f1 = g0p[24 + dir * 4 + h];
            const bf16* kt = KT + ((size_t)(chunk * 4 + h) * 64 + nt * 16 + rr) * 128 + q * 8; const bf16* vt = VT + ((size_t)(chunk * 4 + h) * 64 + rr) * 128 + q * 8;
            v4u krr[4]; bf16x8 vfr[4][4];
#pragma unroll
            for (int ks = 0; ks < 4; ++ks) { krr[ks] = *(const v4u*)(kt + ks * 32);
#pragma unroll
                for (int m = 0; m < 4; ++m) vfr[ks][m] = *(const bf16x8*)(vt + (size_t)m * 16 * 128 + ks * 32); }
            float bc0, bc1, tot;
            if (dir == 0) { const float inc = wscan_add(f0 + f1, lane); bc1 = inc; bc0 = inc - f1; tot = lane_bcast(inc, 63); }
            else { const float suf = wscan_add_rev(f0 + f1, lane); bc0 = suf; bc1 = suf - f0; tot = lane_bcast(suf, 0); }
            const float g0 = tot - bc0 + li0, g1 = tot - bc1 + li1; float mx = fmaxf(g0, g1);
#pragma unroll
            for (int o = 1; o < 2; o <<= 1) mx = wave_max(mx);
            *(LAS f32x2v*)(wl + s0) = (f32x2v){fexp(g0 - mx), fexp(g1 - mx)};
            if (nt == 0 && lane == 0) { MLOC[sidx] = mx; BLAST[sidx] = tot; }
            LDS_WAIT(); asm volatile("" ::: "memory");
            f32x4 acc[4]; float nsum = 0.f;
#pragma unroll
            for (int m = 0; m < 4; ++m) acc[m] = (f32x4){0.f, 0.f, 0.f, 0.f};
#pragma unroll
            for (int ks = 0; ks < 4; ++ks) { const v4u kr = krr[ks]; const f32x4 wa = *(const LAS f32x4*)(wl + ks * 32 + q * 8), wb = *(const LAS f32x4*)(wl + ks * 32 + q * 8 + 4);
                const float k0 = bf_lo(kr.x) * wa.x, k1 = bf_hi(kr.x) * wa.y, k2 = bf_lo(kr.y) * wa.z, k3 = bf_hi(kr.y) * wa.w, k4 = bf_lo(kr.z) * wb.x, k5 = bf_hi(kr.z) * wb.y, k6 = bf_lo(kr.w) * wb.z, k7 = bf_hi(kr.w) * wb.w;
                nsum += ((k0 + k1) + (k2 + k3)) + ((k4 + k5) + (k6 + k7));
                v4u pk; pk.x = pk2(k0, k1); pk.y = pk2(k2, k3); pk.z = pk2(k4, k5); pk.w = pk2(k6, k7); const bf16x8 bfr = __builtin_bit_cast(bf16x8, pk);
#pragma unroll
                for (int m = 0; m < 4; ++m) acc[m] = MFMA16(vfr[ks][m], bfr, acc[m]); }
            nsum += __shfl_xor(nsum, 16); nsum += __shfl_xor(nsum, 32);
            float* out = CST + (size_t)sidx * CST_SZ;
#pragma unroll
            for (int m = 0; m < 4; ++m)
#pragma unroll
                for (int j = 0; j < 4; ++j) out[(m * 16 + 4 * q + j) * 64 + nt * 16 + rr] = acc[m][j];
            if (q == 0) out[4096 + nt * 16 + rr] = nsum;
            LDS_WAIT(); asm volatile("" ::: "memory");
        }
    }
}

__device__ __forceinline__ void mlstm_scan_phase(const Ctx& C0) {
    const Ctx C = phase_ctx(C0);
    const float* CST = (const float*)(C.ws + WS_CST); bf16* CSB = (bf16*)(C.ws + WS_CSB); const float* MLOC = (const float*)(C.ws + WS_MSC); const float* BLAST = MLOC + 2048; float* MST = (float*)(C.ws + WS_MSC) + 4096;
    const int spg = 64 / C.ng, lt = C.lb * 512 + C.tid, LT = C.GB * 512;
    LAS float* tb = (LAS float*)(C.ldsl + RING_OFF);
    for (int sq = C.wave; sq < spg; sq += 8) { const int seq = C.grp * spg + sq, dir = seq & 1, ln = C.lane;
        float mlv = 0.f, blv = 0.f; if (ln < 32) { const int cc = dir ? 31 - ln : ln; mlv = MLOC[seq * 32 + cc]; blv = BLAST[seq * 32 + cc]; }
        float m = 0.f;
        for (int s2 = 0; s2 < 32; ++s2) { const float b_ = lane_bcast(blv, s2), ml_ = lane_bcast(mlv, s2); const float mn = fmaxf(b_ + m, ml_);
            if (ln == s2) { tb[(sq * 32 + s2) * 4 + 0] = m; tb[(sq * 32 + s2) * 4 + 1] = fexp(b_ + m - mn); tb[(sq * 32 + s2) * 4 + 2] = fexp(ml_ - mn); }
            m = mn; } }
    __syncthreads();
    for (int li = lt; li < spg * CST_SZ; li += LT) {
        const int sq = li / CST_SZ, el = li - sq * CST_SZ, seq = C.grp * spg + sq, dir = seq & 1;
        float loc[32];
#pragma unroll
        for (int s = 0; s < 32; ++s) { const int c = dir ? 31 - s : s; const int idx = seq * 32 + c; loc[s] = CST[(size_t)idx * CST_SZ + el]; }
        float st = 0.f;
#pragma unroll
        for (int s = 0; s < 32; ++s) { const int c = dir ? 31 - s : s; const int idx = seq * 32 + c;
            CSB[(size_t)idx * CST_SZ + el] = (bf16)f2bf(st);
            const f32x4 cf = *(const LAS f32x4*)(tb + (sq * 32 + s) * 4); st = cf.y * st + cf.z * loc[s]; }
    }
    { const float* GATES = (const float*)(C.ws + WS_GATES); float* GV = (float*)(C.ws + WS_GV); const int lane = C.lane;
      for (int task = C.lb * 8 + C.wave; task < spg * 32; task += C.GB * 8) {
        const int sq = task >> 5, c = task & 31, seq = C.grp * spg + sq, dir = seq & 1, bh = seq >> 1, b = bh >> 2, h = bh & 3; const int sidx = seq * 32 + c;
        const int npre = dir ? 31 - c : c; const float mst = tb[(sq * 32 + npre) * 4];
        const size_t row0 = (size_t)b * 4096 + c * 128; const int s0 = 2 * lane, s1 = s0 + 1;
        const float* g0p = GATES + (row0 + s0) * 16; const float li0 = g0p[dir * 4 + h], li1 = g0p[16 + dir * 4 + h], f0 = g0p[8 + dir * 4 + h], f1 = g0p[24 + dir * 4 + h];
        float bc0, bc1;
        if (dir == 0) { const float inc = wscan_add(f0 + f1, lane); bc1 = inc; bc0 = inc - f1; }
        else { const float suf = wscan_add_rev(f0 + f1, lane); bc0 = suf; bc1 = suf - f0; }
        const float cb0 = li0 - bc0, cb1 = li1 - bc1; float mx0, mx1;
        if (dir == 0) { const float inc = wscan_max(fmaxf(cb0, cb1), lane); float prev = __shfl_up(inc, 1); if (lane == 0) prev = -INFINITY; mx1 = inc; mx0 = fmaxf(prev, cb0); }
        else { const float suf = wscan_max_rev(fmaxf(cb0, cb1), lane); float nxt = __shfl_down(suf, 1); if (lane == 63) nxt = -INFINITY; mx0 = suf; mx1 = fmaxf(nxt, cb1); }
        const float m0 = bc0 + fmaxf(mst, mx0), m1 = bc1 + fmaxf(mst, mx1);
        float* gv = GV + (size_t)sidx * 512 + s0;
        *(f32x2v*)(gv) = (f32x2v){cb0, cb1}; *(f32x2v*)(gv + 128) = (f32x2v){bc0 - m0, bc1 - m1};
        *(f32x2v*)(gv + 256) = (f32x2v){fexp(bc0 + mst - m0), fexp(bc1 + mst - m1)}; *(f32x2v*)(gv + 384) = (f32x2v){fexp(-m0), fexp(-m1)};
      } }
}

constexpr int MO_WAVE_BYTES = 2 * 4352;
constexpr int MO_K_OFF = 0, MO_V_OFF = MO_K_OFF + 128 * 144, MO_CF_OFF = MO_V_OFF + 64 * 272, MO_CB_OFF = MO_CF_OFF + 65 * 144, MO_GV_OFF = MO_CB_OFF + 65 * 144, MO_P_OFF = MO_GV_OFF + 4096;
static_assert(MO_P_OFF % 16 == 0 && MO_P_OFF + 8 * MO_WAVE_BYTES <= RING_BYTES, "mlstm_out LDS");
__device__ __forceinline__ void mlstm_out_phase(const Ctx& C0, int layer, const float* const* in) {
    const Ctx C = phase_ctx(C0);
    const bf16* PROJ = (const bf16*)(C.ws + WS_PROJ); const bf16* MQK = (const bf16*)(C.ws + WS_MQK); const bf16* VT = (const bf16*)(C.ws + WS_VT);
    const bf16* CSB = (const bf16*)(C.ws + WS_CSB); const float* GV = (const float*)(C.ws + WS_GV); bf16* YCAT = (bf16*)(C.ws + WS_YCAT);
    const float* ng = in[I_MNORMG] + layer * 256;
    const int tid = C.tid, lane = C.lane, wave = C.wave, rr = lane & 15, q = lane >> 4, j0 = wave * 16;
    LAS bf16* Ks = (LAS bf16*)(C.ldsl + RING_OFF + MO_K_OFF); LAS bf16* Vs = (LAS bf16*)(C.ldsl + RING_OFF + MO_V_OFF);
    LAS bf16* Cfs = (LAS bf16*)(C.ldsl + RING_OFF + MO_CF_OFF); LAS bf16* Cbs = (LAS bf16*)(C.ldsl + RING_OFF + MO_CB_OFF); LAS float* GVs = (LAS float*)(C.ldsl + RING_OFF + MO_GV_OFF);
    LAS bf16* Psf = (LAS bf16*)(C.ldsl + RING_OFF + MO_P_OFF + wave * MO_WAVE_BYTES); LAS bf16* Psb = Psf + 16 * 136;
    const int upg = NBATCH * 4 * 32 / C.ng;
    v4u pk[2], pv[2], pcf[2], pcb[2], pg; bf16x8 qan[2]; bf16 ogn[4][4];
    pcf[1] = (v4u){0u, 0u, 0u, 0u}; pcb[1] = pcf[1]; pg = pcf[1];
#define MO_ISSUE(lu_) do { const int un_ = C.grp * upg + (lu_); const int c_ = un_ & 31, h_ = (un_ >> 5) & 3, b_ = un_ >> 7; const size_t rw_ = (size_t)b_ * 4096 + c_ * 128; const int ch_ = b_ * 32 + c_; \
        const int sf_ = ((b_ * 4 + h_) * 2) * 32 + c_, sb_ = sf_ + 32; \
        _Pragma("unroll") for (int i_ = 0; i_ < 2; ++i_) { const int ix_ = tid + 512 * i_; \
            pk[i_] = *(const v4u*)(MQK + (rw_ + (ix_ >> 3)) * 512 + 256 + h_ * 64 + (ix_ & 7) * 8); \
            pv[i_] = *(const v4u*)(VT + ((size_t)(ch_ * 4 + h_) * 64 + (ix_ >> 4)) * 128 + (ix_ & 15) * 8); } \
        pcf[0] = *(const v4u*)(CSB + (size_t)sf_ * CST_SZ + tid * 8); pcb[0] = *(const v4u*)(CSB + (size_t)sb_ * CST_SZ + tid * 8); \
        if (tid < 8) { pcf[1] = *(const v4u*)(CSB + (size_t)sf_ * CST_SZ + (512 + tid) * 8); pcb[1] = *(const v4u*)(CSB + (size_t)sb_ * CST_SZ + (512 + tid) * 8); } \
        if (tid < 256) pg = *(const v4u*)(GV + (size_t)(tid < 128 ? sf_ : sb_) * 512 + (tid & 127) * 4); \
        _Pragma("unroll") for (int ks_ = 0; ks_ < 2; ++ks_) qan[ks_] = *(const bf16x8*)(MQK + (rw_ + j0 + rr) * 512 + h_ * 64 + ks_ * 32 + q * 8); \
        _Pragma("unroll") for (int i_ = 0; i_ < 4; ++i_) _Pragma("unroll") for (int et_ = 0; et_ < 4; ++et_) ogn[i_][et_] = PROJ[(rw_ + j0 + 4 * q + i_) * NPROJ + C_MO + h_ * 64 + et_ * 16 + rr]; } while (0)
#define MO_COMMIT() do { \
        _Pragma("unroll") for (int i_ = 0; i_ < 2; ++i_) { const int ix_ = tid + 512 * i_; \
            *(LAS v4u*)(Ks + (ix_ >> 3) * 72 + (ix_ & 7) * 8) = pk[i_]; *(LAS v4u*)(Vs + (ix_ >> 4) * 136 + (ix_ & 15) * 8) = pv[i_]; } \
        *(LAS v4u*)(Cfs + (tid >> 3) * 72 + (tid & 7) * 8) = pcf[0]; *(LAS v4u*)(Cbs + (tid >> 3) * 72 + (tid & 7) * 8) = pcb[0]; \
        if (tid < 8) { *(LAS v4u*)(Cfs + 64 * 72 + tid * 8) = pcf[1]; *(LAS v4u*)(Cbs + 64 * 72 + tid * 8) = pcb[1]; } \
        if (tid < 256) *(LAS v4u*)(GVs + tid * 4) = pg; } while (0)
    if (C.lb < upg) { MO_ISSUE(C.lb); MO_COMMIT(); }
    __syncthreads();
    for (int lu = C.lb; lu < upg; lu += C.GB) { const int unit = C.grp * upg + lu;
        const int c = unit & 31, h = (unit >> 5) & 3, b = unit >> 7; const size_t row0 = (size_t)b * 4096 + c * 128;
        bf16x8 qa[2]; bf16 ogr[4][4];
#pragma unroll
        for (int ks = 0; ks < 2; ++ks) qa[ks] = qan[ks];
#pragma unroll
        for (int i = 0; i < 4; ++i)
#pragma unroll
            for (int et = 0; et < 4; ++et) ogr[i][et] = ogn[i][et];
        const bool more = (lu + C.GB < upg);
        if (more) MO_ISSUE(lu + C.GB);
        const f32x4 raf = *(const LAS f32x4*)(GVs + 128 + j0 + 4 * q), aif = *(const LAS f32x4*)(GVs + 256 + j0 + 4 * q), emf = *(const LAS f32x4*)(GVs + 384 + j0 + 4 * q);
        const f32x4 rab = *(const LAS f32x4*)(GVs + 512 + 128 + j0 + 4 * q), aib = *(const LAS f32x4*)(GVs + 512 + 256 + j0 + 4 * q), emb = *(const LAS f32x4*)(GVs + 512 + 384 + j0 + 4 * q);
        float rsf[4] = {0.f, 0.f, 0.f, 0.f}, rsb[4] = {0.f, 0.f, 0.f, 0.f};
#pragma unroll
        for (int nt = 0; nt < 8; ++nt) { const int s = nt * 16 + rr; const bool usef = (nt * 16 <= j0 + 15), useb = (nt * 16 + 15 >= j0);
            const float cbf = GVs[nt * 16 + rr], cbb = GVs[512 + nt * 16 + rr];
            f32x4 acc = (f32x4){0.f, 0.f, 0.f, 0.f};
#pragma unroll
            for (int ks = 0; ks < 2; ++ks) acc = MFMA16(qa[ks], *(const LAS bf16x8*)(Ks + (nt * 16 + rr) * 72 + ks * 32 + q * 8), acc);
#pragma unroll
            for (int i = 0; i < 4; ++i) { const int j = j0 + 4 * q + i;
                float pf = 0.f, pb = 0.f;
                if (usef) { pf = (s <= j) ? acc[i] * fexp(raf[i] + cbf) : 0.f; rsf[i] += pf; }
                if (useb) { pb = (s >= j) ? acc[i] * fexp(rab[i] + cbb) : 0.f; rsb[i] += pb; }
                Psf[(4 * q + i) * 136 + s] = (bf16)f2bf(pf); Psb[(4 * q + i) * 136 + s] = (bf16)f2bf(pb); } }
        LDS_WAIT(); asm volatile("" ::: "memory");
#pragma unroll
        for (int i = 0; i < 4; ++i) {
#pragma unroll
            for (int o = 1; o < 2; o <<= 1) { rsf[i] = row_sum(rsf[i]); rsb[i] = row_sum(rsb[i]); } }
        f32x4 hsum[4];
#pragma unroll
        for (int dir = 0; dir < 2; ++dir) { LAS bf16* Cs = dir ? Cbs : Cfs; LAS bf16* Ps = dir ? Psb : Psf; const f32x4 ai = dir ? aib : aif, em = dir ? emb : emf;
          f32x4 o[5];
#pragma unroll
          for (int et = 0; et < 5; ++et) { o[et] = (f32x4){0.f, 0.f, 0.f, 0.f};
#pragma unroll
              for (int ks = 0; ks < 2; ++ks) { bf16x8 cf = (bf16x8){0, 0, 0, 0, 0, 0, 0, 0}; if (et < 4 || rr == 0) cf = *(const LAS bf16x8*)(Cs + (et * 16 + rr) * 72 + ks * 32 + q * 8);
                  o[et] = MFMA16(qa[ks], cf, o[et]); } }
          float qn[4];
#pragma unroll
          for (int i = 0; i < 4; ++i) qn[i] = __shfl(o[4][i], lane & 48);
#pragma unroll
          for (int et = 0; et < 4; ++et)
#pragma unroll
              for (int i = 0; i < 4; ++i) o[et][i] *= ai[i];
#pragma unroll
          for (int ks = 0; ks < 4; ++ks) { const bool on = dir ? (ks * 32 + 31 >= j0) : (ks * 32 <= j0 + 15);
              if (on) { const bf16x8 afr = *(const LAS bf16x8*)(Ps + rr * 136 + ks * 32 + q * 8);
#pragma unroll
              for (int et = 0; et < 4; ++et) o[et] = MFMA16(afr, *(const LAS bf16x8*)(Vs + (et * 16 + rr) * 136 + ks * 32 + q * 8), o[et]); } }
#pragma unroll
          for (int i = 0; i < 4; ++i) { const float den = (dir ? rsb[i] : rsf[i]) + ai[i] * qn[i]; const float rinv = __builtin_amdgcn_rcpf(fmaxf(fabsf(den), em[i]));
#pragma unroll
              for (int et = 0; et < 4; ++et) { const float t = o[et][i] * rinv; hsum[et][i] = dir ? hsum[et][i] + t : t; } } }
#pragma unroll
        for (int i = 0; i < 4; ++i) { float ss = 0.f;
#pragma unroll
            for (int et = 0; et < 4; ++et) ss += hsum[et][i] * hsum[et][i];
#pragma unroll
            for (int o = 1; o < 2; o <<= 1) ss = row_sum(ss);
            const float rs = __builtin_amdgcn_rsqf(ss * (1.0f / 64.0f) + EPS); const size_t row = row0 + j0 + 4 * q + i;
#pragma unroll
            for (int et = 0; et < 4; ++et) { const int e = et * 16 + rr; const float og = bf2f(ogr[i][et]);
                const float y = hsum[et][i] * rs * ng[h * 64 + e] * fsigmoid(og); YCAT[row * 1024 + 256 + h * 64 + e] = (bf16)f2bf(y); } }
        LDS_WAIT(); asm volatile("" ::: "memory");
        __syncthreads();
        if (more) MO_COMMIT();
        __syncthreads();
    }
#undef MO_ISSUE
#undef MO_COMMIT
}

__device__ __forceinline__ void topk_phase(const Ctx& C0) {
    const Ctx C = phase_ctx(C0);
    const float* AFF = (const float*)(C.ws + WS_AFF); int* TOKI = (int*)(C.ws + WS_TOKI); float* GATEV = (float*)(C.ws + WS_TOKI + 262144); float* RSTDS = (float*)(C.ws + WS_TOKI + 524288); const float* RSTD3 = (const float*)(C.ws + WS_TOKI + 786432 + 131072); int* SLOTMAP = (int*)(C.ws + WS_SLOTMAP);
    LAS unsigned* hist = (LAS unsigned*)(C.ldsl + RING_OFF); LAS unsigned* sel = hist + 4096; LAS unsigned* wtot = hist + 4104;
    const int tid = C.tid, lane = C.lane, wave = C.wave;
    const int upg = NBATCH * NEXP / C.ng;
    for (int lu = C.lb; lu < upg; lu += C.GB) { const int unit = C.grp * upg + lu;
        const int b = unit >> 4, e = unit & 15; const float* a = AFF + (size_t)unit * 4096;
        unsigned key[8];
#pragma unroll
        for (int i = 0; i < 2; ++i) { const f32x4 v = *(const f32x4*)(a + 8 * tid + 4 * i); key[4 * i] = __float_as_uint(v.x); key[4 * i + 1] = __float_as_uint(v.y); key[4 * i + 2] = __float_as_uint(v.z); key[4 * i + 3] = __float_as_uint(v.w); }
        unsigned prefix = 0u, mask = 0u; int krem = CAP;
#pragma unroll 1
        for (int pass = 0; pass < 3; ++pass) { const int shift = 20 - 10 * pass; const unsigned nbm = pass ? 1023u : 4095u;
#pragma unroll
            for (int j = 0; j < 8; ++j) hist[tid * 8 + j] = 0u;
            __syncthreads();
#pragma unroll
            for (int i = 0; i < 8; ++i) if ((key[i] & mask) == prefix) atomicAdd((unsigned*)&hist[(key[i] >> shift) & nbm], 1u);
            __syncthreads();
            unsigned h[8]; unsigned tsum = 0u;
#pragma unroll
            for (int j = 0; j < 8; ++j) { h[j] = hist[tid * 8 + j]; tsum += h[j]; }
            unsigned sfx = tsum;
#pragma unroll
            for (int o = 1; o < 64; o <<= 1) { const unsigned t2 = __shfl_down(sfx, o); if (lane + o < 64) sfx += t2; }
            if (lane == 0) wtot[wave] = sfx;
            __syncthreads();
            { unsigned s2 = sfx - tsum;
#pragma unroll
              for (int w = 1; w < 8; ++w) if (w > wave) s2 += wtot[w];
#pragma unroll
              for (int j = 7; j >= 0; --j) { if ((int)s2 < krem && (int)(s2 + h[j]) >= krem) { sel[0] = (unsigned)(tid * 8 + j); sel[1] = s2; } s2 += h[j]; } }
            __syncthreads();
            prefix |= sel[0] << shift; mask |= nbm << shift; krem -= (int)sel[1];
            __syncthreads();
        }
        const int cnt_gt = CAP - krem;
        unsigned pk = 0u;
#pragma unroll
        for (int i = 0; i < 8; ++i) pk += (key[i] > prefix ? 1u : 0u) + (key[i] == prefix ? 65536u : 0u);
        unsigned inc = pk;
#pragma unroll
        for (int o = 1; o < 64; o <<= 1) { const unsigned t2 = __shfl_up(inc, o); if (lane >= o) inc += t2; }
        if (lane == 63) wtot[wave] = inc;
        __syncthreads();
        unsigned woff = 0u;
#pragma unroll
        for (int w = 0; w < 8; ++w) { const unsigned x = wtot[w]; if (w < wave) woff += x; }
        const unsigned ex = woff + inc - pk; int pos_gt = (int)(ex & 0xffffu), pos_eq = (int)(ex >> 16);
        int slots[8];
#pragma unroll
        for (int i = 0; i < 8; ++i) { const bool gt = key[i] > prefix, eq = key[i] == prefix; const bool selected = gt || (eq && pos_eq < krem);
            slots[i] = selected ? (gt ? pos_gt : cnt_gt + pos_eq) : -1; pos_gt += gt ? 1 : 0; pos_eq += eq ? 1 : 0;
            if (selected) { TOKI[e * ROWS_E + b * CAP + slots[i]] = b * 4096 + 8 * tid + i; GATEV[e * ROWS_E + b * CAP + slots[i]] = __uint_as_float(key[i]); RSTDS[e * ROWS_E + b * CAP + slots[i]] = RSTD3[b * 4096 + 8 * tid + i]; } }
#pragma unroll
        for (int i = 0; i < 8; ++i) SLOTMAP[((size_t)(b * 4096 + 8 * tid + i)) * 16 + e] = slots[i];
        __syncthreads();
    }
}
#ifndef MK_ONE_LAUNCH
#define MK_ONE_LAUNCH 1
#endif
#ifndef PHM
#define PHM 0xFFFF
#endif
#ifndef STAGGER_ITEMS
#define STAGGER_ITEMS 4
#endif
#ifndef A_ALIGN
#define A_ALIGN true
#endif
#ifndef RES_ALIGN
#define RES_ALIGN false
#endif
#ifndef PREP_SECS
#define PREP_SECS 15
#endif
#ifndef MN_LOCAL
#define MN_LOCAL 0
#endif
#ifndef LOCAL_SEAMS
#define LOCAL_SEAMS 1
#endif
#ifndef CONV_PARTS
#define CONV_PARTS 1
#endif
#ifndef PROBE_N
#define PROBE_N 2
#endif
#ifndef REP_BARL
#define REP_BARL 1
#endif
#ifndef REP_BAR
#define REP_BAR 1
#endif
#ifndef REP_P0
#define REP_P0 1
#endif
#ifndef REP_A
#define REP_A 1
#endif
#ifndef REP_C
#define REP_C 1
#endif
#ifndef REP_E1
#define REP_E1 1
#endif
#ifndef REP_E2
#define REP_E2 1
#endif
#ifndef REP_G
#define REP_G 1
#endif
#ifndef REP_H
#define REP_H 1
#endif
#ifndef REP_K
#define REP_K 1
#endif
#ifndef REP_L
#define REP_L 1
#endif
#ifndef REP_M
#define REP_M 1
#endif
#ifndef REP_N
#define REP_N 1
#endif
#ifndef REP_B
#define REP_B 1
#endif
#ifndef REP_D
#define REP_D 1
#endif
#ifndef REP_F
#define REP_F 1
#endif
#ifndef REP_I
#define REP_I 1
#endif
#ifndef REP_J
#define REP_J 1
#endif
#ifndef REP_O
#define REP_O 1
#endif
#define REPEAT(n) for (int rep_ = 0; rep_ < (n); ++rep_)
constexpr int NWAVES = 8;
constexpr int GU_MAXU = 16;
static_assert(XTRA_OFF + GU_MAXU * (512 + 1024) <= LDS_BYTES, "gather tables");
static_assert(GU_MAXU >= 16, "gather table");
constexpr int PH_PER_LAYER = 12, N_PHASES = 1 + DEPTH * PH_PER_LAYER;
struct Args { const float* in[N_IN]; float* out; unsigned char* ws; int ph_lo, ph_hi; };
static_assert(sizeof(Args) == (N_IN + 2) * 8 + 8, "no padding in Args");

__global__ void __launch_bounds__(NWAVES * 64, 2) mk_fwd(Args args) {
    extern __shared__ __attribute__((aligned(16))) unsigned char lds[];
    Ctx C;
    C.tid = threadIdx.x; C.lane = C.tid & 63; C.wave = __builtin_amdgcn_readfirstlane(C.tid >> 6);
    C.G = gridDim.x; { const int bx = blockIdx.x; C.vcu = (C.G % 8 == 0) ? (bx % 8) * (C.G / 8) + bx / 8 : bx; }
    C.gw = C.vcu * NWAVES + C.wave; C.NGW = C.G * NWAVES; C.ng = (C.G % 8 == 0) ? 8 : 1; C.GB = C.G / C.ng; C.grp = C.vcu / C.GB; C.lb = C.vcu % C.GB; C.lds = lds; C.ws = args.ws; C.ldsl = (LAS unsigned char*)lds;
    unsigned char* ws = args.ws;
    LAS unsigned char* ldsl = (LAS unsigned char*)lds;
    volatile LAS unsigned* MISC = (volatile LAS unsigned*)(ldsl + MISC_OFF);
    for (int u = C.tid; u < (LDS_BYTES - LDSCTL_OFF) / 4; u += NWAVES * 64) ((LAS unsigned*)(ldsl + LDSCTL_OFF))[u] = 0u;
    __syncthreads();
    XcdBarrier bar; bar.bar = (unsigned*)(ws + WS_CTL) + CW_BAR; bar.x = 0; bar.st = nullptr;
    if (MK_ONE_LAUNCH) bar = xcd_barrier_post((unsigned*)(ws + WS_CTL) + CW_BAR, MISC + 8);
    const int lo = args.ph_lo, hi = args.ph_hi;
#define IN(k) (lo <= (k) && (k) < hi)
#define SEAM(k) do { if (IN(k) && IN((k) + 1)) { REPEAT(REP_BAR) xcd_barrier(bar); } } while (0)
#define SEAM_L(k) do { if (IN(k) && IN((k) + 1)) { REPEAT(REP_BARL) { if (fastmode) local_barrier((unsigned*)(ws + WS_CTL) + CW_BAR, (unsigned*)(ws + WS_CTL) + CW_LOC + 64 * C.grp, (unsigned)C.GB, MISC + 20); else xcd_barrier(bar); } } } while (0)
    const float* const* in = args.in;
#define HN ((bf16*)(ws + WS_HN))
#define PROJ ((bf16*)(ws + WS_PROJ))
#define YCAT ((bf16*)(ws + WS_YCAT))
#define QCA ((bf16*)(ws + WS_QCA))
#define X ((float*)(ws + WS_X))
#define XB ((bf16*)(ws + WS_X))
#define RSTD1 ((float*)(ws + WS_TOKI + 786432))
#define RSTD3 ((float*)(ws + WS_TOKI + 786432 + 131072))
#define RSTDS ((float*)(ws + WS_TOKI + 524288))
#define GATES ((float*)(ws + WS_GATES))
#define AFF ((float*)(ws + WS_AFF))
#define TOKI ((int*)(ws + WS_TOKI))
#define GATEV ((float*)(ws + WS_TOKI + 262144))
#define SLOTMAP ((int*)(ws + WS_SLOTMAP))
#define ACT ((bf16*)(ws + WS_ACT))
#define YS ((bf16*)(ws + WS_YS))

    if ((PHM & 1) && IN(0)) {
        REPEAT(REP_P0) { prologue_convert(C, in, MK_ONE_LAUNCH != 0);
        __syncthreads(); }
        row_phase<1, false, true>(C, in[I_X], XB, in[I_NMIXG], RSTD1, in[I_WIN] + 1280, 2064, in[I_GATEB], GATES, nullptr, nullptr, nullptr);
        if (MK_ONE_LAUNCH && LOCAL_SEAMS && C.tid == 0) atomicOr((unsigned*)(ws + WS_CTL) + CW_LOC + 1024 + 64 * C.grp, 1u << bar.x);
        SEAM(0);
    }
    bool fastmode = false;
    const bool mnloc = (C.ng == 8 && C.GB == 32);
    if (MK_ONE_LAUNCH && LOCAL_SEAMS && lo == 0 && hi == N_PHASES) {
        if (C.tid == 0) { unsigned ok = (C.ng == 8) ? 1u : 0u;
            for (int g = 0; g < 8; ++g) { const unsigned m = xb_ld((unsigned*)(ws + WS_CTL) + CW_LOC + 1024 + 64 * g); if (m == 0u || (m & (m - 1u)) != 0u) ok = 0u; }
            MISC[21] = ok; }
        __syncthreads();
        fastmode = (MISC[21] != 0u);
    }
#pragma unroll 1
    for (int l = 0; l < DEPTH; ++l) {
        const int pb = 1 + l * PH_PER_LAYER;
        if ((PHM & (1 << 1)) && IN(pb + 0)) {
            if (l == 0) { pg8::Gemm g{(const pg8::bf16_t*)(ws + WS_MEMB), (const pg8::bf16_t*)(ws + WS_WCAKV), 1024, 0, 1024L * 1024, nullptr, 0, nullptr}; pg8::Sched S; S.init(8, 4, 4, C.G, (int)blockIdx.x);
                pg8::EpiBf16 E{(pg8::bf16_t*)(ws + WS_KVCA), 1024, 2048L * 1024, 1.0f};
                pg8::gemm_phase<pg8::EpiBf16, true, false>(ldsl + RING_OFF, g, S, E); }
            REPEAT(REP_A) { pg8::Gemm g{(const pg8::bf16_t*)XB, (const pg8::bf16_t*)(ws + WS_WIN) + (size_t)l * 2048 * 1024, 1024, 0, 0, nullptr, 0, nullptr}; pg8::Sched S; S.init(NTOK / 256, NPROJ / 256, 1, C.G, (int)blockIdx.x);
              pg8::row_table((LAS float*)(ldsl + XTRA_OFF), RSTD1, 0, S, GU_MAXU);
              pg8::EpiBf16S E{(pg8::bf16_t*)PROJ, NPROJ, (const LAS float*)(ldsl + XTRA_OFF)};
              pg8::gemm_phase<pg8::EpiBf16S, A_ALIGN, false>(ldsl + RING_OFF, g, S, E); }
            if (l == 0) SEAM(pb + 0); else SEAM_L(pb + 0);
        }
        if ((PHM & (1 << 2)) && IN(pb + 1)) { REPEAT(REP_B - 1) prep_phase(C, l, in, ACT, PREP_SECS); prep_phase(C, l, in, PROJ); VM_WAIT(); __syncthreads(); REPEAT(REP_C) mlstm_local_phase(C); SEAM_L(pb + 1); }
        if ((PHM & (1 << 4)) && IN(pb + 2)) { REPEAT(REP_D) mlstm_scan_phase(C); SEAM_L(pb + 2); }
        if ((PHM & (1 << 5)) && IN(pb + 3)) {
#ifndef NO_MOUT
            REPEAT(REP_E1) { mlstm_out_phase(C, l, in);
            __syncthreads(); }
#endif
#ifndef NO_ATTN
            REPEAT(REP_E2) for (int i = 0; i < 4; ++i) { const int u = C.vcu * 4 + i; if (u >= NBATCH * 8 * 16) break; const int qb = u & 15, h = (u >> 4) & 7, b = u >> 7;
                attn_body::attn_unit<8>((long)b * 4096, qb * 256, (const attn_body::bf16*)PROJ + C_AQ + h * 64, (const attn_body::bf16*)PROJ + C_AK + (h >> 2) * 64, (const attn_body::bf16*)PROJ + C_AV + (h >> 2) * 64,
                                        (attn_body::bf16*)YCAT + 512 + h * 64, (char*)lds + RING_OFF);
#if CONV_PARTS == 2
                if (MK_ONE_LAUNCH && (i == (C.vcu & 3) || i == ((C.vcu + 2) & 3))) { convert_share(ws, in, ldsl, l, C.vcu, C.G, (i == (C.vcu & 3)) ? 0 : 1, 2); __syncthreads(); } }
#else
                if (MK_ONE_LAUNCH && i == (C.vcu & 3)) { convert_share(ws, in, ldsl, l, C.vcu, C.G); __syncthreads();
#if defined(CV_MODE)
                    convert_share_probe(ws, in, ldsl, l, C.vcu, C.G); __syncthreads();
#endif
                } }
#endif
#endif
            SEAM_L(pb + 3);
        }
        if ((PHM & (1 << 6)) && IN(pb + 4)) {
            pg8::Gemm g{(const pg8::bf16_t*)YCAT, (const pg8::bf16_t*)(ws + WS_WOUT) + (size_t)l * 1024 * 1024, 1024, 0, 0, nullptr, 0, nullptr}; pg8::Sched S; S.init(NTOK / 256, 4, 1, C.G, (int)blockIdx.x);
            pg8::EpiResidXB E{(const pg8::bf16_t*)XB, (pg8::bf16_t*)XB, (float*)(ws + WS_PART), 1024};
            pg8::gemm_phase<pg8::EpiResidXB, RES_ALIGN, false>(ldsl + RING_OFF, g, S, E);
            SEAM_L(pb + 4);
        }
        if ((PHM & (1 << 8)) && IN(pb + 5)) {
            pg8::Gemm g{(const pg8::bf16_t*)XB, (const pg8::bf16_t*)(ws + WS_WCAQ) + (size_t)l * 512 * 1024, 1024, 0, 0, nullptr, 0, nullptr}; pg8::Sched S; S.init(NTOK / 256, 2, 1, C.G, (int)blockIdx.x);
            pg8::EpiBf16R E{(pg8::bf16_t*)QCA, 512, attn_body::CA_C2, (const float*)(ws + WS_PART), EPS};
            REPEAT(REP_H) pg8::gemm_phase<pg8::EpiBf16R, true, false>(ldsl + RING_OFF, g, S, E);
            VM_WAIT(); __syncthreads();
            { pg8::Unit u;
              for (int rep_ = 0; rep_ < REP_I; ++rep_)
              for (int i = 0; S.next(i, u); ++i) { const int b = u.pm >> 4, qt = u.pm & 15;
                  for (int hh = 0; hh < 2; ++hh)
                      attn_body::ca_tiles<1>(b, 2 * u.pn + hh, qt, (const attn_body::bf16*)QCA, (const attn_body::bf16*)(ws + WS_KVCA) + (size_t)l * 2048 * 1024, (attn_body::bf16*)(rep_ + 1 < REP_I ? ACT : QCA), (char*)lds + RING_OFF, (float*)(lds + XTRA_OFF)); } }
            SEAM_L(pb + 5);
        }
        if ((PHM & (1 << 10)) && IN(pb + 6)) {
            pg8::Gemm g{(const pg8::bf16_t*)QCA, (const pg8::bf16_t*)(ws + WS_WCAO) + (size_t)l * 1024 * 512, 512, 0, 0, nullptr, 0, nullptr}; pg8::Sched S; S.init(NTOK / 256, 4, 1, C.G, (int)blockIdx.x);
            REPEAT(REP_J - 1) { pg8::EpiResidB E2{(const pg8::bf16_t*)XB, (pg8::bf16_t*)ACT, 1024}; pg8::gemm_phase<pg8::EpiResidB, true, false>(ldsl + RING_OFF, g, S, E2); }
            pg8::EpiResidB E{(const pg8::bf16_t*)XB, (pg8::bf16_t*)XB, 1024};
            pg8::gemm_phase<pg8::EpiResidB, RES_ALIGN, false>(ldsl + RING_OFF, g, S, E);
            SEAM_L(pb + 6);
        }
        if ((PHM & (1 << 11)) && IN(pb + 7)) { REPEAT(REP_K) router_phase(C, XB, in[I_NFFNG] + l * 1024, in[I_ROUTER] + (size_t)l * 1024 * 16, AFF, RSTD3); SEAM_L(pb + 7); }
        if ((PHM & (1 << 12)) && IN(pb + 8)) { REPEAT(REP_L) topk_phase(C); SEAM(pb + 8); }
        if ((PHM & (1 << 13)) && IN(pb + 9)) {
            pg8::Gemm g{(const pg8::bf16_t*)XB, (const pg8::bf16_t*)(ws + WS_WGU) + (size_t)l * 16 * 4096 * 1024, 1024, 0, 4096L * 1024, TOKI, ROWS_E, (const LAS unsigned short*)(ldsl + XTRA_OFF)}; pg8::Sched S; if (MN_LOCAL && mnloc) S.init(2, 16, NEXP, C.GB, C.lb, 2 * C.grp); else S.init(ROWS_E / 256, 16, NEXP, C.G, (int)blockIdx.x);
            pg8::gather_table((LAS unsigned short*)(ldsl + XTRA_OFF), TOKI, ROWS_E, S, GU_MAXU, (LAS float*)(ldsl + XTRA_OFF + GU_MAXU * 512), RSTDS);
            pg8::EpiSwiGLU E{(pg8::bf16_t*)ACT, FFE, ROWS_E, (const LAS float*)(ldsl + XTRA_OFF + GU_MAXU * 512)};
            REPEAT(REP_M) pg8::gemm_phase<pg8::EpiSwiGLU, true, true>(ldsl + RING_OFF, g, S, E);
            if (MN_LOCAL && mnloc) SEAM_L(pb + 9); else SEAM(pb + 9);
        }
        if ((PHM & (1 << 14)) && IN(pb + 10)) {
            pg8::Gemm g{(const pg8::bf16_t*)ACT, (const pg8::bf16_t*)(ws + WS_WDN) + (size_t)l * 16 * 1024 * 2048, 2048, (long)ROWS_E * FFE, 1024L * 2048, nullptr, 0, nullptr}; pg8::Sched S; if (MN_LOCAL && mnloc) S.init(2, 4, NEXP, C.GB, C.lb, 2 * C.grp); else S.init(ROWS_E / 256, 4, NEXP, C.G, (int)blockIdx.x);
            pg8::row_table((LAS float*)(ldsl + XTRA_OFF), GATEV, ROWS_E, S, GU_MAXU);
            pg8::EpiDown E{(pg8::bf16_t*)YS, 1024, ROWS_E, (const LAS float*)(ldsl + XTRA_OFF)};
            REPEAT(REP_N) pg8::gemm_phase<pg8::EpiDown, true, false>(ldsl + RING_OFF, g, S, E);
            if (MN_LOCAL && mnloc) SEAM_L(pb + 10); else SEAM(pb + 10);
        }
        if ((PHM & (1 << 15)) && IN(pb + 11)) {
            if (l + 1 < DEPTH) { REPEAT(REP_O - 1) row_phase<1, true>(C, XB, (bf16*)ACT, in[I_NMIXG] + (l + 1) * 1024, RSTD1, in[I_WIN] + (size_t)(l + 1) * 1024 * 2064 + 1280, 2064, in[I_GATEB] + (l + 1) * 16, GATES, nullptr, SLOTMAP, YS);
              row_phase<1, true>(C, XB, XB, in[I_NMIXG] + (l + 1) * 1024, RSTD1, in[I_WIN] + (size_t)(l + 1) * 1024 * 2064 + 1280, 2064, in[I_GATEB] + (l + 1) * 16, GATES, nullptr, SLOTMAP, YS); SEAM_L(pb + 11); }
            else row_phase<3, true>(C, XB, XB, in[I_FNG], nullptr, nullptr, 0, nullptr, nullptr, args.out, SLOTMAP, YS);
        }
    }
#if defined(PROBE_TAIL)
    if (IN(N_PHASES - 1)) {
        __syncthreads();
        const int l = DEPTH - 1;
        for (int rep_ = 0; rep_ < PROBE_N; ++rep_) {
#if PROBE_TAIL == 1
            pg8::Gemm g{(const pg8::bf16_t*)XB, (const pg8::bf16_t*)(ws + WS_WIN) + (size_t)l * 2048 * 1024, 1024, 0, 0, nullptr, 0, nullptr}; pg8::Sched S; S.init(NTOK / 256, NPROJ / 256, 1, C.G, (int)blockIdx.x);
            pg8::EpiBf16 E{(pg8::bf16_t*)PROJ, NPROJ, 0, 1.0f};
            pg8::gemm_phase<pg8::EpiBf16, true, false>(ldsl + RING_OFF, g, S, E);
#elif PROBE_TAIL == 2
            pg8::Gemm g{(const pg8::bf16_t*)YCAT, (const pg8::bf16_t*)(ws + WS_WOUT) + (size_t)l * 1024 * 1024, 1024, 0, 0, nullptr, 0, nullptr}; pg8::Sched S; S.init(NTOK / 256, 4, 1, C.G, (int)blockIdx.x);
            pg8::EpiResidB E{(const pg8::bf16_t*)XB, (pg8::bf16_t*)PROJ, 1024};
            pg8::gemm_phase<pg8::EpiResidB, false, false>(ldsl + RING_OFF, g, S, E);
#elif PROBE_TAIL == 3
            pg8::Gemm g{(const pg8::bf16_t*)XB, (const pg8::bf16_t*)(ws + WS_WGU) + (size_t)l * 16 * 4096 * 1024, 1024, 0, 4096L * 1024, TOKI, ROWS_E, (const LAS unsigned short*)(ldsl + XTRA_OFF)}; pg8::Sched S; S.init(ROWS_E / 256, 16, NEXP, C.G, (int)blockIdx.x);
            pg8::gather_table((LAS unsigned short*)(ldsl + XTRA_OFF), TOKI, ROWS_E, S, GU_MAXU, (LAS float*)(ldsl + XTRA_OFF + GU_MAXU * 512), RSTDS);
            pg8::EpiSwiGLU E{(pg8::bf16_t*)ACT, FFE, ROWS_E, (const LAS float*)(ldsl + XTRA_OFF + GU_MAXU * 512)};
            pg8::gemm_phase<pg8::EpiSwiGLU, true, true>(ldsl + RING_OFF, g, S, E);
#elif PROBE_TAIL == 4
            pg8::Gemm g{(const pg8::bf16_t*)ACT, (const pg8::bf16_t*)(ws + WS_WDN) + (size_t)l * 16 * 1024 * 2048, 2048, (long)ROWS_E * FFE, 1024L * 2048, nullptr, 0, nullptr}; pg8::Sched S; S.init(ROWS_E / 256, 4, NEXP, C.G, (int)blockIdx.x);
            pg8::row_table((LAS float*)(ldsl + XTRA_OFF), GATEV, ROWS_E, S, GU_MAXU);
            pg8::EpiDown E{(pg8::bf16_t*)YS, 1024, ROWS_E, (const LAS float*)(ldsl + XTRA_OFF)};
            pg8::gemm_phase<pg8::EpiDown, true, false>(ldsl + RING_OFF, g, S, E);
#elif PROBE_TAIL == 6
            pg8::Gemm g{(const pg8::bf16_t*)YCAT, (const pg8::bf16_t*)(ws + WS_WOUT) + (size_t)l * 1024 * 1024, 1024, 0, 0, nullptr, 0, nullptr}; pg8::Sched S; S.init(NTOK / 256, 4, 1, C.G, (int)blockIdx.x);
            pg8::EpiBf16 E{(pg8::bf16_t*)PROJ, 1024, 0, 1.0f};
            pg8::gemm_phase<pg8::EpiBf16, true, false>(ldsl + RING_OFF, g, S, E);
#elif PROBE_TAIL == 5
            pg8::Gemm g{(const pg8::bf16_t*)QCA, (const pg8::bf16_t*)(ws + WS_WCAO) + (size_t)l * 1024 * 512, 512, 0, 0, nullptr, 0, nullptr}; pg8::Sched S; S.init(NTOK / 256, 4, 1, C.G, (int)blockIdx.x);
            pg8::EpiResidB E{(const pg8::bf16_t*)XB, (pg8::bf16_t*)PROJ, 1024};
            pg8::gemm_phase<pg8::EpiResidB, false, false>(ldsl + RING_OFF, g, S, E);
#endif
            __syncthreads();
        }
    }
#endif
#undef IN
#undef SEAM
#undef HN
#undef PROJ
#undef YCAT
#undef QCA
#undef X
#undef GATES
#undef AFF
#undef TOKI
#undef GATEV
#undef SLOTMAP
#undef ACT
#undef YS
}

extern "C" void kernel_launch(void* const* d_in, const int* in_sizes, int n_in, void* d_out, int out_size, void* d_ws, size_t ws_size, hipStream_t stream) {
    static int grid = 0;
    if (grid == 0) {
        if (n_in != N_IN || in_sizes[0] != NTOK * DMODEL || out_size != NTOK * DMODEL || ws_size < WS_END) { fprintf(stderr, "kernel_launch: unexpected shapes (n_in %d, in0 %d, out %d, ws %zu); nothing launched\n", n_in, n_in > 0 ? in_sizes[0] : -1, out_size, ws_size); grid = -1; return; }
        int dev = 0, cus = 0, per_cu = 0;
        if (hipGetDevice(&dev) != hipSuccess || hipDeviceGetAttribute(&cus, hipDeviceAttributeMultiprocessorCount, dev) != hipSuccess) { grid = -1; return; }
        if (hipFuncSetAttribute((const void*)mk_fwd, hipFuncAttributeMaxDynamicSharedMemorySize, LDS_BYTES) != hipSuccess) { fprintf(stderr, "kernel_launch: hipFuncSetAttribute failed\n"); grid = -1; return; }
        if (hipOccupancyMaxActiveBlocksPerMultiprocessor(&per_cu, (const void*)mk_fwd, NWAVES * 64, LDS_BYTES) != hipSuccess || per_cu < 1) fprintf(stderr, "kernel_launch: occupancy query reports %d workgroups per CU\n", per_cu);
        (void)hipGetLastError();
        if (cus < 256) { fprintf(stderr, "kernel_launch: built for a 256-CU device (the attention and expert phases deal one unit group per workgroup); found %d CUs; nothing launched\n", cus); grid = -1; return; }
        grid = cus;
    }
    if (grid < 0) return;
    if (hipMemsetAsync((char*)d_ws + WS_CTL, 0, CTL_ZERO_BYTES, stream) != hipSuccess) { fprintf(stderr, "kernel_launch: memset failed\n"); return; }
    Args a{};
    for (int i = 0; i < N_IN; ++i) a.in[i] = (const float*)d_in[i];
    a.out = (float*)d_out; a.ws = (unsigned char*)d_ws;
#if MK_ONE_LAUNCH
    a.ph_lo = 0; a.ph_hi = N_PHASES;
    hipLaunchKernelGGL(mk_fwd, dim3(grid), dim3(NWAVES * 64), LDS_BYTES, stream, a);
#else
    for (int p = 0; p < N_PHASES; ++p) { a.ph_lo = p; a.ph_hi = p + 1; hipLaunchKernelGGL(mk_fwd, dim3(grid), dim3(NWAVES * 64), LDS_BYTES, stream, a); }
#endif
    const hipError_t le = hipPeekAtLastError();
    if (le != hipSuccess) fprintf(stderr, "kernel_launch: launch failed: %s\n", hipGetErrorName(le));
}
```

```cpp
#include <hip/hip_runtime.h>
#include <hip/hip_bf16.h>
#include <cstdio>
#include <cstdint>
#include <cmath>
__device__ __forceinline__ int opaque_tid() { int t = (int)threadIdx.x; asm volatile("" : "+v"(t)); return t; }
#ifndef WGM_SET
#define WGM_SET 8
#endif
namespace pg8 {
#define PG8_LAS __attribute__((address_space(3)))
typedef unsigned short bf16_t;
typedef short bf16x8 __attribute__((ext_vector_type(8)));
typedef float f32x4 __attribute__((ext_vector_type(4)));
typedef unsigned u32x4 __attribute__((ext_vector_type(4)));
constexpr int BM = 256, BK = 64, HALF = 128, HTB = HALF * BK * 2  , STAGE_BYTES = 8 * HTB, NXCD = 8, WGM = WGM_SET;

__host__ __device__ __forceinline__ int lds_byte(int r, int c) { const int st = (r >> 4) * 2 + (c >> 5), rr = r & 15, cc = c & 31, ob = rr * 64 + cc * 2; return st * 1024 + (ob ^ (((ob >> 9) & 1) << 5)); }
__host__ __device__ __forceinline__ void stage_rc(int b, int& R, int& C) { const int st = b / 1024, sb = b % 1024, swz = sb ^ (((sb >> 9) & 1) << 5); R = (st >> 1) * 16 + swz / 64; C = (st & 1) * 32 + (swz % 64) / 2; }
__host__ __device__ __forceinline__ int perm32(int rho) { const int n = rho >> 4, i = rho & 15; return 8 * (i >> 2) + 4 * n + (i & 3); }

struct Unit { int pm, pn, e, i; };
struct Gemm { const bf16_t* A; const bf16_t* Bt; int K; long sAe, sBe; const int* gidx; int rowsPerE; const PG8_LAS unsigned short* ltab; };

struct Sched {
    int nM, nN, P, total, G, c, pm0;
    __device__ __forceinline__ void init(int nM_, int nN_, int nE_, int G_, int c_, int pm0_ = 0) { nM = nM_; nN = nN_; P = nM_ * nN_; total = P * nE_; G = G_; c = c_; pm0 = pm0_; }
    __device__ __forceinline__ bool next(int i, Unit& u) const {
        const long L = (long)i * G + c; if (L >= total) return false;
        const int e = (int)(L / P); int wgid = (int)(L % P);
        { const int q = P / NXCD, r = P % NXCD, xcd = wgid % NXCD, off = wgid / NXCD; wgid = (xcd < r ? xcd * (q + 1) : r * (q + 1) + (xcd - r) * q) + off; }
        const int nig = WGM * nN, gid = wgid / nig, fm = gid * WGM, gsz = (nM - fm) < WGM ? (nM - fm) : WGM;
        u.pm = pm0 + fm + ((wgid % nig) % gsz); u.pn = (wgid % nig) / gsz; u.e = e; u.i = i; return true;
    }
};

__device__ __forceinline__ unsigned cvt_pk_bf16(float lo, float hi) { unsigned r; asm volatile("v_cvt_pk_bf16_f32 %0, %1, %2" : "=v"(r) : "v"(lo), "v"(hi)); return r; }


#ifndef EPI_WT
#define EPI_WT 0
#endif
__device__ __forceinline__ void st16_u(void* p, u32x4 v) {
#if EPI_WT
    asm volatile("global_store_dwordx4 %0, %1, off sc1\n\ts_nop 2" :: "v"(p), "v"(v) : "memory");
#else
    *(u32x4*)p = v;
#endif
}
__device__ __forceinline__ void st16_f(void* p, f32x4 v) {
#if EPI_WT
    asm volatile("global_store_dwordx4 %0, %1, off sc1\n\ts_nop 2" :: "v"(p), "v"(v) : "memory");
#else
    *(f32x4*)p = v;
#endif
}
__device__ __forceinline__ float sum_rows4(float x) { auto a = __builtin_amdgcn_permlane16_swap(__float_as_uint(x), __float_as_uint(x), false, false); const float y = __uint_as_float(a[0]) + __uint_as_float(a[1]);
    auto b = __builtin_amdgcn_permlane32_swap(__float_as_uint(y), __float_as_uint(y), false, false); return __uint_as_float(b[0]) + __uint_as_float(b[1]); }
struct EpiBf16 {
    static constexpr int NST = 16;
    bf16_t* O; int ldc; long strideE; float scale;
    __device__ __forceinline__ void operator()(const f32x4 (&acc)[2][2][4][2], const Unit& u, int wr, int wc, int fr, int fq) const {
        const int row0 = u.pm * BM + wr * 64 + fr; const int col0 = u.pn * BM + wc * 32 + 8 * fq; bf16_t* base = O + (long)u.e * strideE;
#pragma unroll
        for (int ai = 0; ai < 2; ++ai)
#pragma unroll
            for (int m = 0; m < 4; ++m) { bf16_t* rowp = base + (size_t)(row0 + ai * HALF + m * 16) * ldc + col0;
#pragma unroll
                for (int bj = 0; bj < 2; ++bj) { const f32x4 v0 = acc[ai][bj][m][0] * scale, v1 = acc[ai][bj][m][1] * scale;
                    u32x4 w; w.x = cvt_pk_bf16(v0[0], v0[1]); w.y = cvt_pk_bf16(v0[2], v0[3]); w.z = cvt_pk_bf16(v1[0], v1[1]); w.w = cvt_pk_bf16(v1[2], v1[3]);
                    st16_u(rowp + bj * HALF, w); } }
    }
};
struct EpiResid {
    const float* xin; float* xout; int ldc; static constexpr int NST = 32;
    __device__ __forceinline__ void operator()(const f32x4 (&acc)[2][2][4][2], const Unit& u, int wr, int wc, int fr, int fq) const {
        const int row0 = u.pm * BM + wr * 64 + fr; const int col0 = u.pn * BM + wc * 32 + 8 * fq;
#pragma unroll
        for (int ai = 0; ai < 2; ++ai) { f32x4 r[4][2][2];
#pragma unroll
            for (int m = 0; m < 4; ++m) { const size_t ro = (size_t)(row0 + ai * HALF + m * 16) * ldc + col0;
#pragma unroll
                for (int bj = 0; bj < 2; ++bj) { r[m][bj][0] = *(const f32x4*)(xin + ro + bj * HALF); r[m][bj][1] = *(const f32x4*)(xin + ro + bj * HALF + 4); } }
#pragma unroll
            for (int m = 0; m < 4; ++m) { const size_t ro = (size_t)(row0 + ai * HALF + m * 16) * ldc + col0;
#pragma unroll
                for (int bj = 0; bj < 2; ++bj) { st16_f(xout + ro + bj * HALF, r[m][bj][0] + acc[ai][bj][m][0]); st16_f(xout + ro + bj * HALF + 4, r[m][bj][1] + acc[ai][bj][m][1]); } } }
    }
};
struct EpiResidX {
    const float* xin; float* xout; bf16_t* xb; float* part; int ldc; static constexpr int NST = 55;
    __device__ __forceinline__ void operator()(const f32x4 (&acc)[2][2][4][2], const Unit& u, int wr, int wc, int fr, int fq) const {
        const int row0 = u.pm * BM + wr * 64 + fr; const int col0 = u.pn * BM + wc * 32 + 8 * fq;
#pragma unroll
        for (int ai = 0; ai < 2; ++ai) { f32x4 r[4][2][2];
#pragma unroll
            for (int m = 0; m < 4; ++m) { const size_t ro = (size_t)(row0 + ai * HALF + m * 16) * ldc + col0;
#pragma unroll
                for (int bj = 0; bj < 2; ++bj) { r[m][bj][0] = *(const f32x4*)(xin + ro + bj * HALF); r[m][bj][1] = *(const f32x4*)(xin + ro + bj * HALF + 4); } }
#pragma unroll
            for (int m = 0; m < 4; ++m) { const int row = row0 + ai * HALF + m * 16; const size_t ro = (size_t)row * ldc + col0; float ss = 0.f;
#pragma unroll
                for (int bj = 0; bj < 2; ++bj) { const f32x4 n0 = r[m][bj][0] + acc[ai][bj][m][0], n1 = r[m][bj][1] + acc[ai][bj][m][1];
                    st16_f(xout + ro + bj * HALF, n0); st16_f(xout + ro + bj * HALF + 4, n1);
                    u32x4 w; w.x = cvt_pk_bf16(n0[0], n0[1]); w.y = cvt_pk_bf16(n0[2], n0[3]); w.z = cvt_pk_bf16(n1[0], n1[1]); w.w = cvt_pk_bf16(n1[2], n1[3]);
                    st16_u(xb + ro + bj * HALF, w);
                    ss += ((n0[0] * n0[0] + n0[1] * n0[1]) + (n0[2] * n0[2] + n0[3] * n0[3])) + ((n1[0] * n1[0] + n1[1] * n1[1]) + (n1[2] * n1[2] + n1[3] * n1[3])); }
                ss = sum_rows4(ss);
                if (fq == 0) part[(size_t)row * 16 + u.pn * 4 + wc] = ss; } }
    }
};
struct EpiBf16S {
    bf16_t* O; int ldc; const PG8_LAS float* rs; static constexpr int NST = 16;
    __device__ __forceinline__ void operator()(const f32x4 (&acc)[2][2][4][2], const Unit& u, int wr, int wc, int fr, int fq) const {
        const int row0 = u.pm * BM + wr * 64 + fr; const int col0 = u.pn * BM + wc * 32 + 8 * fq;
        float rq[2][4];
#pragma unroll
        for (int ai = 0; ai < 2; ++ai)
#pragma unroll
            for (int m = 0; m < 4; ++m) rq[ai][m] = rs[u.i * BM + wr * 64 + fr + ai * HALF + m * 16];
#pragma unroll
        for (int ai = 0; ai < 2; ++ai)
#pragma unroll
            for (int m = 0; m < 4; ++m) { bf16_t* rowp = O + (size_t)(row0 + ai * HALF + m * 16) * ldc + col0;
#pragma unroll
                for (int bj = 0; bj < 2; ++bj) { const f32x4 v0 = acc[ai][bj][m][0] * rq[ai][m], v1 = acc[ai][bj][m][1] * rq[ai][m];
                    u32x4 w; w.x = cvt_pk_bf16(v0[0], v0[1]); w.y = cvt_pk_bf16(v0[2], v0[3]); w.z = cvt_pk_bf16(v1[0], v1[1]); w.w = cvt_pk_bf16(v1[2], v1[3]);
                    st16_u(rowp + bj * HALF, w); } }
    }
};
struct EpiResidB {
    const bf16_t* xin; bf16_t* xout; int ldc; static constexpr int NST = 16;
    __device__ __forceinline__ void operator()(const f32x4 (&acc)[2][2][4][2], const Unit& u, int wr, int wc, int fr, int fq) const {
        const int row0 = u.pm * BM + wr * 64 + fr; const int col0 = u.pn * BM + wc * 32 + 8 * fq;
#pragma unroll
        for (int ai = 0; ai < 2; ++ai) { u32x4 r[4][2];
#pragma unroll
            for (int m = 0; m < 4; ++m) { const size_t ro = (size_t)(row0 + ai * HALF + m * 16) * ldc + col0;
#pragma unroll
                for (int bj = 0; bj < 2; ++bj) r[m][bj] = *(const u32x4*)(xin + ro + bj * HALF); }
#pragma unroll
            for (int m = 0; m < 4; ++m) { const size_t ro = (size_t)(row0 + ai * HALF + m * 16) * ldc + col0;
#pragma unroll
                for (int bj = 0; bj < 2; ++bj) { const u32x4 q = r[m][bj];
                    const f32x4 n0 = (f32x4){__uint_as_float(q.x << 16), __uint_as_float(q.x & 0xffff0000u), __uint_as_float(q.y << 16), __uint_as_float(q.y & 0xffff0000u)} + acc[ai][bj][m][0];
                    const f32x4 n1 = (f32x4){__uint_as_float(q.z << 16), __uint_as_float(q.z & 0xffff0000u), __uint_as_float(q.w << 16), __uint_as_float(q.w & 0xffff0000u)} + acc[ai][bj][m][1];
                    u32x4 w; w.x = cvt_pk_bf16(n0[0], n0[1]); w.y = cvt_pk_bf16(n0[2], n0[3]); w.z = cvt_pk_bf16(n1[0], n1[1]); w.w = cvt_pk_bf16(n1[2], n1[3]);
                    st16_u(xout + ro + bj * HALF, w); } } }
    }
};
struct EpiResidXB {
    const bf16_t* xin; bf16_t* xout; float* part; int ldc; static constexpr int NST = 24;
    __device__ __forceinline__ void operator()(const f32x4 (&acc)[2][2][4][2], const Unit& u, int wr, int wc, int fr, int fq) const {
        const int row0 = u.pm * BM + wr * 64 + fr; const int col0 = u.pn * BM + wc * 32 + 8 * fq;
#pragma unroll
        for (int ai = 0; ai < 2; ++ai) { u32x4 r[4][2];
#pragma unroll
            for (int m = 0; m < 4; ++m) { const size_t ro = (size_t)(row0 + ai * HALF + m * 16) * ldc + col0;
#pragma unroll
                for (int bj = 0; bj < 2; ++bj) r[m][bj] = *(const u32x4*)(xin + ro + bj * HALF); }
#pragma unroll
            for (int m = 0; m < 4; ++m) { const int row = row0 + ai * HALF + m * 16; const size_t ro = (size_t)row * ldc + col0; float ss = 0.f;
#pragma unroll
                for (int bj = 0; bj < 2; ++bj) { const u32x4 q = r[m][bj];
                    const f32x4 n0 = (f32x4){__uint_as_float(q.x << 16), __uint_as_float(q.x & 0xffff0000u), __uint_as_float(q.y << 16), __uint_as_float(q.y & 0xffff0000u)} + acc[ai][bj][m][0];
                    const f32x4 n1 = (f32x4){__uint_as_float(q.z << 16), __uint_as_float(q.z & 0xffff0000u), __uint_as_float(q.w << 16), __uint_as_float(q.w & 0xffff0000u)} + acc[ai][bj][m][1];
                    u32x4 w; w.x = cvt_pk_bf16(n0[0], n0[1]); w.y = cvt_pk_bf16(n0[2], n0[3]); w.z = cvt_pk_bf16(n1[0], n1[1]); w.w = cvt_pk_bf16(n1[2], n1[3]);
                    st16_u(xout + ro + bj * HALF, w);
                    ss += ((n0[0] * n0[0] + n0[1] * n0[1]) + (n0[2] * n0[2] + n0[3] * n0[3])) + ((n1[0] * n1[0] + n1[1] * n1[1]) + (n1[2] * n1[2] + n1[3] * n1[3])); }
                ss = sum_rows4(ss);
                if (fq == 0) part[(size_t)row * 16 + u.pn * 4 + wc] = ss; } }
    }
};
struct EpiBf16R {
    bf16_t* O; int ldc; float scale; const float* part; float eps; static constexpr int NST = 16;
    __device__ __forceinline__ void operator()(const f32x4 (&acc)[2][2][4][2], const Unit& u, int wr, int wc, int fr, int fq) const {
        const int row0 = u.pm * BM + wr * 64 + fr; const int col0 = u.pn * BM + wc * 32 + 8 * fq;
        f32x4 pq[2][4];
#pragma unroll
        for (int ai = 0; ai < 2; ++ai)
#pragma unroll
            for (int m = 0; m < 4; ++m) pq[ai][m] = *(const f32x4*)(part + (size_t)(row0 + ai * HALF + m * 16) * 16 + 4 * fq);
#pragma unroll
        for (int ai = 0; ai < 2; ++ai)
#pragma unroll
            for (int m = 0; m < 4; ++m) { const int row = row0 + ai * HALF + m * 16; const f32x4 p = pq[ai][m];
                float sq = (p[0] + p[1]) + (p[2] + p[3]); sq = sum_rows4(sq);
                const float rs = scale * __builtin_amdgcn_rsqf(sq * (1.0f / 1024.0f) + eps);
                bf16_t* rowp = O + (size_t)row * ldc + col0;
#pragma unroll
                for (int bj = 0; bj < 2; ++bj) { const f32x4 v0 = acc[ai][bj][m][0] * rs, v1 = acc[ai][bj][m][1] * rs;
                    u32x4 w; w.x = cvt_pk_bf16(v0[0], v0[1]); w.y = cvt_pk_bf16(v0[2], v0[3]); w.z = cvt_pk_bf16(v1[0], v1[1]); w.w = cvt_pk_bf16(v1[2], v1[3]);
                    st16_u(rowp + bj * HALF, w); } }
    }
};
__device__ __forceinline__ float silu_f(float x) { return x * __builtin_amdgcn_rcpf(1.0f + __builtin_amdgcn_exp2f(-1.4426950408889634f * x)); }
struct EpiSwiGLU {
    bf16_t* O; int ldc; int rowsPerE; const PG8_LAS float* rs; static constexpr int NST = 8;
    __device__ __forceinline__ void operator()(const f32x4 (&acc)[2][2][4][2], const Unit& u, int wr, int wc, int fr, int fq) const {
        const int row0 = u.e * rowsPerE + u.pm * BM + wr * 64 + fr; const int col0 = u.pn * HALF + wc * 32 + 8 * fq;
        float rq[2][4];
#pragma unroll
        for (int ai = 0; ai < 2; ++ai)
#pragma unroll
            for (int m = 0; m < 4; ++m) rq[ai][m] = rs[u.i * BM + wr * 64 + fr + ai * HALF + m * 16];
#pragma unroll
        for (int ai = 0; ai < 2; ++ai)
#pragma unroll
            for (int m = 0; m < 4; ++m) { bf16_t* rowp = O + (size_t)(row0 + ai * HALF + m * 16) * ldc + col0; const float r = rq[ai][m];
                const f32x4 g0 = acc[ai][0][m][0] * r, g1 = acc[ai][0][m][1] * r, u0 = acc[ai][1][m][0] * r, u1 = acc[ai][1][m][1] * r;
                u32x4 w; w.x = cvt_pk_bf16(silu_f(g0[0]) * u0[0], silu_f(g0[1]) * u0[1]); w.y = cvt_pk_bf16(silu_f(g0[2]) * u0[2], silu_f(g0[3]) * u0[3]);
                w.z = cvt_pk_bf16(silu_f(g1[0]) * u1[0], silu_f(g1[1]) * u1[1]); w.w = cvt_pk_bf16(silu_f(g1[2]) * u1[2], silu_f(g1[3]) * u1[3]);
                st16_u(rowp, w); }
    }
};
struct EpiDown {
    bf16_t* O; int ldc; int rowsPerE; const PG8_LAS float* gate; static constexpr int NST = 16;
    __device__ __forceinline__ void operator()(const f32x4 (&acc)[2][2][4][2], const Unit& u, int wr, int wc, int fr, int fq) const {
        const int row0 = u.e * rowsPerE + u.pm * BM + wr * 64 + fr; const int col0 = u.pn * BM + wc * 32 + 8 * fq;
        float gt[2][4];
#pragma unroll
        for (int ai = 0; ai < 2; ++ai)
#pragma unroll
            for (int m = 0; m < 4; ++m) gt[ai][m] = gate[u.i * BM + wr * 64 + fr + ai * HALF + m * 16];
#pragma unroll
        for (int ai = 0; ai < 2; ++ai)
#pragma unroll
            for (int m = 0; m < 4; ++m) { const int row = row0 + ai * HALF + m * 16; bf16_t* rowp = O + (size_t)row * ldc + col0;
#pragma unroll
                for (int bj = 0; bj < 2; ++bj) { const f32x4 v0 = acc[ai][bj][m][0] * gt[ai][m], v1 = acc[ai][bj][m][1] * gt[ai][m];
                    u32x4 w; w.x = cvt_pk_bf16(v0[0], v0[1]); w.y = cvt_pk_bf16(v0[2], v0[3]); w.z = cvt_pk_bf16(v1[0], v1[1]); w.w = cvt_pk_bf16(v1[2], v1[3]);
                    st16_u(rowp + bj * HALF, w); } }
    }
};

typedef int i32x4 __attribute__((ext_vector_type(4)));
constexpr int TAB_MAXU = 16;
__device__ __forceinline__ void gather_table(PG8_LAS unsigned short* ltab, const int* gidx, int rowsPerE, const Sched& S, int maxu, PG8_LAS float* rtab, const float* rsrc) {
    const int tid = opaque_tid(), i = tid >> 5, r = (tid & 31) * 8; Unit u;
    if (i < maxu && S.next(i, u)) { const size_t o = (size_t)u.e * rowsPerE + u.pm * BM + r;
        const i32x4 g0 = *(const i32x4*)(gidx + o), g1 = *(const i32x4*)(gidx + o + 4); const f32x4 r0 = *(const f32x4*)(rsrc + o), r1 = *(const f32x4*)(rsrc + o + 4);
        u32x4 pk; pk.x = (unsigned)g0.x | ((unsigned)g0.y << 16); pk.y = (unsigned)g0.z | ((unsigned)g0.w << 16); pk.z = (unsigned)g1.x | ((unsigned)g1.y << 16); pk.w = (unsigned)g1.z | ((unsigned)g1.w << 16);
        *(PG8_LAS u32x4*)(ltab + i * BM + r) = pk; *(PG8_LAS f32x4*)(rtab + i * BM + r) = r0; *(PG8_LAS f32x4*)(rtab + i * BM + r + 4) = r1; }
    __syncthreads();
}
__device__ __forceinline__ void row_table(PG8_LAS float* tab, const float* src, int rowsPerE, const Sched& S, int maxu) {
    const int tid = opaque_tid(), i = tid >> 5, r = (tid & 31) * 8; Unit u;
    if (i < maxu && S.next(i, u)) { const size_t o = (size_t)u.e * rowsPerE + u.pm * BM + r; const f32x4 r0 = *(const f32x4*)(src + o), r1 = *(const f32x4*)(src + o + 4);
        *(PG8_LAS f32x4*)(tab + i * BM + r) = r0; *(PG8_LAS f32x4*)(tab + i * BM + r + 4) = r1; }
    __syncthreads();
}
template <class Epi, bool ALIGN_EPI, bool GATHER>
__device__ __forceinline__ void gemm_phase(PG8_LAS unsigned char* lds, const Gemm g, const Sched& S, const Epi& E) {
    const int tid = opaque_tid(), wid = __builtin_amdgcn_readfirstlane(tid >> 6), lane = tid & 63, wr = wid >> 2, wc = wid & 3, fr = lane & 15, fq = lane >> 4;
    const int K = g.K, nt = K / BK;
    int Rr[2], Cc[2]; unsigned voffB[2];
#pragma unroll
    for (int i = 0; i < 2; ++i) { stage_rc(tid * 16 + i * 8192, Rr[i], Cc[i]); const int Rb = (Rr[i] & ~31) + perm32(Rr[i] & 31); voffB[i] = (unsigned)(Rb * K + Cc[i]) * 2u; }
    const size_t kstep = (size_t)(BK * 2);
    const size_t hstep = (size_t)HALF * K * 2;
    const size_t tstep = 2 * hstep;
    const unsigned ldsw = (unsigned)wid * 1024u;
    const int aoff = lds_byte(wr * 64 + fr, fq * 8), boff = lds_byte(wc * 32 + fr, fq * 8);
#define PG8_SA(b, h) (((b) * 2 + (h)) * HTB)
#define PG8_SB(b, h) ((4 + (b) * 2 + (h)) * HTB)
#define PG8_STAGE(bufoff, gbase, voff) do { _Pragma("unroll") for (int _i = 0; _i < 2; ++_i) \
        __builtin_amdgcn_global_load_lds((const unsigned*)((const char*)(gbase) + (voff)[_i]), (PG8_LAS unsigned*)(lds + (bufoff) + ldsw + _i * 8192), 16, 0, 0); } while (0)
#define PG8_LDA(dst, b, h) do { _Pragma("unroll") for (int m = 0; m < 4; ++m) _Pragma("unroll") for (int k = 0; k < 2; ++k) dst[m][k] = *(const PG8_LAS bf16x8*)(lds + PG8_SA(b, h) + aoff + m * 2048 + k * 1024); } while (0)
#define PG8_LDB(dst, b, h) do { _Pragma("unroll") for (int n = 0; n < 2; ++n) _Pragma("unroll") for (int k = 0; k < 2; ++k) dst[n][k] = *(const PG8_LAS bf16x8*)(lds + PG8_SB(b, h) + boff + n * 2048 + k * 1024); } while (0)
#define PG8_MMA(ai, bj, At, Bt) do { __builtin_amdgcn_s_setprio(1); _Pragma("unroll") for (int m = 0; m < 4; ++m) _Pragma("unroll") for (int n = 0; n < 2; ++n) _Pragma("unroll") for (int k = 0; k < 2; ++k) \
        acc[ai][bj][m][n] = __builtin_amdgcn_mfma_f32_16x16x32_bf16(Bt[n][k], At[m][k], acc[ai][bj][m][n], 0, 0, 0); __builtin_amdgcn_s_setprio(0); } while (0)
#define PG8_WAIT_V(n) asm volatile("s_waitcnt vmcnt(" #n ")" ::: "memory")
#define PG8_WAIT_L(n) asm volatile("s_waitcnt lgkmcnt(" #n ")" ::: "memory")
#define PG8_WAIT_VR(flag, n) asm volatile("s_cmp_lg_u32 %0, 0\n\ts_cbranch_scc1 .Lrlx%=\n\ts_waitcnt vmcnt(8)\n.Lrlx%=:\n\ts_waitcnt vmcnt(%1)" :: "s"(flag), "n"(n) : "memory", "scc")
#define PG8_BAR __builtin_amdgcn_s_barrier()
#define PG8_SCHED __builtin_amdgcn_sched_barrier(0)
#define PG8_AOFF(dst, un, uidx) do { _Pragma("unroll") for (int _h = 0; _h < 2; ++_h) _Pragma("unroll") for (int _i = 0; _i < 2; ++_i) { \
        if constexpr (GATHER) { const int _row = g.ltab[(uidx) * BM + _h * HALF + Rr[_i]]; dst[_h][_i] = (unsigned)(_row * K + Cc[_i]) * 2u; } \
        else dst[_h][_i] = (unsigned)((Rr[_i] + _h * HALF) * K + Cc[_i]) * 2u; } } while (0)
#define PG8_ABASE(un) (GATHER ? (const char*)g.A : (const char*)g.A + ((size_t)(un).e * g.sAe) * 2 + (size_t)(un).pm * tstep)
#define PG8_BBASE(un) ((const char*)g.Bt + ((size_t)(un).e * g.sBe) * 2 + (size_t)(un).pn * tstep)
    Unit cur, nxt; int ui = 0;
    if (!S.next(0, cur)) return;
    f32x4 acc[2][2][4][2];
#pragma unroll
    for (int a = 0; a < 2; ++a)
#pragma unroll
        for (int b = 0; b < 2; ++b)
#pragma unroll
            for (int m = 0; m < 4; ++m)
#pragma unroll
                for (int n = 0; n < 2; ++n) acc[a][b][m][n] = (f32x4){0.f, 0.f, 0.f, 0.f};
    bf16x8 At[4][2], B0[2][2], B1[2][2];
    unsigned vC[2][2], vN[2][2];
    PG8_AOFF(vC, cur, 0);
#pragma unroll
    for (int _h = 0; _h < 2; ++_h) { vN[_h][0] = vC[_h][0]; vN[_h][1] = vC[_h][1]; }
    const char* cA = PG8_ABASE(cur); const char* cB = PG8_BBASE(cur);
    PG8_STAGE(PG8_SB(0, 0), cB, voffB); PG8_STAGE(PG8_SB(0, 1), cB + hstep, voffB); PG8_STAGE(PG8_SA(0, 0), cA, vC[0]); PG8_STAGE(PG8_SA(0, 1), cA, vC[1]);
    if (wr == 1) PG8_BAR;
    PG8_WAIT_V(2); PG8_BAR;
    PG8_STAGE(PG8_SB(1, 0), cB + kstep, voffB); PG8_STAGE(PG8_SA(1, 0), cA + kstep, vC[0]); PG8_STAGE(PG8_SB(1, 1), cB + hstep + kstep, voffB);
    PG8_WAIT_V(6); PG8_BAR;
    for (;;) {
        const bool has_next = S.next(ui + 1, nxt);
        const char* nA = has_next ? PG8_ABASE(nxt) : cA; const char* nB = has_next ? PG8_BBASE(nxt) : cB;
        if constexpr (GATHER) { if (has_next) { PG8_AOFF(vN, nxt, ui + 1); } else {
#pragma unroll
            for (int _h = 0; _h < 2; ++_h) { vN[_h][0] = vC[_h][0]; vN[_h][1] = vC[_h][1]; } } }
        for (int t = 0; t < nt; t += 2) {
            const bool last = (t == nt - 2);
            const char* a1 = cA + (size_t)(t + 1) * kstep;
            const char* a2 = last ? nA : cA + (size_t)(t + 2) * kstep; const char* b2 = last ? nB : cB + (size_t)(t + 2) * kstep;
            const char* a3 = a2 + kstep; const char* b3 = b2 + kstep;
            unsigned v2[2][2];
#pragma unroll
            for (int _h = 0; _h < 2; ++_h)
#pragma unroll
                for (int _i = 0; _i < 2; ++_i) { if constexpr (GATHER) v2[_h][_i] = last ? vN[_h][_i] : vC[_h][_i]; else v2[_h][_i] = vC[_h][_i]; }
            const int relax = __builtin_amdgcn_readfirstlane(((t == 0) && (ui > 0)) ? 1 : 0);
            PG8_LDB(B0, 0, 0); PG8_LDB(B1, 0, 1); PG8_SCHED; PG8_LDA(At, 0, 0); PG8_STAGE(PG8_SA(1, 1), a1, vC[1]);
            PG8_WAIT_VR(relax, 8 + Epi::NST);
            PG8_WAIT_L(0); PG8_BAR; PG8_MMA(0, 0, At, B0); PG8_MMA(0, 1, At, B1); PG8_BAR; PG8_SCHED;
            PG8_LDA(At, 0, 1); PG8_STAGE(PG8_SB(0, 0), b2, voffB); PG8_STAGE(PG8_SB(0, 1), b2 + hstep, voffB); PG8_STAGE(PG8_SA(0, 0), a2, v2[0]);
            PG8_WAIT_VR(relax, 8 + Epi::NST);
            PG8_WAIT_L(0); PG8_BAR; PG8_MMA(1, 0, At, B0); PG8_MMA(1, 1, At, B1); PG8_BAR; PG8_SCHED;
            PG8_LDB(B0, 1, 0); PG8_LDB(B1, 1, 1); PG8_SCHED; PG8_LDA(At, 1, 0); PG8_STAGE(PG8_SA(0, 1), a2, v2[1]);
            PG8_WAIT_V(8); PG8_WAIT_L(0); PG8_BAR; PG8_MMA(0, 0, At, B0); PG8_MMA(0, 1, At, B1); PG8_BAR; PG8_SCHED;
            PG8_LDA(At, 1, 1); PG8_STAGE(PG8_SB(1, 0), b3, voffB); PG8_STAGE(PG8_SB(1, 1), b3 + hstep, voffB); PG8_STAGE(PG8_SA(1, 0), a3, v2[0]);
            PG8_WAIT_V(8); PG8_WAIT_L(0); PG8_BAR; PG8_MMA(1, 0, At, B0); PG8_MMA(1, 1, At, B1); PG8_BAR; PG8_SCHED;
        }
        if constexpr (ALIGN_EPI) { if (wr == 0) PG8_BAR; }
        E(acc, cur, wr, wc, fr, fq);
        if (!has_next) break;
#pragma unroll
        for (int a = 0; a < 2; ++a)
#pragma unroll
            for (int b = 0; b < 2; ++b)
#pragma unroll
                for (int m = 0; m < 4; ++m)
#pragma unroll
                    for (int n = 0; n < 2; ++n) acc[a][b][m][n] = (f32x4){0.f, 0.f, 0.f, 0.f};
        cur = nxt; cA = nA; cB = nB; ++ui;
#pragma unroll
        for (int _h = 0; _h < 2; ++_h) { vC[_h][0] = vN[_h][0]; vC[_h][1] = vN[_h][1]; }
        if constexpr (ALIGN_EPI) { if (wr == 1) PG8_BAR; }
    }
    PG8_WAIT_V(0);
    if constexpr (!ALIGN_EPI) { if (wr == 0) PG8_BAR; }
    PG8_BAR;
#undef PG8_SA
#undef PG8_SB
#undef PG8_STAGE
#undef PG8_LDA
#undef PG8_LDB
#undef PG8_MMA
#undef PG8_WAIT_V
#undef PG8_WAIT_L
#undef PG8_WAIT_VR
#undef PG8_BAR
#undef PG8_SCHED
#undef PG8_AOFF
#undef PG8_ABASE
#undef PG8_BBASE
}
}
namespace attn_body {
using bf16=__hip_bfloat16;
using bf16x8=__attribute__((ext_vector_type(8)))short;
using s16x4=__attribute__((ext_vector_type(4)))short;
using f32x16=__attribute__((ext_vector_type(16)))float;
using u32x4=__attribute__((ext_vector_type(4)))unsigned;
constexpr int SEQ=4096,D=64,QP=2048,KP=2048,VP=2048,OP=1024;
constexpr int NW=8,QBLK=32,QB=QBLK*NW,KVBLK=64;
constexpr int ATTN_UNIT_ROWS=QB;
__device__ __forceinline__ int crow(int r,int hi){return (r&3)+8*(r>>2)+4*hi;}
#define SBAR() __builtin_amdgcn_sched_barrier(0)
__device__ __forceinline__ void cmask(f32x16&p0,f32x16&p1,int jb,int qrel,int hi){
  const float NEG=-INFINITY; int kb=64*jb+4*hi;
  #pragma unroll
  for(int r=0;r<16;++r){int kv=kb+(r&3)+8*(r>>2); if(kv>qrel)p0[r]=NEG; if(kv+32>qrel)p1[r]=NEG;}
}

#ifndef MAXCHK
#define MAXCHK 8
#endif
constexpr int NSLOT=3, SLOTB=8192;
constexpr int LDS_K=0, LDS_V=NSLOT*SLOTB, LDS_WS=2*NSLOT*SLOTB, LDS_OST=LDS_WS+NW*64*4, LDS_BYTES=LDS_OST+NW*4096;
constexpr float C2=0.125f*1.4426950408889634f;
__device__ __forceinline__ void glds16(const void*gsrc,unsigned lds_dst){unsigned keep;
  asm volatile("s_mov_b32 %0, m0\n\ts_mov_b32 m0, %2\n\ts_nop 0\n\tglobal_load_lds_dwordx4 %1, off\n\ts_mov_b32 m0, %0":"=&s"(keep):"v"(gsrc),"s"(lds_dst):"memory");}
__device__ __forceinline__ float max3f(float a,float b,float c){float r;asm("v_max3_f32 %0, %1, %2, %3":"=v"(r):"v"(a),"v"(b),"v"(c));return r;}
__device__ __forceinline__ float max2f(float a,float b){float r;asm("v_max_f32_e32 %0, %1, %2":"=v"(r):"v"(a),"v"(b));return r;}
__device__ __forceinline__ float fadd_s(float a,float b){float r;asm("v_add_f32_e32 %0, %1, %2":"=v"(r):"v"(a),"v"(b));return r;}
__device__ __forceinline__ float fsub_s(float a,float b){float r;asm("v_sub_f32_e32 %0, %1, %2":"=v"(r):"v"(a),"v"(b));return r;}
typedef float f32x2_t __attribute__((ext_vector_type(2))); typedef __bf16 bf16x2_t __attribute__((ext_vector_type(2)));
__device__ __forceinline__ unsigned cvtpk_s(float lo,float hi){f32x2_t v={lo,hi};bf16x2_t b=__builtin_convertvector(v,bf16x2_t);return __builtin_bit_cast(unsigned,b);}
#define WAIT_BAR(N) asm volatile("s_waitcnt vmcnt(" #N ") lgkmcnt(0)\n\ts_barrier":::"memory")

__device__ __forceinline__ void qkt(f32x16&p0,f32x16&p1,const char*Kslot,const bf16x8*qr,const f32x16&negm,int r32,int hi){
  const char*kb=Kslot+hi*1024+r32*16;
  #pragma unroll
  for(int d0=0;d0<4;++d0){
    const bf16x8 b0=*reinterpret_cast<const bf16x8*>(kb+d0*2048);
    const bf16x8 b1=*reinterpret_cast<const bf16x8*>(kb+d0*2048+512);
    if(d0==0){p0=__builtin_amdgcn_mfma_f32_32x32x16_bf16(b0,qr[0],negm,0,0,0);p1=__builtin_amdgcn_mfma_f32_32x32x16_bf16(b1,qr[0],negm,0,0,0);}
    else{p0=__builtin_amdgcn_mfma_f32_32x32x16_bf16(b0,qr[d0],p0,0,0,0);p1=__builtin_amdgcn_mfma_f32_32x32x16_bf16(b1,qr[d0],p1,0,0,0);}}
}
typedef __attribute__((address_space(3))) const char* lds_cptr;
typedef short v4i16_t __attribute__((ext_vector_type(4)));
__device__ __forceinline__ void kload8(bf16x8*kf,lds_cptr kp){
  kf[0]=*(const __attribute__((address_space(3))) bf16x8*)(kp);      kf[1]=*(const __attribute__((address_space(3))) bf16x8*)(kp+512);
  kf[2]=*(const __attribute__((address_space(3))) bf16x8*)(kp+2048); kf[3]=*(const __attribute__((address_space(3))) bf16x8*)(kp+2560);
  kf[4]=*(const __attribute__((address_space(3))) bf16x8*)(kp+4096); kf[5]=*(const __attribute__((address_space(3))) bf16x8*)(kp+4608);
  kf[6]=*(const __attribute__((address_space(3))) bf16x8*)(kp+6144); kf[7]=*(const __attribute__((address_space(3))) bf16x8*)(kp+6656);
}
__device__ __forceinline__ void kload2(bf16x8*kf,lds_cptr kp,int j){ kf[2*j]=*(const __attribute__((address_space(3))) bf16x8*)(kp+j*2048); kf[2*j+1]=*(const __attribute__((address_space(3))) bf16x8*)(kp+j*2048+512); }
__device__ __forceinline__ s16x4 vtr(lds_cptr p){ return __builtin_bit_cast(s16x4,__builtin_amdgcn_ds_read_tr16_b64_v4i16((__attribute__((address_space(3))) v4i16_t*)p)); }
__device__ __forceinline__ float rowmax(const f32x16&p0,const f32x16&p1){
  float a=max3f(p0[0],p0[1],p1[0]),b=max3f(p0[2],p0[3],p1[1]);a=max3f(a,p1[2],p1[3]);
  #pragma unroll
  for(int r=4;r<16;r+=4){a=max3f(a,p0[r],p0[r+1]);b=max3f(b,p0[r+2],p0[r+3]);a=max3f(a,p1[r],p1[r+1]);b=max3f(b,p1[r+2],p1[r+3]);}
  const float m=max2f(a,b);
  auto rr=__builtin_amdgcn_permlane32_swap(__float_as_uint(m),__float_as_uint(m),false,false);
  return max2f(__uint_as_float(rr[0]),__uint_as_float(rr[1]));
}
__device__ __forceinline__ void pv(f32x16*o,int vb,bf16x8 pa0,bf16x8 pa1,bf16x8 pa2,bf16x8 pa3){
  #pragma unroll
  for(int d0=0;d0<2;++d0){s16x4 lo[4],hi[4];
    #pragma unroll
    for(int ks=0;ks<4;++ks){
      asm volatile("ds_read_b64_tr_b16 %0,%1 offset:%c2":"=&v"(lo[ks]):"v"(vb),"i"(d0*4096+ks*1024):"memory");
      asm volatile("ds_read_b64_tr_b16 %0,%1 offset:%c2":"=&v"(hi[ks]):"v"(vb),"i"(d0*4096+ks*1024+512):"memory");}
    asm volatile("s_waitcnt lgkmcnt(0)":::"memory");SBAR();
    #define PK(k) (bf16x8){lo[k][0],lo[k][1],lo[k][2],lo[k][3],hi[k][0],hi[k][1],hi[k][2],hi[k][3]}
    o[d0]=__builtin_amdgcn_mfma_f32_32x32x16_bf16(pa0,PK(0),o[d0],0,0,0);
    o[d0]=__builtin_amdgcn_mfma_f32_32x32x16_bf16(pa1,PK(1),o[d0],0,0,0);
    o[d0]=__builtin_amdgcn_mfma_f32_32x32x16_bf16(pa2,PK(2),o[d0],0,0,0);
    o[d0]=__builtin_amdgcn_mfma_f32_32x32x16_bf16(pa3,PK(3),o[d0],0,0,0);
    #undef PK
  }
}

#ifndef ATTN_STORE16
#define ATTN_STORE16(p,v) (*(u32x4*)(p)=(v))
#endif
template<int THRL> __device__ __forceinline__ void attn_unit(long rowbase,int q0,const bf16*Qh,const bf16*__restrict__ Kh,const bf16*__restrict__ Vh,bf16*Oh,char*shm){
  const int tid=opaque_tid(),lane=tid&63,r32=lane&31,hi=lane>>5; const int wid=__builtin_amdgcn_readfirstlane(tid>>6);
  const bf16*Qw=Qh+(rowbase+q0+wid*QBLK)*QP;
  const bf16*Kb=Kh+rowbase*KP,*Vb=Vh+rowbase*VP;
  const unsigned lds0=(unsigned)(uintptr_t)shm;
  float*wsf=(float*)(shm+LDS_WS)+wid*64;
  const bf16*ksrc=Kb+(long)lane*KP+wid*8;
  const bf16*vsrc=Vb+(long)(16*(wid&3)+(lane>>2))*VP+(wid>>2)*32+(lane&3)*8;
  const unsigned kdst=lds0+LDS_K+wid*1024, vdst=lds0+LDS_V+wid*1024;
  #define DMA_K(t,slot) glds16(ksrc+(long)(t)*KVBLK*KP,(unsigned)__builtin_amdgcn_readfirstlane(kdst+(slot)))
  #define DMA_V(t,slot) glds16(vsrc+(long)(t)*KVBLK*VP,(unsigned)__builtin_amdgcn_readfirstlane(vdst+(slot)))
  const int vb0=(int)(lds0+LDS_V)+((lane>>4)&1)*32+(lane&3)*8+(4*hi+((lane&15)>>2))*64;
  const char*Kbase=shm+LDS_K; bf16x8 kf[8];
  const lds_cptr shm3=(lds_cptr)shm; const lds_cptr kp0=shm3+LDS_K+hi*1024+r32*16; const lds_cptr vp0=shm3+LDS_V+((lane>>4)&1)*32+(lane&3)*8+(4*hi+((lane&15)>>2))*64;
  constexpr int NT=SEQ/KVBLK;
  DMA_K(0,0);DMA_V(0,0);DMA_K(1,SLOTB);
  bf16x8 qr[4];
  #pragma unroll
  for(int d0=0;d0<4;++d0)qr[d0]=*reinterpret_cast<const bf16x8*>(&Qw[(long)r32*QP+d0*16+hi*8]);
  float mhat=0.f,l_reg=0.f;f32x16 o[2];o[0]=f32x16{};o[1]=f32x16{};f32x16 negm=f32x16{};asm volatile("":"+v"(negm));
  const int qrel=wid*QBLK+r32;
  #define CMASK(P0,P1,t) do{}while(0)
  bool resc=false;
  #define START(P0,P1) do{ const float rm=rowmax(P0,P1); resc=false; \
    { const float dl=rm; mhat=fadd_s(mhat,dl); \
      _Pragma("unroll") for(int r=0;r<16;++r){P0[r]=fsub_s(P0[r],dl);P1[r]=fsub_s(P1[r],dl);} \
      _Pragma("unroll") for(int r=0;r<16;++r)negm[r]=-mhat; asm volatile("":"+v"(negm)); } \
    _Pragma("unroll") for(int r=0;r<16;++r)P0[r]=__builtin_amdgcn_exp2f(P0[r]); }while(0)
  #define RESC() do{ if(resc){ asm volatile("s_waitcnt lgkmcnt(0)":::"memory"); \
      _Pragma("unroll") for(int d_=0;d_<2;++d_) _Pragma("unroll") for(int r=0;r<16;++r)o[d_][r]*=wsf[crow(r,hi)]; } }while(0)
  f32x16 pA0,pA1,pB0,pB1;
  int sl_prev=0,sl_cur=0,sl_next=SLOTB;
  #define ROT() do{sl_prev=sl_cur;sl_cur=sl_next;sl_next=(sl_next==(NSLOT-1)*SLOTB)?0:sl_next+SLOTB;}while(0)
  DMA_K(2,2*SLOTB);
  WAIT_BAR(3);
  qkt(pA0,pA1,Kbase,qr,negm,r32,hi);asm volatile("s_nop 15\n\ts_nop 7":"+v"(pA0),"+v"(pA1));CMASK(pA0,pA1,0);
  START(pA0,pA1);
  _Pragma("unroll") for(int r=0;r<16;++r)pA1[r]=__builtin_amdgcn_exp2f(pA1[r]);
  WAIT_BAR(0);
  DMA_K(3,0);DMA_V(1,SLOTB);
  ROT();
  kload8(kf,kp0+sl_cur);
  WAIT_BAR(2);
  s16x4 vlo[8],vhi[8]; u32x4 pw0,pw1,pw2,pw3;
  #define PKW(P,B) cvtpk_s(P[B],P[B+1])
  #define PAF(k) __builtin_bit_cast(bf16x8,pw##k)
  #define VFR(i) (bf16x8){vlo[i][0],vlo[i][1],vlo[i][2],vlo[i][3],vhi[i][0],vhi[i][1],vhi[i][2],vhi[i][3]}
  #define PIN(x) asm volatile("":"+v"(x))
  #define MX3(a,b,c) __builtin_fmaxf(__builtin_fmaxf((a),(b)),(c))
  #define GAPA(MF,A0,A1,A2,A3,W0,W1,PW) do{ MF; sacc+=A0; sacc+=A1; sacc+=A2; sacc+=A3; PIN(sacc); W0; W1; PIN(PW); SBAR(); }while(0)
  #define EX(v) __builtin_amdgcn_exp2f(v)
  #define GAPB(MF,X,B) do{ MF; X[B]=EX(X[B]); X[B+1]=EX(X[B+1]); X[B+2]=EX(X[B+2]); X[B+3]=EX(X[B+3]); PIN(X); SBAR(); }while(0)
  #define VRD(i) do{ vlo[i]=vtr(vp_+(((i)>>2)*4096+((i)&3)*1024)); vhi[i]=vtr(vp_+(((i)>>2)*4096+((i)&3)*1024+512)); }while(0)
  #define KRD(G,j) do{ if(G){ kload2(kf,kp0+sl_next,j); SBAR(); } }while(0)
  #define STEP(C0,C1,P0,P1,t,GK,GV,GL) do{ SBAR(); \
    const lds_cptr vp_=vp0+sl_prev; \
    VRD(0); SBAR(); float sacc=(P0[0]+P0[1]); \
    GAPA(C0=__builtin_amdgcn_mfma_f32_32x32x16_bf16(kf[0],qr[0],negm,0,0,0), P0[2],P0[3],P0[4],P0[5],     pw0[0]=PKW(P0,0), pw0[1]=PKW(P0,2), pw0); \
    VRD(4); SBAR(); GAPA(C1=__builtin_amdgcn_mfma_f32_32x32x16_bf16(kf[1],qr[0],negm,0,0,0), P0[6],P0[7],P0[8],P0[9],     pw0[2]=PKW(P0,4), pw0[3]=PKW(P0,6), pw0); \
    VRD(1); SBAR(); GAPA(C0=__builtin_amdgcn_mfma_f32_32x32x16_bf16(kf[2],qr[1],C0,0,0,0),   P0[10],P0[11],P0[12],P0[13], pw1[0]=PKW(P0,8), pw1[1]=PKW(P0,10), pw1); \
    VRD(5); SBAR(); GAPA(C1=__builtin_amdgcn_mfma_f32_32x32x16_bf16(kf[3],qr[1],C1,0,0,0),   P0[14],P0[15],P1[0],P1[1],   pw1[2]=PKW(P0,12),pw1[3]=PKW(P0,14), pw1); \
    VRD(2); SBAR(); GAPA(C0=__builtin_amdgcn_mfma_f32_32x32x16_bf16(kf[4],qr[2],C0,0,0,0),   P1[2],P1[3],P1[4],P1[5],     pw2[0]=PKW(P1,0), pw2[1]=PKW(P1,2), pw2); \
    VRD(6); SBAR(); GAPA(C1=__builtin_amdgcn_mfma_f32_32x32x16_bf16(kf[5],qr[2],C1,0,0,0),   P1[6],P1[7],P1[8],P1[9],     pw2[2]=PKW(P1,4), pw2[3]=PKW(P1,6), pw2); \
    VRD(3); SBAR(); GAPA(C0=__builtin_amdgcn_mfma_f32_32x32x16_bf16(kf[6],qr[3],C0,0,0,0),   P1[10],P1[11],P1[12],P1[13], pw3[0]=PKW(P1,8), pw3[1]=PKW(P1,10), pw3); \
    VRD(7); SBAR(); GAPA(C1=__builtin_amdgcn_mfma_f32_32x32x16_bf16(kf[7],qr[3],C1,0,0,0),   P1[14],P1[15],0.f,0.f,       pw3[2]=PKW(P1,12),pw3[3]=PKW(P1,14), pw3); \
    l_reg+=sacc; \
    if(GK){DMA_K((t)+3,sl_cur);} if(GV){DMA_V((t)+1,sl_next);} \
    CMASK(C0,C1,t); \
    resc=false; \
    if((((t)&(MAXCHK-1))==0)){ float a=MX3(C0[0],C0[1],C1[0]),b=MX3(C0[2],C0[3],C1[1]); a=MX3(a,C1[2],C1[3]); \
      _Pragma("unroll") for(int r=4;r<16;r+=4){a=MX3(a,C0[r],C0[r+1]);b=MX3(b,C0[r+2],C0[r+3]);a=MX3(a,C1[r],C1[r+1]);b=MX3(b,C1[r+2],C1[r+3]);} \
      float rm=__builtin_fmaxf(a,b); { auto rr=__builtin_amdgcn_permlane32_swap(__float_as_uint(rm),__float_as_uint(rm),false,false); rm=__builtin_fmaxf(__uint_as_float(rr[0]),__uint_as_float(rr[1])); } \
      if(__builtin_expect(__any(rm>(float)THRL),0)){ const float dl=__builtin_fmaxf(rm,0.f); mhat+=dl; \
        _Pragma("unroll") for(int r=0;r<16;++r){C0[r]-=dl;C1[r]-=dl;} \
        _Pragma("unroll") for(int r=0;r<16;++r)negm[r]=-mhat; asm volatile("":"+v"(negm)); \
        const float f=__builtin_amdgcn_exp2f(-dl); l_reg*=f; if(hi==0)wsf[r32]=f; resc=true; } } \
    SBAR(); \
    GAPB(o[0]=__builtin_amdgcn_mfma_f32_32x32x16_bf16(PAF(0),VFR(0),o[0],0,0,0), C0,0); \
    GAPB(o[1]=__builtin_amdgcn_mfma_f32_32x32x16_bf16(PAF(0),VFR(4),o[1],0,0,0), C0,4); \
    KRD(GL,0); GAPB(o[0]=__builtin_amdgcn_mfma_f32_32x32x16_bf16(PAF(1),VFR(1),o[0],0,0,0), C0,8); \
    KRD(GL,1); GAPB(o[1]=__builtin_amdgcn_mfma_f32_32x32x16_bf16(PAF(1),VFR(5),o[1],0,0,0), C0,12); \
    KRD(GL,2); GAPB(o[0]=__builtin_amdgcn_mfma_f32_32x32x16_bf16(PAF(2),VFR(2),o[0],0,0,0), C1,0); \
    KRD(GL,3); GAPB(o[1]=__builtin_amdgcn_mfma_f32_32x32x16_bf16(PAF(2),VFR(6),o[1],0,0,0), C1,4); \
    GAPB(o[0]=__builtin_amdgcn_mfma_f32_32x32x16_bf16(PAF(3),VFR(3),o[0],0,0,0), C1,8); \
    GAPB(o[1]=__builtin_amdgcn_mfma_f32_32x32x16_bf16(PAF(3),VFR(7),o[1],0,0,0), C1,12); \
    }while(0)
  int t=1;
  #undef CMASK
  #define CMASK(P0,P1,t) do{}while(0)
  for(;t+5<NT;t+=2){
    STEP(pB0,pB1,pA0,pA1,t,true,true,true);     WAIT_BAR(2); RESC(); ROT();
    STEP(pA0,pA1,pB0,pB1,t+1,true,true,true);   WAIT_BAR(2); RESC(); ROT();
  }
  #undef CMASK
  #define CMASK(P0,P1,t) do{}while(0)
  #define ENDW(tt) do{ if((tt)+3<NT){WAIT_BAR(2);} else if((tt)+2<NT){WAIT_BAR(1);} else {WAIT_BAR(0);} }while(0)
  for(;t+1<NT;t+=2){
    STEP(pB0,pB1,pA0,pA1,t,(t+3<NT),(t+1<NT),(t+1<NT));       ENDW(t);   RESC(); ROT();
    STEP(pA0,pA1,pB0,pB1,t+1,(t+4<NT),(t+2<NT),(t+2<NT));     ENDW(t+1); RESC(); ROT();
  }
  STEP(pB0,pB1,pA0,pA1,NT-1,false,false,false); RESC();
  { float sacc=pB0[0]+pB0[1]; _Pragma("unroll") for(int r=2;r<16;++r)sacc+=pB0[r]; _Pragma("unroll") for(int r=0;r<16;++r)sacc+=pB1[r]; l_reg+=sacc;
    pw0=(u32x4){PKW(pB0,0),PKW(pB0,2),PKW(pB0,4),PKW(pB0,6)};pw1=(u32x4){PKW(pB0,8),PKW(pB0,10),PKW(pB0,12),PKW(pB0,14)};pw2=(u32x4){PKW(pB1,0),PKW(pB1,2),PKW(pB1,4),PKW(pB1,6)};pw3=(u32x4){PKW(pB1,8),PKW(pB1,10),PKW(pB1,12),PKW(pB1,14)};
    SBAR(); pv(o,vb0+sl_cur,PAF(0),PAF(1),PAF(2),PAF(3)); }
  #undef PKW
  #undef PAF
  #undef VFR
  #undef PIN
  #undef MX3
  #undef GAPA
  #undef GAPB
  #undef EX
  #undef VRD
  #undef KRD
  #undef STEP
  #undef ENDW
  {auto rr=__builtin_amdgcn_permlane32_swap(__float_as_uint(l_reg),__float_as_uint(l_reg),false,false);l_reg=__uint_as_float(rr[0])+__uint_as_float(rr[1]);}
  if(hi==0)wsf[32+r32]=l_reg;asm volatile("s_waitcnt lgkmcnt(0)":::"memory");
  float rli[16];
  #pragma unroll
  for(int r=0;r<16;++r)rli[r]=__builtin_amdgcn_rcpf(wsf[32+crow(r,hi)]);
  bf16*Ow=Oh+(rowbase+q0+wid*QBLK)*OP;
  { bf16*stg=(bf16*)(shm+LDS_OST)+wid*2048;
    #pragma unroll
    for(int r=0;r<16;++r){const int orow=crow(r,hi);
      #pragma unroll
      for(int d0=0;d0<2;++d0)stg[orow*64+d0*32+r32]=__float2bfloat16(o[d0][r]*rli[r]);}
    asm volatile("s_waitcnt lgkmcnt(0)":::"memory");
    #pragma unroll
    for(int i=0;i<4;++i){const int row=i*8+(lane>>3),ch=lane&7; const u32x4 v=*(const u32x4*)(stg+row*64+ch*8); ATTN_STORE16(Ow+(long)row*OP+ch*8,v);} }
  asm volatile("s_waitcnt lgkmcnt(0)\n\ts_barrier":::"memory");
  #undef DMA_K
  #undef DMA_V
  #undef CMASK
  #undef START
  #undef RESC
  #undef ROT
}
constexpr int CA_K=0, CA_V=65536, CA_BYTES=131072;
constexpr int CQP=512, CKP=1024;
constexpr float CA_C2=0.08838834764831845f*1.4426950408889634f;
__device__ __forceinline__ void ca_qkt(f32x16&p0,f32x16&p1,const char*Kslot,const bf16x8*qr,const f32x16&init,int r32,int hi){
  #pragma unroll
  for(int dh=0;dh<2;++dh){ const char*kb=Kslot+dh*8192+hi*1024+r32*16;
    #pragma unroll
    for(int d0=0;d0<4;++d0){
      const bf16x8 b0=*reinterpret_cast<const bf16x8*>(kb+d0*2048);
      const bf16x8 b1=*reinterpret_cast<const bf16x8*>(kb+d0*2048+512);
      if(dh==0&&d0==0){p0=__builtin_amdgcn_mfma_f32_32x32x16_bf16(b0,qr[0],init,0,0,0);p1=__builtin_amdgcn_mfma_f32_32x32x16_bf16(b1,qr[0],init,0,0,0);}
      else{p0=__builtin_amdgcn_mfma_f32_32x32x16_bf16(b0,qr[dh*4+d0],p0,0,0,0);p1=__builtin_amdgcn_mfma_f32_32x32x16_bf16(b1,qr[dh*4+d0],p1,0,0,0);}}}
}
template<int NQ> __device__ __forceinline__ void ca_tiles(int b,int hd,int qt0,const bf16*Q,const bf16*__restrict__ KV,bf16*O,char*shm,float*wsf_all){
  const int tid=opaque_tid(),lane=tid&63,r32=lane&31,hi=lane>>5; const int wid=__builtin_amdgcn_readfirstlane(tid>>6);
  const unsigned lds0=(unsigned)(uintptr_t)shm;
  float*wsf=wsf_all+wid*64;
  const bf16*Kg=KV+(long)(b*256)*CKP+hd*128; const bf16*Vg=Kg+512;
  #pragma unroll
  for(int kt=0;kt<4;++kt){
    #pragma unroll
    for(int dh=0;dh<2;++dh) glds16(Kg+(long)(kt*64+lane)*CKP+dh*64+wid*8,(unsigned)__builtin_amdgcn_readfirstlane(lds0+CA_K+(kt*2+dh)*8192+wid*1024)); }

  const int vb0=(int)(lds0+CA_V)+((lane>>4)&1)*32+(lane&3)*8+(4*hi+((lane&15)>>2))*64;
  for(int qi=0;qi<NQ;++qi){
    const long rowq=(long)b*4096+(qt0+qi)*256+wid*32;
    const bf16*Qw=Q+rowq*CQP+hd*128;
    bf16x8 qr[8];
    #pragma unroll
    for(int d0=0;d0<8;++d0)qr[d0]=*reinterpret_cast<const bf16x8*>(&Qw[(long)r32*CQP+d0*16+hi*8]);
    if(qi==0){
      #pragma unroll
      for(int kt=0;kt<4;++kt){
        #pragma unroll
        for(int dh=0;dh<2;++dh) glds16(Vg+(long)(kt*64+16*(wid&3)+(lane>>2))*CKP+dh*64+(wid>>2)*32+(lane&3)*8,(unsigned)__builtin_amdgcn_readfirstlane(lds0+CA_V+(kt*2+dh)*8192+wid*1024)); }
      WAIT_BAR(8); }
    f32x16 zero=f32x16{};
    f32x16 sc[4][2];
    #pragma unroll
    for(int kt=0;kt<4;++kt) ca_qkt(sc[kt][0],sc[kt][1],shm+CA_K+kt*2*8192,qr,zero,r32,hi);
    float mx=-INFINITY;
    #pragma unroll
    for(int kt=0;kt<4;++kt){
      #pragma unroll
      for(int r=0;r<16;++r)mx=__builtin_fmaxf(mx,__builtin_fmaxf(sc[kt][0][r],sc[kt][1][r])); }
    { auto rr=__builtin_amdgcn_permlane32_swap(__float_as_uint(mx),__float_as_uint(mx),false,false); mx=__builtin_fmaxf(__uint_as_float(rr[0]),__uint_as_float(rr[1])); }
    float l=0.f; u32x4 pw[4][4];
    #pragma unroll
    for(int kt=0;kt<4;++kt){ f32x16&p0=sc[kt][0]; f32x16&p1=sc[kt][1];
      #pragma unroll
      for(int r=0;r<16;++r){p0[r]=__builtin_amdgcn_exp2f(p0[r]-mx);p1[r]=__builtin_amdgcn_exp2f(p1[r]-mx);}
      float sacc=0.f;
      #pragma unroll
      for(int r=0;r<16;++r)sacc+=p0[r]+p1[r];
      l+=sacc;
      pw[kt][0]=(u32x4){cvtpk_s(p0[0],p0[1]),cvtpk_s(p0[2],p0[3]),cvtpk_s(p0[4],p0[5]),cvtpk_s(p0[6],p0[7])};
      pw[kt][1]=(u32x4){cvtpk_s(p0[8],p0[9]),cvtpk_s(p0[10],p0[11]),cvtpk_s(p0[12],p0[13]),cvtpk_s(p0[14],p0[15])};
      pw[kt][2]=(u32x4){cvtpk_s(p1[0],p1[1]),cvtpk_s(p1[2],p1[3]),cvtpk_s(p1[4],p1[5]),cvtpk_s(p1[6],p1[7])};
      pw[kt][3]=(u32x4){cvtpk_s(p1[8],p1[9]),cvtpk_s(p1[10],p1[11]),cvtpk_s(p1[12],p1[13]),cvtpk_s(p1[14],p1[15])}; }
    f32x16 o[4]; o[0]=f32x16{};o[1]=f32x16{};o[2]=f32x16{};o[3]=f32x16{};
    if(qi==0){ WAIT_BAR(0); }
    SBAR();
    #pragma unroll
    for(int kt=0;kt<4;++kt){
      pv(o,vb0+(kt*2)*8192,__builtin_bit_cast(bf16x8,pw[kt][0]),__builtin_bit_cast(bf16x8,pw[kt][1]),__builtin_bit_cast(bf16x8,pw[kt][2]),__builtin_bit_cast(bf16x8,pw[kt][3]));
      pv(o+2,vb0+(kt*2+1)*8192,__builtin_bit_cast(bf16x8,pw[kt][0]),__builtin_bit_cast(bf16x8,pw[kt][1]),__builtin_bit_cast(bf16x8,pw[kt][2]),__builtin_bit_cast(bf16x8,pw[kt][3]));
    }
    { auto rr=__builtin_amdgcn_permlane32_swap(__float_as_uint(l),__float_as_uint(l),false,false); l=__uint_as_float(rr[0])+__uint_as_float(rr[1]); }
    if(hi==0)wsf[r32]=l;
    asm volatile("s_waitcnt lgkmcnt(0)":::"memory");
    bf16*Ow=O+rowq*CQP+hd*128;
    float rli[16];
    #pragma unroll
    for(int r=0;r<16;++r)rli[r]=__builtin_amdgcn_rcpf(wsf[crow(r,hi)]);
    bf16*stg=(bf16*)(wsf_all+8*64)+wid*1024;
    #pragma unroll
    for(int d0=0;d0<4;++d0){
      #pragma unroll
      for(int r=0;r<16;++r)stg[crow(r,hi)*32+r32]=__float2bfloat16(o[d0][r]*rli[r]);
      asm volatile("s_waitcnt lgkmcnt(0)":::"memory");
      #pragma unroll
      for(int i=0;i<2;++i){const int idx=i*64+lane,row=idx>>2,ch=idx&3; const u32x4 v=*(const u32x4*)(stg+row*32+ch*8); *(u32x4*)(Ow+(long)row*CQP+d0*32+ch*8)=v;}
      asm volatile("s_waitcnt lgkmcnt(0)":::"memory");
    }
  }
  asm volatile("s_waitcnt lgkmcnt(0)\n\ts_barrier":::"memory");
}
#undef SBAR
#undef WAIT_BAR
}
#define GAS __attribute__((address_space(1)))
#define LAS __attribute__((address_space(3)))
typedef unsigned short bf16;
typedef unsigned v4u __attribute__((ext_vector_type(4)));
typedef float f32x4 __attribute__((ext_vector_type(4)));
typedef short bf16x8 __attribute__((ext_vector_type(8)));
typedef GAS unsigned gu32;
typedef GAS unsigned long long gu64;
#define RLX_AGENT __ATOMIC_RELAXED, __HIP_MEMORY_SCOPE_AGENT
#define LDS_WAIT() asm volatile("s_waitcnt lgkmcnt(0)" ::: "memory")
#define VM_WAIT() asm volatile("s_waitcnt vmcnt(0)" ::: "memory")
__device__ __forceinline__ unsigned long long rt() { return __builtin_amdgcn_s_memrealtime(); }
typedef float f32x2h __attribute__((ext_vector_type(2))); typedef __bf16 bf16x2h __attribute__((ext_vector_type(2)));
__device__ __forceinline__ unsigned pk2(float lo, float hi) { f32x2h v = {lo, hi}; bf16x2h b = __builtin_convertvector(v, bf16x2h); return __builtin_bit_cast(unsigned, b); }
__device__ __forceinline__ unsigned f2bf(float f) { return pk2(f, 0.f) & 0xffffu; }

#define XB_TMO      128
#define XB_XCNT(j)  (256  + 64 * (j))
#define XB_XSUB(j)  (1280 + 64 * (j))
#define XB_XGEN(j)  (2304 + 64 * (j))
#define XB_TOP      3328
#define XB_TOPGEN   3392
#define XCD_BAR_WORDS 3456
#define XB_SPIN_CAP (1u << 18)

__device__ __forceinline__ unsigned xb_ld(unsigned* p)              { return __hip_atomic_load(p, __ATOMIC_RELAXED, __HIP_MEMORY_SCOPE_AGENT); }
__device__ __forceinline__ unsigned xb_add(unsigned* p, unsigned v) { return __hip_atomic_fetch_add(p, v, __ATOMIC_RELAXED, __HIP_MEMORY_SCOPE_AGENT); }
__device__ __forceinline__ unsigned xb_xcc_id() { return (unsigned)__builtin_amdgcn_s_getreg((3 << 11) | 20) & 0xFu; }
__device__ __forceinline__ unsigned xb_poll(unsigned* p) { unsigned r; const unsigned z = 0u; asm volatile("global_atomic_add %0, %1, %2, off sc0\n\ts_waitcnt vmcnt(0)" : "=&v"(r) : "v"(p), "v"(z) : "memory"); return r; }
#define XB_SPIN(cond, bar) do { unsigned _sp = 0; while (cond) { __builtin_amdgcn_s_sleep(1); \
    if ((++_sp & 255u) == 0u) { if (xb_ld(&(bar)[XB_TMO])) break; if (_sp > XB_SPIN_CAP) { atomicAdd(&(bar)[XB_TMO], 1u); break; } } } } while (0)

struct XcdBarrier {
    unsigned* bar; unsigned x;
    volatile LAS unsigned* st;
};

__device__ __forceinline__ XcdBarrier xcd_barrier_post(unsigned* bar, volatile LAS unsigned* st) {
    XcdBarrier b; b.bar = bar; b.x = xb_xcc_id(); b.st = st;
    if (threadIdx.x == 0) (void)xb_add(&bar[XB_XCNT(b.x)], 1u);
    return b;
}
__device__ __forceinline__ void xcd_barrier_complete(unsigned* bar, unsigned x, unsigned& nloc, unsigned& nx) {
    const unsigned G = gridDim.x * gridDim.y * gridDim.z;
    unsigned sum, cnt, mine, sp = 0u;
    for (;;) {
        sum = 0u; cnt = 0u; mine = 0u;
#pragma unroll
        for (unsigned j = 0; j < 16; ++j) { const unsigned c = xb_ld(&bar[XB_XCNT(j)]); sum += c; cnt += (c > 0u) ? 1u : 0u; mine = (j == x) ? c : mine; }
        if (sum == G) break;
        __builtin_amdgcn_s_sleep(1);
        if ((++sp & 255u) == 0u) { if (xb_ld(&bar[XB_TMO])) break; if (sp > XB_SPIN_CAP) { atomicAdd(&bar[XB_TMO], 1u); break; } }
    }
    nloc = mine > 0u ? mine : 1u; nx = cnt > 0u ? cnt : 1u;
}

__device__ __forceinline__ void xcd_barrier(const XcdBarrier& b) {
    asm volatile("s_waitcnt vmcnt(0)" ::: "memory");
    __syncthreads();
    if (threadIdx.x == 0) {
        unsigned* bar = b.bar;
        __builtin_amdgcn_s_waitcnt(0);
        unsigned nloc = b.st[0], nx = b.st[1];
        if (nloc == 0u) { xcd_barrier_complete(bar, b.x, nloc, nx); b.st[0] = nloc; b.st[1] = nx; }
        const unsigned old = xb_add(&bar[XB_XSUB(b.x)], 1u);
        const unsigned gen = old / nloc;
        if (old + 1u == (gen + 1u) * nloc) {
            __builtin_amdgcn_fence(__ATOMIC_RELEASE, "agent");
            asm volatile("s_waitcnt vmcnt(0)" ::: "memory");
            const unsigned og = xb_add(&bar[XB_TOP], 1u);
            const unsigned tg = og / nx;
            if (og + 1u == (tg + 1u) * nx) xb_add(&bar[XB_TOPGEN], 1u);
            else XB_SPIN(xb_poll(&bar[XB_TOPGEN]) == tg, bar);
            __builtin_amdgcn_fence(__ATOMIC_ACQUIRE, "agent");
            xb_add(&bar[XB_XGEN(b.x)], 1u);
            asm volatile("s_waitcnt vmcnt(0)" ::: "memory");
        } else {
            XB_SPIN(xb_poll(&bar[XB_XGEN(b.x)]) == gen, bar);
            __builtin_amdgcn_fence(__ATOMIC_ACQUIRE, "agent");
            asm volatile("s_waitcnt vmcnt(0)" ::: "memory");
        }
    }
    __syncthreads();
}

template <class Work>
__device__ __forceinline__ void xcd_barrier_w(const XcdBarrier& b, const Work& work, volatile LAS unsigned* ctl) {
    asm volatile("s_waitcnt vmcnt(0)" ::: "memory");
    if (threadIdx.x == 0) { ctl[0] = 0u; work.reset(ctl); }
    __syncthreads();
    if (__builtin_amdgcn_readfirstlane(threadIdx.x >> 6) != 0) { work(ctl); }
    else if (threadIdx.x == 0) {
        unsigned* bar = b.bar;
        __builtin_amdgcn_s_waitcnt(0);
        unsigned nloc = b.st[0], nx = b.st[1];
        if (nloc == 0u) { xcd_barrier_complete(bar, b.x, nloc, nx); b.st[0] = nloc; b.st[1] = nx; }
        const unsigned old = xb_add(&bar[XB_XSUB(b.x)], 1u);
        const unsigned gen = old / nloc;
        if (old + 1u == (gen + 1u) * nloc) {
            __builtin_amdgcn_fence(__ATOMIC_RELEASE, "agent");
            asm volatile("s_waitcnt vmcnt(0)" ::: "memory");
            const unsigned og = xb_add(&bar[XB_TOP], 1u);
            const unsigned tg = og / nx;
            if (og + 1u == (tg + 1u) * nx) xb_add(&bar[XB_TOPGEN], 1u);
            else XB_SPIN(xb_ld(&bar[XB_TOPGEN]) == tg, bar);
            __builtin_amdgcn_fence(__ATOMIC_ACQUIRE, "agent");
            xb_add(&bar[XB_XGEN(b.x)], 1u);
            asm volatile("s_waitcnt vmcnt(0)" ::: "memory");
        } else {
            XB_SPIN(xb_ld(&bar[XB_XGEN(b.x)]) == gen, bar);
            __builtin_amdgcn_fence(__ATOMIC_ACQUIRE, "agent");
            asm volatile("s_waitcnt vmcnt(0)" ::: "memory");
        }
        ctl[0] = 1u;
    }
    __syncthreads();
}

__device__ __forceinline__ void local_barrier(unsigned* bar, unsigned* cnt, unsigned nblk, volatile LAS unsigned* genw) {
    asm volatile("s_waitcnt vmcnt(0)" ::: "memory");
    __syncthreads();
    if (threadIdx.x == 0) {
        __builtin_amdgcn_s_waitcnt(0);
        const unsigned gen = genw[0] + 1u; genw[0] = gen;
        (void)xb_add(cnt, 1u);
        XB_SPIN(xb_poll(cnt) < gen * nblk, bar);
        __builtin_amdgcn_fence(__ATOMIC_ACQUIRE, "agent");
        asm volatile("s_waitcnt vmcnt(0)" ::: "memory");
    }
    __syncthreads();
}

constexpr int DMODEL = 1024, NBATCH = 8, SEQL = 4096, DEPTH = 4, NTOK = NBATCH * SEQL;
constexpr int NPROJ = 2048;
constexpr int C_POOL = 0, C_MQ = 256, C_MK = 512, C_MV = 768, C_MO = 1024, C_AQ = 1280, C_AK = 1792, C_AV = 1920;
constexpr int NEXP = 16, CAP = 512, FFE = 2048, ROWS_E = NBATCH * CAP  , NSLOTS = NEXP * ROWS_E;
constexpr float EPS = 1e-6f;
enum { I_X = 0, I_MEM, I_NMIXG, I_WIN, I_POOLW, I_POOLS, I_CONVW, I_GATEB, I_MNORMG, I_QNG, I_KNG, I_WOUT, I_NMEMG, I_CAWQ, I_CAWKV, I_CAWO, I_NFFNG, I_ROUTER, I_WGU, I_WDN, I_FNG, N_IN };

constexpr size_t MiB = 1u << 20;
constexpr size_t WS_CTL = 0, CTL_ZERO_BYTES = 1 * MiB;
constexpr size_t WS_ROPE = 1 * MiB;
constexpr size_t WS_POOLW = 2 * MiB;
constexpr size_t WS_MEMB = 3 * MiB;
constexpr size_t WS_WIN = 8 * MiB;
constexpr size_t WS_WOUT = 24 * MiB;
constexpr size_t WS_WCAQ = 32 * MiB;
constexpr size_t WS_WCAKV = 36 * MiB;
constexpr size_t WS_WCAO = 44 * MiB;
constexpr size_t WS_KVCA = 48 * MiB;
constexpr size_t WS_WGU = 64 * MiB;
constexpr size_t WS_WDN = 576 * MiB;
constexpr size_t WS_X = 832 * MiB;
constexpr size_t WS_HN = 960 * MiB;
constexpr size_t WS_PROJ = 1024 * MiB;
constexpr size_t WS_MQK = 1152 * MiB;
constexpr size_t WS_YCAT = 1184 * MiB;
constexpr size_t WS_QCA = 1248 * MiB;
constexpr size_t WS_GATES = 1280 * MiB;
constexpr size_t WS_AFF = 1282 * MiB;
constexpr size_t WS_TOKI = 1284 * MiB;
constexpr size_t WS_SLOTMAP = 1285 * MiB;
constexpr size_t WS_MSC = 1287 * MiB;
constexpr size_t WS_CST = 1288 * MiB;
constexpr size_t WS_ACT = 1322 * MiB;
constexpr size_t WS_YS = 1578 * MiB;
constexpr size_t WS_KT = 1706 * MiB;
constexpr size_t WS_VT = 1722 * MiB;
constexpr size_t WS_CSB = 1738 * MiB;
constexpr size_t WS_PART = 1756 * MiB;
constexpr size_t WS_GV = 1758 * MiB;
constexpr size_t WS_END = 1762 * MiB;
constexpr int CST_SZ = 65 * 64;
constexpr int CW_BAR = 4096;
constexpr int CW_LOC = 8192;

constexpr int RING_OFF = 0, RING_BYTES = 131072;
constexpr int LDSCTL_OFF = RING_BYTES, MISC_OFF = LDSCTL_OFF + 320;
constexpr int XTRA_OFF = MISC_OFF + 128;
constexpr int LDS_BYTES = 156672;

template <int CTRL> __device__ __forceinline__ float dpp_mov(float x) { return __builtin_bit_cast(float, __builtin_amdgcn_update_dpp(0, __builtin_bit_cast(int, x), CTRL, 0xF, 0xF, true)); }
__device__ __forceinline__ float quad_sum(float v) { v += dpp_mov<0xB1>(v); v += dpp_mov<0x4E>(v); return v; }
__device__ __forceinline__ float oct_sum(float v) { v = quad_sum(v); v += dpp_mov<0x141>(v); return v; }
__device__ __forceinline__ float row_sum(float v) { v = oct_sum(v); v += dpp_mov<0x140>(v); return v; }
__device__ __forceinline__ float row_max(float v) { v = fmaxf(v, dpp_mov<0xB1>(v)); v = fmaxf(v, dpp_mov<0x4E>(v)); v = fmaxf(v, dpp_mov<0x141>(v)); v = fmaxf(v, dpp_mov<0x140>(v)); return v; }
__device__ __forceinline__ float wave_sum(float v) { v = row_sum(v);
    const float a = __builtin_bit_cast(float, __builtin_amdgcn_readlane(__builtin_bit_cast(int, v), 0)), b = __builtin_bit_cast(float, __builtin_amdgcn_readlane(__builtin_bit_cast(int, v), 16));
    const float c = __builtin_bit_cast(float, __builtin_amdgcn_readlane(__builtin_bit_cast(int, v), 32)), d = __builtin_bit_cast(float, __builtin_amdgcn_readlane(__builtin_bit_cast(int, v), 48));
    return (a + b) + (c + d); }
__device__ __forceinline__ float lane_bcast(float v, int l) { return __builtin_bit_cast(float, __builtin_amdgcn_readlane(__builtin_bit_cast(int, v), l)); }
__device__ __forceinline__ float wave_max(float v) { v = row_max(v); return fmaxf(fmaxf(lane_bcast(v, 0), lane_bcast(v, 16)), fmaxf(lane_bcast(v, 32), lane_bcast(v, 48))); }
__device__ __forceinline__ float bf_lo(unsigned w) { return __uint_as_float(w << 16); }
__device__ __forceinline__ float bf_hi(unsigned w) { return __uint_as_float(w & 0xffff0000u); }
__device__ __forceinline__ float bf2f(bf16 h) { return __uint_as_float(((unsigned)h) << 16); }
__device__ __forceinline__ float wscan_add(float v, int lane) {
#pragma unroll
    for (int o = 1; o < 64; o <<= 1) { const float t = __shfl_up(v, o); if (lane >= o) v += t; }
    return v;
}
__device__ __forceinline__ float wscan_add_rev(float v, int lane) {
#pragma unroll
    for (int o = 1; o < 64; o <<= 1) { const float t = __shfl_down(v, o); if (lane + o < 64) v += t; }
    return v;
}
__device__ __forceinline__ float wscan_max(float v, int lane) {
#pragma unroll
    for (int o = 1; o < 64; o <<= 1) { const float t = __shfl_up(v, o); if (lane >= o) v = fmaxf(v, t); }
    return v;
}
__device__ __forceinline__ float wscan_max_rev(float v, int lane) {
#pragma unroll
    for (int o = 1; o < 64; o <<= 1) { const float t = __shfl_down(v, o); if (lane + o < 64) v = fmaxf(v, t); }
    return v;
}
__device__ __forceinline__ float fexp(float x) { return __builtin_amdgcn_exp2f(x * 1.4426950408889634f); }
__device__ __forceinline__ float flog(float x) { return __builtin_amdgcn_logf(x) * 0.6931471805599453f; }
__device__ __forceinline__ float fsigmoid(float x) { return __builtin_amdgcn_rcpf(1.0f + fexp(-x)); }
typedef float f32x2v __attribute__((ext_vector_type(2)));
#define MFMA16(a, b, c) __builtin_amdgcn_mfma_f32_16x16x32_bf16((a), (b), (c), 0, 0, 0)

struct Ctx { int tid, lane, wave, G, vcu, gw, NGW; unsigned char* lds; unsigned char* ws; LAS unsigned char* ldsl; int ng, GB, grp, lb; };
__device__ __forceinline__ Ctx phase_ctx(const Ctx& C0) { Ctx C = C0; C.tid = opaque_tid(); C.lane = C.tid & 63; return C; }

__device__ __forceinline__ void transpose_item(const float* W, int ldw, bf16* WT, int K, int n0dst, int srccol0, int k0, LAS float* scr, int lane, const float* kscale = nullptr) {
    f32x4 v[8]; const int lr = lane >> 3, lc = (lane & 7) * 4;
#pragma unroll
    for (int i = 0; i < 8; ++i) v[i] = __builtin_nontemporal_load((const f32x4*)(W + (size_t)(k0 + 8 * i + lr) * ldw + srccol0 + lc));
    if (kscale) { float kq[8];
#pragma unroll
        for (int i = 0; i < 8; ++i) kq[i] = kscale[k0 + 8 * i + lr];
#pragma unroll
        for (int i = 0; i < 8; ++i) v[i] = v[i] * kq[i]; }
#pragma unroll
    for (int i = 0; i < 8; ++i) { LAS float* d = scr + (8 * i + lr) * 33 + lc; d[0] = v[i].x; d[1] = v[i].y; d[2] = v[i].z; d[3] = v[i].w; }
    LDS_WAIT(); asm volatile("" ::: "memory");
    const int c = lane & 7;
#pragma unroll
    for (int j = 0; j < 4; ++j) { const int n = (lane >> 3) + 8 * j; const LAS float* s = scr + (8 * c) * 33 + n;
        v4u o; o.x = pk2(s[0 * 33], s[1 * 33]); o.y = pk2(s[2 * 33], s[3 * 33]); o.z = pk2(s[4 * 33], s[5 * 33]); o.w = pk2(s[6 * 33], s[7 * 33]);
        *(v4u*)(WT + (size_t)(n0dst + n) * K + k0 + 8 * c) = o; }
    LDS_WAIT(); asm volatile("" ::: "memory");
}
#ifndef CV_NT
#define CV_NT 1
#endif
constexpr int EXP_ITEMS = 16 * 2048 + 16 * 1024;
struct ItemSrc { const float* W; int ldw; bf16* WT; int K, n0dst, srccol0, k0; const float* ks; };
__device__ __forceinline__ ItemSrc expert_item(unsigned char* ws, const float* const* in, int layer, int j) {
    ItemSrc I;
    if (j < 32768) { const int le = layer * 16 + (j >> 11), r = j & 2047, kb = r >> 7, nb = r & 127, n0 = nb * 32, pn = n0 >> 8, jj = n0 & 255;
        I.W = in[I_WGU] + (size_t)le * 1024 * 4096; I.ldw = 4096; I.WT = (bf16*)(ws + WS_WGU) + (size_t)le * 4096 * 1024; I.K = 1024; I.n0dst = n0; I.srccol0 = jj < 128 ? pn * 128 + jj : 2048 + pn * 128 + (jj - 128); I.k0 = kb * 64; I.ks = in[I_NFFNG] + layer * 1024; }
    else { const int q = j - 32768, le = layer * 16 + (q >> 10), r = q & 1023, kb = r >> 5, nb = r & 31;
        I.W = in[I_WDN] + (size_t)le * 2048 * 1024; I.ldw = 1024; I.WT = (bf16*)(ws + WS_WDN) + (size_t)le * 1024 * 2048; I.K = 2048; I.n0dst = nb * 32; I.srccol0 = nb * 32; I.k0 = kb * 64; I.ks = nullptr; }
    return I;
}
__device__ __forceinline__ void item_load(const ItemSrc& I, f32x4 (&v)[8], int lane) {
    const int lr = lane >> 3, lc = (lane & 7) * 4;
#pragma unroll
    for (int i = 0; i < 8; ++i) { const f32x4* p_ = (const f32x4*)(I.W + (size_t)(I.k0 + 8 * i + lr) * I.ldw + I.srccol0 + lc); v[i] = CV_NT ? __builtin_nontemporal_load(p_) : *p_; }
}
__device__ __forceinline__ void item_scale(const ItemSrc& I, f32x4 (&v)[8], int lane) {
    if (I.ks) { const int lr = lane >> 3; float kq[8];
#pragma unroll
        for (int i = 0; i < 8; ++i) kq[i] = I.ks[I.k0 + 8 * i + lr];
#pragma unroll
        for (int i = 0; i < 8; ++i) v[i] = v[i] * kq[i]; }
}
__device__ __forceinline__ void item_store(const ItemSrc& I, const f32x4 (&v)[8], LAS float* scr, int lane) {
    const int lr = lane >> 3, lc = (lane & 7) * 4;
#pragma unroll
    for (int i = 0; i < 8; ++i) { LAS float* d = scr + (8 * i + lr) * 33 + lc; d[0] = v[i].x; d[1] = v[i].y; d[2] = v[i].z; d[3] = v[i].w; }
    LDS_WAIT(); asm volatile("" ::: "memory");
    const int c = lane & 7;
#pragma unroll
    for (int j = 0; j < 4; ++j) { const int n = (lane >> 3) + 8 * j; const LAS float* s = scr + (8 * c) * 33 + n;
        v4u o; o.x = pk2(s[0 * 33], s[1 * 33]); o.y = pk2(s[2 * 33], s[3 * 33]); o.z = pk2(s[4 * 33], s[5 * 33]); o.w = pk2(s[6 * 33], s[7 * 33]);
        asm volatile("global_store_dwordx4 %0, %1, off sc1\n\ts_nop 2" :: "v"(I.WT + (size_t)(I.n0dst + n) * I.K + I.k0 + 8 * c), "v"(o) : "memory"); }
    LDS_WAIT(); asm volatile("" ::: "memory");
}
struct ConvWork {
    unsigned char* ws; const float* const* in; LAS unsigned char* ldsl; int layer, finish, vcu, G;
    __device__ __forceinline__ void reset(volatile LAS unsigned* ctl) const { if (layer < DEPTH && ctl[2] != (unsigned)(layer + 1)) { ctl[2] = (unsigned)(layer + 1); ctl[1] = 0u; } }
    __device__ __forceinline__ void operator()(volatile LAS unsigned* ctl) const {
        if (layer >= DEPTH) return;
        const int tid = opaque_tid(), lane = tid & 63, wave = __builtin_amdgcn_readfirstlane(tid >> 6);
        LAS float* scr = (LAS float*)(ldsl + RING_OFF + wave * 16384);
        for (;;) {
            if (!finish && ctl[0] != 0u) break;
            unsigned k = 0u; if (lane == 0) k = __hip_atomic_fetch_add((LAS unsigned*)(ctl + 1), 1u, __ATOMIC_RELAXED, __HIP_MEMORY_SCOPE_WORKGROUP);
            k = (unsigned)__builtin_amdgcn_readfirstlane((int)k);
            const long j = (long)k * G + vcu; if (j >= EXP_ITEMS) break;
            const ItemSrc J = expert_item(ws, in, layer, (int)j); f32x4 w[8]; item_load(J, w, lane); item_scale(J, w, lane); item_store(J, w, scr, lane);
        }
    }
};
__device__ __forceinline__ void phase_convert(unsigned char* ws, const float* const* in, LAS unsigned char* ldsl, int layer, int nper, int vcu, int G, volatile LAS unsigned* ctl) {
    if (layer >= DEPTH || ctl[2] != (unsigned)(layer + 1)) return;
    const int tid = opaque_tid(), lane = tid & 63, wave = __builtin_amdgcn_readfirstlane(tid >> 6);
    LAS float* scr = (LAS float*)(ldsl + RING_OFF + wave * 16384);
    for (int n = 0; n < nper; ++n) {
        unsigned k = 0u; if (lane == 0) k = __hip_atomic_fetch_add((LAS unsigned*)(ctl + 1), 1u, __ATOMIC_RELAXED, __HIP_MEMORY_SCOPE_WORKGROUP);
        k = (unsigned)__builtin_amdgcn_readfirstlane((int)k);
        const long j = (long)k * G + vcu; if (j >= EXP_ITEMS) break;
        const ItemSrc J = expert_item(ws, in, layer, (int)j); f32x4 w[8]; item_load(J, w, lane); item_scale(J, w, lane); item_store(J, w, scr, lane);
    }
}
#ifndef CV_NIT
#define CV_NIT 4
#endif
#ifndef CV_MAP
#define CV_MAP 1
#endif
__device__ __forceinline__ void convert_share(unsigned char* ws, const float* const* in, LAS unsigned char* ldsl, int layer, int vcu, int G, int part = 0, int nparts = 1) {
    const int tid = opaque_tid(), lane = tid & 63, wave = __builtin_amdgcn_readfirstlane(tid >> 6);
    LAS float* scr = (LAS float*)(ldsl + RING_OFF + wave * 16384);
    const int nk = (EXP_ITEMS - vcu + G - 1) / G;
    const int kspan = ((nk + nparts - 1) / nparts + 8 * CV_NIT - 1) / (8 * CV_NIT) * (8 * CV_NIT), kbeg = part * kspan, kend = min(nk, kbeg + kspan);
#pragma unroll 1
    for (int k0 = kbeg + wave; k0 < kend; k0 += 8 * CV_NIT) {
        ItemSrc I[CV_NIT]; f32x4 v[CV_NIT][8]; bool on[CV_NIT];
#pragma unroll
        for (int t = 0; t < CV_NIT; ++t) { const int k = k0 + 8 * t; on[t] = k < kend; if (on[t]) { I[t] = expert_item(ws, in, layer, (CV_MAP && G == 256) ? (((vcu & 3) * 192 + k) * 64 + (vcu >> 2)) : (k * G + vcu)); item_load(I[t], v[t], lane); } }
#pragma unroll
        for (int t = 0; t < CV_NIT; ++t) if (on[t]) { item_scale(I[t], v[t], lane); item_store(I[t], v[t], scr, lane); }
    }
}
#if defined(CV_MODE)
__device__ __forceinline__ void convert_share_probe(unsigned char* ws, const float* const* in, LAS unsigned char* ldsl, int layer, int vcu, int G) {
    const int tid = opaque_tid(), lane = tid & 63, wave = __builtin_amdgcn_readfirstlane(tid >> 6);
    LAS float* scr = (LAS float*)(ldsl + RING_OFF + wave * 16384);
    const int nk = (EXP_ITEMS - vcu + G - 1) / G; float sink = 0.f;
#pragma unroll 1
    for (int k0 = wave; k0 < nk; k0 += 24) {
        ItemSrc I[3]; f32x4 v[3][8]; bool on[3];
#pragma unroll
        for (int t = 0; t < 3; ++t) { const int k = k0 + 8 * t; on[t] = k < nk; if (on[t]) { I[t] = expert_item(ws, in, layer, k * G + vcu);
#if defined(CV_PAT) && CV_PAT == 1
            { const int lr4 = lane >> 4, lc16 = (lane & 15) * 4; const int c0 = I[t].srccol0 & ~63;
              _Pragma("unroll") for (int i = 0; i < 8; ++i) v[t][i] = __builtin_nontemporal_load((const f32x4*)(I[t].W + (size_t)(I[t].k0 + 4 * i + lr4) * I[t].ldw + c0 + lc16)); }
#elif defined(CV_PAT) && CV_PAT == 2
            { const int lr2 = lane >> 5, lc32 = (lane & 31) * 4; const int c0 = I[t].srccol0 & ~127;
              _Pragma("unroll") for (int i = 0; i < 8; ++i) v[t][i] = __builtin_nontemporal_load((const f32x4*)(I[t].W + (size_t)(I[t].k0 + 2 * i + lr2) * I[t].ldw + c0 + lc32)); }
#else
            item_load(I[t], v[t], lane);
#endif
            } }
#pragma unroll
        for (int t = 0; t < 3; ++t) if (on[t]) {
#if CV_MODE == 1
#pragma unroll
            for (int i = 0; i < 8; ++i) sink += v[t][i].x + v[t][i].y + v[t][i].z + v[t][i].w;
#elif CV_MODE == 2
            { const int lr = lane >> 3, lc = (lane & 7) * 4;
#pragma unroll
              for (int i = 0; i < 8; ++i) { LAS float* d = scr + (8 * i + lr) * 33 + lc; d[0] = v[t][i].x; d[1] = v[t][i].y; d[2] = v[t][i].z; d[3] = v[t][i].w; }
              LDS_WAIT(); asm volatile("" ::: "memory");
              const int c = lane & 7;
#pragma unroll
              for (int j = 0; j < 4; ++j) { const int n = (lane >> 3) + 8 * j; const LAS float* sp = scr + (8 * c) * 33 + n;
                  sink += __uint_as_float(pk2(sp[0 * 33], sp[1 * 33]) ^ pk2(sp[2 * 33], sp[3 * 33]) ^ pk2(sp[4 * 33], sp[5 * 33]) ^ pk2(sp[6 * 33], sp[7 * 33])); }
              LDS_WAIT(); asm volatile("" ::: "memory"); }
#else
            { ItemSrc J = I[t]; J.WT = (bf16*)(ws + WS_ACT) + (J.WT - (bf16*)(ws + (J.K == 1024 ? WS_WGU : WS_WDN))) % (size_t)(120u << 20); item_store(J, v[t], scr, lane); }
#endif
        }
    }
    if (sink == 123.456f) ((float*)(ws + WS_ACT))[tid] = sink;
}
#endif
__device__ __forceinline__ int conv_target(int p) { if (p <= 8) return 0; if (p < 10) return DEPTH; const int q = p - 10; return (q % 12 >= 11) ? DEPTH : q / 12 + 1; }
__device__ __forceinline__ void prologue_convert(const Ctx& C0, const float* const* in, bool defer_experts) {
    const Ctx C = phase_ctx(C0);
    LAS float* scr = (LAS float*)(C.ldsl + RING_OFF + C.wave * 16384);
    unsigned char* ws = C.ws;
    constexpr int N0 = 4 * 1024, N1 = N0 + 4 * 512, N2 = N1 + 4 * 256, N3 = N2 + 4 * 512, N4 = N3 + 4 * 256, N5 = N4 + 64 * 2048, N6 = N5 + 64 * 1024;
    const int nlim = defer_experts ? N4 : N6;
    if (defer_experts) {
        auto small_item = [&](int it) { ItemSrc I; I.ks = nullptr;
            if (it < N0) { const int l = it >> 10, r = it & 1023, kb = r >> 6, nb = r & 63, n0 = nb * 32;
                I.W = in[I_WIN] + (size_t)l * 1024 * 2064; I.ldw = 2064; I.WT = (bf16*)(ws + WS_WIN) + (size_t)l * 2048 * 1024; I.K = 1024; I.n0dst = n0; I.srccol0 = n0 < 1280 ? n0 : n0 + 16; I.k0 = kb * 64; I.ks = in[I_NMIXG] + l * 1024; }
            else if (it < N1) { const int q = it - N0, l = q >> 9, r = q & 511, kb = r >> 5, nb = r & 31;
                I.W = in[I_WOUT] + (size_t)l * 1024 * 1024; I.ldw = 1024; I.WT = (bf16*)(ws + WS_WOUT) + (size_t)l * 1024 * 1024; I.K = 1024; I.n0dst = nb * 32; I.srccol0 = nb * 32; I.k0 = kb * 64; }
            else if (it < N2) { const int q = it - N1, l = q >> 8, r = q & 255, kb = r >> 4, nb = r & 15;
                I.W = in[I_CAWQ] + (size_t)l * 1024 * 512; I.ldw = 512; I.WT = (bf16*)(ws + WS_WCAQ) + (size_t)l * 512 * 1024; I.K = 1024; I.n0dst = nb * 32; I.srccol0 = nb * 32; I.k0 = kb * 64; I.ks = in[I_NMEMG] + l * 1024; }
            else if (it < N3) { const int q = it - N2, l = q >> 9, r = q & 511, kb = r >> 5, nb = r & 31;
                I.W = in[I_CAWKV] + (size_t)l * 1024 * 1024; I.ldw = 1024; I.WT = (bf16*)(ws + WS_WCAKV) + (size_t)l * 1024 * 1024; I.K = 1024; I.n0dst = nb * 32; I.srccol0 = nb * 32; I.k0 = kb * 64; }
            else { const int q = it - N3, l = q >> 8, r = q & 255, kb = r >> 5, nb = r & 31;
                I.W = in[I_CAWO] + (size_t)l * 512 * 1024; I.ldw = 1024; I.WT = (bf16*)(ws + WS_WCAO) + (size_t)l * 1024 * 512; I.K = 512; I.n0dst = nb * 32; I.srccol0 = nb * 32; I.k0 = kb * 64; }
            return I; };
#pragma unroll 1
        for (int it0 = C.gw; it0 < N4; it0 += CV_NIT * C.NGW) {
            ItemSrc I[CV_NIT]; f32x4 v[CV_NIT][8]; bool on[CV_NIT];
#pragma unroll
            for (int t = 0; t < CV_NIT; ++t) { const int it = it0 + t * C.NGW; on[t] = it < N4; if (on[t]) { I[t] = small_item(it); item_load(I[t], v[t], C.lane); } }
#pragma unroll
            for (int t = 0; t < CV_NIT; ++t) if (on[t]) { item_scale(I[t], v[t], C.lane); item_store(I[t], v[t], scr, C.lane); }
        }
    } else
    for (int it = C.gw; it < nlim; it += C.NGW) {
        if (it < N0) { const int l = it >> 10, r = it & 1023, kb = r >> 6, nb = r & 63, n0 = nb * 32;
            transpose_item(in[I_WIN] + (size_t)l * 1024 * 2064, 2064, (bf16*)(ws + WS_WIN) + (size_t)l * 2048 * 1024, 1024, n0, n0 < 1280 ? n0 : n0 + 16, kb * 64, scr, C.lane, in[I_NMIXG] + l * 1024); }
        else if (it < N1) { const int q = it - N0, l = q >> 9, r = q & 511, kb = r >> 5, nb = r & 31;
            transpose_item(in[I_WOUT] + (size_t)l * 1024 * 1024, 1024, (bf16*)(ws + WS_WOUT) + (size_t)l * 1024 * 1024, 1024, nb * 32, nb * 32, kb * 64, scr, C.lane); }
        else if (it < N2) { const int q = it - N1, l = q >> 8, r = q & 255, kb = r >> 4, nb = r & 15;
            transpose_item(in[I_CAWQ] + (size_t)l * 1024 * 512, 512, (bf16*)(ws + WS_WCAQ) + (size_t)l * 512 * 1024, 1024, nb * 32, nb * 32, kb * 64, scr, C.lane, in[I_NMEMG] + l * 1024); }
        else if (it < N3) { const int q = it - N2, l = q >> 9, r = q & 511, kb = r >> 5, nb = r & 31;
            transpose_item(in[I_CAWKV] + (size_t)l * 1024 * 1024, 1024, (bf16*)(ws + WS_WCAKV) + (size_t)l * 1024 * 1024, 1024, nb * 32, nb * 32, kb * 64, scr, C.lane); }
        else if (it < N4) { const int q = it - N3, l = q >> 8, r = q & 255, kb = r >> 5, nb = r & 31;
            transpose_item(in[I_CAWO] + (size_t)l * 512 * 1024, 1024, (bf16*)(ws + WS_WCAO) + (size_t)l * 1024 * 512, 512, nb * 32, nb * 32, kb * 64, scr, C.lane); }
        else if (it < N5) { const int q = it - N4, le = q >> 11, r = q & 2047, kb = r >> 7, nb = r & 127, n0 = nb * 32, pn = n0 >> 8, j = n0 & 255;
            transpose_item(in[I_WGU] + (size_t)le * 1024 * 4096, 4096, (bf16*)(ws + WS_WGU) + (size_t)le * 4096 * 1024, 1024, n0, j < 128 ? pn * 128 + j : 2048 + pn * 128 + (j - 128), kb * 64, scr, C.lane, in[I_NFFNG] + (le >> 4) * 1024); }
        else { const int q = it - N5, le = q >> 10, r = q & 1023, kb = r >> 5, nb = r & 31;
            transpose_item(in[I_WDN] + (size_t)le * 2048 * 1024, 1024, (bf16*)(ws + WS_WDN) + (size_t)le * 1024 * 2048, 2048, nb * 32, nb * 32, kb * 64, scr, C.lane); }
    }
    const int gt = C.gw * 64 + C.lane, NGT = C.NGW * 64;
    for (int i = gt; i < 2048 * 1024 / 8; i += NGT) { const f32x4* s = (const f32x4*)(in[I_MEM]) + 2 * (size_t)i; const f32x4 a = s[0], b = s[1];
        v4u o; o.x = pk2(a.x, a.y); o.y = pk2(a.z, a.w); o.z = pk2(b.x, b.y); o.w = pk2(b.z, b.w); ((v4u*)(ws + WS_MEMB))[i] = o; }
    for (int i = gt; i < 4096 * 32; i += NGT) { const int t = i >> 5, f = i & 31; const int pos = (f < 16) ? (t >> 6) : (t & 63);
        double invd = 1.0; for (int k = 0; k < (f & 15); ++k) invd *= 0.5623413251903491;
        const float inv = (float)invd; const float ang = (float)pos * inv; const double ad = (double)ang;
        const double nq = rint(ad * 0.6366197723675814); const double r = ad - nq * 1.5707963267948966, r2 = r * r;
        const double sr = r * (1.0 + r2 * (-1.0 / 6 + r2 * (1.0 / 120 + r2 * (-1.0 / 5040 + r2 * (1.0 / 362880 + r2 * (-1.0 / 39916800 + r2 * (1.0 / 6227020800.0)))))));
        const double cr = 1.0 + r2 * (-0.5 + r2 * (1.0 / 24 + r2 * (-1.0 / 720 + r2 * (1.0 / 40320 + r2 * (-1.0 / 3628800 + r2 * (1.0 / 479001600.0))))));
        const int qd = ((int)nq) & 3; const double sn = (qd == 0) ? sr : (qd == 1) ? cr : (qd == 2) ? -sr : -cr; const double cs = (qd == 0) ? cr : (qd == 1) ? -sr : (qd == 2) ? -cr : sr;
        ((float*)(ws + WS_ROPE))[i] = (float)cs; ((float*)(ws + WS_ROPE))[4096 * 32 + i] = (float)sn; }
    for (int i = gt; i < 4 * 4 * 64 * 64; i += NGT) { const int c = i & 63, e = (i >> 6) & 63, g = (i >> 12) & 3, l = i >> 14;
        const float v = in[I_POOLW][((size_t)(l * 4 + g) * 64 + c) * 64 + e] * in[I_POOLS][l * 256 + g * 64 + e]; ((bf16*)(ws + WS_POOLW))[i] = (bf16)f2bf(v); }
}

constexpr int RT_PITCH = 1032;
__device__ __forceinline__ void proj16_stage(const Ctx& C, const float* gain, const float* w16, int w16s) {
    LAS bf16* Wh = (LAS bf16*)(C.ldsl + RING_OFF); LAS bf16* Wl = Wh + 16 * RT_PITCH;
    { f32x4 wv[8]; float gq[8];
#pragma unroll
      for (int j = 0; j < 8; ++j) { const int idx = C.tid + 512 * j, k = idx >> 2, e4 = (idx & 3) * 4; wv[j] = *(const f32x4*)(w16 + (size_t)k * w16s + e4); gq[j] = gain[k]; }
#pragma unroll
      for (int j = 0; j < 8; ++j) { const int idx = C.tid + 512 * j, k = idx >> 2, e4 = (idx & 3) * 4;
#pragma unroll
        for (int i = 0; i < 4; ++i) { const float v = wv[j][i] * gq[j]; const unsigned short h = f2bf(v); const unsigned short lo = f2bf(v - bf2f((bf16)h));
            Wh[(e4 + i) * RT_PITCH + k] = (bf16)h; Wl[(e4 + i) * RT_PITCH + k] = (bf16)lo; } } }
    __syncthreads();
}
template <int MODE>
__device__ __forceinline__ void proj16_tile(const Ctx& C, const bf16x8 (&xa)[32], int t, const float* bias16, float* out16, float* rs) {
    const int lane = C.lane, rr = lane & 15, q = lane >> 4;
    LAS bf16* Wh = (LAS bf16*)(C.ldsl + RING_OFF); LAS bf16* Wl = Wh + 16 * RT_PITCH;
    f32x4 acc = (f32x4){0.f, 0.f, 0.f, 0.f}; float ss = 0.f;
#pragma unroll
    for (int s = 0; s < 32; ++s) {
        const bf16x8 bh = *(const LAS bf16x8*)(Wh + rr * RT_PITCH + s * 32 + q * 8), bl = *(const LAS bf16x8*)(Wl + rr * RT_PITCH + s * 32 + q * 8);
        acc = MFMA16(xa[s], bh, acc); acc = MFMA16(xa[s], bl, acc);
        const v4u xw = __builtin_bit_cast(v4u, xa[s]);
        ss += (bf_lo(xw.x) * bf_lo(xw.x) + bf_hi(xw.x) * bf_hi(xw.x)) + (bf_lo(xw.y) * bf_lo(xw.y) + bf_hi(xw.y) * bf_hi(xw.y));
        ss += (bf_lo(xw.z) * bf_lo(xw.z) + bf_hi(xw.z) * bf_hi(xw.z)) + (bf_lo(xw.w) * bf_lo(xw.w) + bf_hi(xw.w) * bf_hi(xw.w));
        if ((s & 3) == 3) asm volatile("" ::: "memory"); }
    ss = pg8::sum_rows4(ss);
    const float rstd = __builtin_amdgcn_rsqf(ss * (1.0f / 1024.0f) + EPS);
    if (MODE == 2 && q == 0) rs[(size_t)t * 16 + rr] = rstd;
    if (MODE == 2) { f32x4 pr;
#pragma unroll
        for (int i = 0; i < 4; ++i) { const float r = __shfl(rstd, 4 * q + i); const float val = acc[i] * r; float mx = val;
#pragma unroll
            for (int o = 1; o < 2; o <<= 1) mx = row_max(mx);
            const float ex = fexp(val - mx); float sm = row_sum(ex);
            pr[i] = ex * __builtin_amdgcn_rcpf(sm); }
        const int row = t * 16 + 4 * q;
        *(f32x4*)(out16 + ((size_t)((row >> 12) * 16 + rr)) * 4096 + (row & 4095)) = pr; }
    else { const float bs = bias16[rr];
#pragma unroll
        for (int i = 0; i < 4; ++i) { const float r = __shfl(rstd, 4 * q + i); float val = acc[i] * r + bs;
            if (rr >= 8) val = fminf(val, 0.f) - flog(1.0f + fexp(-fabsf(val)));
            out16[(size_t)(t * 16 + 4 * q + i) * 16 + rr] = val; } }
}
__device__ __forceinline__ void router_phase(const Ctx& C0, const bf16* xb, const float* gain, const float* w16, float* aff, float* rs) {
    const Ctx C = phase_ctx(C0);
    const int rr = C.lane & 15, q = C.lane >> 4;
    const int tpg = (NTOK / 16) / C.ng, t0 = C.grp * tpg + C.lb * 8 + C.wave, ts = C.GB * 8, te = (C.grp + 1) * tpg;
    bf16x8 xa[32];
    if (t0 < te) {
#pragma unroll
        for (int s = 0; s < 32; ++s) xa[s] = *(const bf16x8*)(xb + (size_t)(t0 * 16 + rr) * 1024 + s * 32 + q * 8);
    }
    proj16_stage(C, gain, w16, 16);
    for (int t = t0; t < te; t += ts) {
        if (t != t0) {
#pragma unroll
            for (int s = 0; s < 32; ++s) xa[s] = *(const bf16x8*)(xb + (size_t)(t * 16 + rr) * 1024 + s * 32 + q * 8); }
        proj16_tile<2>(C, xa, t, nullptr, aff, rs);
    }
    __syncthreads();
}

template <int MODE, bool COMBINE, bool SRC32 = false>
__device__ __forceinline__ void row_phase(const Ctx& C0, const void* xsrc_, bf16* xdst, const float* gain, float* rsout, const float* w16, int w16s, const float* bias16, float* out16, float* outf,
                                          const int* slotmap, const bf16* ys) {
    const Ctx C = phase_ctx(C0);
    if (MODE == 1) proj16_stage(C, gain, w16, w16s);
    const int lane = C.lane;
    f32x4 gv[4];
#pragma unroll
    for (int j = 0; j < 4; ++j) gv[j] = *(const f32x4*)(gain + 4 * lane + 256 * j);
    const float* xsrc = (const float*)xsrc_; const bf16* xsrb = (const bf16*)xsrc_;
    f32x4 vn[2][4]; uint2 vnb[2][4]; int smc[2] = {-1, -1}, smn[2] = {-1, -1}; unsigned mrem[2] = {0u, 0u}; uint2 yb[2][4][4];
    const int tpg = (NTOK / 16) / C.ng, t0 = C.grp * tpg + C.lb * 8 + C.wave, ts = C.GB * 8, te = (C.grp + 1) * tpg;
#define RP_LOADX(prq) do { _Pragma("unroll") for (int r = 0; r < 2; ++r) { _Pragma("unroll") for (int j = 0; j < 4; ++j) { \
        if (SRC32) vn[r][j] = *(const f32x4*)(xsrc + (size_t)(2 * (prq) + r) * 1024 + 4 * lane + 256 * j); else vnb[r][j] = *(const uint2*)(xsrb + (size_t)(2 * (prq) + r) * 1024 + 4 * lane + 256 * j); } } } while (0)
#define RP_LOADSM(SMQ, prq) do { _Pragma("unroll") for (int r = 0; r < 2; ++r) SMQ[r] = slotmap[(size_t)(2 * (prq) + r) * 16 + (lane & 15)]; } while (0)
#define RP_LOADY(SMQ, prq) do { _Pragma("unroll") for (int r = 0; r < 2; ++r) { unsigned mk = (unsigned)(__ballot(SMQ[r] >= 0) & 0xFFFFull); const int b = (2 * (prq) + r) >> 12; \
        _Pragma("unroll") for (int k = 0; k < 4; ++k) { \
            if (mk) { const int e = __builtin_ctz(mk); mk &= mk - 1u; const int sl = __builtin_amdgcn_readlane(SMQ[r], e); \
                const bf16* yr = ys + ((size_t)(e * ROWS_E + b * CAP + sl)) * 1024 + 4 * lane; \
                _Pragma("unroll") for (int j = 0; j < 4; ++j) yb[r][k][j] = *(const uint2*)(yr + 256 * j); } \
            else { _Pragma("unroll") for (int j = 0; j < 4; ++j) yb[r][k][j] = make_uint2(0u, 0u); } } \
        mrem[r] = mk; } } while (0)
    for (int t = t0; t < te; t += ts) {
      const int prb = 8 * t, pre = prb + 8;
      RP_LOADX(prb);
      if (COMBINE) { RP_LOADSM(smc, prb); RP_LOADSM(smn, prb + 1); RP_LOADY(smc, prb); }
#pragma unroll 1
      for (int pr = prb; pr < pre; ++pr) {
        const int row0 = 2 * pr;
        f32x4 v[2][4]; int smnn[2] = {-1, -1};
#pragma unroll
        for (int r = 0; r < 2; ++r) {
#pragma unroll
            for (int j = 0; j < 4; ++j) { if (SRC32) v[r][j] = vn[r][j]; else { const uint2 w = vnb[r][j]; v[r][j] = (f32x4){bf_lo(w.x), bf_hi(w.x), bf_lo(w.y), bf_hi(w.y)}; } } }
        { const int prn = pr + 1; if (prn < pre) RP_LOADX(prn);
          if (COMBINE) { const int prnn = pr + 2; if (prnn < pre) RP_LOADSM(smnn, prnn); } }
        if (COMBINE) {
#pragma unroll
            for (int r = 0; r < 2; ++r) { const int row = row0 + r, b = row >> 12;
#pragma unroll
                for (int k = 0; k < 4; ++k)
#pragma unroll
                    for (int j = 0; j < 4; ++j) { const uint2 w = yb[r][k][j]; v[r][j] += (f32x4){bf_lo(w.x), bf_hi(w.x), bf_lo(w.y), bf_hi(w.y)}; }
                unsigned mk = mrem[r];
                while (mk) { const int e = __builtin_ctz(mk); mk &= mk - 1u; const int sl = __builtin_amdgcn_readlane(smc[r], e);
                    const bf16* yr = ys + ((size_t)(e * ROWS_E + b * CAP + sl)) * 1024 + 4 * lane;
#pragma unroll
                    for (int j = 0; j < 4; ++j) { const uint2 w = *(const uint2*)(yr + 256 * j); v[r][j] += (f32x4){bf_lo(w.x), bf_hi(w.x), bf_lo(w.y), bf_hi(w.y)}; } } }
            { const int prn = pr + 1; if (prn < pre) RP_LOADY(smn, prn); }
#pragma unroll
            for (int r = 0; r < 2; ++r) { smc[r] = smn[r]; smn[r] = smnn[r]; }
        }
        if ((COMBINE && MODE != 3) || SRC32) {
#pragma unroll
            for (int r = 0; r < 2; ++r)
#pragma unroll
                for (int j = 0; j < 4; ++j) { uint2 o; o.x = pk2(v[r][j].x, v[r][j].y); o.y = pk2(v[r][j].z, v[r][j].w); *(uint2*)(xdst + (size_t)(row0 + r) * 1024 + 4 * lane + 256 * j) = o; }
        }
        float rstd[2];
#pragma unroll
        for (int r = 0; r < 2; ++r) { float ss = 0.f;
#pragma unroll
            for (int j = 0; j < 4; ++j) ss += (v[r][j].x * v[r][j].x + v[r][j].y * v[r][j].y) + (v[r][j].z * v[r][j].z + v[r][j].w * v[r][j].w);
            rstd[r] = __builtin_amdgcn_rsqf(wave_sum(ss) * (1.0f / 1024.0f) + EPS); }
        if (MODE == 3) {
#pragma unroll
            for (int r = 0; r < 2; ++r)
#pragma unroll
                for (int j = 0; j < 4; ++j) { const f32x4 h = v[r][j] * rstd[r] * gv[j]; *(f32x4*)(outf + (size_t)(row0 + r) * 1024 + 4 * lane + 256 * j) = h; } }
        else if (lane < 2) rsout[row0 + lane] = lane ? rstd[1] : rstd[0];
      }
      if (MODE == 1) {
          asm volatile("s_waitcnt vmcnt(0)" ::: "memory"); __builtin_amdgcn_fence(__ATOMIC_ACQUIRE, "agent");
          const int rr = lane & 15, q = lane >> 4; bf16x8 xa[32];
#pragma unroll
          for (int s = 0; s < 32; ++s) xa[s] = *(const bf16x8*)(xdst + (size_t)(t * 16 + rr) * 1024 + s * 32 + q * 8);
          proj16_tile<1>(C, xa, t, bias16, out16, nullptr); }
    }
#undef RP_LOADX
#undef RP_LOADSM
#undef RP_LOADY
    if (MODE == 1) __syncthreads();
}

__device__ __forceinline__ void prep_phase(const Ctx& C0, int layer, const float* const* in, bf16* ropedst, const int secs = 15) {
    const Ctx C = phase_ctx(C0);
    bf16* PROJ = (bf16*)(C.ws + WS_PROJ); bf16* YCAT = (bf16*)(C.ws + WS_YCAT); bf16* MQK = (bf16*)(C.ws + WS_MQK);
    const bf16* PW = (const bf16*)(C.ws + WS_POOLW) + (size_t)layer * 4 * 64 * 64;
    const float* ROPEC = (const float*)(C.ws + WS_ROPE); const float* ROPES = ROPEC + 4096 * 32;
    const float* qg = in[I_QNG] + layer * 64; const float* kg = in[I_KNG] + layer * 64;
    const float* cw = in[I_CONVW] + (size_t)layer * 5 * 512;
    const int lane = C.lane, rr = lane & 15, q = lane >> 4;
    bf16* KT = (bf16*)(C.ws + WS_KT); bf16* VT = (bf16*)(C.ws + WS_VT);
    LAS bf16* tile = (LAS bf16*)(C.ldsl + RING_OFF + C.wave * 16384);
    for (int grp = C.gw; grp < NTOK / 16; grp += C.NGW) {
        const int r0 = grp * 16, brow = r0 & ~4095, t0 = r0 & 4095;
#ifndef NO_POOL
        if (secs & 1)
        { LAS bf16* pst = (LAS bf16*)(C.ldsl + RING_OFF + C.wave * 16384);
          { v4u st[16];
#pragma unroll
            for (int i = 0; i < 16; ++i) { const int id = i * 64 + lane, row = id >> 5, c = id & 31, tu = t0 - 8 + row; st[i] = (v4u){0u, 0u, 0u, 0u};
                if (id < 992 && tu >= 0 && tu < 4096) st[i] = *(const v4u*)(PROJ + (size_t)(brow + tu) * NPROJ + C_POOL + c * 8); }
#pragma unroll
            for (int i = 0; i < 16; ++i) { const int id = i * 64 + lane, row = id >> 5, c = id & 31; if (id < 992) *(LAS v4u*)(pst + row * 264 + c * 8) = st[i]; } }
          LDS_WAIT(); asm volatile("" ::: "memory");
          const int t = t0 + rr;
#pragma unroll 1
          for (int g = 0; g < 4; ++g) { const int half = 1 << g, w = 2 << g; const int lo = max(t - half, 0), hi = min(t + half, 4096); const float inv = __builtin_amdgcn_rcpf((float)(hi - lo));
            bf16x8 bfr[2], afr[4][2]; float sum[2][8];
#pragma unroll
            for (int ks = 0; ks < 2; ++ks) {
#pragma unroll
                for (int i = 0; i < 8; ++i) sum[ks][i] = 0.f;
#pragma unroll
                for (int et = 0; et < 4; ++et) afr[et][ks] = *(const bf16x8*)(PW + ((size_t)(g * 64 + et * 16 + rr)) * 64 + ks * 32 + q * 8); }
            const LAS bf16* wp = pst + (rr + 8 - half) * 264 + g * 64 + q * 8;
#pragma unroll 2
            for (int u = 0; u < w; ++u) {
#pragma unroll
                for (int ks = 0; ks < 2; ++ks) { const v4u x = *(const LAS v4u*)(wp + u * 264 + ks * 32);
                    sum[ks][0] += bf_lo(x.x); sum[ks][1] += bf_hi(x.x); sum[ks][2] += bf_lo(x.y); sum[ks][3] += bf_hi(x.y); sum[ks][4] += bf_lo(x.z); sum[ks][5] += bf_hi(x.z); sum[ks][6] += bf_lo(x.w); sum[ks][7] += bf_hi(x.w); } }
#pragma unroll
            for (int ks = 0; ks < 2; ++ks) { const v4u s = *(const LAS v4u*)(pst + (rr + 8) * 264 + g * 64 + ks * 32 + q * 8);
                const float d0 = sum[ks][0] * inv - bf_lo(s.x), d1 = sum[ks][1] * inv - bf_hi(s.x), d2 = sum[ks][2] * inv - bf_lo(s.y), d3 = sum[ks][3] * inv - bf_hi(s.y);
                const float d4 = sum[ks][4] * inv - bf_lo(s.z), d5 = sum[ks][5] * inv - bf_hi(s.z), d6 = sum[ks][6] * inv - bf_lo(s.w), d7 = sum[ks][7] * inv - bf_hi(s.w);
                v4u pk; pk.x = pk2(d0, d1); pk.y = pk2(d2, d3); pk.z = pk2(d4, d5); pk.w = pk2(d6, d7); bfr[ks] = __builtin_bit_cast(bf16x8, pk); }
#pragma unroll
            for (int et = 0; et < 4; ++et) { f32x4 acc = (f32x4){0.f, 0.f, 0.f, 0.f};
#pragma unroll
                for (int ks = 0; ks < 2; ++ks) acc = MFMA16(afr[et][ks], bfr[ks], acc);
                uint2 o; o.x = pk2(acc.x, acc.y); o.y = pk2(acc.z, acc.w);
                *(uint2*)(YCAT + (size_t)(r0 + rr) * 1024 + g * 64 + et * 16 + 4 * q) = o; } }
          LDS_WAIT(); asm volatile("" ::: "memory"); }
#endif
        asm volatile("" ::: "memory");
#ifndef NO_CONV
        if (secs & 2)
        { float cwv[5][8];
#pragma unroll
          for (int j = 0; j < 5; ++j) { const f32x4 a = *(const f32x4*)(cw + j * 512 + lane * 8), b2 = *(const f32x4*)(cw + j * 512 + lane * 8 + 4);
              cwv[j][0] = a.x; cwv[j][1] = a.y; cwv[j][2] = a.z; cwv[j][3] = a.w; cwv[j][4] = b2.x; cwv[j][5] = b2.y; cwv[j][6] = b2.z; cwv[j][7] = b2.w; }
          const float ksc = (lane >= 32) ? 0.125f : 1.0f;
#pragma unroll
          for (int hf = 0; hf < 2; ++hf) { v4u xr[12];
#pragma unroll
            for (int u = 0; u < 12; ++u) { const int tu = t0 + hf * 8 + u - 2; const int tc = min(max(tu, 0), 4095); xr[u] = *(const v4u*)(PROJ + (size_t)(brow + tc) * NPROJ + C_MQ + lane * 8); }
#pragma unroll
            for (int u = 0; u < 12; ++u) { const int tu = t0 + hf * 8 + u - 2; if (tu < 0 || tu >= 4096) xr[u] = (v4u){0u, 0u, 0u, 0u}; }
#pragma unroll
            for (int r = 0; r < 8; ++r) { float acc[8];
#pragma unroll
                for (int i = 0; i < 8; ++i) acc[i] = 0.f;
#pragma unroll
                for (int j = 0; j < 5; ++j) { const v4u x = xr[r + j];
                    acc[0] += cwv[j][0] * bf_lo(x.x); acc[1] += cwv[j][1] * bf_hi(x.x); acc[2] += cwv[j][2] * bf_lo(x.y); acc[3] += cwv[j][3] * bf_hi(x.y);
                    acc[4] += cwv[j][4] * bf_lo(x.z); acc[5] += cwv[j][5] * bf_hi(x.z); acc[6] += cwv[j][6] * bf_lo(x.w); acc[7] += cwv[j][7] * bf_hi(x.w); }
#pragma unroll
                for (int i = 0; i < 8; ++i) acc[i] = acc[i] * fsigmoid(acc[i]) * ksc;
                v4u o; o.x = pk2(acc[0], acc[1]); o.y = pk2(acc[2], acc[3]); o.z = pk2(acc[4], acc[5]); o.w = pk2(acc[6], acc[7]);
                const int rw = hf * 8 + r;
                *(v4u*)(MQK + (size_t)(r0 + rw) * 512 + lane * 8) = o;
                if (lane >= 32) *(LAS v4u*)(tile + rw * 264 + (lane - 32) * 8) = o; } asm volatile("" ::: "memory"); } }
#endif
        asm volatile("" ::: "memory");
#ifndef NO_ROPE
        if (secs & 4)
        { const int c8 = lane & 7, rl = lane >> 3;
          f32x4 csv[2], snv[2];
#pragma unroll
          for (int hf = 0; hf < 2; ++hf) { const int t = t0 + hf * 8 + rl; csv[hf] = *(const f32x4*)(ROPEC + t * 32 + 4 * c8); snv[hf] = *(const f32x4*)(ROPES + t * 32 + 4 * c8); }
          const f32x4 qg0 = *(const f32x4*)(qg + 8 * c8), qg1 = *(const f32x4*)(qg + 8 * c8 + 4), kg0 = *(const f32x4*)(kg + 8 * c8), kg1 = *(const f32x4*)(kg + 8 * c8 + 4);
#pragma unroll 1
          for (int hb = 0; hb < 10; hb += 5) {
          v4u w[5][2];
#pragma unroll
          for (int h = 0; h < 5; ++h)
#pragma unroll
              for (int hf = 0; hf < 2; ++hf) { const int hh = hb + h; const int col = (hh < 8) ? C_AQ + hh * 64 : C_AK + (hh - 8) * 64; w[h][hf] = *(const v4u*)(PROJ + (size_t)(r0 + hf * 8 + rl) * NPROJ + col + 8 * c8); }
#pragma unroll
          for (int h = 0; h < 5; ++h)
#pragma unroll
              for (int hf = 0; hf < 2; ++hf) { const int hh = hb + h; const v4u x = w[h][hf];
                  const float x0 = bf_lo(x.x), x1 = bf_hi(x.x), x2 = bf_lo(x.y), x3 = bf_hi(x.y), x4 = bf_lo(x.z), x5 = bf_hi(x.z), x6 = bf_lo(x.w), x7 = bf_hi(x.w);
                  float ss = ((x0 * x0 + x1 * x1) + (x2 * x2 + x3 * x3)) + ((x4 * x4 + x5 * x5) + (x6 * x6 + x7 * x7));
                  ss = oct_sum(ss);
                  const float rs = __builtin_amdgcn_rsqf(ss * (1.0f / 64.0f) + EPS); const bool isq = hh < 8; const f32x4 g0 = isq ? qg0 : kg0, g1 = isq ? qg1 : kg1; const float sc = rs * (isq ? attn_body::C2 : 1.0f);
                  const float y0 = x0 * sc * g0.x, y1 = x1 * sc * g0.y, y2 = x2 * sc * g0.z, y3 = x3 * sc * g0.w, y4 = x4 * sc * g1.x, y5 = x5 * sc * g1.y, y6 = x6 * sc * g1.z, y7 = x7 * sc * g1.w;
                  const f32x4 c = csv[hf], sn4 = snv[hf];
                  v4u o; o.x = pk2(y0 * c.x - y1 * sn4.x, y0 * sn4.x + y1 * c.x); o.y = pk2(y2 * c.y - y3 * sn4.y, y2 * sn4.y + y3 * c.y);
                  o.z = pk2(y4 * c.z - y5 * sn4.z, y4 * sn4.z + y5 * c.z); o.w = pk2(y6 * c.w - y7 * sn4.w, y6 * sn4.w + y7 * c.w);
                  w[h][hf] = o; }
#pragma unroll
          for (int h = 0; h < 5; ++h)
#pragma unroll
              for (int hf = 0; hf < 2; ++hf) { const int hh = hb + h; const int col = (hh < 8) ? C_AQ + hh * 64 : C_AK + (hh - 8) * 64; *(v4u*)(ropedst + (size_t)(r0 + hf * 8 + rl) * NPROJ + col + 8 * c8) = w[h][hf]; }
          asm volatile("" ::: "memory"); }
          asm volatile("" ::: "memory"); }
#endif
        if (secs & 8) { const int chunk = grp >> 3, s0 = (grp & 7) * 16;
#pragma unroll 1
          for (int pass = 0; pass < 2; ++pass) {
            if (pass == 1) { v4u tv[8];
#pragma unroll
                for (int r2 = 0; r2 < 8; ++r2) { const int row = 2 * r2 + (lane >> 5), col8 = (lane & 31) * 8; tv[r2] = *(const v4u*)(PROJ + (size_t)(r0 + row) * NPROJ + C_MV + col8); }
#pragma unroll
                for (int r2 = 0; r2 < 8; ++r2) { const int row = 2 * r2 + (lane >> 5), col8 = (lane & 31) * 8; *(LAS v4u*)(tile + row * 264 + col8) = tv[r2]; } }
            LDS_WAIT(); asm volatile("" ::: "memory");
            bf16* dst = pass ? VT : KT;
#pragma unroll
            for (int k = 0; k < 4; ++k) { const int cidx = lane + 64 * k, hh = cidx >> 6, d = cidx & 63;
#pragma unroll
                for (int half = 0; half < 2; ++half) { unsigned w[4];
#pragma unroll
                    for (int i = 0; i < 4; ++i) w[i] = (unsigned)tile[(half * 8 + 2 * i) * 264 + cidx] | ((unsigned)tile[(half * 8 + 2 * i + 1) * 264 + cidx] << 16);
                    v4u o; o.x = w[0]; o.y = w[1]; o.z = w[2]; o.w = w[3];
                    *(v4u*)(dst + ((size_t)(chunk * 4 + hh) * 64 + d) * 128 + s0 + half * 8) = o; } }
            LDS_WAIT(); asm volatile("" ::: "memory");
          } }
    }
}

__device__ __forceinline__ void mlstm_local_phase(const Ctx& C0) {
    const Ctx C = phase_ctx(C0);
    const bf16* KT = (const bf16*)(C.ws + WS_KT); const bf16* VT = (const bf16*)(C.ws + WS_VT); const float* GATES = (const float*)(C.ws + WS_GATES);
    float* CST = (float*)(C.ws + WS_CST); float* MLOC = (float*)(C.ws + WS_MSC); float* BLAST = MLOC + 2048;
    const int lane = C.lane, wave = C.wave, rr = lane & 15, q = lane >> 4, dir = wave >> 2, nt = wave & 3;
    LAS float* wl = (LAS float*)(C.ldsl + RING_OFF) + wave * 128;
    for (int chunk = C.vcu; chunk < NBATCH * 32; chunk += C.G) {
        const int b = chunk >> 5, c = chunk & 31; const size_t row0 = (size_t)chunk * 128;
#pragma unroll 1
        for (int h = 0; h < 4; ++h) {
            const int sidx = ((b * 4 + h) * 2 + dir) * 32 + c; const int s0 = 2 * lane, s1 = s0 + 1;
            const float* g0p = GATES + (row0 + s0) * 16; const float li0 = g0p[dir * 4 + h], li1 = g0p[16 + dir * 4 + h], f0 = g0p[8 + dir * 4 + h], f1 = g0p[24 + dir * 4 + h];
            const bf16* kt = KT + ((size_t)(chunk * 4 + h) * 64 + nt * 16 + rr) * 128 + q * 8; const bf16* vt = VT + ((size_t)(chunk * 4 + h) * 64 + rr) * 128 + q * 8;
            v4u krr[4]; bf16x8 vfr[4][4];
#pragma unroll
            for (int ks = 0; ks < 4; ++ks) { krr[ks] = *(const v4u*)(kt + ks * 32);
#pragma unroll
                for (int m = 0; m < 4; ++m) vfr[ks][m] = *(const bf16x8*)(vt + (size_t)m * 16 * 128 + ks * 32); }
            float bc0, bc1, tot;
            if (dir == 0) { const float inc = wscan_add(f0 + f1, lane); bc1 = inc; bc0 = inc - f1; tot = lane_bcast(inc, 63); }
            else { const float suf = wscan_add_rev(f0 + f1, lane); bc0 = suf; bc1 = suf - f0; tot = lane_bcast(suf, 0); }
            const float g0 = tot - bc0 + li0, g1 = tot - bc1 + li1; float mx = fmaxf(g0, g1);
#pragma unroll
            for (int o = 1; o < 2; o <<= 1) mx = wave_max(mx);
            *(LAS f32x2v*)(wl + s0) = (f32x2v){fexp(g0 - mx), fexp(g1 - mx)};
            if (nt == 0 && lane == 0) { MLOC[sidx] = mx; BLAST[sidx] = tot; }
            LDS_WAIT(); asm volatile("" ::: "memory");
            f32x4 acc[4]; float nsum = 0.f;
#pragma unroll
            for (int m = 0; m < 4; ++m) acc[m] = (f32x4){0.f, 0.f, 0.f, 0.f};
#pragma unroll
            for (int ks = 0; ks < 4; ++ks) { const v4u kr = krr[ks]; const f32x4 wa = *(const LAS f32x4*)(wl + ks * 32 + q * 8), wb = *(const LAS f32x4*)(wl + ks * 32 + q * 8 + 4);
                const float k0 = bf_lo(kr.x) * wa.x, k1 = bf_hi(kr.x) * wa.y, k2 = bf_lo(kr.y) * wa.z, k3 = bf_hi(kr.y) * wa.w, k4 = bf_lo(kr.z) * wb.x, k5 = bf_hi(kr.z) * wb.y, k6 = bf_lo(kr.w) * wb.z, k7 = bf_hi(kr.w) * wb.w;
                nsum += ((k0 + k1) + (k2 + k3)) + ((k4 + k5) + (k6 + k7));
                v4u pk; pk.x = pk2(k0, k1); pk.y = pk2(k2, k3); pk.z = pk2(k4, k5); pk.w = pk2(k6, k7); const bf16x8 bfr = __builtin_bit_cast(bf16x8, pk);
#pragma unroll
                for (int m = 0; m < 4; ++m) acc[m] = MFMA16(vfr[ks][m], bfr, acc[m]); }
            nsum = pg8::sum_rows4(nsum);
            float* out = CST + (size_t)sidx * CST_SZ;
#pragma unroll
            for (int m = 0; m < 4; ++m)
#pragma unroll
                for (int j = 0; j < 4; ++j) out[(m * 16 + 4 * q + j) * 64 + nt * 16 + rr] = acc[m][j];
            if (q == 0) out[4096 + nt * 16 + rr] = nsum;
            LDS_WAIT(); asm volatile("" ::: "memory");
        }
    }
}

__device__ __forceinline__ void mlstm_scan_phase(const Ctx& C0) {
    const Ctx C = phase_ctx(C0);
    const float* CST = (const float*)(C.ws + WS_CST); bf16* CSB = (bf16*)(C.ws + WS_CSB); const float* MLOC = (const float*)(C.ws + WS_MSC); const float* BLAST = MLOC + 2048; float* MST = (float*)(C.ws + WS_MSC) + 4096;
    const int spg = 64 / C.ng, lt = C.lb * 512 + C.tid, LT = C.GB * 512;
    LAS float* tb = (LAS float*)(C.ldsl + RING_OFF);
    for (int sq = C.wave; sq < spg; sq += 8) { const int seq = C.grp * spg + sq, dir = seq & 1, ln = C.lane;
        float mlv = 0.f, blv = 0.f; if (ln < 32) { const int cc = dir ? 31 - ln : ln; mlv = MLOC[seq * 32 + cc]; blv = BLAST[seq * 32 + cc]; }
        float m = 0.f;
        for (int s2 = 0; s2 < 32; ++s2) { const float b_ = lane_bcast(blv, s2), ml_ = lane_bcast(mlv, s2); const float mn = fmaxf(b_ + m, ml_);
            if (ln == s2) { tb[(sq * 32 + s2) * 4 + 0] = m; tb[(sq * 32 + s2) * 4 + 1] = fexp(b_ + m - mn); tb[(sq * 32 + s2) * 4 + 2] = fexp(ml_ - mn); }
            m = mn; } }
    __syncthreads();
    for (int li = lt; li < spg * CST_SZ; li += LT) {
        const int sq = li / CST_SZ, el = li - sq * CST_SZ, seq = C.grp * spg + sq, dir = seq & 1;
        float loc[32];
#pragma unroll
        for (int s = 0; s < 32; ++s) { const int c = dir ? 31 - s : s; const int idx = seq * 32 + c; loc[s] = CST[(size_t)idx * CST_SZ + el]; }
        float st = 0.f;
#pragma unroll
        for (int s = 0; s < 32; ++s) { const int c = dir ? 31 - s : s; const int idx = seq * 32 + c;
            CSB[(size_t)idx * CST_SZ + el] = (bf16)f2bf(st);
            const f32x4 cf = *(const LAS f32x4*)(tb + (sq * 32 + s) * 4); st = cf.y * st + cf.z * loc[s]; }
    }
    { const float* GATES = (const float*)(C.ws + WS_GATES); float* GV = (float*)(C.ws + WS_GV); const int lane = C.lane;
      for (int task = C.lb * 8 + C.wave; task < spg * 32; task += C.GB * 8) {
        const int sq = task >> 5, c = task & 31, seq = C.grp * spg + sq, dir = seq & 1, bh = seq >> 1, b = bh >> 2, h = bh & 3; const int sidx = seq * 32 + c;
        const int npre = dir ? 31 - c : c; const float mst = tb[(sq * 32 + npre) * 4];
        const size_t row0 = (size_t)b * 4096 + c * 128; const int s0 = 2 * lane, s1 = s0 + 1;
        const float* g0p = GATES + (row0 + s0) * 16; const float li0 = g0p[dir * 4 + h], li1 = g0p[16 + dir * 4 + h], f0 = g0p[8 + dir * 4 + h], f1 = g0p[24 + dir * 4 + h];
        float bc0, bc1;
        if (dir == 0) { const float inc = wscan_add(f0 + f1, lane); bc1 = inc; bc0 = inc - f1; }
        else { const float suf = wscan_add_rev(f0 + f1, lane); bc0 = suf; bc1 = suf - f0; }
        const float cb0 = li0 - bc0, cb1 = li1 - bc1; float mx0, mx1;
        if (dir == 0) { const float inc = wscan_max(fmaxf(cb0, cb1), lane); float prev = __shfl_up(inc, 1); if (lane == 0) prev = -INFINITY; mx1 = inc; mx0 = fmaxf(prev, cb0); }
        else { const float suf = wscan_max_rev(fmaxf(cb0, cb1), lane); float nxt = __shfl_down(suf, 1); if (lane == 63) nxt = -INFINITY; mx0 = suf; mx1 = fmaxf(nxt, cb1); }
        const float m0 = bc0 + fmaxf(mst, mx0), m1 = bc1 + fmaxf(mst, mx1);
        float* gv = GV + (size_t)sidx * 512 + s0;
        *(f32x2v*)(gv) = (f32x2v){cb0, cb1}; *(f32x2v*)(gv + 128) = (f32x2v){bc0 - m0, bc1 - m1};
        *(f32x2v*)(gv + 256) = (f32x2v){fexp(bc0 + mst - m0), fexp(bc1 + mst - m1)}; *(f32x2v*)(gv + 384) = (f32x2v){fexp(-m0), fexp(-m1)};
      } }
}

constexpr int MO_WAVE_BYTES = 2 * 4352;
constexpr int MO_K_OFF = 0, MO_V_OFF = MO_K_OFF + 128 * 144, MO_CF_OFF = MO_V_OFF + 64 * 272, MO_CB_OFF = MO_CF_OFF + 65 * 144, MO_GV_OFF = MO_CB_OFF + 65 * 144, MO_P_OFF = MO_GV_OFF + 4096;
static_assert(MO_P_OFF % 16 == 0 && MO_P_OFF + 8 * MO_WAVE_BYTES <= RING_BYTES, "mlstm_out LDS");
__device__ __forceinline__ void mlstm_out_phase(const Ctx& C0, int layer, const float* const* in) {
    const Ctx C = phase_ctx(C0);
    const bf16* PROJ = (const bf16*)(C.ws + WS_PROJ); const bf16* MQK = (const bf16*)(C.ws + WS_MQK); const bf16* VT = (const bf16*)(C.ws + WS_VT);
    const bf16* CSB = (const bf16*)(C.ws + WS_CSB); const float* GV = (const float*)(C.ws + WS_GV); bf16* YCAT = (bf16*)(C.ws + WS_YCAT);
    const float* ng = in[I_MNORMG] + layer * 256;
    const int tid = C.tid, lane = C.lane, wave = C.wave, rr = lane & 15, q = lane >> 4, j0 = wave * 16;
    LAS bf16* Ks = (LAS bf16*)(C.ldsl + RING_OFF + MO_K_OFF); LAS bf16* Vs = (LAS bf16*)(C.ldsl + RING_OFF + MO_V_OFF);
    LAS bf16* Cfs = (LAS bf16*)(C.ldsl + RING_OFF + MO_CF_OFF); LAS bf16* Cbs = (LAS bf16*)(C.ldsl + RING_OFF + MO_CB_OFF); LAS float* GVs = (LAS float*)(C.ldsl + RING_OFF + MO_GV_OFF);
    LAS bf16* Psf = (LAS bf16*)(C.ldsl + RING_OFF + MO_P_OFF + wave * MO_WAVE_BYTES); LAS bf16* Psb = Psf + 16 * 136;
    const int upg = NBATCH * 4 * 32 / C.ng;
    v4u pk[2], pv[2], pcf[2], pcb[2], pg; bf16x8 qan[2]; bf16 ogn[4][4];
    pcf[1] = (v4u){0u, 0u, 0u, 0u}; pcb[1] = pcf[1]; pg = pcf[1];
#define MO_ISSUE(lu_) do { const int un_ = C.grp * upg + (lu_); const int c_ = un_ & 31, h_ = (un_ >> 5) & 3, b_ = un_ >> 7; const size_t rw_ = (size_t)b_ * 4096 + c_ * 128; const int ch_ = b_ * 32 + c_; \
        const int sf_ = ((b_ * 4 + h_) * 2) * 32 + c_, sb_ = sf_ + 32; \
        _Pragma("unroll") for (int i_ = 0; i_ < 2; ++i_) { const int ix_ = tid + 512 * i_; \
            pk[i_] = *(const v4u*)(MQK + (rw_ + (ix_ >> 3)) * 512 + 256 + h_ * 64 + (ix_ & 7) * 8); \
            pv[i_] = *(const v4u*)(VT + ((size_t)(ch_ * 4 + h_) * 64 + (ix_ >> 4)) * 128 + (ix_ & 15) * 8); } \
        pcf[0] = *(const v4u*)(CSB + (size_t)sf_ * CST_SZ + tid * 8); pcb[0] = *(const v4u*)(CSB + (size_t)sb_ * CST_SZ + tid * 8); \
        if (tid < 8) { pcf[1] = *(const v4u*)(CSB + (size_t)sf_ * CST_SZ + (512 + tid) * 8); pcb[1] = *(const v4u*)(CSB + (size_t)sb_ * CST_SZ + (512 + tid) * 8); } \
        if (tid < 256) pg = *(const v4u*)(GV + (size_t)(tid < 128 ? sf_ : sb_) * 512 + (tid & 127) * 4); \
        _Pragma("unroll") for (int ks_ = 0; ks_ < 2; ++ks_) qan[ks_] = *(const bf16x8*)(MQK + (rw_ + j0 + rr) * 512 + h_ * 64 + ks_ * 32 + q * 8); \
        _Pragma("unroll") for (int i_ = 0; i_ < 4; ++i_) _Pragma("unroll") for (int et_ = 0; et_ < 4; ++et_) ogn[i_][et_] = PROJ[(rw_ + j0 + 4 * q + i_) * NPROJ + C_MO + h_ * 64 + et_ * 16 + rr]; } while (0)
#define MO_COMMIT() do { \
        _Pragma("unroll") for (int i_ = 0; i_ < 2; ++i_) { const int ix_ = tid + 512 * i_; \
            *(LAS v4u*)(Ks + (ix_ >> 3) * 72 + (ix_ & 7) * 8) = pk[i_]; *(LAS v4u*)(Vs + (ix_ >> 4) * 136 + (ix_ & 15) * 8) = pv[i_]; } \
        *(LAS v4u*)(Cfs + (tid >> 3) * 72 + (tid & 7) * 8) = pcf[0]; *(LAS v4u*)(Cbs + (tid >> 3) * 72 + (tid & 7) * 8) = pcb[0]; \
        if (tid < 8) { *(LAS v4u*)(Cfs + 64 * 72 + tid * 8) = pcf[1]; *(LAS v4u*)(Cbs + 64 * 72 + tid * 8) = pcb[1]; } \
        if (tid < 256) *(LAS v4u*)(GVs + tid * 4) = pg; } while (0)
    if (C.lb < upg) { MO_ISSUE(C.lb); MO_COMMIT(); }
    __syncthreads();
    for (int lu = C.lb; lu < upg; lu += C.GB) { const int unit = C.grp * upg + lu;
        const int c = unit & 31, h = (unit >> 5) & 3, b = unit >> 7; const size_t row0 = (size_t)b * 4096 + c * 128;
        bf16x8 qa[2]; bf16 ogr[4][4];
#pragma unroll
        for (int ks = 0; ks < 2; ++ks) qa[ks] = qan[ks];
#pragma unroll
        for (int i = 0; i < 4; ++i)
#pragma unroll
            for (int et = 0; et < 4; ++et) ogr[i][et] = ogn[i][et];
        const bool more = (lu + C.GB < upg);
        if (more) MO_ISSUE(lu + C.GB);
        const f32x4 raf = *(const LAS f32x4*)(GVs + 128 + j0 + 4 * q), aif = *(const LAS f32x4*)(GVs + 256 + j0 + 4 * q), emf = *(const LAS f32x4*)(GVs + 384 + j0 + 4 * q);
        const f32x4 rab = *(const LAS f32x4*)(GVs + 512 + 128 + j0 + 4 * q), aib = *(const LAS f32x4*)(GVs + 512 + 256 + j0 + 4 * q), emb = *(const LAS f32x4*)(GVs + 512 + 384 + j0 + 4 * q);
        float rsf[4] = {0.f, 0.f, 0.f, 0.f}, rsb[4] = {0.f, 0.f, 0.f, 0.f};
#pragma unroll
        for (int nt = 0; nt < 8; ++nt) { const int s = nt * 16 + rr; const bool usef = (nt * 16 <= j0 + 15), useb = (nt * 16 + 15 >= j0);
            const float cbf = GVs[nt * 16 + rr], cbb = GVs[512 + nt * 16 + rr];
            f32x4 acc = (f32x4){0.f, 0.f, 0.f, 0.f};
#pragma unroll
            for (int ks = 0; ks < 2; ++ks) acc = MFMA16(qa[ks], *(const LAS bf16x8*)(Ks + (nt * 16 + rr) * 72 + ks * 32 + q * 8), acc);
#pragma unroll
            for (int i = 0; i < 4; ++i) { const int j = j0 + 4 * q + i;
                float pf = 0.f, pb = 0.f;
                if (usef) { pf = (s <= j) ? acc[i] * fexp(raf[i] + cbf) : 0.f; rsf[i] += pf; }
                if (useb) { pb = (s >= j) ? acc[i] * fexp(rab[i] + cbb) : 0.f; rsb[i] += pb; }
                Psf[(4 * q + i) * 136 + s] = (bf16)f2bf(pf); Psb[(4 * q + i) * 136 + s] = (bf16)f2bf(pb); } }
        LDS_WAIT(); asm volatile("" ::: "memory");
#pragma unroll
        for (int i = 0; i < 4; ++i) {
#pragma unroll
            for (int o = 1; o < 2; o <<= 1) { rsf[i] = row_sum(rsf[i]); rsb[i] = row_sum(rsb[i]); } }
        f32x4 hsum[4];
#pragma unroll
        for (int dir = 0; dir < 2; ++dir) { LAS bf16* Cs = dir ? Cbs : Cfs; LAS bf16* Ps = dir ? Psb : Psf; const f32x4 ai = dir ? aib : aif, em = dir ? emb : emf;
          f32x4 o[5];
#pragma unroll
          for (int et = 0; et < 5; ++et) { o[et] = (f32x4){0.f, 0.f, 0.f, 0.f};
#pragma unroll
              for (int ks = 0; ks < 2; ++ks) { bf16x8 cf = (bf16x8){0, 0, 0, 0, 0, 0, 0, 0}; if (et < 4 || rr == 0) cf = *(const LAS bf16x8*)(Cs + (et * 16 + rr) * 72 + ks * 32 + q * 8);
                  o[et] = MFMA16(qa[ks], cf, o[et]); } }
          float qn[4];
#pragma unroll
          for (int i = 0; i < 4; ++i) qn[i] = __shfl(o[4][i], lane & 48);
#pragma unroll
          for (int et = 0; et < 4; ++et)
#pragma unroll
              for (int i = 0; i < 4; ++i) o[et][i] *= ai[i];
#pragma unroll
          for (int ks = 0; ks < 4; ++ks) { const bool on = dir ? (ks * 32 + 31 >= j0) : (ks * 32 <= j0 + 15);
              if (on) { const bf16x8 afr = *(const LAS bf16x8*)(Ps + rr * 136 + ks * 32 + q * 8);
#pragma unroll
              for (int et = 0; et < 4; ++et) o[et] = MFMA16(afr, *(const LAS bf16x8*)(Vs + (et * 16 + rr) * 136 + ks * 32 + q * 8), o[et]); } }
#pragma unroll
          for (int i = 0; i < 4; ++i) { const float den = (dir ? rsb[i] : rsf[i]) + ai[i] * qn[i]; const float rinv = __builtin_amdgcn_rcpf(fmaxf(fabsf(den), em[i]));
#pragma unroll
              for (int et = 0; et < 4; ++et) { const float t = o[et][i] * rinv; hsum[et][i] = dir ? hsum[et][i] + t : t; } } }
#pragma unroll
        for (int i = 0; i < 4; ++i) { float ss = 0.f;
#pragma unroll
            for (int et = 0; et < 4; ++et) ss += hsum[et][i] * hsum[et][i];
#pragma unroll
            for (int o = 1; o < 2; o <<= 1) ss = row_sum(ss);
            const float rs = __builtin_amdgcn_rsqf(ss * (1.0f / 64.0f) + EPS); const size_t row = row0 + j0 + 4 * q + i;
#pragma unroll
            for (int et = 0; et < 4; ++et) { const int e = et * 16 + rr; const float og = bf2f(ogr[i][et]);
                const float y = hsum[et][i] * rs * ng[h * 64 + e] * fsigmoid(og); YCAT[row * 1024 + 256 + h * 64 + e] = (bf16)f2bf(y); } }
        LDS_WAIT(); asm volatile("" ::: "memory");
        __syncthreads();
        if (more) MO_COMMIT();
        __syncthreads();
    }
#undef MO_ISSUE
#undef MO_COMMIT
}

__device__ __forceinline__ void topk_phase(const Ctx& C0) {
    const Ctx C = phase_ctx(C0);
    const float* AFF = (const float*)(C.ws + WS_AFF); int* TOKI = (int*)(C.ws + WS_TOKI); float* GATEV = (float*)(C.ws + WS_TOKI + 262144); float* RSTDS = (float*)(C.ws + WS_TOKI + 524288); const float* RSTD3 = (const float*)(C.ws + WS_TOKI + 786432 + 131072); int* SLOTMAP = (int*)(C.ws + WS_SLOTMAP);
    LAS unsigned* hist = (LAS unsigned*)(C.ldsl + RING_OFF); LAS unsigned* sel = hist + 4096; LAS unsigned* wtot = hist + 4104;
    const int tid = C.tid, lane = C.lane, wave = C.wave;
    const int upg = NBATCH * NEXP / C.ng;
    for (int lu = C.lb; lu < upg; lu += C.GB) { const int unit = C.grp * upg + lu;
        const int b = unit >> 4, e = unit & 15; const float* a = AFF + (size_t)unit * 4096;
        unsigned key[8];
#pragma unroll
        for (int i = 0; i < 2; ++i) { const f32x4 v = *(const f32x4*)(a + 8 * tid + 4 * i); key[4 * i] = __float_as_uint(v.x); key[4 * i + 1] = __float_as_uint(v.y); key[4 * i + 2] = __float_as_uint(v.z); key[4 * i + 3] = __float_as_uint(v.w); }
        unsigned prefix = 0u, mask = 0u; int krem = CAP;
#pragma unroll 1
        for (int pass = 0; pass < 3; ++pass) { const int shift = 20 - 10 * pass; const unsigned nbm = pass ? 1023u : 4095u;
#pragma unroll
            for (int j = 0; j < 8; ++j) hist[tid * 8 + j] = 0u;
            __syncthreads();
#pragma unroll
            for (int i = 0; i < 8; ++i) if ((key[i] & mask) == prefix) atomicAdd((unsigned*)&hist[(key[i] >> shift) & nbm], 1u);
            __syncthreads();
            unsigned h[8]; unsigned tsum = 0u;
#pragma unroll
            for (int j = 0; j < 8; ++j) { h[j] = hist[tid * 8 + j]; tsum += h[j]; }
            unsigned sfx = tsum;
#pragma unroll
            for (int o = 1; o < 64; o <<= 1) { const unsigned t2 = __shfl_down(sfx, o); if (lane + o < 64) sfx += t2; }
            if (lane == 0) wtot[wave] = sfx;
            __syncthreads();
            { unsigned s2 = sfx - tsum;
#pragma unroll
              for (int w = 1; w < 8; ++w) if (w > wave) s2 += wtot[w];
#pragma unroll
              for (int j = 7; j >= 0; --j) { if ((int)s2 < krem && (int)(s2 + h[j]) >= krem) { sel[0] = (unsigned)(tid * 8 + j); sel[1] = s2; } s2 += h[j]; } }
            __syncthreads();
            prefix |= sel[0] << shift; mask |= nbm << shift; krem -= (int)sel[1];
            __syncthreads();
        }
        const int cnt_gt = CAP - krem;
        unsigned pk = 0u;
#pragma unroll
        for (int i = 0; i < 8; ++i) pk += (key[i] > prefix ? 1u : 0u) + (key[i] == prefix ? 65536u : 0u);
        unsigned inc = pk;
#pragma unroll
        for (int o = 1; o < 64; o <<= 1) { const unsigned t2 = __shfl_up(inc, o); if (lane >= o) inc += t2; }
        if (lane == 63) wtot[wave] = inc;
        __syncthreads();
        unsigned woff = 0u;
#pragma unroll
        for (int w = 0; w < 8; ++w) { const unsigned x = wtot[w]; if (w < wave) woff += x; }
        const unsigned ex = woff + inc - pk; int pos_gt = (int)(ex & 0xffffu), pos_eq = (int)(ex >> 16);
        int slots[8];
#pragma unroll
        for (int i = 0; i < 8; ++i) { const bool gt = key[i] > prefix, eq = key[i] == prefix; const bool selected = gt || (eq && pos_eq < krem);
            slots[i] = selected ? (gt ? pos_gt : cnt_gt + pos_eq) : -1; pos_gt += gt ? 1 : 0; pos_eq += eq ? 1 : 0;
            if (selected) { TOKI[e * ROWS_E + b * CAP + slots[i]] = b * 4096 + 8 * tid + i; GATEV[e * ROWS_E + b * CAP + slots[i]] = __uint_as_float(key[i]); RSTDS[e * ROWS_E + b * CAP + slots[i]] = RSTD3[b * 4096 + 8 * tid + i]; } }
#pragma unroll
        for (int i = 0; i < 8; ++i) SLOTMAP[((size_t)(b * 4096 + 8 * tid + i)) * 16 + e] = slots[i];
        __syncthreads();
    }
}
#ifndef MK_ONE_LAUNCH
#define MK_ONE_LAUNCH 1
#endif
#ifndef PHM
#define PHM 0xFFFF
#endif
#ifndef STAGGER_ITEMS
#define STAGGER_ITEMS 4
#endif
#ifndef A_ALIGN
#define A_ALIGN true
#endif
#ifndef RES_ALIGN
#define RES_ALIGN false
#endif
#ifndef PREP_SECS
#define PREP_SECS 15
#endif
#ifndef MN_LOCAL
#define MN_LOCAL 0
#endif
#ifndef LOCAL_SEAMS
#define LOCAL_SEAMS 1
#endif
#ifndef CONV_PARTS
#define CONV_PARTS 1
#endif
#ifndef PROBE_N
#define PROBE_N 2
#endif
#ifndef REP_BARL
#define REP_BARL 1
#endif
#ifndef REP_BAR
#define REP_BAR 1
#endif
#ifndef REP_P0
#define REP_P0 1
#endif
#ifndef REP_A
#define REP_A 1
#endif
#ifndef REP_C
#define REP_C 1
#endif
#ifndef REP_E1
#define REP_E1 1
#endif
#ifndef REP_E2
#define REP_E2 1
#endif
#ifndef REP_G
#define REP_G 1
#endif
#ifndef REP_H
#define REP_H 1
#endif
#ifndef REP_K
#define REP_K 1
#endif
#ifndef REP_L
#define REP_L 1
#endif
#ifndef REP_M
#define REP_M 1
#endif
#ifndef REP_N
#define REP_N 1
#endif
#ifndef REP_B
#define REP_B 1
#endif
#ifndef REP_D
#define REP_D 1
#endif
#ifndef REP_F
#define REP_F 1
#endif
#ifndef REP_I
#define REP_I 1
#endif
#ifndef REP_J
#define REP_J 1
#endif
#ifndef REP_O
#define REP_O 1
#endif
#define REPEAT(n) for (int rep_ = 0; rep_ < (n); ++rep_)
constexpr int NWAVES = 8;
constexpr int GU_MAXU = 16;
static_assert(XTRA_OFF + GU_MAXU * (512 + 1024) <= LDS_BYTES, "gather tables");
static_assert(GU_MAXU >= 16, "gather table");
constexpr int PH_PER_LAYER = 12, N_PHASES = 1 + DEPTH * PH_PER_LAYER;
struct Args { const float* in[N_IN]; float* out; unsigned char* ws; int ph_lo, ph_hi; };
static_assert(sizeof(Args) == (N_IN + 2) * 8 + 8, "no padding in Args");

__global__ void __launch_bounds__(NWAVES * 64, 2) mk_fwd(Args args) {
    extern __shared__ __attribute__((aligned(16))) unsigned char lds[];
    Ctx C;
    C.tid = threadIdx.x; C.lane = C.tid & 63; C.wave = __builtin_amdgcn_readfirstlane(C.tid >> 6);
    C.G = gridDim.x; { const int bx = blockIdx.x; C.vcu = (C.G % 8 == 0) ? (bx % 8) * (C.G / 8) + bx / 8 : bx; }
    C.gw = C.vcu * NWAVES + C.wave; C.NGW = C.G * NWAVES; C.ng = (C.G % 8 == 0) ? 8 : 1; C.GB = C.G / C.ng; C.grp = C.vcu / C.GB; C.lb = C.vcu % C.GB; C.lds = lds; C.ws = args.ws; C.ldsl = (LAS unsigned char*)lds;
    unsigned char* ws = args.ws;
    LAS unsigned char* ldsl = (LAS unsigned char*)lds;
    volatile LAS unsigned* MISC = (volatile LAS unsigned*)(ldsl + MISC_OFF);
    for (int u = C.tid; u < (LDS_BYTES - LDSCTL_OFF) / 4; u += NWAVES * 64) ((LAS unsigned*)(ldsl + LDSCTL_OFF))[u] = 0u;
    __syncthreads();
    XcdBarrier bar; bar.bar = (unsigned*)(ws + WS_CTL) + CW_BAR; bar.x = 0; bar.st = nullptr;
    if (MK_ONE_LAUNCH) bar = xcd_barrier_post((unsigned*)(ws + WS_CTL) + CW_BAR, MISC + 8);
    const int lo = args.ph_lo, hi = args.ph_hi;
#define IN(k) (lo <= (k) && (k) < hi)
#define SEAM(k) do { if (IN(k) && IN((k) + 1)) { REPEAT(REP_BAR) xcd_barrier(bar); } } while (0)
#define SEAM_L(k) do { if (IN(k) && IN((k) + 1)) { REPEAT(REP_BARL) { if (fastmode) local_barrier((unsigned*)(ws + WS_CTL) + CW_BAR, (unsigned*)(ws + WS_CTL) + CW_LOC + 64 * C.grp, (unsigned)C.GB, MISC + 20); else xcd_barrier(bar); } } } while (0)
    const float* const* in = args.in;
#define HN ((bf16*)(ws + WS_HN))
#define PROJ ((bf16*)(ws + WS_PROJ))
#define YCAT ((bf16*)(ws + WS_YCAT))
#define QCA ((bf16*)(ws + WS_QCA))
#define X ((float*)(ws + WS_X))
#define XB ((bf16*)(ws + WS_X))
#define RSTD1 ((float*)(ws + WS_TOKI + 786432))
#define RSTD3 ((float*)(ws + WS_TOKI + 786432 + 131072))
#define RSTDS ((float*)(ws + WS_TOKI + 524288))
#define GATES ((float*)(ws + WS_GATES))
#define AFF ((float*)(ws + WS_AFF))
#define TOKI ((int*)(ws + WS_TOKI))
#define GATEV ((float*)(ws + WS_TOKI + 262144))
#define SLOTMAP ((int*)(ws + WS_SLOTMAP))
#define ACT ((bf16*)(ws + WS_ACT))
#define YS ((bf16*)(ws + WS_YS))

    if ((PHM & 1) && IN(0)) {
        REPEAT(REP_P0) { prologue_convert(C, in, MK_ONE_LAUNCH != 0);
        __syncthreads(); }
        row_phase<1, false, true>(C, in[I_X], XB, in[I_NMIXG], RSTD1, in[I_WIN] + 1280, 2064, in[I_GATEB], GATES, nullptr, nullptr, nullptr);
        if (MK_ONE_LAUNCH && LOCAL_SEAMS && C.tid == 0) atomicOr((unsigned*)(ws + WS_CTL) + CW_LOC + 1024 + 64 * C.grp, 1u << bar.x);
        SEAM(0);
    }
    bool fastmode = false;
    const bool mnloc = (C.ng == 8 && C.GB == 32);
    if (MK_ONE_LAUNCH && LOCAL_SEAMS && lo == 0 && hi == N_PHASES) {
        if (C.tid == 0) { unsigned ok = (C.ng == 8) ? 1u : 0u;
            for (int g = 0; g < 8; ++g) { const unsigned m = xb_ld((unsigned*)(ws + WS_CTL) + CW_LOC + 1024 + 64 * g); if (m == 0u || (m & (m - 1u)) != 0u) ok = 0u; }
            MISC[21] = ok; }
        __syncthreads();
        fastmode = (MISC[21] != 0u);
    }
#pragma unroll 1
    for (int l = 0; l < DEPTH; ++l) {
        const int pb = 1 + l * PH_PER_LAYER;
        if ((PHM & (1 << 1)) && IN(pb + 0)) {
            if (l == 0) { pg8::Gemm g{(const pg8::bf16_t*)(ws + WS_MEMB), (const pg8::bf16_t*)(ws + WS_WCAKV), 1024, 0, 1024L * 1024, nullptr, 0, nullptr}; pg8::Sched S; S.init(8, 4, 4, C.G, (int)blockIdx.x);
                pg8::EpiBf16 E{(pg8::bf16_t*)(ws + WS_KVCA), 1024, 2048L * 1024, 1.0f};
                pg8::gemm_phase<pg8::EpiBf16, true, false>(ldsl + RING_OFF, g, S, E); }
            REPEAT(REP_A) { pg8::Gemm g{(const pg8::bf16_t*)XB, (const pg8::bf16_t*)(ws + WS_WIN) + (size_t)l * 2048 * 1024, 1024, 0, 0, nullptr, 0, nullptr}; pg8::Sched S; S.init(NTOK / 256, NPROJ / 256, 1, C.G, (int)blockIdx.x);
              pg8::row_table((LAS float*)(ldsl + XTRA_OFF), RSTD1, 0, S, GU_MAXU);
              pg8::EpiBf16S E{(pg8::bf16_t*)PROJ, NPROJ, (const LAS float*)(ldsl + XTRA_OFF)};
              pg8::gemm_phase<pg8::EpiBf16S, A_ALIGN, false>(ldsl + RING_OFF, g, S, E); }
            if (l == 0) SEAM(pb + 0); else SEAM_L(pb + 0);
        }
        if ((PHM & (1 << 2)) && IN(pb + 1)) { REPEAT(REP_B - 1) prep_phase(C, l, in, ACT, PREP_SECS); prep_phase(C, l, in, PROJ); VM_WAIT(); __syncthreads(); REPEAT(REP_C) mlstm_local_phase(C); SEAM_L(pb + 1); }
        if ((PHM & (1 << 4)) && IN(pb + 2)) { REPEAT(REP_D) mlstm_scan_phase(C); SEAM_L(pb + 2); }
        if ((PHM & (1 << 5)) && IN(pb + 3)) {
#ifndef NO_MOUT
            REPEAT(REP_E1) { mlstm_out_phase(C, l, in);
            __syncthreads(); }
#endif
#ifndef NO_ATTN
            REPEAT(REP_E2) for (int i = 0; i < 4; ++i) { const int u = C.vcu * 4 + i; if (u >= NBATCH * 8 * 16) break; const int qb = u & 15, h = (u >> 4) & 7, b = u >> 7;
                attn_body::attn_unit<8>((long)b * 4096, qb * 256, (const attn_body::bf16*)PROJ + C_AQ + h * 64, (const attn_body::bf16*)PROJ + C_AK + (h >> 2) * 64, (const attn_body::bf16*)PROJ + C_AV + (h >> 2) * 64,
                                        (attn_body::bf16*)YCAT + 512 + h * 64, (char*)lds + RING_OFF);
#if CONV_PARTS == 2
                if (MK_ONE_LAUNCH && (i == (C.vcu & 3) || i == ((C.vcu + 2) & 3))) { convert_share(ws, in, ldsl, l, C.vcu, C.G, (i == (C.vcu & 3)) ? 0 : 1, 2); __syncthreads(); } }
#else
                if (MK_ONE_LAUNCH && i == (C.vcu & 3)) { convert_share(ws, in, ldsl, l, C.vcu, C.G); __syncthreads();
#if defined(CV_MODE)
                    convert_share_probe(ws, in, ldsl, l, C.vcu, C.G); __syncthreads();
#endif
                } }
#endif
#endif
            SEAM_L(pb + 3);
        }
        if ((PHM & (1 << 6)) && IN(pb + 4)) {
            pg8::Gemm g{(const pg8::bf16_t*)YCAT, (const pg8::bf16_t*)(ws + WS_WOUT) + (size_t)l * 1024 * 1024, 1024, 0, 0, nullptr, 0, nullptr}; pg8::Sched S; S.init(NTOK / 256, 4, 1, C.G, (int)blockIdx.x);
            pg8::EpiResidXB E{(const pg8::bf16_t*)XB, (pg8::bf16_t*)XB, (float*)(ws + WS_PART), 1024};
            pg8::gemm_phase<pg8::EpiResidXB, RES_ALIGN, false>(ldsl + RING_OFF, g, S, E);
            SEAM_L(pb + 4);
        }
        if ((PHM & (1 << 8)) && IN(pb + 5)) {
            pg8::Gemm g{(const pg8::bf16_t*)XB, (const pg8::bf16_t*)(ws + WS_WCAQ) + (size_t)l * 512 * 1024, 1024, 0, 0, nullptr, 0, nullptr}; pg8::Sched S; S.init(NTOK / 256, 2, 1, C.G, (int)blockIdx.x);
            pg8::EpiBf16R E{(pg8::bf16_t*)QCA, 512, attn_body::CA_C2, (const float*)(ws + WS_PART), EPS};
            REPEAT(REP_H) pg8::gemm_phase<pg8::EpiBf16R, true, false>(ldsl + RING_OFF, g, S, E);
            VM_WAIT(); __syncthreads();
            { pg8::Unit u;
              for (int rep_ = 0; rep_ < REP_I; ++rep_)
              for (int i = 0; S.next(i, u); ++i) { const int b = u.pm >> 4, qt = u.pm & 15;
                  for (int hh = 0; hh < 2; ++hh)
                      attn_body::ca_tiles<1>(b, 2 * u.pn + hh, qt, (const attn_body::bf16*)QCA, (const attn_body::bf16*)(ws + WS_KVCA) + (size_t)l * 2048 * 1024, (attn_body::bf16*)(rep_ + 1 < REP_I ? ACT : QCA), (char*)lds + RING_OFF, (float*)(lds + XTRA_OFF)); } }
            SEAM_L(pb + 5);
        }
        if ((PHM & (1 << 10)) && IN(pb + 6)) {
            pg8::Gemm g{(const pg8::bf16_t*)QCA, (const pg8::bf16_t*)(ws + WS_WCAO) + (size_t)l * 1024 * 512, 512, 0, 0, nullptr, 0, nullptr}; pg8::Sched S; S.init(NTOK / 256, 4, 1, C.G, (int)blockIdx.x);
            REPEAT(REP_J - 1) { pg8::EpiResidB E2{(const pg8::bf16_t*)XB, (pg8::bf16_t*)ACT, 1024}; pg8::gemm_phase<pg8::EpiResidB, true, false>(ldsl + RING_OFF, g, S, E2); }
            pg8::EpiResidB E{(const pg8::bf16_t*)XB, (pg8::bf16_t*)XB, 1024};
            pg8::gemm_phase<pg8::EpiResidB, RES_ALIGN, false>(ldsl + RING_OFF, g, S, E);
            SEAM_L(pb + 6);
        }
        if ((PHM & (1 << 11)) && IN(pb + 7)) { REPEAT(REP_K) router_phase(C, XB, in[I_NFFNG] + l * 1024, in[I_ROUTER] + (size_t)l * 1024 * 16, AFF, RSTD3); SEAM_L(pb + 7); }
        if ((PHM & (1 << 12)) && IN(pb + 8)) { REPEAT(REP_L) topk_phase(C); SEAM(pb + 8); }
        if ((PHM & (1 << 13)) && IN(pb + 9)) {
            pg8::Gemm g{(const pg8::bf16_t*)XB, (const pg8::bf16_t*)(ws + WS_WGU) + (size_t)l * 16 * 4096 * 1024, 1024, 0, 4096L * 1024, TOKI, ROWS_E, (const LAS unsigned short*)(ldsl + XTRA_OFF)}; pg8::Sched S; if (MN_LOCAL && mnloc) S.init(2, 16, NEXP, C.GB, C.lb, 2 * C.grp); else S.init(ROWS_E / 256, 16, NEXP, C.G, (int)blockIdx.x);
            pg8::gather_table((LAS unsigned short*)(ldsl + XTRA_OFF), TOKI, ROWS_E, S, GU_MAXU, (LAS float*)(ldsl + XTRA_OFF + GU_MAXU * 512), RSTDS);
            pg8::EpiSwiGLU E{(pg8::bf16_t*)ACT, FFE, ROWS_E, (const LAS float*)(ldsl + XTRA_OFF + GU_MAXU * 512)};
            REPEAT(REP_M) pg8::gemm_phase<pg8::EpiSwiGLU, true, true>(ldsl + RING_OFF, g, S, E);
            if (MN_LOCAL && mnloc) SEAM_L(pb + 9); else SEAM(pb + 9);
        }
        if ((PHM & (1 << 14)) && IN(pb + 10)) {
            pg8::Gemm g{(const pg8::bf16_t*)ACT, (const pg8::bf16_t*)(ws + WS_WDN) + (size_t)l * 16 * 1024 * 2048, 2048, (long)ROWS_E * FFE, 1024L * 2048, nullptr, 0, nullptr}; pg8::Sched S; if (MN_LOCAL && mnloc) S.init(2, 4, NEXP, C.GB, C.lb, 2 * C.grp); else S.init(ROWS_E / 256, 4, NEXP, C.G, (int)blockIdx.x);
            pg8::row_table((LAS float*)(ldsl + XTRA_OFF), GATEV, ROWS_E, S, GU_MAXU);
            pg8::EpiDown E{(pg8::bf16_t*)YS, 1024, ROWS_E, (const LAS float*)(ldsl + XTRA_OFF)};
            REPEAT(REP_N) pg8::gemm_phase<pg8::EpiDown, true, false>(ldsl + RING_OFF, g, S, E);
            if (MN_LOCAL && mnloc) SEAM_L(pb + 10); else SEAM(pb + 10);
        }
        if ((PHM & (1 << 15)) && IN(pb + 11)) {
            if (l + 1 < DEPTH) { REPEAT(REP_O - 1) row_phase<1, true>(C, XB, (bf16*)ACT, in[I_NMIXG] + (l + 1) * 1024, RSTD1, in[I_WIN] + (size_t)(l + 1) * 1024 * 2064 + 1280, 2064, in[I_GATEB] + (l + 1) * 16, GATES, nullptr, SLOTMAP, YS);
              row_phase<1, true>(C, XB, XB, in[I_NMIXG] + (l + 1) * 1024, RSTD1, in[I_WIN] + (size_t)(l + 1) * 1024 * 2064 + 1280, 2064, in[I_GATEB] + (l + 1) * 16, GATES, nullptr, SLOTMAP, YS); SEAM_L(pb + 11); }
            else row_phase<3, true>(C, XB, XB, in[I_FNG], nullptr, nullptr, 0, nullptr, nullptr, args.out, SLOTMAP, YS);
        }
    }
#if defined(PROBE_TAIL)
    if (IN(N_PHASES - 1)) {
        __syncthreads();
        const int l = DEPTH - 1;
        for (int rep_ = 0; rep_ < PROBE_N; ++rep_) {
#if PROBE_TAIL == 1
            pg8::Gemm g{(const pg8::bf16_t*)XB, (const pg8::bf16_t*)(ws + WS_WIN) + (size_t)l * 2048 * 1024, 1024, 0, 0, nullptr, 0, nullptr}; pg8::Sched S; S.init(NTOK / 256, NPROJ / 256, 1, C.G, (int)blockIdx.x);
            pg8::EpiBf16 E{(pg8::bf16_t*)PROJ, NPROJ, 0, 1.0f};
            pg8::gemm_phase<pg8::EpiBf16, true, false>(ldsl + RING_OFF, g, S, E);
#elif PROBE_TAIL == 2
            pg8::Gemm g{(const pg8::bf16_t*)YCAT, (const pg8::bf16_t*)(ws + WS_WOUT) + (size_t)l * 1024 * 1024, 1024, 0, 0, nullptr, 0, nullptr}; pg8::Sched S; S.init(NTOK / 256, 4, 1, C.G, (int)blockIdx.x);
            pg8::EpiResidB E{(const pg8::bf16_t*)XB, (pg8::bf16_t*)PROJ, 1024};
            pg8::gemm_phase<pg8::EpiResidB, false, false>(ldsl + RING_OFF, g, S, E);
#elif PROBE_TAIL == 3
            pg8::Gemm g{(const pg8::bf16_t*)XB, (const pg8::bf16_t*)(ws + WS_WGU) + (size_t)l * 16 * 4096 * 1024, 1024, 0, 4096L * 1024, TOKI, ROWS_E, (const LAS unsigned short*)(ldsl + XTRA_OFF)}; pg8::Sched S; S.init(ROWS_E / 256, 16, NEXP, C.G, (int)blockIdx.x);
            pg8::gather_table((LAS unsigned short*)(ldsl + XTRA_OFF), TOKI, ROWS_E, S, GU_MAXU, (LAS float*)(ldsl + XTRA_OFF + GU_MAXU * 512), RSTDS);
            pg8::EpiSwiGLU E{(pg8::bf16_t*)ACT, FFE, ROWS_E, (const LAS float*)(ldsl + XTRA_OFF + GU_MAXU * 512)};
            pg8::gemm_phase<pg8::EpiSwiGLU, true, true>(ldsl + RING_OFF, g, S, E);
#elif PROBE_TAIL == 4
            pg8::Gemm g{(const pg8::bf16_t*)ACT, (const pg8::bf16_t*)(ws + WS_WDN) + (size_t)l * 16 * 1024 * 2048, 2048, (long)ROWS_E * FFE, 1024L * 2048, nullptr, 0, nullptr}; pg8::Sched S; S.init(ROWS_E / 256, 4, NEXP, C.G, (int)blockIdx.x);
            pg8::row_table((LAS float*)(ldsl + XTRA_OFF), GATEV, ROWS_E, S, GU_MAXU);
            pg8::EpiDown E{(pg8::bf16_t*)YS, 1024, ROWS_E, (const LAS float*)(ldsl + XTRA_OFF)};
            pg8::gemm_phase<pg8::EpiDown, true, false>(ldsl + RING_OFF, g, S, E);
#elif PROBE_TAIL == 6
            pg8::Gemm g{(const pg8::bf16_t*)YCAT, (const pg8::bf16_t*)(ws + WS_WOUT) + (size_t)l * 1024 * 1024, 1024, 0, 0, nullptr, 0, nullptr}; pg8::Sched S; S.init(NTOK / 256, 4, 1, C.G, (int)blockIdx.x);
            pg8::EpiBf16 E{(pg8::bf16_t*)PROJ, 1024, 0, 1.0f};
            pg8::gemm_phase<pg8::EpiBf16, true, false>(ldsl + RING_OFF, g, S, E);
#elif PROBE_TAIL == 5
            pg8::Gemm g{(const pg8::bf16_t*)QCA, (const pg8::bf16_t*)(ws + WS_WCAO) + (size_t)l * 1024 * 512, 512, 0, 0, nullptr, 0, nullptr}; pg8::Sched S; S.init(NTOK / 256, 4, 1, C.G, (int)blockIdx.x);
            pg8::EpiResidB E{(const pg8::bf16_t*)XB, (pg8::bf16_t*)PROJ, 1024};
            pg8::gemm_phase<pg8::EpiResidB, false, false>(ldsl + RING_OFF, g, S, E);
#endif
            __syncthreads();
        }
    }
#endif
#undef IN
#undef SEAM
#undef HN
#undef PROJ
#undef YCAT
#undef QCA
#undef X
#undef GATES
#undef AFF
#undef TOKI
#undef GATEV
#undef SLOTMAP
#undef ACT
#undef YS
}

extern "C" void kernel_launch(void* const* d_in, const int* in_sizes, int n_in, void* d_out, int out_size, void* d_ws, size_t ws_size, hipStream_t stream) {
    static int grid = 0;
    if (grid == 0) {
        if (n_in != N_IN || in_sizes[0] != NTOK * DMODEL || out_size != NTOK * DMODEL || ws_size < WS_END) { fprintf(stderr, "kernel_launch: unexpected shapes (n_in %d, in0 %d, out %d, ws %zu); nothing launched\n", n_in, n_in > 0 ? in_sizes[0] : -1, out_size, ws_size); grid = -1; return; }
        int dev = 0, cus = 0, per_cu = 0;
        if (hipGetDevice(&dev) != hipSuccess || hipDeviceGetAttribute(&cus, hipDeviceAttributeMultiprocessorCount, dev) != hipSuccess) { grid = -1; return; }
        if (hipFuncSetAttribute((const void*)mk_fwd, hipFuncAttributeMaxDynamicSharedMemorySize, LDS_BYTES) != hipSuccess) { fprintf(stderr, "kernel_launch: hipFuncSetAttribute failed\n"); grid = -1; return; }
        if (hipOccupancyMaxActiveBlocksPerMultiprocessor(&per_cu, (const void*)mk_fwd, NWAVES * 64, LDS_BYTES) != hipSuccess || per_cu < 1) fprintf(stderr, "kernel_launch: occupancy query reports %d workgroups per CU\n", per_cu);
        (void)hipGetLastError();
        if (cus < 256) { fprintf(stderr, "kernel_launch: built for a 256-CU device (the attention and expert phases deal one unit group per workgroup); found %d CUs; nothing launched\n", cus); grid = -1; return; }
        grid = cus;
    }
    if (grid < 0) return;
    if (hipMemsetAsync((char*)d_ws + WS_CTL, 0, CTL_ZERO_BYTES, stream) != hipSuccess) { fprintf(stderr, "kernel_launch: memset failed\n"); return; }
    Args a{};
    for (int i = 0; i < N_IN; ++i) a.in[i] = (const float*)d_in[i];
    a.out = (float*)d_out; a.ws = (unsigned char*)d_ws;
#if MK_ONE_LAUNCH
    a.ph_lo = 0; a.ph_hi = N_PHASES;
    hipLaunchKernelGGL(mk_fwd, dim3(grid), dim3(NWAVES * 64), LDS_BYTES, stream, a);
#else
    for (int p = 0; p < N_PHASES; ++p) { a.ph_lo = p; a.ph_hi = p + 1; hipLaunchKernelGGL(mk_fwd, dim3(grid), dim3(NWAVES * 64), LDS_BYTES, stream, a); }
#endif
    const hipError_t le = hipPeekAtLastError();
    if (le != hipSuccess) fprintf(stderr, "kernel_launch: launch failed: %s\n", hipGetErrorName(le));
}
```
